# Optimizing an MI355X kernel written in HIP

```python
import jax
import jax.numpy as jnp
from jax import lax
import numpy as np

D_MODEL = 1024
BATCH = 16
SEQ = 4096
DEPTH = 1

MEM_LEN = 256
NORM_EPS = 1e-6

MLA_HEADS = 8
MLA_NOPE_DIM = 64
MLA_ROPE_DIM = 32
MLA_QK_DIM = MLA_NOPE_DIM + MLA_ROPE_DIM
MLA_V_DIM = 64
MLA_Q_RANK = 192
MLA_KV_RANK = 128
ROPE_BASE = 10000.0
Q_BLOCK = 128

HG_HEADS = 4
HG_KEY_DIM = 128
HG_VAL_DIM = 128
HG_CHUNK = 64

MLA_WIDTH = MLA_HEADS * MLA_V_DIM
HG_FWIDTH = HG_HEADS * HG_KEY_DIM
HG_WIDTH = HG_HEADS * HG_VAL_DIM
MIX_WIDTH = MLA_WIDTH + HG_WIDTH
IN_SIZES = (MLA_Q_RANK, MLA_KV_RANK, MLA_ROPE_DIM, HG_FWIDTH, HG_FWIDTH, HG_FWIDTH, HG_WIDTH, HG_WIDTH)
IN_WIDTH = sum(IN_SIZES)

X_HEADS = 4
X_HEAD_DIM = D_MODEL // X_HEADS

MOE_GROUPS = 8
MOE_PER_GROUP = 8
MOE_EXPERTS = MOE_GROUPS * MOE_PER_GROUP
MOE_TOP_K = 2
MOE_HIDDEN = 256
MOE_BLOCK = 128

kernel_name = 'hybrid_mla_hgrn2_hmoe_encoder_layer'


def rms_norm(x, w):
    xf = x.astype(jnp.float32)
    y = xf * lax.rsqrt(jnp.mean(xf * xf, axis=-1, keepdims=True) + NORM_EPS)
    return (y * w.astype(jnp.float32)).astype(x.dtype)


def split_columns(p):
    out, start = [], 0
    for size in IN_SIZES:
        out.append(p[..., start:start + size])
        start += size
    return out


def rope_tables(positions):
    half = MLA_ROPE_DIM // 2
    inv_freq = 1.0 / (ROPE_BASE ** (jnp.arange(half, dtype=jnp.float32) / half))
    ang = positions.astype(jnp.float32)[..., None] * inv_freq
    return jnp.cos(ang)[:, :, None, :], jnp.sin(ang)[:, :, None, :]


def apply_rope(x, cos, sin):
    x1, x2 = jnp.split(x.astype(jnp.float32), 2, axis=-1)
    return jnp.concatenate([x1 * cos - x2 * sin, x2 * cos + x1 * sin], axis=-1).astype(x.dtype)


def blocked_attention(q, k, v, scale):
    B, S, H, Dq = q.shape
    nb = S // Q_BLOCK
    qb = q.reshape(B, nb, Q_BLOCK, H, Dq).transpose(1, 0, 2, 3, 4)

    def one_block(qblk):
        s = jnp.einsum('bqhd,bkhd->bhqk', qblk, k).astype(jnp.float32) * scale
        p = jax.nn.softmax(s, axis=-1).astype(v.dtype)
        return jnp.einsum('bhqk,bkhd->bqhd', p, v)

    o = lax.map(one_block, qb)
    return o.transpose(1, 0, 2, 3, 4).reshape(B, S, H, v.shape[-1])


def mla_mixer(c_q, c_kv, k_rope, cos, sin, q_a_norm, w_q_up, kv_a_norm, w_kv_up, q_norm, k_norm):
    B, S, _ = c_q.shape
    q = (rms_norm(c_q, q_a_norm) @ w_q_up).reshape(B, S, MLA_HEADS, MLA_QK_DIM)
    kv = (rms_norm(c_kv, kv_a_norm) @ w_kv_up).reshape(B, S, MLA_HEADS, MLA_NOPE_DIM + MLA_V_DIM)
    k_nope, v = kv[..., :MLA_NOPE_DIM], kv[..., MLA_NOPE_DIM:]
    k_r = jnp.broadcast_to(k_rope[:, :, None, :], (B, S, MLA_HEADS, MLA_ROPE_DIM))
    k = jnp.concatenate([k_nope, k_r], axis=-1)
    q = rms_norm(q, q_norm)
    k = rms_norm(k, k_norm)
    q = jnp.concatenate([q[..., :MLA_NOPE_DIM], apply_rope(q[..., MLA_NOPE_DIM:], cos, sin)], axis=-1)
    k = jnp.concatenate([k[..., :MLA_NOPE_DIM], apply_rope(k[..., MLA_NOPE_DIM:], cos, sin)], axis=-1)
    o = blocked_attention(q, k, v, MLA_QK_DIM ** -0.5)
    return o.reshape(B, S, MLA_WIDTH)


def gla_chunk_scan(q, k, g, v):
    B, S, H, DK = q.shape
    DV = v.shape[-1]
    n = S // HG_CHUNK

    def to_chunks(t):
        return t.astype(jnp.float32).reshape(B, n, HG_CHUNK, H, t.shape[-1]).transpose(1, 0, 3, 2, 4)

    qc, kc, gc, vc = to_chunks(q), to_chunks(k), to_chunks(g), to_chunks(v)
    mask = jnp.tril(jnp.ones((HG_CHUNK, HG_CHUNK), dtype=bool))

    def step(state, inp):
        qi, ki, gi, vi = inp
        b = jnp.cumsum(gi, axis=2)
        o_inter = jnp.einsum('bhtd,bhdv->bhtv', qi * jnp.exp(b), state)
        diff = b[:, :, :, None, :] - b[:, :, None, :, :]
        decay = jnp.exp(jnp.where(mask[:, :, None], diff, -jnp.inf))
        attn = jnp.einsum('bhtd,bhsd,bhtsd->bhts', qi, ki, decay)
        o_intra = jnp.einsum('bhts,bhsv->bhtv', attn, vi)
        b_last = b[:, :, -1:, :]
        new_state = jnp.exp(b_last[:, :, 0, :])[..., None] * state + jnp.einsum(
            'bhsd,bhsv->bhdv', ki * jnp.exp(b_last - b), vi)
        return new_state, o_inter + o_intra

    s0 = jnp.zeros((B, H, DK, DV), jnp.float32)
    _, o = lax.scan(step, s0, (qc, kc, gc, vc))
    return o.transpose(1, 0, 3, 2, 4).reshape(B, S, H, DV)


def hgrn2_mixer(hq, hf_fwd, hf_bwd, hi, hg, lb, o_norm):
    B, S, _ = hq.shape
    q = jax.nn.silu(hq).reshape(B, S, HG_HEADS, HG_KEY_DIM)
    i = hi.reshape(B, S, HG_HEADS, HG_VAL_DIM)

    def direction(f_pre, lb_dir, reverse):
        z = f_pre.astype(jnp.float32)
        log_f = jnp.logaddexp(jnp.log(lb_dir), jnp.log1p(-lb_dir) + jax.nn.log_sigmoid(z))
        log_f = log_f.reshape(B, S, HG_HEADS, HG_KEY_DIM)
        k = -jnp.expm1(log_f)
        args = (q, k, log_f, i)
        if reverse:
            args = tuple(jnp.flip(a, axis=1) for a in args)
        o = gla_chunk_scan(*args)
        return jnp.flip(o, axis=1) if reverse else o

    o = direction(hf_fwd, lb[0], False) + direction(hf_bwd, lb[1], True)
    o = rms_norm(o, o_norm).astype(hq.dtype) * jax.nn.silu(hg.reshape(B, S, HG_HEADS, HG_VAL_DIM))
    return o.reshape(B, S, HG_WIDTH)


def cross_attention(h, m, w_q, w_kv, q_norm, k_norm, w_o):
    B, S, D = h.shape
    M = m.shape[1]
    q = rms_norm((h @ w_q).reshape(B, S, X_HEADS, X_HEAD_DIM), q_norm)
    kv = (m @ w_kv).reshape(B, M, 2, X_HEADS, X_HEAD_DIM)
    k = rms_norm(kv[:, :, 0], k_norm)
    v = kv[:, :, 1]
    s = jnp.einsum('bqhd,bkhd->bhqk', q, k).astype(jnp.float32) * (X_HEAD_DIM ** -0.5)
    p = jax.nn.softmax(s, axis=-1).astype(v.dtype)
    o = jnp.einsum('bhqk,bkhd->bqhd', p, v).reshape(B, S, X_HEADS * X_HEAD_DIM)
    return o @ w_o


def dropless_experts(t, expert_id, weight, w_gate, w_up, w_down):
    T, D = t.shape
    A = T * MOE_TOP_K
    e_flat = expert_id.reshape(A)
    w_flat = weight.reshape(A)
    tok_flat = jnp.arange(A, dtype=jnp.int32) // MOE_TOP_K
    order = jnp.argsort(e_flat)
    e_sorted, tok_sorted, w_sorted = e_flat[order], tok_flat[order], w_flat[order]
    counts = jnp.bincount(e_flat, length=MOE_EXPERTS)
    padded = (counts + MOE_BLOCK - 1) // MOE_BLOCK * MOE_BLOCK
    start = jnp.cumsum(counts) - counts
    pend = jnp.cumsum(padded)
    pstart = pend - padded
    dest = pstart[e_sorted] + jnp.arange(A, dtype=jnp.int32) - start[e_sorted]
    n_blocks = -(-A // MOE_BLOCK) + MOE_EXPERTS
    rows = jnp.zeros((n_blocks * MOE_BLOCK, D), t.dtype).at[dest].set(t[tok_sorted])
    block_e = jnp.searchsorted(pend, jnp.arange(n_blocks, dtype=jnp.int32) * MOE_BLOCK, side='right')
    block_e = jnp.minimum(block_e, MOE_EXPERTS - 1)

    def expert_block(args):
        xb, e = args
        hb = jax.nn.silu(xb @ w_gate[e]) * (xb @ w_up[e])
        return hb @ w_down[e]

    out = lax.map(expert_block, (rows.reshape(n_blocks, MOE_BLOCK, D), block_e)).reshape(-1, D)
    contrib = out[dest] * w_sorted[:, None].astype(out.dtype)
    return jnp.zeros((T, D), out.dtype).at[tok_sorted].add(contrib)


def hier_moe(h, w_group, b_group, w_expert, b_expert, w_gate, w_up, w_down):
    B, S, D = h.shape
    t = h.reshape(B * S, D)
    g_logits = (t @ w_group).astype(jnp.float32) + b_group.astype(jnp.float32)
    g_prob = jax.nn.softmax(g_logits, axis=-1)
    g_sel = jnp.argmax(g_logits, axis=-1).astype(jnp.int32)
    g_weight = jnp.take_along_axis(g_prob, g_sel[:, None], axis=-1)
    e_logits = ((t @ w_expert).astype(jnp.float32) + b_expert.astype(jnp.float32)).reshape(
        -1, MOE_GROUPS, MOE_PER_GROUP)
    e_logits = jnp.take_along_axis(e_logits, g_sel[:, None, None], axis=1)[:, 0]
    top_logit, top_local = lax.top_k(e_logits, MOE_TOP_K)
    top_w = jax.nn.softmax(top_logit, axis=-1) * g_weight
    expert_id = g_sel[:, None] * MOE_PER_GROUP + top_local.astype(jnp.int32)
    y = dropless_experts(t, expert_id, top_w, w_gate, w_up, w_down)
    return y.reshape(B, S, D)


def setup_inputs(seed: int = 0) -> dict:
    key = jax.random.key(seed)
    keys = jax.random.split(key, 40)
    counter = [0]

    def nk():
        k = keys[counter[0]]
        counter[0] += 1
        return k

    def nrm(shape, fan_in):
        return jax.random.normal(nk(), shape, jnp.float32) * (fan_in ** -0.5)

    def gain(shape):
        return 1.0 + 0.02 * jax.random.normal(nk(), shape, jnp.float32)

    L = DEPTH
    x = jax.random.normal(nk(), (BATCH, SEQ, D_MODEL), jnp.float32)
    mem = jax.random.normal(nk(), (BATCH, MEM_LEN, D_MODEL), jnp.float32)
    positions = jnp.arange(SEQ, dtype=jnp.int32)[None, :] + jax.random.randint(
        nk(), (BATCH, 1), 0, SEQ, dtype=jnp.int32)
    return {
        'x': x,
        'mem': mem,
        'positions': positions,
        'norm_mix': gain((L, D_MODEL)),
        'w_in': nrm((L, D_MODEL, IN_WIDTH), D_MODEL),
        'mla_q_a_norm': gain((L, MLA_Q_RANK)),
        'mla_w_q_up': nrm((L, MLA_Q_RANK, MLA_HEADS * MLA_QK_DIM), MLA_Q_RANK),
        'mla_kv_a_norm': gain((L, MLA_KV_RANK)),
        'mla_w_kv_up': nrm((L, MLA_KV_RANK, MLA_HEADS * (MLA_NOPE_DIM + MLA_V_DIM)), MLA_KV_RANK),
        'mla_q_norm': gain((L, MLA_QK_DIM)),
        'mla_k_norm': gain((L, MLA_QK_DIM)),
        'hg_lb_logits': 0.1 * jax.random.normal(nk(), (L + 1, 2, HG_FWIDTH), jnp.float32),
        'hg_o_norm': gain((L, HG_VAL_DIM)),
        'w_out': nrm((L, MIX_WIDTH, D_MODEL), MIX_WIDTH),
        'norm_cross': gain((L, D_MODEL)),
        'norm_mem': gain((L, D_MODEL)),
        'x_w_q': nrm((L, D_MODEL, X_HEADS * X_HEAD_DIM), D_MODEL),
        'x_w_kv': nrm((L, D_MODEL, 2 * X_HEADS * X_HEAD_DIM), D_MODEL),
        'x_q_norm': gain((L, X_HEAD_DIM)),
        'x_k_norm': gain((L, X_HEAD_DIM)),
        'x_w_o': nrm((L, X_HEADS * X_HEAD_DIM, D_MODEL), X_HEADS * X_HEAD_DIM),
        'norm_ffn': gain((L, D_MODEL)),
        'moe_w_group': nrm((L, D_MODEL, MOE_GROUPS), D_MODEL),
        'moe_b_group': 0.01 * jax.random.normal(nk(), (L, MOE_GROUPS), jnp.float32),
        'moe_w_expert': nrm((L, D_MODEL, MOE_EXPERTS), D_MODEL),
        'moe_b_expert': 0.01 * jax.random.normal(nk(), (L, MOE_EXPERTS), jnp.float32),
        'moe_w_gate': nrm((L, MOE_EXPERTS, D_MODEL, MOE_HIDDEN), D_MODEL),
        'moe_w_up': nrm((L, MOE_EXPERTS, D_MODEL, MOE_HIDDEN), D_MODEL),
        'moe_w_down': nrm((L, MOE_EXPERTS, MOE_HIDDEN, D_MODEL), MOE_HIDDEN),
    }


def reference(x, mem, positions, norm_mix, w_in, mla_q_a_norm, mla_w_q_up, mla_kv_a_norm, mla_w_kv_up,
              mla_q_norm, mla_k_norm, hg_lb_logits, hg_o_norm, w_out, norm_cross, norm_mem, x_w_q, x_w_kv,
              x_q_norm, x_k_norm, x_w_o, norm_ffn, moe_w_group, moe_b_group, moe_w_expert, moe_b_expert,
              moe_w_gate, moe_w_up, moe_w_down):
    cos, sin = rope_tables(positions)
    lb_table = jnp.cumsum(jax.nn.softmax(hg_lb_logits.astype(jnp.float32), axis=0), axis=0)
    for l in range(DEPTH):
        h = rms_norm(x, norm_mix[l])
        c_q, c_kv, k_rope, hq, hf_fwd, hf_bwd, hi, hg = split_columns(h @ w_in[l])
        a = mla_mixer(c_q, c_kv, k_rope, cos, sin, mla_q_a_norm[l], mla_w_q_up[l], mla_kv_a_norm[l],
                      mla_w_kv_up[l], mla_q_norm[l], mla_k_norm[l])
        r = hgrn2_mixer(hq, hf_fwd, hf_bwd, hi, hg, lb_table[l], hg_o_norm[l])
        x = x + jnp.concatenate([a, r], axis=-1) @ w_out[l]
        x = x + cross_attention(rms_norm(x, norm_cross[l]), rms_norm(mem, norm_mem[l]), x_w_q[l], x_w_kv[l],
                                x_q_norm[l], x_k_norm[l], x_w_o[l])
        x = x + hier_moe(rms_norm(x, norm_ffn[l]), moe_w_group[l], moe_b_group[l], moe_w_expert[l],
                         moe_b_expert[l], moe_w_gate[l], moe_w_up[l], moe_w_down[l])
    return x
```

```cpp
#include <hip/hip_runtime.h>
#include <cstdio>
#include <cstdint>
#include <cstring>
#include <cmath>
namespace pg8 {
#define PG8_LAS __attribute__((address_space(3)))
typedef unsigned short bf16_t;
typedef short bf16x8 __attribute__((ext_vector_type(8)));
typedef float f32x4 __attribute__((ext_vector_type(4)));
typedef float f32x2 __attribute__((ext_vector_type(2)));
typedef unsigned u32x4 __attribute__((ext_vector_type(4)));
constexpr int BM = 256, BK = 64, HALF = 128, HTB = HALF * BK * 2, STAGE_BYTES = 8 * HTB, NXCD = 8, WGM = 8;

__host__ __device__ __forceinline__ int lds_byte(int r, int c) { const int st = (r >> 4) * 2 + (c >> 5), rr = r & 15, cc = c & 31, ob = rr * 64 + cc * 2; return st * 1024 + (ob ^ (((ob >> 9) & 1) << 5)); }
__host__ __device__ __forceinline__ void stage_rc(int b, int& R, int& C) { const int st = b / 1024, sb = b % 1024, swz = sb ^ (((sb >> 9) & 1) << 5); R = (st >> 1) * 16 + swz / 64; C = (st & 1) * 32 + (swz % 64) / 2; }
__host__ __device__ __forceinline__ int perm32(int rho) { const int n = rho >> 4, i = rho & 15; return 8 * (i >> 2) + 4 * n + (i & 3); }

struct Unit { int pm, pn; const char* a; const char* b0; const char* b1; const int* rows; };

struct GridOrder {
    int nM, nN, nwg, G, c;
    __device__ void init(int nM_, int nN_, int G_, int c_) { nM = nM_; nN = nN_; nwg = nM * nN; G = G_; c = c_; }
    __device__ bool tile(int i, int& pm, int& pn) const {
        const long L = (long)i * G + c; if (L >= nwg) return false;
        int wgid = (int)L; { const int q = nwg / NXCD, r = nwg % NXCD, xcd = wgid % NXCD, off = wgid / NXCD; wgid = (xcd < r ? xcd * (q + 1) : r * (q + 1) + (xcd - r) * q) + off; }
        const int nig = WGM * nN, gid = wgid / nig, fm = gid * WGM, gsz = (nM - fm) < WGM ? (nM - fm) : WGM;
        pm = fm + ((wgid % nig) % gsz); pn = (wgid % nig) / gsz; return true;
    }
};

__device__ __forceinline__ unsigned cvt_pk_bf16(float lo, float hi) { unsigned r; asm volatile("v_cvt_pk_bf16_f32 %0, %1, %2" : "=v"(r) : "v"(lo), "v"(hi)); return r; }
__device__ __forceinline__ float bf_lo(unsigned w) { return __uint_as_float(w << 16); }
__device__ __forceinline__ float bf_hi(unsigned w) { return __uint_as_float(w & 0xffff0000u); }

template <class Epi, class Sched, bool ALIGN_EPI, bool GATHER, int K, int lda, int ldb, int tsplit>
__device__ __forceinline__ void gemm_phase(PG8_LAS unsigned char* lds, const Sched S, const Epi E) {
    const int tid = threadIdx.x, wid = __builtin_amdgcn_readfirstlane(tid >> 6), lane = tid & 63, wr = wid >> 2, wc = wid & 3, fr = lane & 15, fq = lane >> 4;
    constexpr int nt = K / BK;
    unsigned voffA[2], voffB[2]; int RA[2], CA[2];
#pragma unroll
    for (int i = 0; i < 2; ++i) { int R, C; stage_rc(tid * 16 + i * 8192, R, C); const int Rb = (R & ~31) + perm32(R & 31);
        voffA[i] = (unsigned)(R * lda + C) * 2u; voffB[i] = (unsigned)(Rb * ldb + C) * 2u; RA[i] = R; CA[i] = C; }
    const size_t kstep = (size_t)(BK * 2);
    const size_t hstepA = (size_t)HALF * lda * 2, hstepB = (size_t)HALF * ldb * 2;
    const unsigned ldsw = (unsigned)wid * 1024u;
    const int aoff = lds_byte(wr * 64 + fr, fq * 8), boff = lds_byte(wc * 32 + fr, fq * 8);
#define PG8_SA(b, h) (((b) * 2 + (h)) * HTB)
#define PG8_SB(b, h) ((4 + (b) * 2 + (h)) * HTB)
#define PG8_STAGE(bufoff, gbase, voff) do { _Pragma("unroll") for (int _i = 0; _i < 2; ++_i) \
        __builtin_amdgcn_global_load_lds((const unsigned*)((const char*)(gbase) + (voff)[_i]), (PG8_LAS unsigned*)(lds + (bufoff) + ldsw + _i * 8192), 16, 0, 0); } while (0)
#define PG8_STAGE_A(bufoff, p, h, nx) do { if constexpr (GATHER) { unsigned _o[2]; _o[0] = (nx) ? nvA[h][0] : cvA[h][0]; _o[1] = (nx) ? nvA[h][1] : cvA[h][1]; PG8_STAGE(bufoff, p, _o); } \
        else { PG8_STAGE(bufoff, (p) + (h) * hstepA, voffA); } } while (0)
#define PG8_LDA(dst, b, h) do { _Pragma("unroll") for (int m = 0; m < 4; ++m) _Pragma("unroll") for (int k = 0; k < 2; ++k) dst[m][k] = *(const PG8_LAS bf16x8*)(lds + PG8_SA(b, h) + aoff + m * 2048 + k * 1024); } while (0)
#define PG8_LDB(dst, b, h) do { _Pragma("unroll") for (int n = 0; n < 2; ++n) _Pragma("unroll") for (int k = 0; k < 2; ++k) dst[n][k] = *(const PG8_LAS bf16x8*)(lds + PG8_SB(b, h) + boff + n * 2048 + k * 1024); } while (0)
#define PG8_MMA(ai, bj, At, Bt) do { __builtin_amdgcn_s_setprio(1); _Pragma("unroll") for (int m = 0; m < 4; ++m) _Pragma("unroll") for (int n = 0; n < 2; ++n) _Pragma("unroll") for (int k = 0; k < 2; ++k) \
        acc[ai][bj][m][n] = __builtin_amdgcn_mfma_f32_16x16x32_bf16(Bt[n][k], At[m][k], acc[ai][bj][m][n], 0, 0, 0); __builtin_amdgcn_s_setprio(0); } while (0)
#define PG8_WAIT_V(n) asm volatile("s_waitcnt vmcnt(" #n ")" ::: "memory")
#define PG8_WAIT_L(n) asm volatile("s_waitcnt lgkmcnt(" #n ")" ::: "memory")
#define PG8_BAR __builtin_amdgcn_s_barrier()
#define PG8_SCHED __builtin_amdgcn_sched_barrier(0)
#define PG8_GOFF(dst, u) do { if constexpr (GATHER) { _Pragma("unroll") for (int _h = 0; _h < 2; ++_h) _Pragma("unroll") for (int _i = 0; _i < 2; ++_i) { \
        int _r = (u).rows[_h * HALF + RA[_i]]; _r = _r < 0 ? 0 : _r; dst[_h][_i] = (unsigned)(_r * lda + CA[_i]) * 2u; } } } while (0)
    Unit cur, nxt; int ui = 0;
    if (!S.next(0, cur)) return;
    unsigned cvA[2][2] = {{0u, 0u}, {0u, 0u}}, nvA[2][2] = {{0u, 0u}, {0u, 0u}};
    PG8_GOFF(cvA, cur);
    f32x4 acc[2][2][4][2];
#pragma unroll
    for (int a = 0; a < 2; ++a)
#pragma unroll
        for (int b = 0; b < 2; ++b)
#pragma unroll
            for (int m = 0; m < 4; ++m)
#pragma unroll
                for (int n = 0; n < 2; ++n) acc[a][b][m][n] = (f32x4){0.f, 0.f, 0.f, 0.f};
    bf16x8 At[4][2], B0[2][2], B1[2][2];
    const char* cA = cur.a; const char* cB = cur.b0; const char* cB1 = cur.b1;
    E.prep(cur, 0);
    PG8_STAGE(PG8_SB(0, 0), cB, voffB); PG8_STAGE(PG8_SB(0, 1), cB + hstepB, voffB); PG8_STAGE_A(PG8_SA(0, 0), cA, 0, false); PG8_STAGE_A(PG8_SA(0, 1), cA, 1, false);
    if (wr == 1) PG8_BAR;
    PG8_WAIT_V(2); PG8_BAR;
    PG8_STAGE(PG8_SB(1, 0), cB + kstep, voffB); PG8_STAGE_A(PG8_SA(1, 0), cA + kstep, 0, false); PG8_STAGE(PG8_SB(1, 1), cB + hstepB + kstep, voffB);
    PG8_WAIT_V(6); PG8_BAR;
    for (;;) {
        const bool has_next = S.next(ui + 1, nxt);
        const char* nA = has_next ? nxt.a : cA; const char* nB = has_next ? nxt.b0 : cB;
        for (int t = 0; t < nt; t += 2) {
            const bool last = (t == nt - 2);
            const bool lnx = last && has_next;
            const char* a1 = cA + (size_t)(t + 1) * kstep;
            const char* a2 = last ? nA : cA + (size_t)(t + 2) * kstep;
            const char* b2 = last ? nB : ((t + 2) < tsplit ? cB + (size_t)(t + 2) * kstep : cB1 + (size_t)(t + 2 - tsplit) * kstep);
            const char* a3 = a2 + kstep; const char* b3 = b2 + kstep;
            if (lnx) { PG8_GOFF(nvA, nxt); }
            PG8_LDB(B0, 0, 0); PG8_LDB(B1, 0, 1); PG8_SCHED; PG8_LDA(At, 0, 0); PG8_STAGE_A(PG8_SA(1, 1), a1, 1, false);
            PG8_WAIT_V(8); PG8_WAIT_L(0); PG8_BAR; PG8_MMA(0, 0, At, B0); PG8_MMA(0, 1, At, B1); PG8_BAR; PG8_SCHED;
            PG8_LDA(At, 0, 1); PG8_STAGE(PG8_SB(0, 0), b2, voffB); PG8_STAGE(PG8_SB(0, 1), b2 + hstepB, voffB); PG8_STAGE_A(PG8_SA(0, 0), a2, 0, lnx);
            PG8_WAIT_V(8); PG8_WAIT_L(0); PG8_BAR; PG8_MMA(1, 0, At, B0); PG8_MMA(1, 1, At, B1); PG8_BAR; PG8_SCHED;
            PG8_LDB(B0, 1, 0); PG8_LDB(B1, 1, 1); PG8_SCHED; PG8_LDA(At, 1, 0); PG8_STAGE_A(PG8_SA(0, 1), a2, 1, lnx);
            PG8_WAIT_V(8); PG8_WAIT_L(0); PG8_BAR; PG8_MMA(0, 0, At, B0); PG8_MMA(0, 1, At, B1); PG8_BAR; PG8_SCHED;
            PG8_LDA(At, 1, 1); PG8_STAGE(PG8_SB(1, 0), b3, voffB); PG8_STAGE(PG8_SB(1, 1), b3 + hstepB, voffB); PG8_STAGE_A(PG8_SA(1, 0), a3, 0, lnx);
            PG8_WAIT_V(8); PG8_WAIT_L(0); PG8_BAR; PG8_MMA(1, 0, At, B0); PG8_MMA(1, 1, At, B1); PG8_BAR; PG8_SCHED;
        }
        if constexpr (ALIGN_EPI) { if (wr == 0) PG8_BAR; }
        E(acc, cur, ui & 1, wr, wc, fr, fq, wid, lane);
        if (!has_next) break;
        E.prep(nxt, (ui + 1) & 1);
#pragma unroll
        for (int a = 0; a < 2; ++a)
#pragma unroll
            for (int b = 0; b < 2; ++b)
#pragma unroll
                for (int m = 0; m < 4; ++m)
#pragma unroll
                    for (int n = 0; n < 2; ++n) acc[a][b][m][n] = (f32x4){0.f, 0.f, 0.f, 0.f};
        cur = nxt; cA = nA; cB = nB; cB1 = nxt.b1; ++ui;
        if constexpr (GATHER) {
#pragma unroll
            for (int h = 0; h < 2; ++h) { cvA[h][0] = nvA[h][0]; cvA[h][1] = nvA[h][1]; }
        }
        if constexpr (ALIGN_EPI) { if (wr == 1) PG8_BAR; }
    }
    PG8_WAIT_V(0);
    if constexpr (!ALIGN_EPI) { if (wr == 0) PG8_BAR; }
    PG8_BAR;
#undef PG8_SA
#undef PG8_SB
#undef PG8_STAGE
#undef PG8_STAGE_A
#undef PG8_LDA
#undef PG8_LDB
#undef PG8_MMA
#undef PG8_WAIT_V
#undef PG8_WAIT_L
#undef PG8_BAR
#undef PG8_SCHED
#undef PG8_GOFF
}
}
constexpr int NWAVES = 8;
constexpr int BATCH = 16, SEQ = 4096, D = 1024, T = BATCH * SEQ, MEML = 256;
constexpr float EPS = 1e-6f;
constexpr float LOG2E = 1.4426950408889634f;
constexpr size_t MiB = 1u << 20;
constexpr size_t WS_CTL = 0, CTL_ZERO_BYTES = 1 * MiB;
constexpr size_t WS_COS = 1 * MiB, WS_SIN = 5 * MiB;
constexpr size_t WS_SS0 = 9 * MiB;
constexpr size_t WS_SSP1 = 10 * MiB, WS_SSP2 = 14 * MiB;
constexpr size_t WS_MISC = 18 * MiB;
constexpr size_t WS_W = 20 * MiB;
constexpr size_t W_IN = WS_W, W_Q = W_IN + 6 * MiB, W_KV = W_Q + 512 * 1024, W_OUT = W_KV + 512 * 1024, W_XQ = W_OUT + 2 * MiB, W_XKV = W_XQ + 2 * MiB, W_XO = W_XKV + 4 * MiB, W_R = W_XO + 2 * MiB;
constexpr size_t WS_MN = 40 * MiB, WS_KVX = 48 * MiB;
constexpr size_t WS_XN = 64 * MiB;
constexpr size_t WS_OF = 64 * MiB, WS_OB = 128 * MiB;
constexpr size_t WS_HQ = 192 * MiB, WS_GF = 256 * MiB, WS_GB = 320 * MiB, WS_HI = 384 * MiB, WS_HG = 448 * MiB, WS_LAT = 512 * MiB;
constexpr size_t WS_CAT = 192 * MiB;
constexpr size_t WS_QX = 320 * MiB;
constexpr size_t WS_Q = 576 * MiB, WS_K = 672 * MiB, WS_V = 768 * MiB;
constexpr size_t WS_WGU = 576 * MiB, WS_WD = 640 * MiB;
constexpr size_t WS_H = 672 * MiB;
constexpr size_t WS_LG = 792 * MiB;
constexpr size_t WS_REC = 810 * MiB;
constexpr size_t WS_END = 832 * MiB;
constexpr int MOE_MAXROWS = 122880, MOE_MAXTILES = 480;
constexpr int CW_TMO = 0, CW_BAR = 4096, CW_CNT = 16384  , CW_NT = 17000  , CW_CHK = 20000  ;

constexpr int RING_OFF = 0, RING_BYTES = 131072;
constexpr int AUX_OFF = RING_BYTES;
constexpr int AUX_RS = AUX_OFF, AUX_WG = AUX_OFF + 2048, AUX_TOK = AUX_OFF + 4096, AUX_XP = AUX_OFF + 6144, AUX_WSF = AUX_OFF + 10240;
constexpr int MISC_OFF = AUX_OFF + 12288;
constexpr int LDS_BYTES = 147456;

#define GAS __attribute__((address_space(1)))
#define LAS __attribute__((address_space(3)))
typedef unsigned short bf16;
typedef unsigned v4u __attribute__((ext_vector_type(4)));
typedef unsigned v2u __attribute__((ext_vector_type(2)));
typedef float f32x4 __attribute__((ext_vector_type(4)));
typedef float f32x16 __attribute__((ext_vector_type(16)));
typedef short bf16x8 __attribute__((ext_vector_type(8)));
typedef short s16x4 __attribute__((ext_vector_type(4)));
typedef GAS unsigned gu32;
#define RLX_AGENT __ATOMIC_RELAXED, __HIP_MEMORY_SCOPE_AGENT
#define LDS_WAIT() asm volatile("s_waitcnt lgkmcnt(0)" ::: "memory")
#define VM_WAIT() asm volatile("s_waitcnt vmcnt(0)" ::: "memory")
__device__ __forceinline__ unsigned f2bf(float f) { unsigned u = __builtin_bit_cast(unsigned, f); return (u + 0x7fffu + ((u >> 16) & 1u)) >> 16; }
__device__ __forceinline__ unsigned pk2(float lo, float hi) { return pg8::cvt_pk_bf16(lo, hi); }
__device__ __forceinline__ float bf2f(bf16 h) { return __uint_as_float((unsigned)h << 16); }
__device__ __forceinline__ float fast_rcp(float x) { return __builtin_amdgcn_rcpf(x); }
__device__ __forceinline__ float fast_exp2(float x) { return __builtin_amdgcn_exp2f(x); }
__device__ __forceinline__ float silu_f(float v) { return v * fast_rcp(1.0f + fast_exp2(-LOG2E * v)); }
__device__ __forceinline__ float rsq(float x) { return __builtin_amdgcn_rsqf(x); }
typedef _Float16 h16x2 __attribute__((ext_vector_type(2)));
__device__ __forceinline__ unsigned pkh2(float lo, float hi) { h16x2 h; h.x = (_Float16)lo; h.y = (_Float16)hi; return __builtin_bit_cast(unsigned, h); }
__device__ __forceinline__ float h2f(unsigned short h) { return (float)__builtin_bit_cast(_Float16, h); }

#define XB_TMO      128
#define XB_XCNT(j)  (256  + 64 * (j))
#define XB_XSUB(j)  (1280 + 64 * (j))
#define XB_XGEN(j)  (2304 + 64 * (j))
#define XB_TOP      3328
#define XB_TOPGEN   3392
#define XCD_BAR_WORDS 3456
#define XB_SPIN_CAP (1u << 18)
__device__ __forceinline__ unsigned xb_ld(unsigned* p)              { return __hip_atomic_load(p, __ATOMIC_RELAXED, __HIP_MEMORY_SCOPE_AGENT); }
__device__ __forceinline__ unsigned xb_add(unsigned* p, unsigned v) { return __hip_atomic_fetch_add(p, v, __ATOMIC_RELAXED, __HIP_MEMORY_SCOPE_AGENT); }
__device__ __forceinline__ unsigned xb_xcc_id() { return (unsigned)__builtin_amdgcn_s_getreg((3 << 11) | 20) & 0xFu; }
#define XB_SPIN(cond, bar) do { unsigned _sp = 0; while (cond) { __builtin_amdgcn_s_sleep(1); \
    if ((++_sp & 255u) == 0u) { if (xb_ld(&(bar)[XB_TMO])) break; if (_sp > XB_SPIN_CAP) { atomicAdd(&(bar)[XB_TMO], 1u); break; } } } } while (0)
struct XcdBarrier { unsigned* bar; unsigned x; volatile LAS unsigned* st; };
__device__ __forceinline__ XcdBarrier xcd_barrier_post(unsigned* bar, volatile LAS unsigned* st) {
    XcdBarrier b; b.bar = bar; b.x = xb_xcc_id(); b.st = st;
    if (threadIdx.x == 0) (void)xb_add(&bar[XB_XCNT(b.x)], 1u);
    return b;
}
__device__ __forceinline__ void xcd_barrier_complete(unsigned* bar, unsigned x, unsigned& nloc, unsigned& nx) {
    const unsigned G = gridDim.x * gridDim.y * gridDim.z;
    unsigned sum, cnt, mine, sp = 0u;
    for (;;) {
        sum = 0u; cnt = 0u; mine = 0u;
#pragma unroll
        for (unsigned j = 0; j < 16; ++j) { const unsigned c = xb_ld(&bar[XB_XCNT(j)]); sum += c; cnt += (c > 0u) ? 1u : 0u; mine = (j == x) ? c : mine; }
        if (sum == G) break;
        __builtin_amdgcn_s_sleep(1);
        if ((++sp & 255u) == 0u) { if (xb_ld(&bar[XB_TMO])) break; if (sp > XB_SPIN_CAP) { atomicAdd(&bar[XB_TMO], 1u); break; } }
    }
    nloc = mine > 0u ? mine : 1u; nx = cnt > 0u ? cnt : 1u;
}
__device__ __forceinline__ void xcd_barrier(const XcdBarrier& b) {
    asm volatile("s_waitcnt vmcnt(0)" ::: "memory");
    __syncthreads();
    if (threadIdx.x == 0) {
        unsigned* bar = b.bar;
        __builtin_amdgcn_s_waitcnt(0);
        unsigned nloc = b.st[0], nx = b.st[1];
        if (nloc == 0u) { xcd_barrier_complete(bar, b.x, nloc, nx); b.st[0] = nloc; b.st[1] = nx; }
        const unsigned old = xb_add(&bar[XB_XSUB(b.x)], 1u);
        const unsigned gen = old / nloc;
        if (old + 1u == (gen + 1u) * nloc) {
            __builtin_amdgcn_fence(__ATOMIC_RELEASE, "agent");
            asm volatile("s_waitcnt vmcnt(0)" ::: "memory");
            const unsigned og = xb_add(&bar[XB_TOP], 1u);
            const unsigned tg = og / nx;
            if (og + 1u == (tg + 1u) * nx) xb_add(&bar[XB_TOPGEN], 1u);
            else XB_SPIN(xb_ld(&bar[XB_TOPGEN]) == tg, bar);
            __builtin_amdgcn_fence(__ATOMIC_ACQUIRE, "agent");
            xb_add(&bar[XB_XGEN(b.x)], 1u);
            asm volatile("s_waitcnt vmcnt(0)" ::: "memory");
        } else {
            XB_SPIN(xb_ld(&bar[XB_XGEN(b.x)]) == gen, bar);
            __builtin_amdgcn_fence(__ATOMIC_ACQUIRE, "agent");
            asm volatile("s_waitcnt vmcnt(0)" ::: "memory");
        }
    }
    __syncthreads();
}

struct Inputs {
    const float *x, *mem; const int* pos; const float *norm_mix, *w_in, *q_a_norm, *w_q_up, *kv_a_norm, *w_kv_up, *q_norm, *k_norm, *lb_logits, *o_norm, *w_out, *norm_cross, *norm_mem,
        *x_w_q, *x_w_kv, *x_q_norm, *x_k_norm, *x_w_o, *norm_ffn, *w_group, *b_group, *w_expert, *b_expert, *w_gate, *w_up, *w_down;
};
struct Frame {
    LAS unsigned char* lds;
    volatile LAS unsigned* MISC;
    gu32* ctl;
    unsigned char* ws;
    int tid, lane, wave, vcu, G;
};
__device__ __forceinline__ float wave_sum(float v) {
#pragma unroll
    for (int o = 1; o < 64; o <<= 1) v += __shfl_xor(v, o);
    return v;
}
__device__ __forceinline__ void p0_transpose_item(const float* W, int ldw, int k0, int n0, const float* gain, bf16* WT, int ldt, int row0, LAS float* scr, int lane) {
#pragma unroll 8
    for (int i = 0; i < 32; ++i) { const int kk = 2 * i + (lane >> 5); const float g = gain ? gain[k0 + kk] : 1.0f; scr[kk * 33 + (lane & 31)] = W[(size_t)(k0 + kk) * ldw + n0 + (lane & 31)] * g; }
    LDS_WAIT(); asm volatile("" ::: "memory");
    const int c = lane & 7;
#pragma unroll
    for (int j = 0; j < 4; ++j) { const int n = (lane >> 3) + 8 * j; const LAS float* s = scr + (8 * c) * 33 + n;
        v4u o; o.x = pk2(s[0 * 33], s[1 * 33]); o.y = pk2(s[2 * 33], s[3 * 33]); o.z = pk2(s[4 * 33], s[5 * 33]); o.w = pk2(s[6 * 33], s[7 * 33]);
        *(GAS v4u*)(WT + (size_t)(row0 + n) * ldt + k0 + 8 * c) = o; }
    LDS_WAIT(); asm volatile("" ::: "memory");
}
struct TJob { const float* W; int K, N, ldw; const float* gain; bf16* WT; int ldt; int mode; };
__device__ __forceinline__ int tjob_row(int mode, int n0) {
    if (mode == 1) return n0 >= 352 ? n0 - 352 : n0 + 2560;
    if (mode == 2) return (n0 >> 7) * 256 + (n0 & 127);
    if (mode == 3) return (n0 >> 7) * 256 + 128 + (n0 & 127);
    return n0;
}
__device__ __forceinline__ void tjob_run(const TJob& j, LAS float* scr, int gw, int NGW, int lane) {
    const int nblk = j.N / 32, nit = (j.K / 64) * nblk;
    for (int it = gw; it < nit; it += NGW) { const int kb = it / nblk, nb = it % nblk; p0_transpose_item(j.W, j.ldw, kb * 64, nb * 32, j.gain, j.WT, j.ldt, tjob_row(j.mode, nb * 32), scr, lane); }
}
__device__ __forceinline__ void p0_prologue(Frame& F, const Inputs& in) {
    LAS float* scr = (LAS float*)(F.lds + RING_OFF + F.wave * 16384);
    const int gw = F.vcu * NWAVES + F.wave, NGW = F.G * NWAVES, lane = F.lane;
    unsigned char* ws = F.ws;
    { TJob j{in.w_in, 1024, 2912, 2912, in.norm_mix, (bf16*)(ws + W_IN), 1024, 1}; tjob_run(j, scr, gw, NGW, lane); }
    { TJob j{in.w_q_up, 192, 768, 768, in.q_a_norm, (bf16*)(ws + W_Q), 192, 0}; tjob_run(j, scr, gw, NGW, lane); }
    { TJob j{in.w_kv_up, 128, 1024, 1024, in.kv_a_norm, (bf16*)(ws + W_KV), 128, 0}; tjob_run(j, scr, gw, NGW, lane); }
    { TJob j{in.w_out, 1024, 1024, 1024, nullptr, (bf16*)(ws + W_OUT), 1024, 0}; tjob_run(j, scr, gw, NGW, lane); }
    { TJob j{in.x_w_q, 1024, 1024, 1024, in.norm_cross, (bf16*)(ws + W_XQ), 1024, 0}; tjob_run(j, scr, gw, NGW, lane); }
    { TJob j{in.x_w_kv, 1024, 2048, 2048, nullptr, (bf16*)(ws + W_XKV), 1024, 0}; tjob_run(j, scr, gw, NGW, lane); }
    { TJob j{in.x_w_o, 1024, 1024, 1024, nullptr, (bf16*)(ws + W_XO), 1024, 0}; tjob_run(j, scr, gw, NGW, lane); }
    const int gt = (F.vcu * NWAVES + F.wave) * 64 + lane, NGT = NGW * 64;
    for (int i = gt; i < 160 * 1024 / 8; i += NGT) *(GAS v4u*)((bf16*)(ws + W_IN) + (size_t)2912 * 1024 + (size_t)i * 8) = (v4u){0u, 0u, 0u, 0u};
    for (int i = gt; i < 256 * 1024; i += NGT) { const int c = i >> 10, k = i & 1023; float v = 0.f;
        if (c < 8) v = in.w_group[k * 8 + c] * in.norm_ffn[k]; else if (c < 72) v = in.w_expert[k * 64 + (c - 8)] * in.norm_ffn[k];
        ((bf16*)(ws + W_R))[i] = (bf16)f2bf(v); }
    for (int i = gt; i < T * 16; i += NGT) { const int t = i >> 4, j = i & 15;
        const float inv_freq = 1.0f / powf(10000.0f, (float)j / 16.0f); const float ang = (float)in.pos[t] * inv_freq;
        const double rev = (double)ang * 0.15915494309189535; const float fr = (float)(rev - floor(rev));
        ((float*)(ws + WS_COS))[i] = __builtin_amdgcn_cosf(fr); ((float*)(ws + WS_SIN))[i] = __builtin_amdgcn_sinf(fr); }
    float* misc = (float*)(ws + WS_MISC);
    for (int i = gt; i < 1024; i += NGT) { const float l0 = in.lb_logits[i], l1 = in.lb_logits[1024 + i]; misc[i] = 1.0f / (1.0f + expf(l1 - l0)); }
    if (gw == 0) {
        float mq = 0.f, mk = 0.f, xq = 0.f, xk = 0.f;
        for (int i = lane; i < 96; i += 64) { mq = fmaxf(mq, fabsf(in.q_norm[i])); mk = fmaxf(mk, fabsf(in.k_norm[i])); }
        for (int i = lane; i < 256; i += 64) { xq = fmaxf(xq, fabsf(in.x_q_norm[i])); xk = fmaxf(xk, fabsf(in.x_k_norm[i])); }
#pragma unroll
        for (int o = 1; o < 64; o <<= 1) { mq = fmaxf(mq, __shfl_xor(mq, o)); mk = fmaxf(mk, __shfl_xor(mk, o)); xq = fmaxf(xq, __shfl_xor(xq, o)); xk = fmaxf(xk, __shfl_xor(xk, o)); }
        if (lane == 0) { misc[1024] = LOG2E * 9.797958971132712f * mq * mk; misc[1025] = LOG2E * 16.0f * xq * xk; }
    }
    for (int m = gw; m < T; m += NGW) {
        const GAS f32x4* xr = (const GAS f32x4*)(in.x + (size_t)m * D) + lane; f32x4 v[4]; float s = 0.f;
#pragma unroll
        for (int j = 0; j < 4; ++j) { v[j] = xr[64 * j]; s += (v[j].x * v[j].x + v[j].y * v[j].y) + (v[j].z * v[j].z + v[j].w * v[j].w); }
        s = wave_sum(s);
        GAS unsigned long long* o8 = (GAS unsigned long long*)((bf16*)(ws + WS_XN) + (size_t)m * D) + lane;
#pragma unroll
        for (int j = 0; j < 4; ++j) o8[64 * j] = (unsigned long long)pk2(v[j].x, v[j].y) | ((unsigned long long)pk2(v[j].z, v[j].w) << 32);
        if (lane == 0) ((float*)(ws + WS_SS0))[m] = s;
    }
    for (int m = gw; m < BATCH * MEML; m += NGW) {
        const GAS f32x4* xr = (const GAS f32x4*)(in.mem + (size_t)m * D) + lane; f32x4 v[4]; float s = 0.f;
#pragma unroll
        for (int j = 0; j < 4; ++j) { v[j] = xr[64 * j]; s += (v[j].x * v[j].x + v[j].y * v[j].y) + (v[j].z * v[j].z + v[j].w * v[j].w); }
        const float r = 1.0f / sqrtf(wave_sum(s) * (1.f / D) + EPS);
        GAS unsigned long long* o8 = (GAS unsigned long long*)((bf16*)(ws + WS_MN) + (size_t)m * D) + lane;
#pragma unroll
        for (int j = 0; j < 4; ++j) { const f32x4 g = *((const GAS f32x4*)in.norm_mem + lane + 64 * j);
            o8[64 * j] = (unsigned long long)pk2(v[j].x * r * g.x, v[j].y * r * g.y) | ((unsigned long long)pk2(v[j].z * r * g.z, v[j].w * r * g.w) << 32); }
    }
}
__device__ __forceinline__ void moe_weights(Frame& F, const Inputs& in) {
    LAS float* scr = (LAS float*)(F.lds + RING_OFF + F.wave * 16384);
    const int gw = F.vcu * NWAVES + F.wave, NGW = F.G * NWAVES, lane = F.lane;
    for (int it = gw; it < 64 * 384; it += NGW) {
        const int e = it / 384, r = it % 384, kind = r >> 7, q = r & 127;
        if (kind == 0) { const int kb = q >> 3, nb = q & 7; p0_transpose_item(in.w_gate + (size_t)e * 262144, 256, kb * 64, nb * 32, in.norm_ffn, (bf16*)(F.ws + WS_WGU) + (size_t)e * 524288, 1024, tjob_row(2, nb * 32), scr, lane); }
        else if (kind == 1) { const int kb = q >> 3, nb = q & 7; p0_transpose_item(in.w_up + (size_t)e * 262144, 256, kb * 64, nb * 32, in.norm_ffn, (bf16*)(F.ws + WS_WGU) + (size_t)e * 524288, 1024, tjob_row(3, nb * 32), scr, lane); }
        else { const int kb = q >> 5, nb = q & 31; p0_transpose_item(in.w_down + (size_t)e * 262144, 1024, kb * 64, nb * 32, nullptr, (bf16*)(F.ws + WS_WD) + (size_t)e * 262144, 256, nb * 32, scr, lane); }
    }
}

using pg8::Unit; using pg8::bf16_t;
struct SchedGrid {
    const char* A; const char* B; size_t astep, bstep; pg8::GridOrder o; int pad_;
    __device__ __forceinline__ bool next(int i, Unit& u) const { int pm, pn; if (!o.tile(i, pm, pn)) return false; u.pm = pm; u.pn = pn; u.a = A + (size_t)pm * astep; u.b0 = u.b1 = B + (size_t)pn * bstep; u.rows = nullptr; return true; }
};
__device__ __forceinline__ float rstd16(const float* p) {
    const f32x4 a = *(const f32x4*)p, b = *(const f32x4*)(p + 4), c = *(const f32x4*)(p + 8), d = *(const f32x4*)(p + 12);
    const float s = ((a.x + a.y) + (a.z + a.w)) + ((b.x + b.y) + (b.z + b.w)) + ((c.x + c.y) + (c.z + c.w)) + ((d.x + d.y) + (d.z + d.w));
    return 1.0f / sqrtf(s * (1.f / D) + EPS);
}
typedef pg8::f32x4 (AccT)[2][2][4][2];

struct EpiIn {
    bf16_t* bufs; const float* ss; const float* lbt; LAS float* RS; int pad_;
    __device__ __forceinline__ void prep(const Unit& u, int par) const { const int t = threadIdx.x; if (t < 256) RS[par * 256 + t] = 1.0f / sqrtf(ss[u.pm * 256 + t] * (1.f / D) + EPS); }
    __device__ __forceinline__ void operator()(const AccT& acc, const Unit& u, int par, int wr, int wc, int fr, int fq, int wid, int lane) const {
        const int grp = u.pn >> 1, colg = (u.pn & 1) * 256 + wc * 32 + 8 * fq;
        bf16_t* base = bufs + (size_t)grp * ((size_t)T * 512);
        const int mode = (grp == 0 || grp == 4) ? 1 : ((grp == 1 || grp == 2) ? 2 : 0);
        f32x4 lb[2][2];
#pragma unroll
        for (int bj = 0; bj < 2; ++bj)
#pragma unroll
            for (int n = 0; n < 2; ++n) lb[bj][n] = (mode == 2) ? *(const f32x4*)(lbt + (grp - 1) * 512 + colg + bj * 128 + 4 * n) : (f32x4){0.f, 0.f, 0.f, 0.f};
#pragma unroll
        for (int ai = 0; ai < 2; ++ai)
#pragma unroll
            for (int m = 0; m < 4; ++m) { const int rl = ai * 128 + wr * 64 + m * 16 + fr; const float rs = RS[par * 256 + rl]; bf16_t* rowp = base + (size_t)(u.pm * 256 + rl) * 512 + colg;
#pragma unroll
                for (int bj = 0; bj < 2; ++bj) { f32x4 v[2]; v[0] = acc[ai][bj][m][0] * rs; v[1] = acc[ai][bj][m][1] * rs; v4u w;
                    if (mode == 2) {
#pragma unroll
                        for (int n = 0; n < 2; ++n)
#pragma unroll
                            for (int e = 0; e < 4; ++e) { const float sg = fast_rcp(1.0f + fast_exp2(-LOG2E * v[n][e])); const float l = lb[bj][n][e]; v[n][e] = __builtin_amdgcn_logf(l + (1.0f - l) * sg) * 0.6931471805599453f; }
                        w.x = pkh2(v[0][0], v[0][1]); w.y = pkh2(v[0][2], v[0][3]); w.z = pkh2(v[1][0], v[1][1]); w.w = pkh2(v[1][2], v[1][3]);
                    } else {
                        if (mode == 1) {
#pragma unroll
                            for (int n = 0; n < 2; ++n)
#pragma unroll
                                for (int e = 0; e < 4; ++e) v[n][e] = silu_f(v[n][e]);
                        }
                        w.x = pk2(v[0][0], v[0][1]); w.y = pk2(v[0][2], v[0][3]); w.z = pk2(v[1][0], v[1][1]); w.w = pk2(v[1][2], v[1][3]);
                    }
                    *(v4u*)(rowp + bj * 128) = w; } }
    }
};
struct EpiRes {
    const float* resid; float* out; bf16_t* xn; float* ssp;
    __device__ __forceinline__ void prep(const Unit&, int) const {}
    __device__ __forceinline__ void operator()(const AccT& acc, const Unit& u, int par, int wr, int wc, int fr, int fq, int wid, int lane) const {
        const int col0 = u.pn * 256 + wc * 32 + 8 * fq;
#pragma unroll
        for (int ai = 0; ai < 2; ++ai)
#pragma unroll
            for (int m = 0; m < 4; ++m) { const size_t row = (size_t)(u.pm * 256 + ai * 128 + wr * 64 + m * 16 + fr); float sq = 0.f;
#pragma unroll
                for (int bj = 0; bj < 2; ++bj) { const size_t off = row * D + col0 + bj * 128;
                    const f32x4 o0 = *(const f32x4*)(resid + off) + acc[ai][bj][m][0], o1 = *(const f32x4*)(resid + off + 4) + acc[ai][bj][m][1];
                    *(f32x4*)(out + off) = o0; *(f32x4*)(out + off + 4) = o1;
                    v4u w; w.x = pk2(o0[0], o0[1]); w.y = pk2(o0[2], o0[3]); w.z = pk2(o1[0], o1[1]); w.w = pk2(o1[2], o1[3]); *(v4u*)(xn + off) = w;
                    sq += (o0[0] * o0[0] + o0[1] * o0[1]) + (o0[2] * o0[2] + o0[3] * o0[3]) + (o1[0] * o1[0] + o1[1] * o1[1]) + (o1[2] * o1[2] + o1[3] * o1[3]); }
                sq += __shfl_xor(sq, 16); sq += __shfl_xor(sq, 32);
                if (fq == 0) ssp[row * 16 + u.pn * 4 + wc] = sq; }
    }
};
struct EpiHeadNorm {
    const float* ssp; const float* gain; bf16_t* O; LAS float* RS; LAS float* XP; float gscale; int ldo; int nnorm; int pad_;
    __device__ __forceinline__ void prep(const Unit& u, int par) const { const int t = threadIdx.x; if (ssp && t < 256) RS[par * 256 + t] = rstd16(ssp + (size_t)(u.pm * 256 + t) * 16); }
    __device__ __forceinline__ void operator()(const AccT& acc, const Unit& u, int par, int wr, int wc, int fr, int fq, int wid, int lane) const {
        const bool norm = u.pn < nnorm; const int colh = wc * 32 + 8 * fq;
        if (norm) {
#pragma unroll
            for (int ai = 0; ai < 2; ++ai)
#pragma unroll
                for (int m = 0; m < 4; ++m) { float sq = 0.f;
#pragma unroll
                    for (int bj = 0; bj < 2; ++bj)
#pragma unroll
                        for (int n = 0; n < 2; ++n) { const f32x4 v = acc[ai][bj][m][n]; sq += (v[0] * v[0] + v[1] * v[1]) + (v[2] * v[2] + v[3] * v[3]); }
                    sq += __shfl_xor(sq, 16); sq += __shfl_xor(sq, 32);
                    if (fq == 0) XP[(ai * 128 + wr * 64 + m * 16 + fr) * 4 + wc] = sq; }
        }
        asm volatile("s_waitcnt lgkmcnt(0)" ::: "memory"); __builtin_amdgcn_s_barrier(); asm volatile("" ::: "memory");
        f32x4 g[2][2];
#pragma unroll
        for (int bj = 0; bj < 2; ++bj)
#pragma unroll
            for (int n = 0; n < 2; ++n) g[bj][n] = norm ? *(const f32x4*)(gain + colh + bj * 128 + 4 * n) * gscale : (f32x4){1.f, 1.f, 1.f, 1.f};
#pragma unroll
        for (int ai = 0; ai < 2; ++ai)
#pragma unroll
            for (int m = 0; m < 4; ++m) { const int rl = ai * 128 + wr * 64 + m * 16 + fr; const size_t row = (size_t)(u.pm * 256 + rl);
                float h = 1.0f;
                if (norm) { const f32x4 p = *(const LAS f32x4*)(XP + rl * 4); const float rs = ssp ? RS[par * 256 + rl] : 1.0f; const float s = ((p[0] + p[1]) + (p[2] + p[3])) * rs * rs; h = rs / sqrtf(s * (1.f / 256.f) + EPS); }
#pragma unroll
                for (int bj = 0; bj < 2; ++bj) { const f32x4 v0 = acc[ai][bj][m][0] * h * g[bj][0], v1 = acc[ai][bj][m][1] * h * g[bj][1];
                    v4u w; w.x = pk2(v0[0], v0[1]); w.y = pk2(v0[2], v0[3]); w.z = pk2(v1[0], v1[1]); w.w = pk2(v1[2], v1[3]);
                    *(v4u*)(O + row * ldo + u.pn * 256 + colh + bj * 128) = w; } }
        asm volatile("s_waitcnt lgkmcnt(0)" ::: "memory"); __builtin_amdgcn_s_barrier(); asm volatile("" ::: "memory");
    }
};
struct EpiRouter {
    const float* ssp; const float* bg; const float* be; float* LG; LAS float* RS; int pad_;
    __device__ __forceinline__ void prep(const Unit& u, int par) const { const int t = threadIdx.x; if (t < 256) RS[par * 256 + t] = rstd16(ssp + (size_t)(u.pm * 256 + t) * 16); }
    __device__ __forceinline__ void operator()(const AccT& acc, const Unit& u, int par, int wr, int wc, int fr, int fq, int wid, int lane) const {
        const int col0 = wc * 32 + 8 * fq;
        if (col0 < 72) {
            f32x4 b0, b1;
#pragma unroll
            for (int e = 0; e < 4; ++e) { const int c0 = col0 + e, c1 = col0 + 4 + e; b0[e] = c0 < 8 ? bg[c0] : be[c0 - 8]; b1[e] = c1 < 8 ? bg[c1] : be[c1 - 8]; }
#pragma unroll
            for (int ai = 0; ai < 2; ++ai)
#pragma unroll
                for (int m = 0; m < 4; ++m) { const int rl = ai * 128 + wr * 64 + m * 16 + fr; const float rs = RS[par * 256 + rl]; float* p = LG + (size_t)(u.pm * 256 + rl) * 72 + col0;
                    *(f32x4*)p = acc[ai][0][m][0] * rs + b0; *(f32x4*)(p + 4) = acc[ai][0][m][1] * rs + b1; }
        }
    }
};
struct SchedMoeA {
    const int* tileb; const int* rowlist; const char* XN; const char* WGU; int ntile, G, c, pad_;
    __device__ __forceinline__ bool next(int i, Unit& u) const { const long L = (long)i * G + c; if (L >= (long)ntile * 4) return false; const int tl = (int)(L >> 2), pn = (int)(L & 3);
        const int b = __builtin_amdgcn_readfirstlane(tileb[tl]), e = (b >> 6) * 8 + (pn < 2 ? ((b >> 3) & 7) : (b & 7));
        u.pm = tl; u.pn = pn; u.a = XN; u.rows = rowlist + tl * 256; u.b0 = u.b1 = WGU + (size_t)e * (512 * 1024 * 2) + (size_t)(pn & 1) * (256 * 1024 * 2); return true; }
};
struct EpiMoeA {
    const float* ssp; const float* w0; const float* w1; bf16_t* H; LAS float* RS; LAS float* WG;
    __device__ __forceinline__ void prep(const Unit& u, int par) const { const int t = threadIdx.x; if (t < 256) { const int tok = u.rows[t];
        RS[par * 256 + t] = tok < 0 ? 0.f : rstd16(ssp + (size_t)tok * 16); WG[par * 256 + t] = tok < 0 ? 0.f : (u.pn < 2 ? w0[tok] : w1[tok]); } }
    __device__ __forceinline__ void operator()(const AccT& acc, const Unit& u, int par, int wr, int wc, int fr, int fq, int wid, int lane) const {
#pragma unroll
        for (int ai = 0; ai < 2; ++ai)
#pragma unroll
            for (int m = 0; m < 4; ++m) { const int rl = ai * 128 + wr * 64 + m * 16 + fr; const float rs = RS[par * 256 + rl], wg = WG[par * 256 + rl]; float h[8];
#pragma unroll
                for (int n = 0; n < 2; ++n)
#pragma unroll
                    for (int e = 0; e < 4; ++e) h[n * 4 + e] = silu_f(acc[ai][0][m][n][e] * rs) * (acc[ai][1][m][n][e] * rs) * wg;
                v4u w; w.x = pk2(h[0], h[1]); w.y = pk2(h[2], h[3]); w.z = pk2(h[4], h[5]); w.w = pk2(h[6], h[7]);
                *(v4u*)(H + (size_t)(u.pm * 256 + rl) * 512 + u.pn * 128 + wc * 32 + 8 * fq) = w; }
    }
};
struct SchedMoeB {
    const int* tileb; const int* rowlist; const char* Hb; const char* WD; int ntile, G, c, pad_;
    __device__ __forceinline__ bool next(int i, Unit& u) const { const long L = (long)i * G + c; if (L >= (long)ntile * 4) return false; const int tl = (int)(L >> 2), pn = (int)(L & 3);
        const int b = __builtin_amdgcn_readfirstlane(tileb[tl]), ea = (b >> 6) * 8 + ((b >> 3) & 7), eb = (b >> 6) * 8 + (b & 7);
        u.pm = tl; u.pn = pn; u.a = Hb + (size_t)tl * (256 * 512 * 2); u.rows = rowlist + tl * 256;
        u.b0 = WD + (size_t)ea * (1024 * 256 * 2) + (size_t)pn * (256 * 256 * 2); u.b1 = WD + (size_t)eb * (1024 * 256 * 2) + (size_t)pn * (256 * 256 * 2); return true; }
};
struct EpiMoeB {
    float* out; float* dummy; LAS int* TOK; int pad_;
    __device__ __forceinline__ void prep(const Unit& u, int par) const {}
    __device__ __forceinline__ void operator()(const AccT& acc, const Unit& u, int par, int wr, int wc, int fr, int fq, int wid, int lane) const {
        const int col0 = u.pn * 256 + wc * 32 + 8 * fq;
#pragma unroll
        for (int ai = 0; ai < 2; ++ai)
#pragma unroll
            for (int m = 0; m < 4; ++m) { const int rl = ai * 128 + wr * 64 + m * 16 + fr; const int tok = u.rows[rl];
                float* rowp = tok >= 0 ? out + (size_t)tok * D : dummy;
#pragma unroll
                for (int bj = 0; bj < 2; ++bj) { float* p = rowp + col0 + bj * 128;
                    const f32x4 o0 = *(const f32x4*)p + acc[ai][bj][m][0], o1 = *(const f32x4*)(p + 4) + acc[ai][bj][m][1]; *(f32x4*)p = o0; *(f32x4*)(p + 4) = o1; } }
    }
};
namespace att {
__device__ __forceinline__ int crow(int r, int hi) { return (r & 3) + 8 * (r >> 2) + 4 * hi; }
__device__ __forceinline__ void glds16(const void* gsrc, unsigned lds_dst) { unsigned keep;
    asm volatile("s_mov_b32 %0, m0\n\ts_mov_b32 m0, %2\n\ts_nop 0\n\tglobal_load_lds_dwordx4 %1, off\n\ts_mov_b32 m0, %0" : "=&s"(keep) : "v"(gsrc), "s"(lds_dst) : "memory"); }
typedef __attribute__((address_space(3))) const char* lds_cptr;
typedef short v4i16_t __attribute__((ext_vector_type(4)));
__device__ __forceinline__ s16x4 vtr(lds_cptr p) { return __builtin_bit_cast(s16x4, __builtin_amdgcn_ds_read_tr16_b64_v4i16((__attribute__((address_space(3))) v4i16_t*)p)); }

struct Tensors { const bf16* Q; const bf16* K; const bf16* V; bf16* O; int qp, kp, vp, op; };

template <int KS, int DVB, int NDV, int QW, bool QREG>
__device__ __forceinline__ void unit(const Tensors& Tn, const int q0, const int NT, const float cbound, char* shm, LAS float* wsf_all) {
    constexpr int KSLOT = 64 * KS * 32, VSLOT = 64 * DVB * 64, SLOT = KSLOT + VSLOT, NKP = KS * 2, NVP = DVB * 4;
    const int tid = threadIdx.x, lane = tid & 63, r32 = lane & 31, hi = lane >> 5; const int wid = __builtin_amdgcn_readfirstlane(tid >> 6);
    const int qb = wid % QW, dvb0 = (wid / QW) * NDV;
    const unsigned lds0 = (unsigned)(uintptr_t)shm;
    LAS float* wsf = wsf_all + wid * 64;
    const lds_cptr shm3 = (lds_cptr)shm;
    const bf16* ksrc = Tn.K + (size_t)lane * Tn.kp;
    const bf16* vsrc = Tn.V + (size_t)(lane >> 2) * Tn.vp + (lane & 3) * 8;
#define ATT_DMA(t, slot) do { \
        _Pragma("unroll") for (int p_ = 0; p_ < (NKP + 7) / 8; ++p_) { const int c_ = wid + 8 * p_; if (c_ < NKP) glds16(ksrc + (size_t)(t) * 64 * Tn.kp + c_ * 8, (unsigned)__builtin_amdgcn_readfirstlane(lds0 + (slot) * SLOT + c_ * 1024)); } \
        _Pragma("unroll") for (int p_ = 0; p_ < (NVP + 7) / 8; ++p_) { const int c_ = wid + 8 * p_; if (c_ < NVP) { const int dg_ = c_ >> 2, kg_ = c_ & 3; \
            glds16(vsrc + ((size_t)(t) * 64 + 16 * kg_) * Tn.vp + dg_ * 32, (unsigned)__builtin_amdgcn_readfirstlane(lds0 + (slot) * SLOT + KSLOT + c_ * 1024)); } } } while (0)
    ATT_DMA(0, 0);
    const bf16* Qw = Tn.Q + (size_t)(q0 + qb * 32 + r32) * Tn.qp + hi * 8;
    bf16x8 qr[KS];
    if constexpr (QREG) {
#pragma unroll
      for (int d0 = 0; d0 < KS; ++d0) qr[d0] = *reinterpret_cast<const bf16x8*>(Qw + d0 * 16); }
    f32x16 o[NDV];
#pragma unroll
    for (int j = 0; j < NDV; ++j) o[j] = f32x16{};
    float l_reg = 0.f;
    f32x16 negc;
#pragma unroll
    for (int r = 0; r < 16; ++r) negc[r] = -cbound;
    asm volatile("s_waitcnt vmcnt(0)" ::: "memory"); __builtin_amdgcn_s_barrier(); asm volatile("" ::: "memory");
    for (int t = 0; t < NT; ++t) {
        const int sl = t & 1;
        if (t + 1 < NT) ATT_DMA(t + 1, sl ^ 1);
        const lds_cptr kb = shm3 + sl * SLOT + hi * 1024 + r32 * 16;
        const lds_cptr vp_ = shm3 + sl * SLOT + KSLOT + ((lane >> 4) & 1) * 32 + (lane & 3) * 8 + (4 * hi + ((lane & 15) >> 2)) * 64;
#pragma unroll
        for (int kh = 0; kh < 2; ++kh) {
            f32x16 p = negc;
#pragma unroll
            for (int d0 = 0; d0 < KS; ++d0) {
                if constexpr (!QREG) { if ((d0 & 3) == 0) { asm volatile("" ::: "memory");
#pragma unroll
                    for (int dd = 0; dd < 4; ++dd) qr[d0 + dd] = *reinterpret_cast<const bf16x8*>(Qw + (d0 + dd) * 16);
                    asm volatile("" ::: "memory"); } }
                const bf16x8 b0 = *(const __attribute__((address_space(3))) bf16x8*)(kb + d0 * 2048 + kh * 512);
                p = __builtin_amdgcn_mfma_f32_32x32x16_bf16(b0, qr[d0], p, 0, 0, 0);
            }
            float sacc = 0.f;
#pragma unroll
            for (int r = 0; r < 16; ++r) { p[r] = fast_exp2(p[r]); sacc += p[r]; }
            l_reg += sacc;
            v4u pw[2];
            pw[0] = (v4u){pk2(p[0], p[1]), pk2(p[2], p[3]), pk2(p[4], p[5]), pk2(p[6], p[7])};
            pw[1] = (v4u){pk2(p[8], p[9]), pk2(p[10], p[11]), pk2(p[12], p[13]), pk2(p[14], p[15])};
#pragma unroll
            for (int j = 0; j < NDV; ++j) {
#pragma unroll
                for (int ks = 0; ks < 2; ++ks) {
                    const s16x4 lo = vtr(vp_ + (dvb0 + j) * 4096 + (2 * kh + ks) * 1024), hh = vtr(vp_ + (dvb0 + j) * 4096 + (2 * kh + ks) * 1024 + 512);
                    const bf16x8 vf = (bf16x8){lo[0], lo[1], lo[2], lo[3], hh[0], hh[1], hh[2], hh[3]};
                    o[j] = __builtin_amdgcn_mfma_f32_32x32x16_bf16(__builtin_bit_cast(bf16x8, pw[ks]), vf, o[j], 0, 0, 0);
                }
            }
        }
        asm volatile("s_waitcnt vmcnt(0) lgkmcnt(0)" ::: "memory"); __builtin_amdgcn_s_barrier(); asm volatile("" ::: "memory");
    }
#undef ATT_DMA
    l_reg += __shfl_xor(l_reg, 32);
    if (hi == 0) wsf[r32] = l_reg;
    asm volatile("s_waitcnt lgkmcnt(0)" ::: "memory");
    float rli[16];
#pragma unroll
    for (int r = 0; r < 16; ++r) rli[r] = fast_rcp(wsf[crow(r, hi)]);
    constexpr int SW = NDV * 32;
    LAS bf16* stg = (LAS bf16*)(shm3) + wid * (32 * SW);
#pragma unroll
    for (int r = 0; r < 16; ++r) { const int orow = crow(r, hi);
#pragma unroll
        for (int j = 0; j < NDV; ++j) stg[orow * SW + j * 32 + r32] = (bf16)f2bf(o[j][r] * rli[r]); }
    asm volatile("s_waitcnt lgkmcnt(0)" ::: "memory");
    bf16* Ow = Tn.O + (size_t)(q0 + qb * 32) * Tn.op + dvb0 * 32;
    constexpr int CPR = SW / 8;
#pragma unroll
    for (int i = 0; i < (32 * CPR) / 64; ++i) { const int idx = i * 64 + lane, row = idx / CPR, ch = idx % CPR;
        const v4u v = *(const LAS v4u*)(stg + row * SW + ch * 8); *(v4u*)(Ow + (size_t)row * Tn.op + ch * 8) = v; }
    asm volatile("s_waitcnt vmcnt(0) lgkmcnt(0)" ::: "memory"); __builtin_amdgcn_s_barrier(); asm volatile("" ::: "memory");
}
}
constexpr float QSCALE_MLA = 0.10206207261596575f * LOG2E;
__device__ __forceinline__ void mla_proj(Frame& F, const Inputs& in) {
    const int lane = F.lane, w = F.wave, tk = lane & 15, g = lane >> 4;
    const bf16* LAT = (const bf16*)(F.ws + WS_LAT); const float* COS = (const float*)(F.ws + WS_COS); const float* SIN = (const float*)(F.ws + WS_SIN);
    bf16* Qo = (bf16*)(F.ws + WS_Q); bf16* Ko = (bf16*)(F.ws + WS_K); bf16* Vo = (bf16*)(F.ws + WS_V);
    const int ngrp = T / 16;
    {
        bf16x8 wq[6][6];
        const bf16* W = (const bf16*)(F.ws + W_Q) + (size_t)(96 * w + tk) * 192 + 8 * g;
#pragma unroll
        for (int nt = 0; nt < 6; ++nt)
#pragma unroll
            for (int ks = 0; ks < 6; ++ks) wq[nt][ks] = *(const bf16x8*)(W + (size_t)nt * 16 * 192 + ks * 32);
        float qw[6][4];
#pragma unroll
        for (int nt = 0; nt < 6; ++nt)
#pragma unroll
            for (int r = 0; r < 4; ++r) qw[nt][r] = in.q_norm[16 * nt + 4 * g + r] * QSCALE_MLA;
        for (int grp = F.vcu; grp < ngrp; grp += F.G) {
            const int tok = grp * 16 + tk;
            bf16x8 xf[6]; float ss = 0.f;
#pragma unroll
            for (int ks = 0; ks < 6; ++ks) { xf[ks] = *(const bf16x8*)(LAT + (size_t)tok * 512 + ks * 32 + 8 * g);
#pragma unroll
                for (int j = 0; j < 8; ++j) { const float v = bf2f((bf16)xf[ks][j]); ss += v * v; } }
            ss += __shfl_xor(ss, 16); ss += __shfl_xor(ss, 32);
            const float rc = 1.0f / sqrtf(ss * (1.f / 192.f) + EPS);
            f32x4 acc[6]; float hs = 0.f;
#pragma unroll
            for (int nt = 0; nt < 6; ++nt) { acc[nt] = (f32x4){0.f, 0.f, 0.f, 0.f};
#pragma unroll
                for (int ks = 0; ks < 6; ++ks) acc[nt] = __builtin_amdgcn_mfma_f32_16x16x32_bf16(wq[nt][ks], xf[ks], acc[nt], 0, 0, 0);
                acc[nt] = acc[nt] * rc; hs += (acc[nt][0] * acc[nt][0] + acc[nt][1] * acc[nt][1]) + (acc[nt][2] * acc[nt][2] + acc[nt][3] * acc[nt][3]); }
            hs += __shfl_xor(hs, 16); hs += __shfl_xor(hs, 32);
            const float rq = 1.0f / sqrtf(hs * (1.f / 96.f) + EPS);
#pragma unroll
            for (int nt = 0; nt < 6; ++nt)
#pragma unroll
                for (int r = 0; r < 4; ++r) acc[nt][r] = acc[nt][r] * rq * qw[nt][r];
            const f32x4 c = *(const f32x4*)(COS + (size_t)tok * 16 + 4 * g), s = *(const f32x4*)(SIN + (size_t)tok * 16 + 4 * g);
            const f32x4 x1 = acc[4], x2 = acc[5]; acc[4] = x1 * c - x2 * s; acc[5] = x2 * c + x1 * s;
#pragma unroll
            for (int nt = 0; nt < 6; ++nt) { v2u o; o.x = pk2(acc[nt][0], acc[nt][1]); o.y = pk2(acc[nt][2], acc[nt][3]); *(v2u*)(Qo + (size_t)tok * 768 + 96 * w + 16 * nt + 4 * g) = o; }
        }
    }
    {
        bf16x8 wk[8][4];
        const bf16* W = (const bf16*)(F.ws + W_KV) + (size_t)(128 * w + tk) * 128 + 8 * g;
#pragma unroll
        for (int nt = 0; nt < 8; ++nt)
#pragma unroll
            for (int ks = 0; ks < 4; ++ks) wk[nt][ks] = *(const bf16x8*)(W + (size_t)nt * 16 * 128 + ks * 32);
        float kw[4][4], kwr[8];
#pragma unroll
        for (int nt = 0; nt < 4; ++nt)
#pragma unroll
            for (int r = 0; r < 4; ++r) kw[nt][r] = in.k_norm[16 * nt + 4 * g + r];
#pragma unroll
        for (int e = 0; e < 8; ++e) kwr[e] = in.k_norm[64 + 8 * g + e];
        for (int grp = F.vcu; grp < ngrp; grp += F.G) {
            const int tok = grp * 16 + tk;
            bf16x8 xf[4]; float ss = 0.f;
#pragma unroll
            for (int ks = 0; ks < 4; ++ks) { xf[ks] = *(const bf16x8*)(LAT + (size_t)tok * 512 + 192 + ks * 32 + 8 * g);
#pragma unroll
                for (int j = 0; j < 8; ++j) { const float v = bf2f((bf16)xf[ks][j]); ss += v * v; } }
            const bf16x8 krb = *(const bf16x8*)(LAT + (size_t)tok * 512 + 320 + 8 * g);
            float kr[8], sr = 0.f;
#pragma unroll
            for (int e = 0; e < 8; ++e) { kr[e] = bf2f((bf16)krb[e]); sr += kr[e] * kr[e]; }
            ss += __shfl_xor(ss, 16); ss += __shfl_xor(ss, 32); sr += __shfl_xor(sr, 16); sr += __shfl_xor(sr, 32);
            const float rc = 1.0f / sqrtf(ss * (1.f / 128.f) + EPS);
            f32x4 acc[8]; float hs = 0.f;
#pragma unroll
            for (int nt = 0; nt < 8; ++nt) { acc[nt] = (f32x4){0.f, 0.f, 0.f, 0.f};
#pragma unroll
                for (int ks = 0; ks < 4; ++ks) acc[nt] = __builtin_amdgcn_mfma_f32_16x16x32_bf16(wk[nt][ks], xf[ks], acc[nt], 0, 0, 0);
                acc[nt] = acc[nt] * rc;
                if (nt < 4) hs += (acc[nt][0] * acc[nt][0] + acc[nt][1] * acc[nt][1]) + (acc[nt][2] * acc[nt][2] + acc[nt][3] * acc[nt][3]); }
            hs += __shfl_xor(hs, 16); hs += __shfl_xor(hs, 32);
            const float rk = 1.0f / sqrtf((hs + sr) * (1.f / 96.f) + EPS);
#pragma unroll
            for (int nt = 0; nt < 4; ++nt) { v2u o; o.x = pk2(acc[nt][0] * rk * kw[nt][0], acc[nt][1] * rk * kw[nt][1]); o.y = pk2(acc[nt][2] * rk * kw[nt][2], acc[nt][3] * rk * kw[nt][3]);
                *(v2u*)(Ko + (size_t)tok * 768 + 96 * w + 16 * nt + 4 * g) = o; }
#pragma unroll
            for (int nt = 4; nt < 8; ++nt) { v2u o; o.x = pk2(acc[nt][0], acc[nt][1]); o.y = pk2(acc[nt][2], acc[nt][3]); *(v2u*)(Vo + (size_t)tok * 512 + 64 * w + 16 * (nt - 4) + 4 * g) = o; }
            const f32x4 c0 = *(const f32x4*)(COS + (size_t)tok * 16 + 8 * (g & 1)), c1 = *(const f32x4*)(COS + (size_t)tok * 16 + 8 * (g & 1) + 4);
            const f32x4 s0 = *(const f32x4*)(SIN + (size_t)tok * 16 + 8 * (g & 1)), s1 = *(const f32x4*)(SIN + (size_t)tok * 16 + 8 * (g & 1) + 4);
            float ro[8];
#pragma unroll
            for (int e = 0; e < 8; ++e) { const float own = kr[e] * rk * kwr[e]; const float oth = __shfl_xor(own, 32); const float cc = e < 4 ? c0[e] : c1[e - 4], sn = e < 4 ? s0[e] : s1[e - 4];
                ro[e] = (g < 2) ? own * cc - oth * sn : own * cc + oth * sn; }
            v4u o; o.x = pk2(ro[0], ro[1]); o.y = pk2(ro[2], ro[3]); o.z = pk2(ro[4], ro[5]); o.w = pk2(ro[6], ro[7]);
            *(v4u*)(Ko + (size_t)tok * 768 + 96 * w + 64 + 8 * g) = o;
        }
    }
}

__device__ __forceinline__ float dpp_scan(float v) {
#define HG_DPP(ctrl, rm) v += __builtin_bit_cast(float, __builtin_amdgcn_update_dpp(0, __builtin_bit_cast(int, v), ctrl, rm, 0xf, false))
    HG_DPP(0x111, 0xf); HG_DPP(0x112, 0xf); HG_DPP(0x114, 0xf); HG_DPP(0x118, 0xf); HG_DPP(0x142, 0xa); HG_DPP(0x143, 0xc);
#undef HG_DPP
    return v;
}
constexpr int HGL_QT = 0, HGL_KC = 16384, HGL_KP = 32768, HGL_VP = 49152, HGL_SP = 57344, HGL_DEC = 90112;
__device__ __forceinline__ void hgrn2_scan(Frame& F, char* shm) {
    using att::lds_cptr; using att::vtr; using att::crow;
    const int lane = F.lane, w = F.wave, r32 = lane & 31, hi = lane >> 5;
    const unsigned lds0 = (unsigned)(uintptr_t)shm; const lds_cptr shm3 = (lds_cptr)shm;
    const int laneoff = ((lane >> 4) & 1) * 32 + (lane & 3) * 8 + (4 * hi + ((lane & 15) >> 2)) * 64;
    for (int item = F.vcu; item < 256; item += F.G) {
        const int vh = item & 1, dir = (item >> 1) & 1, h = (item >> 2) & 3, b = item >> 4;
        const bf16* HQ = (const bf16*)(F.ws + WS_HQ) + h * 128 + 16 * w;
        const unsigned short* GG = (const unsigned short*)(F.ws + (dir ? WS_GB : WS_GF)) + h * 128 + 16 * w;
        const bf16* HI = (const bf16*)(F.ws + WS_HI) + h * 128 + vh * 64;
        bf16* OUT = (bf16*)(F.ws + (dir ? WS_OB : WS_OF)) + h * 128 + vh * 64;
        const int tfirst = b * SEQ + (dir ? SEQ - 1 : 0), tstep = dir ? -1 : 1;
        f32x16 S0 = f32x16{}, S1 = f32x16{};
        v4u hq_n[2], g_n[2];
        { const size_t tk = (size_t)(tfirst + tstep * lane) * 512; hq_n[0] = *(const v4u*)(HQ + tk); hq_n[1] = *(const v4u*)(HQ + tk + 8); g_n[0] = *(const v4u*)(GG + tk); g_n[1] = *(const v4u*)(GG + tk + 8); }
        for (int n = 0; n < SEQ / 64; ++n) {
            { const int vg = w >> 2, ig = w & 3; const int trow = tfirst + tstep * (64 * n + 16 * ig + (lane >> 2));
              att::glds16(HI + (size_t)trow * 512 + vg * 32 + (lane & 3) * 8, (unsigned)__builtin_amdgcn_readfirstlane(lds0 + HGL_VP + w * 1024)); }
            float q[16], gg[16];
#pragma unroll
            for (int c = 0; c < 2; ++c)
#pragma unroll
                for (int e = 0; e < 4; ++e) { const unsigned hw = hq_n[c][e], gw_ = g_n[c][e];
                    q[c * 8 + 2 * e] = pg8::bf_lo(hw); q[c * 8 + 2 * e + 1] = pg8::bf_hi(hw); gg[c * 8 + 2 * e] = h2f((unsigned short)(gw_ & 0xffffu)); gg[c * 8 + 2 * e + 1] = h2f((unsigned short)(gw_ >> 16)); }
            if (n + 1 < SEQ / 64) { const size_t tk = (size_t)(tfirst + tstep * (64 * (n + 1) + lane)) * 512; hq_n[0] = *(const v4u*)(HQ + tk); hq_n[1] = *(const v4u*)(HQ + tk + 8); g_n[0] = *(const v4u*)(GG + tk); g_n[1] = *(const v4u*)(GG + tk + 8); }
            unsigned qt[8], kt[8];
#pragma unroll
            for (int j = 0; j < 16; j += 2) { float bq[2], kk[2];
#pragma unroll
                for (int u = 0; u < 2; ++u) { const float gv = gg[j + u]; const float bsum = dpp_scan(gv);
                    const float E = fast_exp2(bsum * LOG2E), Ei = fast_exp2(-bsum * LOG2E), kx = 1.0f - fast_exp2(gv * LOG2E);
                    bq[u] = q[j + u] * E; kk[u] = kx * Ei;
                    if (lane == 63) ((LAS float*)(shm3 + HGL_DEC))[16 * w + j + u] = E; }
                qt[j >> 1] = pk2(bq[0], bq[1]); kt[j >> 1] = pk2(kk[0], kk[1]); }
            { LAS v4u* pq = (LAS v4u*)(shm3 + HGL_QT + (2 * w) * 1024 + lane * 16); pq[0] = (v4u){qt[0], qt[1], qt[2], qt[3]}; pq[64] = (v4u){qt[4], qt[5], qt[6], qt[7]};
              LAS v4u* pk = (LAS v4u*)(shm3 + HGL_KC + (2 * w) * 1024 + lane * 16); pk[0] = (v4u){kt[0], kt[1], kt[2], kt[3]}; pk[64] = (v4u){kt[4], kt[5], kt[6], kt[7]};
              LAS v4u* pp = (LAS v4u*)(shm3 + HGL_KP + ((w >> 1) * 4 + (lane >> 4)) * 1024 + (lane & 15) * 64 + (w & 1) * 32); pp[0] = (v4u){kt[0], kt[1], kt[2], kt[3]}; pp[1] = (v4u){kt[4], kt[5], kt[6], kt[7]}; }
            asm volatile("s_waitcnt vmcnt(0) lgkmcnt(0)" ::: "memory"); __builtin_amdgcn_s_barrier(); asm volatile("" ::: "memory");
            const int spc = HGL_SP + (n & 1) * 16384, spn = HGL_SP + ((n + 1) & 1) * 16384;
            if (w < 4) {
                const int tb = w >> 1, vb = w & 1;
                f32x16 o = f32x16{};
                if (n > 0) {
#pragma unroll
                    for (int kd = 0; kd < 8; ++kd) {
                        const v2u a0 = *(const LAS v2u*)(shm3 + HGL_QT + (2 * kd) * 1024 + (32 * tb + r32) * 16 + 8 * hi), a1 = *(const LAS v2u*)(shm3 + HGL_QT + (2 * kd + 1) * 1024 + (32 * tb + r32) * 16 + 8 * hi);
                        const s16x4 lo = vtr(shm3 + spc + (vb * 8 + kd) * 1024 + laneoff), hh = vtr(shm3 + spc + (vb * 8 + kd) * 1024 + laneoff + 512);
                        const v4u af = (v4u){a0.x, a0.y, a1.x, a1.y};
                        o = __builtin_amdgcn_mfma_f32_32x32x16_bf16(__builtin_bit_cast(bf16x8, af), (bf16x8){lo[0], lo[1], lo[2], lo[3], hh[0], hh[1], hh[2], hh[3]}, o, 0, 0, 0);
                    }
                }
                for (int sb = 0; sb <= tb; ++sb) {
                    f32x16 x = f32x16{};
#pragma unroll
                    for (int kd = 0; kd < 8; ++kd) {
                        const bf16x8 ka = *(const LAS bf16x8*)(shm3 + HGL_KC + (2 * kd + hi) * 1024 + (32 * sb + r32) * 16);
                        const bf16x8 qb = *(const LAS bf16x8*)(shm3 + HGL_QT + (2 * kd + hi) * 1024 + (32 * tb + r32) * 16);
                        x = __builtin_amdgcn_mfma_f32_32x32x16_bf16(ka, qb, x, 0, 0, 0);
                    }
                    if (sb == tb) {
#pragma unroll
                        for (int r = 0; r < 16; ++r) if (crow(r, hi) > r32) x[r] = 0.f;
                    }
                    const v4u pw0 = (v4u){pk2(x[0], x[1]), pk2(x[2], x[3]), pk2(x[4], x[5]), pk2(x[6], x[7])}, pw1 = (v4u){pk2(x[8], x[9]), pk2(x[10], x[11]), pk2(x[12], x[13]), pk2(x[14], x[15])};
#pragma unroll
                    for (int ks = 0; ks < 2; ++ks) {
                        const s16x4 lo = vtr(shm3 + HGL_VP + (vb * 4 + 2 * sb + ks) * 1024 + laneoff), hh = vtr(shm3 + HGL_VP + (vb * 4 + 2 * sb + ks) * 1024 + laneoff + 512);
                        o = __builtin_amdgcn_mfma_f32_32x32x16_bf16(__builtin_bit_cast(bf16x8, ks ? pw1 : pw0), (bf16x8){lo[0], lo[1], lo[2], lo[3], hh[0], hh[1], hh[2], hh[3]}, o, 0, 0, 0);
                    }
                }
#pragma unroll
                for (int r = 0; r < 16; ++r) { const int i = 32 * tb + crow(r, hi); OUT[(size_t)(tfirst + tstep * (64 * n + i)) * 512 + vb * 32 + r32] = (bf16)f2bf(o[r]); }
            } else {
                const int db = w - 4;
#pragma unroll
                for (int ig = 0; ig < 4; ++ig) {
                    const s16x4 klo = vtr(shm3 + HGL_KP + (db * 4 + ig) * 1024 + laneoff), khi = vtr(shm3 + HGL_KP + (db * 4 + ig) * 1024 + laneoff + 512);
                    const bf16x8 ka = (bf16x8){klo[0], klo[1], klo[2], klo[3], khi[0], khi[1], khi[2], khi[3]};
                    const s16x4 v0l = vtr(shm3 + HGL_VP + (0 * 4 + ig) * 1024 + laneoff), v0h = vtr(shm3 + HGL_VP + (0 * 4 + ig) * 1024 + laneoff + 512);
                    const s16x4 v1l = vtr(shm3 + HGL_VP + (1 * 4 + ig) * 1024 + laneoff), v1h = vtr(shm3 + HGL_VP + (1 * 4 + ig) * 1024 + laneoff + 512);
                    S0 = __builtin_amdgcn_mfma_f32_32x32x16_bf16(ka, (bf16x8){v0l[0], v0l[1], v0l[2], v0l[3], v0h[0], v0h[1], v0h[2], v0h[3]}, S0, 0, 0, 0);
                    S1 = __builtin_amdgcn_mfma_f32_32x32x16_bf16(ka, (bf16x8){v1l[0], v1l[1], v1l[2], v1l[3], v1h[0], v1h[1], v1h[2], v1h[3]}, S1, 0, 0, 0);
                }
#pragma unroll
                for (int r = 0; r < 16; ++r) { const int d = 32 * db + crow(r, hi); const float dc = ((const LAS float*)(shm3 + HGL_DEC))[d]; S0[r] *= dc; S1[r] *= dc;
                    *(LAS bf16*)(shm3 + spn + (0 * 8 + (d >> 4)) * 1024 + (d & 15) * 64 + r32 * 2) = (bf16)f2bf(S0[r]);
                    *(LAS bf16*)(shm3 + spn + (1 * 8 + (d >> 4)) * 1024 + (d & 15) * 64 + r32 * 2) = (bf16)f2bf(S1[r]); }
            }
            asm volatile("s_waitcnt vmcnt(0) lgkmcnt(0)" ::: "memory"); __builtin_amdgcn_s_barrier(); asm volatile("" ::: "memory");
        }
    }
}
__device__ __forceinline__ void hg_combine(Frame& F, const Inputs& in) {
    const int gw = F.vcu * NWAVES + F.wave, NGW = F.G * NWAVES, lane = F.lane;
    const bf16* OFp = (const bf16*)(F.ws + WS_OF); const bf16* OBp = (const bf16*)(F.ws + WS_OB); const bf16* HG = (const bf16*)(F.ws + WS_HG); bf16* CAT = (bf16*)(F.ws + WS_CAT);
    float on[8];
#pragma unroll
    for (int e = 0; e < 8; ++e) on[e] = in.o_norm[(lane & 15) * 8 + e];
    for (int t = gw; t < T; t += NGW) {
        const v4u a = *(const v4u*)(OFp + (size_t)t * 512 + lane * 8), bq = *(const v4u*)(OBp + (size_t)t * 512 + lane * 8), gq = *(const v4u*)(HG + (size_t)t * 512 + lane * 8);
        float x[8], ss = 0.f;
#pragma unroll
        for (int e = 0; e < 4; ++e) { x[2 * e] = pg8::bf_lo(a[e]) + pg8::bf_lo(bq[e]); x[2 * e + 1] = pg8::bf_hi(a[e]) + pg8::bf_hi(bq[e]); ss += x[2 * e] * x[2 * e] + x[2 * e + 1] * x[2 * e + 1]; }
        ss += __shfl_xor(ss, 1); ss += __shfl_xor(ss, 2); ss += __shfl_xor(ss, 4); ss += __shfl_xor(ss, 8);
        const float r = 1.0f / sqrtf(ss * (1.f / 128.f) + EPS);
        v4u o;
#pragma unroll
        for (int e = 0; e < 4; ++e) o[e] = pk2(x[2 * e] * r * on[2 * e] * pg8::bf_lo(gq[e]), x[2 * e + 1] * r * on[2 * e + 1] * pg8::bf_hi(gq[e]));
        *(v4u*)(CAT + (size_t)t * 1024 + 512 + lane * 8) = o;
    }
}
__device__ __forceinline__ void moe_route(Frame& F) {
    const int gt = (F.vcu * NWAVES + F.wave) * 64 + F.lane, NGT = F.G * NWAVES * 64;
    const float* LG = (const float*)(F.ws + WS_LG); int* bk = (int*)(F.ws + WS_REC); int* ps = bk + T; float* w0 = (float*)(ps + T); float* w1 = w0 + T;
    for (int tok = gt; tok < T; tok += NGT) {
        const float* l = LG + (size_t)tok * 72;
        float gl[8]; { const f32x4 a = *(const f32x4*)l, b = *(const f32x4*)(l + 4); gl[0] = a[0]; gl[1] = a[1]; gl[2] = a[2]; gl[3] = a[3]; gl[4] = b[0]; gl[5] = b[1]; gl[6] = b[2]; gl[7] = b[3]; }
        float mx = gl[0]; int gs = 0;
#pragma unroll
        for (int g = 1; g < 8; ++g) if (gl[g] > mx) { mx = gl[g]; gs = g; }
        float den = 0.f;
#pragma unroll
        for (int g = 0; g < 8; ++g) den += expf(gl[g] - mx);
        const float gwt = 1.0f / den;
        float el[8]; { const f32x4 a = *(const f32x4*)(l + 8 + gs * 8), b = *(const f32x4*)(l + 12 + gs * 8); el[0] = a[0]; el[1] = a[1]; el[2] = a[2]; el[3] = a[3]; el[4] = b[0]; el[5] = b[1]; el[6] = b[2]; el[7] = b[3]; }
        int i0 = 0; float m0 = el[0];
#pragma unroll
        for (int e = 1; e < 8; ++e) if (el[e] > m0) { m0 = el[e]; i0 = e; }
        int i1 = -1; float m1 = -INFINITY;
#pragma unroll
        for (int e = 0; e < 8; ++e) if (e != i0 && el[e] > m1) { m1 = el[e]; i1 = e; }
        if (i1 < 0) i1 = (i0 == 0) ? 1 : 0;
        const float e1 = expf(m1 - m0); const float wa = gwt / (1.0f + e1), wb = gwt * e1 / (1.0f + e1);
        const int ea = i0 < i1 ? i0 : i1, eb = i0 < i1 ? i1 : i0;
        const int bucket = gs * 64 + ea * 8 + eb;
        const unsigned pos = __hip_atomic_fetch_add((unsigned*)(F.ctl + CW_CNT) + bucket, 1u, RLX_AGENT);
        bk[tok] = bucket; ps[tok] = (int)pos; w0[tok] = i0 < i1 ? wa : wb; w1[tok] = i0 < i1 ? wb : wa;
    }
}
__device__ __forceinline__ void moe_place(Frame& F) {
    LAS int* nt_s = (LAS int*)(F.lds + RING_OFF); LAS int* ts_s = nt_s + 512;
    const int t = F.tid;
    const int cnt = (int)__hip_atomic_load((unsigned*)(F.ctl + CW_CNT) + t, RLX_AGENT);
    nt_s[t] = (cnt + 255) >> 8;
    __syncthreads();
    int st = 0;
    for (int j = 0; j < t; ++j) st += nt_s[j];
    ts_s[t] = st;
    __syncthreads();
    int* rowlist = (int*)(F.ws + WS_REC + 1 * MiB); int* tileb = (int*)(F.ws + WS_REC + 2 * MiB);
    if (blockIdx.x == 0) {
        const int ntb = nt_s[t];
        for (int k = 0; k < ntb; ++k) tileb[st + k] = t;
        for (int r = cnt; r < ntb * 256; ++r) rowlist[st * 256 + r] = -1;
        if (t == 511) __hip_atomic_store((unsigned*)(F.ctl + CW_NT), (unsigned)(st + ntb), RLX_AGENT);
    }
    const int gt = (F.vcu * NWAVES + F.wave) * 64 + F.lane, NGT = F.G * NWAVES * 64;
    const int* bk = (const int*)(F.ws + WS_REC); const int* ps = bk + T;
    for (int tok = gt; tok < T; tok += NGT) rowlist[ts_s[bk[tok]] * 256 + ps[tok]] = tok;
    __syncthreads();
}
constexpr int N_PHASES = 13;
struct Args { Inputs in; float* out; unsigned char* ws; int ph_lo, ph_hi; };
__global__ void __launch_bounds__(NWAVES * 64, 2) mega_fwd(Args args) {
    extern __shared__ __attribute__((aligned(16))) unsigned char lds[];
    Frame F;
    F.lds = (LAS unsigned char*)lds;
    F.MISC = (volatile LAS unsigned*)(F.lds + MISC_OFF);
    F.tid = threadIdx.x; F.lane = F.tid & 63; F.wave = __builtin_amdgcn_readfirstlane(F.tid >> 6);
    F.G = gridDim.x; { const int bx = blockIdx.x; F.vcu = (F.G % 8 == 0) ? (bx % 8) * (F.G / 8) + bx / 8 : bx; }
    F.ws = args.ws; F.ctl = (gu32*)(args.ws + WS_CTL);
    const Inputs& in = args.in;
    unsigned char* ws = args.ws;
    for (int u = F.tid; u < 32; u += NWAVES * 64) ((LAS unsigned*)(F.lds + MISC_OFF))[u] = 0u;
    __syncthreads();
    const int lo = args.ph_lo, hi = args.ph_hi;
    const bool multi = (hi - lo) > 1;
    XcdBarrier bar; bar.bar = (unsigned*)(F.ctl + CW_BAR); bar.x = 0; bar.st = nullptr;
    if (multi) bar = xcd_barrier_post((unsigned*)(F.ctl + CW_BAR), F.MISC + 8);
#ifndef MK_PHASE_MASK
#define MK_PHASE_MASK 0xffff
#endif
#define IN(k) ((((MK_PHASE_MASK) >> (k)) & 1) && lo <= (k) && (k) < hi)
#define SEAM(k) do { if (IN(k) && IN((k) + 1)) xcd_barrier(bar); } while (0)
    LAS float* RS = (LAS float*)(F.lds + AUX_RS); LAS float* WG = (LAS float*)(F.lds + AUX_WG); LAS int* TOK = (LAS int*)(F.lds + AUX_TOK); LAS float* XP = (LAS float*)(F.lds + AUX_XP);
    const float* misc = (const float*)(ws + WS_MISC);

    if (IN(0)) { p0_prologue(F, in); }
    SEAM(0);
    if (IN(1)) {
        SchedGrid S; S.pad_ = 0; S.o.init(T / 256, 12, F.G, (int)blockIdx.x); S.A = (const char*)(ws + WS_XN); S.B = (const char*)(ws + W_IN); S.astep = (size_t)256 * 1024 * 2; S.bstep = (size_t)256 * 1024 * 2;
        EpiIn E{(bf16_t*)(ws + WS_HQ), (const float*)(ws + WS_SS0), misc, RS, 0};
        pg8::gemm_phase<EpiIn, SchedGrid, true, false, 1024, 1024, 1024, 16>(F.lds + RING_OFF, S, E);
    }
    SEAM(1);
    if (IN(2)) {
        mla_proj(F, in);
        { SchedGrid S; S.pad_ = 0; S.o.init(16, 8, F.G, (int)blockIdx.x); S.A = (const char*)(ws + WS_MN); S.B = (const char*)(ws + W_XKV); S.astep = (size_t)256 * 1024 * 2; S.bstep = (size_t)256 * 1024 * 2;
          EpiHeadNorm E{nullptr, in.x_k_norm, (bf16_t*)(ws + WS_KVX), RS, XP, 1.0f, 2048, 4, 0};
          pg8::gemm_phase<EpiHeadNorm, SchedGrid, true, false, 1024, 1024, 1024, 16>(F.lds + RING_OFF, S, E); }
        __syncthreads();
        hgrn2_scan(F, (char*)lds + RING_OFF);
    }
    SEAM(2);
    if (IN(3)) {
        hg_combine(F, in);
        const float cb = misc[1024];
        for (int un = F.vcu; un < BATCH * 8 * 16; un += F.G) {
            const int qb = un & 15, bh = un >> 4, b = bh >> 3, h = bh & 7;
            att::Tensors Tn; Tn.Q = (const bf16*)(ws + WS_Q) + (size_t)b * SEQ * 768 + h * 96; Tn.K = (const bf16*)(ws + WS_K) + (size_t)b * SEQ * 768 + h * 96;
            Tn.V = (const bf16*)(ws + WS_V) + (size_t)b * SEQ * 512 + h * 64; Tn.O = (bf16*)(ws + WS_CAT) + (size_t)b * SEQ * 1024 + h * 64; Tn.qp = 768; Tn.kp = 768; Tn.vp = 512; Tn.op = 1024;
            att::unit<6, 2, 2, 8, true>(Tn, qb * 256, SEQ / 64, cb, (char*)lds + RING_OFF, (LAS float*)(F.lds + AUX_WSF));
        }
    }
    SEAM(3);
    if (IN(4)) {
        SchedGrid S; S.pad_ = 0; S.o.init(T / 256, 4, F.G, (int)blockIdx.x); S.A = (const char*)(ws + WS_CAT); S.B = (const char*)(ws + W_OUT); S.astep = (size_t)256 * 1024 * 2; S.bstep = (size_t)256 * 1024 * 2;
        EpiRes E{in.x, args.out, (bf16_t*)(ws + WS_XN), (float*)(ws + WS_SSP1)};
        pg8::gemm_phase<EpiRes, SchedGrid, true, false, 1024, 1024, 1024, 16>(F.lds + RING_OFF, S, E);
    }
    SEAM(4);
    if (IN(5)) {
        SchedGrid S; S.pad_ = 0; S.o.init(T / 256, 4, F.G, (int)blockIdx.x); S.A = (const char*)(ws + WS_XN); S.B = (const char*)(ws + W_XQ); S.astep = (size_t)256 * 1024 * 2; S.bstep = (size_t)256 * 1024 * 2;
        EpiHeadNorm E{(const float*)(ws + WS_SSP1), in.x_q_norm, (bf16_t*)(ws + WS_QX), RS, XP, 0.0625f * LOG2E, 1024, 4, 0};
        pg8::gemm_phase<EpiHeadNorm, SchedGrid, true, false, 1024, 1024, 1024, 16>(F.lds + RING_OFF, S, E);
    }
    SEAM(5);
    if (IN(6)) {
        const float cb = misc[1025];
        for (int un = F.vcu; un < BATCH * 4 * 32; un += F.G) {
            const int qb = un & 31, bh = un >> 5, b = bh >> 2, h = bh & 3;
            att::Tensors Tn; Tn.Q = (const bf16*)(ws + WS_QX) + (size_t)b * SEQ * 1024 + h * 256; Tn.K = (const bf16*)(ws + WS_KVX) + (size_t)b * MEML * 2048 + h * 256;
            Tn.V = (const bf16*)(ws + WS_KVX) + (size_t)b * MEML * 2048 + 1024 + h * 256; Tn.O = (bf16*)(ws + WS_QX) + (size_t)b * SEQ * 1024 + h * 256; Tn.qp = 1024; Tn.kp = 2048; Tn.vp = 2048; Tn.op = 1024;
            att::unit<16, 8, 4, 4, false>(Tn, qb * 128, MEML / 64, cb, (char*)lds + RING_OFF, (LAS float*)(F.lds + AUX_WSF));
        }
    }
    SEAM(6);
    if (IN(7)) {
        SchedGrid S; S.pad_ = 0; S.o.init(T / 256, 4, F.G, (int)blockIdx.x); S.A = (const char*)(ws + WS_QX); S.B = (const char*)(ws + W_XO); S.astep = (size_t)256 * 1024 * 2; S.bstep = (size_t)256 * 1024 * 2;
        EpiRes E{args.out, args.out, (bf16_t*)(ws + WS_XN), (float*)(ws + WS_SSP2)};
        pg8::gemm_phase<EpiRes, SchedGrid, true, false, 1024, 1024, 1024, 16>(F.lds + RING_OFF, S, E);
    }
    SEAM(7);
    if (IN(8)) {
        { SchedGrid S; S.pad_ = 0; S.o.init(T / 256, 1, F.G, (int)blockIdx.x); S.A = (const char*)(ws + WS_XN); S.B = (const char*)(ws + W_R); S.astep = (size_t)256 * 1024 * 2; S.bstep = 0;
          EpiRouter E{(const float*)(ws + WS_SSP2), in.b_group, in.b_expert, (float*)(ws + WS_LG), RS, 0};
          pg8::gemm_phase<EpiRouter, SchedGrid, true, false, 1024, 1024, 1024, 16>(F.lds + RING_OFF, S, E); }
        __syncthreads();
        moe_weights(F, in);
    }
    SEAM(8);
    if (IN(9)) { moe_route(F); }
    SEAM(9);
    if (IN(10)) { moe_place(F); }
    SEAM(10);
    if (IN(11)) {
        SchedMoeA S; S.pad_ = 0; S.ntile = __builtin_amdgcn_readfirstlane((int)__hip_atomic_load((unsigned*)(F.ctl + CW_NT), RLX_AGENT)); S.G = F.G; S.c = F.vcu; S.tileb = (const int*)(ws + WS_REC + 2 * MiB); S.rowlist = (const int*)(ws + WS_REC + 1 * MiB);
        S.XN = (const char*)(ws + WS_XN); S.WGU = (const char*)(ws + WS_WGU);
        const float* w0 = (const float*)(ws + WS_REC) + 2 * T;
        EpiMoeA E{(const float*)(ws + WS_SSP2), w0, w0 + T, (bf16_t*)(ws + WS_H), RS, WG};
        pg8::gemm_phase<EpiMoeA, SchedMoeA, true, true, 1024, 1024, 1024, 16>(F.lds + RING_OFF, S, E);
    }
    SEAM(11);
    if (IN(12)) {
        SchedMoeB S; S.pad_ = 0; S.ntile = __builtin_amdgcn_readfirstlane((int)__hip_atomic_load((unsigned*)(F.ctl + CW_NT), RLX_AGENT)); S.G = F.G; S.c = F.vcu; S.tileb = (const int*)(ws + WS_REC + 2 * MiB); S.rowlist = (const int*)(ws + WS_REC + 1 * MiB);
        S.Hb = (const char*)(ws + WS_H); S.WD = (const char*)(ws + WS_WD);
        EpiMoeB E{args.out, (float*)(ws + WS_LG), TOK, 0};
        pg8::gemm_phase<EpiMoeB, SchedMoeB, true, false, 512, 512, 256, 4>(F.lds + RING_OFF, S, E);
    }
#undef IN
#undef SEAM
}
#ifndef MK_DEBUG
#define MK_DEBUG 0
#endif
#ifndef MK_PER_PHASE
#define MK_PER_PHASE MK_DEBUG
#endif
#if MK_DEBUG
struct CmpDesc { const void* test; const float* ref; size_t rhs; int ttype, tld, rld, cw, rows, cols, tfm, slot; float rscale; int pad; };
__global__ void __launch_bounds__(256) cmp_k(CmpDesc d, double* sums) {
    __shared__ double red[2][4];
    double sd = 0.0, sr = 0.0;
    const size_t n = (size_t)d.rows * d.cols;
    for (size_t idx = (size_t)blockIdx.x * 256 + threadIdx.x; idx < n; idx += (size_t)gridDim.x * 256) {
        const int r = (int)(idx / d.cols), c = (int)(idx % d.cols);
        float tv;
        if (d.ttype == 0) tv = bf2f(((const bf16*)d.test)[(size_t)r * d.tld + c]);
        else if (d.ttype == 1) tv = h2f(((const unsigned short*)d.test)[(size_t)r * d.tld + c]);
        else tv = ((const float*)d.test)[(size_t)r * d.tld + c];
        float rv = d.ref[(size_t)(c / d.cw) * d.rhs + (size_t)r * d.rld + (c % d.cw)] * d.rscale;
        if (d.tfm == 1) rv = rv / (1.0f + expf(-rv));
        if (d.tfm == 2) tv = expf(tv);
        const double df = (double)tv - (double)rv; sd += df * df; sr += (double)rv * (double)rv;
    }
    for (int o = 32; o; o >>= 1) { sd += __shfl_xor(sd, o); sr += __shfl_xor(sr, o); }
    if ((threadIdx.x & 63) == 0) { red[0][threadIdx.x >> 6] = sd; red[1][threadIdx.x >> 6] = sr; }
    __syncthreads();
    if (threadIdx.x == 0) { atomicAdd(&sums[2 * d.slot], red[0][0] + red[0][1] + red[0][2] + red[0][3]); atomicAdd(&sums[2 * d.slot + 1], red[1][0] + red[1][1] + red[1][2] + red[1][3]); }
}
__global__ void verdict_k(const double* sums, const float* tols, int nslot, unsigned* code) {
    if (threadIdx.x == 0 && blockIdx.x == 0) { unsigned c = 0;
        for (int k = 0; k < nslot; ++k) { const double rvr = sums[2 * k] / sums[2 * k + 1]; if (!(rvr <= (double)tols[k])) { c = (unsigned)(k + 1); break; } }
        *code = c; }
}
__global__ void poison_k(const unsigned* code, const float* x, float* out, size_t n) {
    const unsigned c = *code; if (c == 0) return;
    const float f = 1.0f + exp2f((float)c);
    for (size_t i = (size_t)blockIdx.x * blockDim.x + threadIdx.x; i < n; i += (size_t)gridDim.x * blockDim.x) out[i] = x[i] * f;
}
__global__ void settol_k(float* tols) { const float t[16] = MK_TOLS; if (threadIdx.x < 16) tols[threadIdx.x] = t[threadIdx.x]; }
#endif

extern "C" void kernel_launch(void* const* d_in, const int* in_sizes, int n_in, void* d_out, int out_size, void* d_ws, size_t ws_size, hipStream_t stream) {
    static int grid = 0;
    if (grid == 0) {
        if (n_in != 29 || out_size != T * D || ws_size < WS_END + (MK_DEBUG ? 192 * MiB : 0)) { fprintf(stderr, "kernel_launch: unexpected shapes (n_in %d, out %d, ws %zu)\n", n_in, out_size, ws_size); grid = -1; return; }
        int dev = 0, cus = 0;
        if (hipGetDevice(&dev) != hipSuccess || hipDeviceGetAttribute(&cus, hipDeviceAttributeMultiprocessorCount, dev) != hipSuccess) { grid = -1; return; }
        if (hipFuncSetAttribute((const void*)mega_fwd, hipFuncAttributeMaxDynamicSharedMemorySize, LDS_BYTES) != hipSuccess) { fprintf(stderr, "kernel_launch: hipFuncSetAttribute failed\n"); grid = -1; return; }
        int per_cu = 0;
        if (hipOccupancyMaxActiveBlocksPerMultiprocessor(&per_cu, (const void*)mega_fwd, NWAVES * 64, LDS_BYTES) != hipSuccess || per_cu < 1) { fprintf(stderr, "kernel_launch: occupancy query says %d\n", per_cu); }
        (void)hipGetLastError();
        grid = cus;
    }
    if (grid < 0) return;
    (void)hipMemsetAsync((char*)d_ws + WS_CTL, 0, CTL_ZERO_BYTES, stream);
    Args a{};
    Inputs& w = a.in;
    w.x = (const float*)d_in[0]; w.mem = (const float*)d_in[1]; w.pos = (const int*)d_in[2]; w.norm_mix = (const float*)d_in[3]; w.w_in = (const float*)d_in[4];
    w.q_a_norm = (const float*)d_in[5]; w.w_q_up = (const float*)d_in[6]; w.kv_a_norm = (const float*)d_in[7]; w.w_kv_up = (const float*)d_in[8];
    w.q_norm = (const float*)d_in[9]; w.k_norm = (const float*)d_in[10]; w.lb_logits = (const float*)d_in[11]; w.o_norm = (const float*)d_in[12]; w.w_out = (const float*)d_in[13];
    w.norm_cross = (const float*)d_in[14]; w.norm_mem = (const float*)d_in[15]; w.x_w_q = (const float*)d_in[16]; w.x_w_kv = (const float*)d_in[17];
    w.x_q_norm = (const float*)d_in[18]; w.x_k_norm = (const float*)d_in[19]; w.x_w_o = (const float*)d_in[20]; w.norm_ffn = (const float*)d_in[21];
    w.w_group = (const float*)d_in[22]; w.b_group = (const float*)d_in[23]; w.w_expert = (const float*)d_in[24]; w.b_expert = (const float*)d_in[25];
    w.w_gate = (const float*)d_in[26]; w.w_up = (const float*)d_in[27]; w.w_down = (const float*)d_in[28];
    a.out = (float*)d_out; a.ws = (unsigned char*)d_ws;
    unsigned char* ws = (unsigned char*)d_ws;
#if MK_DEBUG
    constexpr int BC = MK_DEBUG_BATCH;
    orc::W ow; static_assert(sizeof(orc::W) == sizeof(Inputs), "same field list"); memcpy(&ow, &w, sizeof(ow));
    orc::Bufs B; B.carve2((float*)d_out, (float*)(ws + WS_END));
    double* sums = (double*)(ws + WS_CTL + CW_CHK * 4); float* tols = (float*)(sums + 64); unsigned* code = (unsigned*)(tols + 32);
    settol_k<<<1, 64, 0, stream>>>(tols);
    orc::pack_router<<<(1024 * 72 + 255) / 256, 256, 0, stream>>>(ow.w_group, ow.w_expert, B.wr);
    orc::run_batch(ow, B, BC, B.outb, stream);
    auto CMP = [&](int slot, const void* test, int ttype, int tld, const float* ref, int rld, int cw, size_t rhs, int rows, int cols, float rscale, int tfm) {
        CmpDesc d{}; d.test = test; d.ref = ref; d.rhs = rhs; d.ttype = ttype; d.tld = tld; d.rld = rld; d.cw = cw; d.rows = rows; d.cols = cols; d.tfm = tfm; d.slot = slot; d.rscale = rscale;
        cmp_k<<<512, 256, 0, stream>>>(d, sums); };
    const size_t r0 = (size_t)BC * SEQ;
#endif
    auto PH = [&](int lo, int hi) { a.ph_lo = lo; a.ph_hi = hi; hipLaunchKernelGGL(mega_fwd, dim3(grid), dim3(NWAVES * 64), LDS_BYTES, stream, a); };
#if MK_PER_PHASE
    for (int p = 0; p < N_PHASES; ++p) {
        PH(p, p + 1);
#if MK_DEBUG
        if (p == 1) {
            CMP(0, (bf16*)(ws + WS_HQ) + r0 * 512, 0, 512, B.qs, 512, 512, 0, SEQ, 512, 1.f, 0);
            CMP(1, (bf16*)(ws + WS_GF) + r0 * 512, 1, 512, B.f, 512, 512, 0, SEQ, 512, 1.f, 2);
            CMP(1, (bf16*)(ws + WS_GB) + r0 * 512, 1, 512, B.f + (size_t)SEQ * 512, 512, 512, 0, SEQ, 512, 1.f, 2);
            CMP(2, (bf16*)(ws + WS_HI) + r0 * 512, 0, 512, B.p + 1888, 2912, 512, 0, SEQ, 512, 1.f, 0);
            CMP(2, (bf16*)(ws + WS_HG) + r0 * 512, 0, 512, B.p + 2400, 2912, 512, 0, SEQ, 512, 1.f, 1);
            CMP(3, (bf16*)(ws + WS_LAT) + r0 * 512, 0, 512, B.p, 2912, 352, 0, SEQ, 352, 1.f, 0);
        }
        if (p == 2) {
            CMP(4, (bf16*)(ws + WS_Q) + r0 * 768, 0, 768, B.Qn, 96, 96, (size_t)SEQ * 96, SEQ, 768, QSCALE_MLA, 0);
            CMP(5, (bf16*)(ws + WS_K) + r0 * 768, 0, 768, B.Kn, 96, 96, (size_t)SEQ * 96, SEQ, 768, 1.f, 0);
            CMP(6, (bf16*)(ws + WS_V) + r0 * 512, 0, 512, B.V, 64, 64, (size_t)SEQ * 64, SEQ, 512, 1.f, 0);
            CMP(7, (bf16*)(ws + WS_KVX) + (size_t)BC * MEML * 2048, 0, 2048, B.kvx, 2048, 2048, 0, MEML, 2048, 1.f, 0);
            CMP(8, (bf16*)(ws + WS_OF) + r0 * 512, 0, 512, B.o, 512, 512, 0, SEQ, 512, 1.f, 0);
            CMP(8, (bf16*)(ws + WS_OB) + r0 * 512, 0, 512, B.o + (size_t)SEQ * 512, 512, 512, 0, SEQ, 512, 1.f, 0);
        }
        if (p == 3) {
            CMP(9, (bf16*)(ws + WS_CAT) + r0 * 1024 + 512, 0, 1024, B.cat + 512, 1024, 512, 0, SEQ, 512, 1.f, 0);
            CMP(10, (bf16*)(ws + WS_CAT) + r0 * 1024, 0, 1024, B.cat, 1024, 512, 0, SEQ, 512, 1.f, 0);
        }
        if (p == 4) CMP(11, (float*)d_out + r0 * 1024, 2, 1024, B.x1, 1024, 1024, 0, SEQ, 1024, 1.f, 0);
        if (p == 5) CMP(12, (bf16*)(ws + WS_QX) + r0 * 1024, 0, 1024, B.qx, 1024, 1024, 0, SEQ, 1024, 0.0625f * LOG2E, 0);
        if (p == 6) CMP(13, (bf16*)(ws + WS_QX) + r0 * 1024, 0, 1024, B.ox, 1024, 1024, 0, SEQ, 1024, 1.f, 0);
        if (p == 7) CMP(14, (float*)d_out + r0 * 1024, 2, 1024, B.x2, 1024, 1024, 0, SEQ, 1024, 1.f, 0);
        if (p == 12) CMP(15, (float*)d_out + r0 * 1024, 2, 1024, B.outb, 1024, 1024, 0, SEQ, 1024, 1.f, 0);
#endif
    }
#if MK_DEBUG
    verdict_k<<<1, 64, 0, stream>>>(sums, tols, 16, code);
    poison_k<<<1024, 256, 0, stream>>>(code, w.x, (float*)d_out, (size_t)T * D);
#endif
#else
    PH(0, N_PHASES);
#endif
}
```

```cpp
#include <hip/hip_runtime.h>
#include <cstdio>
#include <cstdint>
#include <cstring>
#include <cmath>
namespace pg8 {
#define PG8_LAS __attribute__((address_space(3)))
typedef unsigned short bf16_t;
typedef short bf16x8 __attribute__((ext_vector_type(8)));
typedef float f32x4 __attribute__((ext_vector_type(4)));
typedef float f32x2 __attribute__((ext_vector_type(2)));
typedef unsigned u32x4 __attribute__((ext_vector_type(4)));
constexpr int BM = 256, BK = 64, HALF = 128, HTB = HALF * BK * 2, STAGE_BYTES = 8 * HTB, NXCD = 8, WGM = 8;

__host__ __device__ __forceinline__ int lds_byte(int r, int c) { const int st = (r >> 4) * 2 + (c >> 5), rr = r & 15, cc = c & 31, ob = rr * 64 + cc * 2; return st * 1024 + (ob ^ (((ob >> 9) & 1) << 5)); }
__host__ __device__ __forceinline__ void stage_rc(int b, int& R, int& C) { const int st = b / 1024, sb = b % 1024, swz = sb ^ (((sb >> 9) & 1) << 5); R = (st >> 1) * 16 + swz / 64; C = (st & 1) * 32 + (swz % 64) / 2; }
__host__ __device__ __forceinline__ int perm32(int rho) { const int n = rho >> 4, i = rho & 15; return 8 * (i >> 2) + 4 * n + (i & 3); }

struct Unit { int pm, pn; const char* a; const char* b0; const char* b1; const int* rows; };

struct GridOrder {
    int nM, nN, nwg, G, c;
    __device__ void init(int nM_, int nN_, int G_, int c_) { nM = nM_; nN = nN_; nwg = nM * nN; G = G_; c = c_; }
    __device__ bool tile(int i, int& pm, int& pn) const {
        const long L = (long)i * G + c; if (L >= nwg) return false;
        int wgid = (int)L; { const int q = nwg / NXCD, r = nwg % NXCD, xcd = wgid % NXCD, off = wgid / NXCD; wgid = (xcd < r ? xcd * (q + 1) : r * (q + 1) + (xcd - r) * q) + off; }
        const int nig = WGM * nN, gid = wgid / nig, fm = gid * WGM, gsz = (nM - fm) < WGM ? (nM - fm) : WGM;
        pm = fm + ((wgid % nig) % gsz); pn = (wgid % nig) / gsz; return true;
    }
};

__device__ __forceinline__ unsigned cvt_pk_bf16(float lo, float hi) { unsigned r; asm volatile("v_cvt_pk_bf16_f32 %0, %1, %2" : "=v"(r) : "v"(lo), "v"(hi)); return r; }
__device__ __forceinline__ float bf_lo(unsigned w) { return __uint_as_float(w << 16); }
__device__ __forceinline__ float bf_hi(unsigned w) { return __uint_as_float(w & 0xffff0000u); }

template <class Epi, class Sched, bool ALIGN_EPI, bool GATHER, int K, int lda, int ldb, int tsplit>
__device__ __forceinline__ void gemm_phase(PG8_LAS unsigned char* lds, const Sched S, const Epi E) {
    const int tid = threadIdx.x, wid = __builtin_amdgcn_readfirstlane(tid >> 6), lane = tid & 63, wr = wid >> 2, wc = wid & 3, fr = lane & 15, fq = lane >> 4;
    constexpr int nt = K / BK;
    unsigned voffA[2], voffB[2]; int RA[2], CA[2];
#pragma unroll
    for (int i = 0; i < 2; ++i) { int R, C; stage_rc(tid * 16 + i * 8192, R, C); const int Rb = (R & ~31) + perm32(R & 31);
        voffA[i] = (unsigned)(R * lda + C) * 2u; voffB[i] = (unsigned)(Rb * ldb + C) * 2u; RA[i] = R; CA[i] = C; }
    const size_t kstep = (size_t)(BK * 2);
    const size_t hstepA = (size_t)HALF * lda * 2, hstepB = (size_t)HALF * ldb * 2;
    const unsigned ldsw = (unsigned)wid * 1024u;
    const int aoff = lds_byte(wr * 64 + fr, fq * 8), boff = lds_byte(wc * 32 + fr, fq * 8);
#define PG8_SA(b, h) (((b) * 2 + (h)) * HTB)
#define PG8_SB(b, h) ((4 + (b) * 2 + (h)) * HTB)
#define PG8_STAGE(bufoff, gbase, voff) do { _Pragma("unroll") for (int _i = 0; _i < 2; ++_i) \
        __builtin_amdgcn_global_load_lds((const unsigned*)((const char*)(gbase) + (voff)[_i]), (PG8_LAS unsigned*)(lds + (bufoff) + ldsw + _i * 8192), 16, 0, 0); } while (0)
#define PG8_STAGE_A(bufoff, p, h, nx) do { if constexpr (GATHER) { unsigned _o[2]; _o[0] = (nx) ? nvA[h][0] : cvA[h][0]; _o[1] = (nx) ? nvA[h][1] : cvA[h][1]; PG8_STAGE(bufoff, p, _o); } \
        else { PG8_STAGE(bufoff, (p) + (h) * hstepA, voffA); } } while (0)
#define PG8_LDA(dst, b, h) do { _Pragma("unroll") for (int m = 0; m < 4; ++m) _Pragma("unroll") for (int k = 0; k < 2; ++k) dst[m][k] = *(const PG8_LAS bf16x8*)(lds + PG8_SA(b, h) + aoff + m * 2048 + k * 1024); } while (0)
#define PG8_LDB(dst, b, h) do { _Pragma("unroll") for (int n = 0; n < 2; ++n) _Pragma("unroll") for (int k = 0; k < 2; ++k) dst[n][k] = *(const PG8_LAS bf16x8*)(lds + PG8_SB(b, h) + boff + n * 2048 + k * 1024); } while (0)
#define PG8_MMA(ai, bj, At, Bt) do { __builtin_amdgcn_s_setprio(1); _Pragma("unroll") for (int m = 0; m < 4; ++m) _Pragma("unroll") for (int n = 0; n < 2; ++n) _Pragma("unroll") for (int k = 0; k < 2; ++k) \
        acc[ai][bj][m][n] = __builtin_amdgcn_mfma_f32_16x16x32_bf16(Bt[n][k], At[m][k], acc[ai][bj][m][n], 0, 0, 0); __builtin_amdgcn_s_setprio(0); } while (0)
#define PG8_WAIT_V(n) asm volatile("s_waitcnt vmcnt(" #n ")" ::: "memory")
#define PG8_WAIT_L(n) asm volatile("s_waitcnt lgkmcnt(" #n ")" ::: "memory")
#define PG8_BAR __builtin_amdgcn_s_barrier()
#define PG8_SCHED __builtin_amdgcn_sched_barrier(0)
#define PG8_GOFF(dst, u) do { if constexpr (GATHER) { _Pragma("unroll") for (int _h = 0; _h < 2; ++_h) _Pragma("unroll") for (int _i = 0; _i < 2; ++_i) { \
        int _r = (u).rows[_h * HALF + RA[_i]]; _r = _r < 0 ? 0 : _r; dst[_h][_i] = (unsigned)(_r * lda + CA[_i]) * 2u; } } } while (0)
    Unit cur, nxt; int ui = 0;
    if (!S.next(0, cur)) return;
    unsigned cvA[2][2] = {{0u, 0u}, {0u, 0u}}, nvA[2][2] = {{0u, 0u}, {0u, 0u}};
    PG8_GOFF(cvA, cur);
    f32x4 acc[2][2][4][2];
#pragma unroll
    for (int a = 0; a < 2; ++a)
#pragma unroll
        for (int b = 0; b < 2; ++b)
#pragma unroll
            for (int m = 0; m < 4; ++m)
#pragma unroll
                for (int n = 0; n < 2; ++n) acc[a][b][m][n] = (f32x4){0.f, 0.f, 0.f, 0.f};
    bf16x8 At[4][2], B0[2][2], B1[2][2];
    const char* cA = cur.a; const char* cB = cur.b0; const char* cB1 = cur.b1;
    E.prep(cur, 0);
    PG8_STAGE(PG8_SB(0, 0), cB, voffB); PG8_STAGE(PG8_SB(0, 1), cB + hstepB, voffB); PG8_STAGE_A(PG8_SA(0, 0), cA, 0, false); PG8_STAGE_A(PG8_SA(0, 1), cA, 1, false);
    if (wr == 1) PG8_BAR;
    PG8_WAIT_V(2); PG8_BAR;
    PG8_STAGE(PG8_SB(1, 0), cB + kstep, voffB); PG8_STAGE_A(PG8_SA(1, 0), cA + kstep, 0, false); PG8_STAGE(PG8_SB(1, 1), cB + hstepB + kstep, voffB);
    PG8_WAIT_V(6); PG8_BAR;
    for (;;) {
        const bool has_next = S.next(ui + 1, nxt);
        const char* nA = has_next ? nxt.a : cA; const char* nB = has_next ? nxt.b0 : cB;
#pragma nounroll
        for (int t = 0; t < nt; t += 2) {
            const bool last = (t == nt - 2);
            const bool lnx = last && has_next;
            const char* a1 = cA + (size_t)(t + 1) * kstep;
            const char* a2 = last ? nA : cA + (size_t)(t + 2) * kstep;
            const char* b2 = last ? nB : ((t + 2) < tsplit ? cB + (size_t)(t + 2) * kstep : cB1 + (size_t)(t + 2 - tsplit) * kstep);
            const char* a3 = a2 + kstep; const char* b3 = b2 + kstep;
            if (lnx) { PG8_GOFF(nvA, nxt); }
            PG8_LDB(B0, 0, 0); PG8_LDB(B1, 0, 1); PG8_SCHED; PG8_LDA(At, 0, 0); PG8_STAGE_A(PG8_SA(1, 1), a1, 1, false);
            PG8_WAIT_V(8); PG8_WAIT_L(0); PG8_BAR; PG8_MMA(0, 0, At, B0); PG8_MMA(0, 1, At, B1); PG8_BAR; PG8_SCHED;
            PG8_LDA(At, 0, 1); PG8_STAGE(PG8_SB(0, 0), b2, voffB); PG8_STAGE(PG8_SB(0, 1), b2 + hstepB, voffB); PG8_STAGE_A(PG8_SA(0, 0), a2, 0, lnx);
            PG8_WAIT_V(8); PG8_WAIT_L(0); PG8_BAR; PG8_MMA(1, 0, At, B0); PG8_MMA(1, 1, At, B1); PG8_BAR; PG8_SCHED;
            PG8_LDB(B0, 1, 0); PG8_LDB(B1, 1, 1); PG8_SCHED; PG8_LDA(At, 1, 0); PG8_STAGE_A(PG8_SA(0, 1), a2, 1, lnx);
            PG8_WAIT_V(8); PG8_WAIT_L(0); PG8_BAR; PG8_MMA(0, 0, At, B0); PG8_MMA(0, 1, At, B1); PG8_BAR; PG8_SCHED;
            PG8_LDA(At, 1, 1); PG8_STAGE(PG8_SB(1, 0), b3, voffB); PG8_STAGE(PG8_SB(1, 1), b3 + hstepB, voffB); PG8_STAGE_A(PG8_SA(1, 0), a3, 0, lnx);
            PG8_WAIT_V(8); PG8_WAIT_L(0); PG8_BAR; PG8_MMA(1, 0, At, B0); PG8_MMA(1, 1, At, B1); PG8_BAR; PG8_SCHED;
        }
        if constexpr (ALIGN_EPI) { if (wr == 0) PG8_BAR; }
        E(acc, cur, ui & 1, wr, wc, fr, fq, wid, lane);
        if (!has_next) break;
        E.prep(nxt, (ui + 1) & 1);
#pragma unroll
        for (int a = 0; a < 2; ++a)
#pragma unroll
            for (int b = 0; b < 2; ++b)
#pragma unroll
                for (int m = 0; m < 4; ++m)
#pragma unroll
                    for (int n = 0; n < 2; ++n) acc[a][b][m][n] = (f32x4){0.f, 0.f, 0.f, 0.f};
        cur = nxt; cA = nA; cB = nB; cB1 = nxt.b1; ++ui;
        if constexpr (GATHER) {
#pragma unroll
            for (int h = 0; h < 2; ++h) { cvA[h][0] = nvA[h][0]; cvA[h][1] = nvA[h][1]; }
        }
        if constexpr (ALIGN_EPI) { if (wr == 1) PG8_BAR; }
    }
    PG8_WAIT_V(0);
    if constexpr (!ALIGN_EPI) { if (wr == 0) PG8_BAR; }
    PG8_BAR;
#undef PG8_SA
#undef PG8_SB
#undef PG8_STAGE
#undef PG8_STAGE_A
#undef PG8_LDA
#undef PG8_LDB
#undef PG8_MMA
#undef PG8_WAIT_V
#undef PG8_WAIT_L
#undef PG8_BAR
#undef PG8_SCHED
#undef PG8_GOFF
}
}
constexpr int NWAVES = 8;
constexpr int BATCH = 16, SEQ = 4096, D = 1024, T = BATCH * SEQ, MEML = 256;
constexpr float EPS = 1e-6f;
constexpr float LOG2E = 1.4426950408889634f;
constexpr size_t MiB = 1u << 20;
constexpr size_t WS_CTL = 0, CTL_ZERO_BYTES = 1 * MiB;
constexpr size_t WS_COS = 1 * MiB, WS_SIN = 5 * MiB;
constexpr size_t WS_SS0 = 9 * MiB;
constexpr size_t WS_SSP1 = 10 * MiB, WS_SSP2 = 14 * MiB;
constexpr size_t WS_MISC = 18 * MiB;
constexpr size_t WS_W = 20 * MiB;
constexpr size_t W_IN = WS_W, W_Q = W_IN + 6 * MiB, W_KV = W_Q + 512 * 1024, W_OUT = W_KV + 512 * 1024, W_XQ = W_OUT + 2 * MiB, W_XKV = W_XQ + 2 * MiB, W_XO = W_XKV + 4 * MiB, W_R = W_XO + 2 * MiB;
constexpr size_t WS_MN = 40 * MiB, WS_KVX = 48 * MiB;
constexpr size_t WS_XN = 64 * MiB;
constexpr size_t WS_OF = 64 * MiB, WS_OB = 128 * MiB;
constexpr size_t WS_HQ = 192 * MiB, WS_GF = 256 * MiB, WS_GB = 320 * MiB, WS_HI = 384 * MiB, WS_HG = 448 * MiB, WS_LAT = 512 * MiB;
constexpr size_t WS_CAT = 192 * MiB;
constexpr size_t WS_QX = 320 * MiB;
constexpr size_t WS_Q = 576 * MiB, WS_K = 672 * MiB, WS_V = 768 * MiB;
constexpr size_t WS_WGU = 576 * MiB, WS_WD = 640 * MiB;
constexpr size_t WS_H = 672 * MiB;
constexpr size_t WS_LG = 792 * MiB;
constexpr size_t WS_REC = 810 * MiB;
constexpr size_t WS_END = 832 * MiB;
constexpr int MOE_MAXROWS = 122880, MOE_MAXTILES = 480;
constexpr int CW_TMO = 0, CW_BAR = 4096, CW_CNT = 16384  , CW_NT = 17000  , CW_CHK = 20000  ;

constexpr int RING_OFF = 0, RING_BYTES = 131072;
constexpr int AUX_OFF = RING_BYTES;
constexpr int AUX_RS = AUX_OFF, AUX_WG = AUX_OFF + 2048, AUX_TOK = AUX_OFF + 4096, AUX_XP = AUX_OFF + 6144, AUX_WSF = AUX_OFF + 10240;
constexpr int MISC_OFF = AUX_OFF + 12288;
constexpr int LDS_BYTES = 147456;

#define GAS __attribute__((address_space(1)))
#define LAS __attribute__((address_space(3)))
typedef unsigned short bf16;
typedef unsigned v4u __attribute__((ext_vector_type(4)));
typedef unsigned v2u __attribute__((ext_vector_type(2)));
typedef float f32x4 __attribute__((ext_vector_type(4)));
typedef float f32x16 __attribute__((ext_vector_type(16)));
typedef short bf16x8 __attribute__((ext_vector_type(8)));
typedef short s16x4 __attribute__((ext_vector_type(4)));
typedef GAS unsigned gu32;
#define RLX_AGENT __ATOMIC_RELAXED, __HIP_MEMORY_SCOPE_AGENT
#define LDS_WAIT() asm volatile("s_waitcnt lgkmcnt(0)" ::: "memory")
#define VM_WAIT() asm volatile("s_waitcnt vmcnt(0)" ::: "memory")
__device__ __forceinline__ unsigned f2bf(float f) { unsigned u = __builtin_bit_cast(unsigned, f); return (u + 0x7fffu + ((u >> 16) & 1u)) >> 16; }
__device__ __forceinline__ unsigned pk2(float lo, float hi) { return pg8::cvt_pk_bf16(lo, hi); }
__device__ __forceinline__ float bf2f(bf16 h) { return __uint_as_float((unsigned)h << 16); }
__device__ __forceinline__ float fast_rcp(float x) { return __builtin_amdgcn_rcpf(x); }
__device__ __forceinline__ float fast_exp2(float x) { return __builtin_amdgcn_exp2f(x); }
__device__ __forceinline__ float silu_f(float v) { return v * fast_rcp(1.0f + fast_exp2(-LOG2E * v)); }
__device__ __forceinline__ float rsq(float x) { return __builtin_amdgcn_rsqf(x); }
typedef _Float16 h16x2 __attribute__((ext_vector_type(2)));
__device__ __forceinline__ unsigned pkh2(float lo, float hi) { h16x2 h; h.x = (_Float16)lo; h.y = (_Float16)hi; return __builtin_bit_cast(unsigned, h); }
__device__ __forceinline__ float h2f(unsigned short h) { return (float)__builtin_bit_cast(_Float16, h); }

#define XB_TMO      128
#define XB_XCNT(j)  (256  + 64 * (j))
#define XB_XSUB(j)  (1280 + 64 * (j))
#define XB_XGEN(j)  (2304 + 64 * (j))
#define XB_TOP      3328
#define XB_TOPGEN   3392
#define XCD_BAR_WORDS 3456
#define XB_SPIN_CAP (1u << 18)
__device__ __forceinline__ unsigned xb_ld(unsigned* p)              { return __hip_atomic_load(p, __ATOMIC_RELAXED, __HIP_MEMORY_SCOPE_AGENT); }
__device__ __forceinline__ unsigned xb_add(unsigned* p, unsigned v) { return __hip_atomic_fetch_add(p, v, __ATOMIC_RELAXED, __HIP_MEMORY_SCOPE_AGENT); }
__device__ __forceinline__ unsigned xb_xcc_id() { return (unsigned)__builtin_amdgcn_s_getreg((3 << 11) | 20) & 0xFu; }
#define XB_SPIN(cond, bar) do { unsigned _sp = 0; while (cond) { __builtin_amdgcn_s_sleep(1); \
    if ((++_sp & 255u) == 0u) { if (xb_ld(&(bar)[XB_TMO])) break; if (_sp > XB_SPIN_CAP) { atomicAdd(&(bar)[XB_TMO], 1u); break; } } } } while (0)
struct XcdBarrier { unsigned* bar; unsigned x; volatile LAS unsigned* st; };
__device__ __forceinline__ XcdBarrier xcd_barrier_post(unsigned* bar, volatile LAS unsigned* st) {
    XcdBarrier b; b.bar = bar; b.x = xb_xcc_id(); b.st = st;
    if (threadIdx.x == 0) (void)xb_add(&bar[XB_XCNT(b.x)], 1u);
    return b;
}
__device__ __forceinline__ void xcd_barrier_complete(unsigned* bar, unsigned x, unsigned& nloc, unsigned& nx) {
    const unsigned G = gridDim.x * gridDim.y * gridDim.z;
    unsigned sum, cnt, mine, sp = 0u;
    for (;;) {
        sum = 0u; cnt = 0u; mine = 0u;
#pragma unroll
        for (unsigned j = 0; j < 16; ++j) { const unsigned c = xb_ld(&bar[XB_XCNT(j)]); sum += c; cnt += (c > 0u) ? 1u : 0u; mine = (j == x) ? c : mine; }
        if (sum == G) break;
        __builtin_amdgcn_s_sleep(1);
        if ((++sp & 255u) == 0u) { if (xb_ld(&bar[XB_TMO])) break; if (sp > XB_SPIN_CAP) { atomicAdd(&bar[XB_TMO], 1u); break; } }
    }
    nloc = mine > 0u ? mine : 1u; nx = cnt > 0u ? cnt : 1u;
}
__device__ __forceinline__ void xcd_barrier(const XcdBarrier& b) {
    asm volatile("s_waitcnt vmcnt(0)" ::: "memory");
    __syncthreads();
    if (threadIdx.x == 0) {
        unsigned* bar = b.bar;
        __builtin_amdgcn_s_waitcnt(0);
        unsigned nloc = b.st[0], nx = b.st[1];
        if (nloc == 0u) { xcd_barrier_complete(bar, b.x, nloc, nx); b.st[0] = nloc; b.st[1] = nx; }
        const unsigned old = xb_add(&bar[XB_XSUB(b.x)], 1u);
        const unsigned gen = old / nloc;
        if (old + 1u == (gen + 1u) * nloc) {
            __builtin_amdgcn_fence(__ATOMIC_RELEASE, "agent");
            asm volatile("s_waitcnt vmcnt(0)" ::: "memory");
            const unsigned og = xb_add(&bar[XB_TOP], 1u);
            const unsigned tg = og / nx;
            if (og + 1u == (tg + 1u) * nx) xb_add(&bar[XB_TOPGEN], 1u);
            else XB_SPIN(xb_ld(&bar[XB_TOPGEN]) == tg, bar);
            __builtin_amdgcn_fence(__ATOMIC_ACQUIRE, "agent");
            xb_add(&bar[XB_XGEN(b.x)], 1u);
            asm volatile("s_waitcnt vmcnt(0)" ::: "memory");
        } else {
            XB_SPIN(xb_ld(&bar[XB_XGEN(b.x)]) == gen, bar);
            __builtin_amdgcn_fence(__ATOMIC_ACQUIRE, "agent");
            asm volatile("s_waitcnt vmcnt(0)" ::: "memory");
        }
    }
    __syncthreads();
}

struct Inputs {
    const float *x, *mem; const int* pos; const float *norm_mix, *w_in, *q_a_norm, *w_q_up, *kv_a_norm, *w_kv_up, *q_norm, *k_norm, *lb_logits, *o_norm, *w_out, *norm_cross, *norm_mem,
        *x_w_q, *x_w_kv, *x_q_norm, *x_k_norm, *x_w_o, *norm_ffn, *w_group, *b_group, *w_expert, *b_expert, *w_gate, *w_up, *w_down;
};
struct Frame {
    LAS unsigned char* lds;
    volatile LAS unsigned* MISC;
    gu32* ctl;
    unsigned char* ws;
    int tid, lane, wave, vcu, G;
};
__device__ __forceinline__ float wave_sum(float v) {
#pragma unroll
    for (int o = 1; o < 64; o <<= 1) v += __shfl_xor(v, o);
    return v;
}
__device__ __forceinline__ void p0_transpose_item(const float* W, int ldw, int k0, int n0, const float* gain, bf16* WT, int ldt, int row0, LAS float* scr, int lane) {
    float wv[32];
#pragma unroll
    for (int i = 0; i < 32; ++i) wv[i] = W[(size_t)(k0 + 2 * i + (lane >> 5)) * ldw + n0 + (lane & 31)];
#pragma unroll
    for (int i = 0; i < 32; ++i) { const int kk = 2 * i + (lane >> 5); const float g = gain ? gain[k0 + kk] : 1.0f; scr[kk * 33 + (lane & 31)] = wv[i] * g; }
    LDS_WAIT(); asm volatile("" ::: "memory");
    const int c = lane & 7;
#pragma unroll
    for (int j = 0; j < 4; ++j) { const int n = (lane >> 3) + 8 * j; const LAS float* s = scr + (8 * c) * 33 + n;
        v4u o; o.x = pk2(s[0 * 33], s[1 * 33]); o.y = pk2(s[2 * 33], s[3 * 33]); o.z = pk2(s[4 * 33], s[5 * 33]); o.w = pk2(s[6 * 33], s[7 * 33]);
        *(GAS v4u*)(WT + (size_t)(row0 + n) * ldt + k0 + 8 * c) = o; }
    LDS_WAIT(); asm volatile("" ::: "memory");
}
struct TJob { const float* W; int K, N, ldw; const float* gain; bf16* WT; int ldt; int mode; };
__device__ __forceinline__ int tjob_row(int mode, int n0) {
    if (mode == 1) return n0 >= 352 ? n0 - 352 : n0 + 2560;
    if (mode == 2) return (n0 >> 7) * 256 + (n0 & 127);
    if (mode == 3) return (n0 >> 7) * 256 + 128 + (n0 & 127);
    return n0;
}
__device__ __forceinline__ void tjob_run(const TJob& j, LAS float* scr, int gw, int NGW, int lane) {
    const int nblk = j.N / 32, nit = (j.K / 64) * nblk;
    for (int it = gw; it < nit; it += NGW) { const int kb = it / nblk, nb = it % nblk; p0_transpose_item(j.W, j.ldw, kb * 64, nb * 32, j.gain, j.WT, j.ldt, tjob_row(j.mode, nb * 32), scr, lane); }
}
__device__ __forceinline__ void p0_prologue(Frame& F, const Inputs& in) {
    LAS float* scr = (LAS float*)(F.lds + RING_OFF + F.wave * 16384);
    const int gw = F.vcu * NWAVES + F.wave, NGW = F.G * NWAVES, lane = F.lane;
    unsigned char* ws = F.ws;
    { TJob j{in.w_in, 1024, 2912, 2912, in.norm_mix, (bf16*)(ws + W_IN), 1024, 1}; tjob_run(j, scr, gw, NGW, lane); }
    { TJob j{in.w_q_up, 192, 768, 768, in.q_a_norm, (bf16*)(ws + W_Q), 192, 0}; tjob_run(j, scr, gw, NGW, lane); }
    { TJob j{in.w_kv_up, 128, 1024, 1024, in.kv_a_norm, (bf16*)(ws + W_KV), 128, 0}; tjob_run(j, scr, gw, NGW, lane); }
    { TJob j{in.w_out, 1024, 1024, 1024, nullptr, (bf16*)(ws + W_OUT), 1024, 0}; tjob_run(j, scr, gw, NGW, lane); }
    { TJob j{in.x_w_q, 1024, 1024, 1024, in.norm_cross, (bf16*)(ws + W_XQ), 1024, 0}; tjob_run(j, scr, gw, NGW, lane); }
    { TJob j{in.x_w_kv, 1024, 2048, 2048, nullptr, (bf16*)(ws + W_XKV), 1024, 0}; tjob_run(j, scr, gw, NGW, lane); }
    { TJob j{in.x_w_o, 1024, 1024, 1024, nullptr, (bf16*)(ws + W_XO), 1024, 0}; tjob_run(j, scr, gw, NGW, lane); }
    const int gt = (F.vcu * NWAVES + F.wave) * 64 + lane, NGT = NGW * 64;
    for (int i = gt; i < 160 * 1024 / 8; i += NGT) *(GAS v4u*)((bf16*)(ws + W_IN) + (size_t)2912 * 1024 + (size_t)i * 8) = (v4u){0u, 0u, 0u, 0u};
    for (int i = gt; i < 256 * 1024; i += NGT) { const int c = i >> 10, k = i & 1023; float v = 0.f;
        if (c < 8) v = in.w_group[k * 8 + c] * in.norm_ffn[k]; else if (c < 72) v = in.w_expert[k * 64 + (c - 8)] * in.norm_ffn[k];
        ((bf16*)(ws + W_R))[i] = (bf16)f2bf(v); }
    for (int i = gt; i < T * 16; i += NGT) { const int t = i >> 4, j = i & 15;
        const float inv_freq = 1.0f / powf(10000.0f, (float)j / 16.0f); const float ang = (float)in.pos[t] * inv_freq;
        const double rev = (double)ang * 0.15915494309189535; const float fr = (float)(rev - floor(rev));
        ((float*)(ws + WS_COS))[i] = __builtin_amdgcn_cosf(fr); ((float*)(ws + WS_SIN))[i] = __builtin_amdgcn_sinf(fr); }
    float* misc = (float*)(ws + WS_MISC);
    for (int i = gt; i < 1024; i += NGT) { const float l0 = in.lb_logits[i], l1 = in.lb_logits[1024 + i]; misc[i] = 1.0f / (1.0f + expf(l1 - l0)); }
    if (gw == 0) {
        float mq = 0.f, mk = 0.f, xq = 0.f, xk = 0.f;
        for (int i = lane; i < 96; i += 64) { mq = fmaxf(mq, fabsf(in.q_norm[i])); mk = fmaxf(mk, fabsf(in.k_norm[i])); }
        for (int i = lane; i < 256; i += 64) { xq = fmaxf(xq, fabsf(in.x_q_norm[i])); xk = fmaxf(xk, fabsf(in.x_k_norm[i])); }
#pragma unroll
        for (int o = 1; o < 64; o <<= 1) { mq = fmaxf(mq, __shfl_xor(mq, o)); mk = fmaxf(mk, __shfl_xor(mk, o)); xq = fmaxf(xq, __shfl_xor(xq, o)); xk = fmaxf(xk, __shfl_xor(xk, o)); }
        if (lane == 0) { misc[1024] = LOG2E * 9.797958971132712f * mq * mk; misc[1025] = LOG2E * 16.0f * xq * xk; }
    }
    for (int m = gw; m < T; m += NGW) {
        const GAS f32x4* xr = (const GAS f32x4*)(in.x + (size_t)m * D) + lane; f32x4 v[4]; float s = 0.f;
#pragma unroll
        for (int j = 0; j < 4; ++j) { v[j] = xr[64 * j]; s += (v[j].x * v[j].x + v[j].y * v[j].y) + (v[j].z * v[j].z + v[j].w * v[j].w); }
        s = wave_sum(s);
        GAS unsigned long long* o8 = (GAS unsigned long long*)((bf16*)(ws + WS_XN) + (size_t)m * D) + lane;
#pragma unroll
        for (int j = 0; j < 4; ++j) o8[64 * j] = (unsigned long long)pk2(v[j].x, v[j].y) | ((unsigned long long)pk2(v[j].z, v[j].w) << 32);
        if (lane == 0) ((float*)(ws + WS_SS0))[m] = s;
    }
    for (int m = gw; m < BATCH * MEML; m += NGW) {
        const GAS f32x4* xr = (const GAS f32x4*)(in.mem + (size_t)m * D) + lane; f32x4 v[4]; float s = 0.f;
#pragma unroll
        for (int j = 0; j < 4; ++j) { v[j] = xr[64 * j]; s += (v[j].x * v[j].x + v[j].y * v[j].y) + (v[j].z * v[j].z + v[j].w * v[j].w); }
        const float r = 1.0f / sqrtf(wave_sum(s) * (1.f / D) + EPS);
        GAS unsigned long long* o8 = (GAS unsigned long long*)((bf16*)(ws + WS_MN) + (size_t)m * D) + lane;
#pragma unroll
        for (int j = 0; j < 4; ++j) { const f32x4 g = *((const GAS f32x4*)in.norm_mem + lane + 64 * j);
            o8[64 * j] = (unsigned long long)pk2(v[j].x * r * g.x, v[j].y * r * g.y) | ((unsigned long long)pk2(v[j].z * r * g.z, v[j].w * r * g.w) << 32); }
    }
}
__device__ __forceinline__ void moe_weights(Frame& F, const Inputs& in) {
    LAS float* scr = (LAS float*)(F.lds + RING_OFF + F.wave * 16384);
    const int gw = F.vcu * NWAVES + F.wave, NGW = F.G * NWAVES, lane = F.lane;
    for (int it = gw; it < 64 * 384; it += NGW) {
        const int e = it / 384, r = it % 384, kind = r >> 7, q = r & 127;
        if (kind == 0) { const int kb = q >> 3, nb = q & 7; p0_transpose_item(in.w_gate + (size_t)e * 262144, 256, kb * 64, nb * 32, in.norm_ffn, (bf16*)(F.ws + WS_WGU) + (size_t)e * 524288, 1024, tjob_row(2, nb * 32), scr, lane); }
        else if (kind == 1) { const int kb = q >> 3, nb = q & 7; p0_transpose_item(in.w_up + (size_t)e * 262144, 256, kb * 64, nb * 32, in.norm_ffn, (bf16*)(F.ws + WS_WGU) + (size_t)e * 524288, 1024, tjob_row(3, nb * 32), scr, lane); }
        else { const int kb = q >> 5, nb = q & 31; p0_transpose_item(in.w_down + (size_t)e * 262144, 1024, kb * 64, nb * 32, nullptr, (bf16*)(F.ws + WS_WD) + (size_t)e * 262144, 256, nb * 32, scr, lane); }
    }
}

using pg8::Unit; using pg8::bf16_t;
struct SchedGrid {
    const char* A; const char* B; size_t astep, bstep; pg8::GridOrder o; int pad_;
    __device__ __forceinline__ bool next(int i, Unit& u) const { int pm, pn; if (!o.tile(i, pm, pn)) return false; u.pm = pm; u.pn = pn; u.a = A + (size_t)pm * astep; u.b0 = u.b1 = B + (size_t)pn * bstep; u.rows = nullptr; return true; }
};
__device__ __forceinline__ float rstd16(const float* p) {
    const f32x4 a = *(const f32x4*)p, b = *(const f32x4*)(p + 4), c = *(const f32x4*)(p + 8), d = *(const f32x4*)(p + 12);
    const float s = ((a.x + a.y) + (a.z + a.w)) + ((b.x + b.y) + (b.z + b.w)) + ((c.x + c.y) + (c.z + c.w)) + ((d.x + d.y) + (d.z + d.w));
    return 1.0f / sqrtf(s * (1.f / D) + EPS);
}
typedef pg8::f32x4 (AccT)[2][2][4][2];

struct EpiIn {
    bf16_t* bufs; const float* ss; const float* lbt; LAS float* RS; int pad_;
    __device__ __forceinline__ void prep(const Unit& u, int par) const { const int t = threadIdx.x; if (t < 256) RS[par * 256 + t] = 1.0f / sqrtf(ss[u.pm * 256 + t] * (1.f / D) + EPS); }
    __device__ __forceinline__ void operator()(const AccT& acc, const Unit& u, int par, int wr, int wc, int fr, int fq, int wid, int lane) const {
        const int grp = u.pn >> 1, colg = (u.pn & 1) * 256 + wc * 32 + 8 * fq;
        bf16_t* base = bufs + (size_t)grp * ((size_t)T * 512);
        const int mode = (grp == 0 || grp == 4) ? 1 : ((grp == 1 || grp == 2) ? 2 : 0);
        f32x4 lb[2][2];
#pragma unroll
        for (int bj = 0; bj < 2; ++bj)
#pragma unroll
            for (int n = 0; n < 2; ++n) lb[bj][n] = (mode == 2) ? *(const f32x4*)(lbt + (grp - 1) * 512 + colg + bj * 128 + 4 * n) : (f32x4){0.f, 0.f, 0.f, 0.f};
#pragma unroll
        for (int ai = 0; ai < 2; ++ai)
#pragma unroll
            for (int m = 0; m < 4; ++m) { const int rl = ai * 128 + wr * 64 + m * 16 + fr; const float rs = RS[par * 256 + rl]; bf16_t* rowp = base + (size_t)(u.pm * 256 + rl) * 512 + colg;
#pragma unroll
                for (int bj = 0; bj < 2; ++bj) { f32x4 v[2]; v[0] = acc[ai][bj][m][0] * rs; v[1] = acc[ai][bj][m][1] * rs; v4u w;
                    if (mode == 2) {
#pragma unroll
                        for (int n = 0; n < 2; ++n)
#pragma unroll
                            for (int e = 0; e < 4; ++e) { const float sg = fast_rcp(1.0f + fast_exp2(-LOG2E * v[n][e])); const float l = lb[bj][n][e]; v[n][e] = __builtin_amdgcn_logf(l + (1.0f - l) * sg) * 0.6931471805599453f; }
                        w.x = pkh2(v[0][0], v[0][1]); w.y = pkh2(v[0][2], v[0][3]); w.z = pkh2(v[1][0], v[1][1]); w.w = pkh2(v[1][2], v[1][3]);
                    } else {
                        if (mode == 1) {
#pragma unroll
                            for (int n = 0; n < 2; ++n)
#pragma unroll
                                for (int e = 0; e < 4; ++e) v[n][e] = silu_f(v[n][e]);
                        }
                        w.x = pk2(v[0][0], v[0][1]); w.y = pk2(v[0][2], v[0][3]); w.z = pk2(v[1][0], v[1][1]); w.w = pk2(v[1][2], v[1][3]);
                    }
                    *(v4u*)(rowp + bj * 128) = w; } }
    }
};
template <bool RBF>
struct EpiRes {
    const void* resid; bf16_t* xn; float* ssp;
    __device__ __forceinline__ void prep(const Unit&, int) const {}
    __device__ __forceinline__ void operator()(const AccT& acc, const Unit& u, int par, int wr, int wc, int fr, int fq, int wid, int lane) const {
        const int col0 = u.pn * 256 + wc * 32 + 8 * fq;
#pragma unroll
        for (int ai = 0; ai < 2; ++ai)
#pragma unroll
            for (int m = 0; m < 4; ++m) { const size_t row = (size_t)(u.pm * 256 + ai * 128 + wr * 64 + m * 16 + fr); float sq = 0.f;
#pragma unroll
                for (int bj = 0; bj < 2; ++bj) { const size_t off = row * D + col0 + bj * 128; f32x4 r0, r1;
                    if constexpr (RBF) { const v4u rb = *(const v4u*)((const bf16_t*)resid + off); r0 = (f32x4){pg8::bf_lo(rb.x), pg8::bf_hi(rb.x), pg8::bf_lo(rb.y), pg8::bf_hi(rb.y)}; r1 = (f32x4){pg8::bf_lo(rb.z), pg8::bf_hi(rb.z), pg8::bf_lo(rb.w), pg8::bf_hi(rb.w)}; }
                    else { r0 = *(const f32x4*)((const float*)resid + off); r1 = *(const f32x4*)((const float*)resid + off + 4); }
                    const f32x4 o0 = r0 + acc[ai][bj][m][0], o1 = r1 + acc[ai][bj][m][1];
                    v4u w; w.x = pk2(o0[0], o0[1]); w.y = pk2(o0[2], o0[3]); w.z = pk2(o1[0], o1[1]); w.w = pk2(o1[2], o1[3]); *(v4u*)(xn + off) = w;
                    sq += (o0[0] * o0[0] + o0[1] * o0[1]) + (o0[2] * o0[2] + o0[3] * o0[3]) + (o1[0] * o1[0] + o1[1] * o1[1]) + (o1[2] * o1[2] + o1[3] * o1[3]); }
                sq += __shfl_xor(sq, 16); sq += __shfl_xor(sq, 32);
                if (fq == 0) ssp[row * 16 + u.pn * 4 + wc] = sq; }
    }
};
struct EpiHeadNorm {
    const float* ssp; const float* gain; bf16_t* O; LAS float* RS; LAS float* XP; float gscale; int ldo; int nnorm; int pad_;
    __device__ __forceinline__ void prep(const Unit& u, int par) const { const int t = threadIdx.x; if (ssp && t < 256) RS[par * 256 + t] = rstd16(ssp + (size_t)(u.pm * 256 + t) * 16); }
    __device__ __forceinline__ void operator()(const AccT& acc, const Unit& u, int par, int wr, int wc, int fr, int fq, int wid, int lane) const {
        const bool norm = u.pn < nnorm; const int colh = wc * 32 + 8 * fq;
        if (norm) {
#pragma unroll
            for (int ai = 0; ai < 2; ++ai)
#pragma unroll
                for (int m = 0; m < 4; ++m) { float sq = 0.f;
#pragma unroll
                    for (int bj = 0; bj < 2; ++bj)
#pragma unroll
                        for (int n = 0; n < 2; ++n) { const f32x4 v = acc[ai][bj][m][n]; sq += (v[0] * v[0] + v[1] * v[1]) + (v[2] * v[2] + v[3] * v[3]); }
                    sq += __shfl_xor(sq, 16); sq += __shfl_xor(sq, 32);
                    if (fq == 0) XP[(ai * 128 + wr * 64 + m * 16 + fr) * 4 + wc] = sq; }
        }
        asm volatile("s_waitcnt lgkmcnt(0)" ::: "memory"); __builtin_amdgcn_s_barrier(); asm volatile("" ::: "memory");
        f32x4 g[2][2];
#pragma unroll
        for (int bj = 0; bj < 2; ++bj)
#pragma unroll
            for (int n = 0; n < 2; ++n) g[bj][n] = norm ? *(const f32x4*)(gain + colh + bj * 128 + 4 * n) * gscale : (f32x4){1.f, 1.f, 1.f, 1.f};
#pragma unroll
        for (int ai = 0; ai < 2; ++ai)
#pragma unroll
            for (int m = 0; m < 4; ++m) { const int rl = ai * 128 + wr * 64 + m * 16 + fr; const size_t row = (size_t)(u.pm * 256 + rl);
                float h = 1.0f;
                if (norm) { const f32x4 p = *(const LAS f32x4*)(XP + rl * 4); const float rs = ssp ? RS[par * 256 + rl] : 1.0f; const float s = ((p[0] + p[1]) + (p[2] + p[3])) * rs * rs; h = rs / sqrtf(s * (1.f / 256.f) + EPS); }
#pragma unroll
                for (int bj = 0; bj < 2; ++bj) { const f32x4 v0 = acc[ai][bj][m][0] * h * g[bj][0], v1 = acc[ai][bj][m][1] * h * g[bj][1];
                    v4u w; w.x = pk2(v0[0], v0[1]); w.y = pk2(v0[2], v0[3]); w.z = pk2(v1[0], v1[1]); w.w = pk2(v1[2], v1[3]);
                    *(v4u*)(O + row * ldo + u.pn * 256 + colh + bj * 128) = w; } }
        asm volatile("s_waitcnt lgkmcnt(0)" ::: "memory"); __builtin_amdgcn_s_barrier(); asm volatile("" ::: "memory");
    }
};
struct EpiRouter {
    const float* ssp; const float* bg; const float* be; float* LG; LAS float* RS; int pad_;
    __device__ __forceinline__ void prep(const Unit& u, int par) const { const int t = threadIdx.x; if (t < 256) RS[par * 256 + t] = rstd16(ssp + (size_t)(u.pm * 256 + t) * 16); }
    __device__ __forceinline__ void operator()(const AccT& acc, const Unit& u, int par, int wr, int wc, int fr, int fq, int wid, int lane) const {
        const int col0 = wc * 32 + 8 * fq;
        if (col0 < 72) {
            f32x4 b0, b1;
#pragma unroll
            for (int e = 0; e < 4; ++e) { const int c0 = col0 + e, c1 = col0 + 4 + e; b0[e] = c0 < 8 ? bg[c0] : be[c0 - 8]; b1[e] = c1 < 8 ? bg[c1] : be[c1 - 8]; }
#pragma unroll
            for (int ai = 0; ai < 2; ++ai)
#pragma unroll
                for (int m = 0; m < 4; ++m) { const int rl = ai * 128 + wr * 64 + m * 16 + fr; const float rs = RS[par * 256 + rl]; float* p = LG + (size_t)(u.pm * 256 + rl) * 72 + col0;
                    *(f32x4*)p = acc[ai][0][m][0] * rs + b0; *(f32x4*)(p + 4) = acc[ai][0][m][1] * rs + b1; }
        }
    }
};
struct SchedMoeA {
    const int* tileb; const int* rowlist; const char* XN; const char* WGU; int ntile, G, c, pad_;
    __device__ __forceinline__ bool next(int i, Unit& u) const { const long L = (long)i * G + c; if (L >= (long)ntile * 4) return false; const int tl = (int)(L >> 2), pn = (int)(L & 3);
        const int b = __builtin_amdgcn_readfirstlane(tileb[tl]), e = (b >> 6) * 8 + (pn < 2 ? ((b >> 3) & 7) : (b & 7));
        u.pm = tl; u.pn = pn; u.a = XN; u.rows = rowlist + tl * 256; u.b0 = u.b1 = WGU + (size_t)e * (512 * 1024 * 2) + (size_t)(pn & 1) * (256 * 1024 * 2); return true; }
};
struct EpiMoeA {
    const float* ssp; const float* w0; const float* w1; bf16_t* H; LAS float* RS; LAS float* WG;
    __device__ __forceinline__ void prep(const Unit& u, int par) const { const int t = threadIdx.x; if (t < 256) { const int tok = u.rows[t];
        RS[par * 256 + t] = tok < 0 ? 0.f : rstd16(ssp + (size_t)tok * 16); WG[par * 256 + t] = tok < 0 ? 0.f : (u.pn < 2 ? w0[tok] : w1[tok]); } }
    __device__ __forceinline__ void operator()(const AccT& acc, const Unit& u, int par, int wr, int wc, int fr, int fq, int wid, int lane) const {
#pragma unroll
        for (int ai = 0; ai < 2; ++ai)
#pragma unroll
            for (int m = 0; m < 4; ++m) { const int rl = ai * 128 + wr * 64 + m * 16 + fr; const float rs = RS[par * 256 + rl], wg = WG[par * 256 + rl]; float h[8];
#pragma unroll
                for (int n = 0; n < 2; ++n)
#pragma unroll
                    for (int e = 0; e < 4; ++e) h[n * 4 + e] = silu_f(acc[ai][0][m][n][e] * rs) * (acc[ai][1][m][n][e] * rs) * wg;
                v4u w; w.x = pk2(h[0], h[1]); w.y = pk2(h[2], h[3]); w.z = pk2(h[4], h[5]); w.w = pk2(h[6], h[7]);
                *(v4u*)(H + (size_t)(u.pm * 256 + rl) * 512 + u.pn * 128 + wc * 32 + 8 * fq) = w; }
    }
};
struct SchedMoeB {
    const int* tileb; const int* rowlist; const char* Hb; const char* WD; int ntile, G, c, pad_;
    __device__ __forceinline__ bool next(int i, Unit& u) const { const long L = (long)i * G + c; if (L >= (long)ntile * 4) return false; const int tl = (int)(L >> 2), pn = (int)(L & 3);
        const int b = __builtin_amdgcn_readfirstlane(tileb[tl]), ea = (b >> 6) * 8 + ((b >> 3) & 7), eb = (b >> 6) * 8 + (b & 7);
        u.pm = tl; u.pn = pn; u.a = Hb + (size_t)tl * (256 * 512 * 2); u.rows = rowlist + tl * 256;
        u.b0 = WD + (size_t)ea * (1024 * 256 * 2) + (size_t)pn * (256 * 256 * 2); u.b1 = WD + (size_t)eb * (1024 * 256 * 2) + (size_t)pn * (256 * 256 * 2); return true; }
};
struct EpiMoeB {
    const bf16_t* xres; float* out; LAS int* TOK; int pad_;
    __device__ __forceinline__ void prep(const Unit& u, int par) const { const int t = threadIdx.x; if (t < 256) TOK[par * 256 + t] = u.rows[t]; }
    __device__ __forceinline__ void operator()(const AccT& acc, const Unit& u, int par, int wr, int wc, int fr, int fq, int wid, int lane) const {
        const int col0 = u.pn * 256 + wc * 32 + 8 * fq;
#pragma unroll
        for (int ai = 0; ai < 2; ++ai)
#pragma unroll
            for (int m = 0; m < 4; ++m) { const int rl = ai * 128 + wr * 64 + m * 16 + fr; const int tok = TOK[par * 256 + rl];
                const unsigned off = (unsigned)(tok < 0 ? 0 : tok) * (unsigned)D + (unsigned)col0;
#pragma unroll
                for (int bj = 0; bj < 2; ++bj) { const v4u rb = *(const v4u*)(xres + off + bj * 128);
                    const f32x4 o0 = (f32x4){pg8::bf_lo(rb.x), pg8::bf_hi(rb.x), pg8::bf_lo(rb.y), pg8::bf_hi(rb.y)} + acc[ai][bj][m][0], o1 = (f32x4){pg8::bf_lo(rb.z), pg8::bf_hi(rb.z), pg8::bf_lo(rb.w), pg8::bf_hi(rb.w)} + acc[ai][bj][m][1];
                    if (tok >= 0) { *(f32x4*)(out + off + bj * 128) = o0; *(f32x4*)(out + off + bj * 128 + 4) = o1; } } }
    }
};
namespace att {
__device__ __forceinline__ int crow(int r, int hi) { return (r & 3) + 8 * (r >> 2) + 4 * hi; }
__device__ __forceinline__ void glds16(const void* gsrc, unsigned lds_dst) { unsigned keep;
    asm volatile("s_mov_b32 %0, m0\n\ts_mov_b32 m0, %2\n\ts_nop 0\n\tglobal_load_lds_dwordx4 %1, off\n\ts_mov_b32 m0, %0" : "=&s"(keep) : "v"(gsrc), "s"(lds_dst) : "memory"); }
typedef __attribute__((address_space(3))) const char* lds_cptr;
typedef short v4i16_t __attribute__((ext_vector_type(4)));
__device__ __forceinline__ s16x4 vtr(lds_cptr p) { return __builtin_bit_cast(s16x4, __builtin_amdgcn_ds_read_tr16_b64_v4i16((__attribute__((address_space(3))) v4i16_t*)p)); }

struct Tensors { const bf16* Q; const bf16* K; const bf16* V; bf16* O; int qp, kp, vp, op; };

template <int KS, int DVB, int NDV, int QW, bool QREG, bool NOSHIFT>
__device__ __forceinline__ void unit(const Tensors& Tn, const int q0, const int NT, const float cbound, char* shm, LAS float* wsf_all) {
    constexpr int KSLOT = 64 * KS * 32, VSLOT = 64 * DVB * 64, SLOT = KSLOT + VSLOT, NKP = KS * 2, NVP = DVB * 4;
    const int tid = threadIdx.x, lane = tid & 63, r32 = lane & 31, hi = lane >> 5; const int wid = __builtin_amdgcn_readfirstlane(tid >> 6);
    const int qb = wid % QW, dvb0 = (wid / QW) * NDV;
    const unsigned lds0 = (unsigned)(uintptr_t)shm;
    LAS float* wsf = wsf_all + wid * 64;
    const lds_cptr shm3 = (lds_cptr)shm;
    const bf16* ksrc = Tn.K + (size_t)lane * Tn.kp;
    const bf16* vsrc = Tn.V + (size_t)(lane >> 2) * Tn.vp + (lane & 3) * 8;
#define ATT_DMA(t, slot) do { \
        _Pragma("unroll") for (int p_ = 0; p_ < (NKP + 7) / 8; ++p_) { const int c_ = wid + 8 * p_; if (c_ < NKP) glds16(ksrc + (size_t)(t) * 64 * Tn.kp + c_ * 8, (unsigned)__builtin_amdgcn_readfirstlane(lds0 + (slot) * SLOT + c_ * 1024)); } \
        _Pragma("unroll") for (int p_ = 0; p_ < (NVP + 7) / 8; ++p_) { const int c_ = wid + 8 * p_; if (c_ < NVP) { const int dg_ = c_ >> 2, kg_ = c_ & 3; \
            glds16(vsrc + ((size_t)(t) * 64 + 16 * kg_) * Tn.vp + dg_ * 32, (unsigned)__builtin_amdgcn_readfirstlane(lds0 + (slot) * SLOT + KSLOT + c_ * 1024)); } } } while (0)
    ATT_DMA(0, 0);
    const bf16* Qw = Tn.Q + (size_t)(q0 + qb * 32 + r32) * Tn.qp + hi * 8;
    bf16x8 qr[KS];
    if constexpr (QREG) {
#pragma unroll
      for (int d0 = 0; d0 < KS; ++d0) qr[d0] = *reinterpret_cast<const bf16x8*>(Qw + d0 * 16); }
    f32x16 o[NDV];
#pragma unroll
    for (int j = 0; j < NDV; ++j) o[j] = f32x16{};
    float l_reg = 0.f;
    f32x16 negc;
#pragma unroll
    for (int r = 0; r < 16; ++r) negc[r] = -cbound;
    asm volatile("s_waitcnt vmcnt(0)" ::: "memory"); __builtin_amdgcn_s_barrier(); asm volatile("" ::: "memory");
#ifdef ATT_PROBE_TILES
    for (int rep_ = 0; rep_ < 2; ++rep_) {
    if (rep_ == 1) { ATT_DMA(0, 0); l_reg = 0.f;
#pragma unroll
        for (int j = 0; j < NDV; ++j) o[j] = f32x16{};
        asm volatile("s_waitcnt vmcnt(0)" ::: "memory"); __builtin_amdgcn_s_barrier(); asm volatile("" ::: "memory"); }
#endif
#pragma nounroll
    for (int t = 0; t < NT; ++t) {
        const int sl = t & 1;
        if (t + 1 < NT) ATT_DMA(t + 1, sl ^ 1);
        const lds_cptr kb = shm3 + sl * SLOT + hi * 1024 + r32 * 16;
        const lds_cptr vp_ = shm3 + sl * SLOT + KSLOT + ((lane >> 4) & 1) * 32 + (lane & 3) * 8 + (4 * hi + ((lane & 15) >> 2)) * 64;
#pragma nounroll
        for (int kh = 0; kh < 2; ++kh) {
            f32x16 p; if constexpr (NOSHIFT) p = f32x16{}; else p = negc;
#pragma unroll
            for (int d0 = 0; d0 < KS; ++d0) {
                if constexpr (!QREG) { if ((d0 & 3) == 0) { asm volatile("" ::: "memory");
#pragma unroll
                    for (int dd = 0; dd < 4; ++dd) qr[d0 + dd] = *reinterpret_cast<const bf16x8*>(Qw + (d0 + dd) * 16);
                    asm volatile("" ::: "memory"); } }
                const bf16x8 b0 = *(const __attribute__((address_space(3))) bf16x8*)(kb + d0 * 2048 + kh * 512);
                p = __builtin_amdgcn_mfma_f32_32x32x16_bf16(b0, qr[d0], p, 0, 0, 0);
            }
            float sacc = 0.f;
#pragma unroll
            for (int r = 0; r < 16; ++r) { p[r] = fast_exp2(p[r]); sacc += p[r]; }
            l_reg += sacc;
            v4u pw[2];
            pw[0] = (v4u){pk2(p[0], p[1]), pk2(p[2], p[3]), pk2(p[4], p[5]), pk2(p[6], p[7])};
            pw[1] = (v4u){pk2(p[8], p[9]), pk2(p[10], p[11]), pk2(p[12], p[13]), pk2(p[14], p[15])};
#pragma unroll
            for (int j = 0; j < NDV; ++j) {
#pragma unroll
                for (int ks = 0; ks < 2; ++ks) {
                    const s16x4 lo = vtr(vp_ + (dvb0 + j) * 4096 + (2 * kh + ks) * 1024), hh = vtr(vp_ + (dvb0 + j) * 4096 + (2 * kh + ks) * 1024 + 512);
                    const bf16x8 vf = (bf16x8){lo[0], lo[1], lo[2], lo[3], hh[0], hh[1], hh[2], hh[3]};
                    o[j] = __builtin_amdgcn_mfma_f32_32x32x16_bf16(__builtin_bit_cast(bf16x8, pw[ks]), vf, o[j], 0, 0, 0);
                }
            }
        }
        asm volatile("s_waitcnt vmcnt(0) lgkmcnt(0)" ::: "memory"); __builtin_amdgcn_s_barrier(); asm volatile("" ::: "memory");
    }
#ifdef ATT_PROBE_TILES
    }
#endif
#undef ATT_DMA
    l_reg += __shfl_xor(l_reg, 32);
    if (hi == 0) wsf[r32] = l_reg;
    asm volatile("s_waitcnt lgkmcnt(0)" ::: "memory");
    float rli[16];
#pragma unroll
    for (int r = 0; r < 16; ++r) rli[r] = fast_rcp(wsf[crow(r, hi)]);
    constexpr int SW = NDV * 32;
    LAS bf16* stg = (LAS bf16*)(shm3) + wid * (32 * SW);
#pragma unroll
    for (int r = 0; r < 16; ++r) { const int orow = crow(r, hi);
#pragma unroll
        for (int j = 0; j < NDV; ++j) stg[orow * SW + j * 32 + r32] = (bf16)f2bf(o[j][r] * rli[r]); }
    asm volatile("s_waitcnt lgkmcnt(0)" ::: "memory");
    bf16* Ow = Tn.O + (size_t)(q0 + qb * 32) * Tn.op + dvb0 * 32;
    constexpr int CPR = SW / 8;
#pragma unroll
    for (int i = 0; i < (32 * CPR) / 64; ++i) { const int idx = i * 64 + lane, row = idx / CPR, ch = idx % CPR;
        const v4u v = *(const LAS v4u*)(stg + row * SW + ch * 8); *(v4u*)(Ow + (size_t)row * Tn.op + ch * 8) = v; }
    asm volatile("s_waitcnt vmcnt(0) lgkmcnt(0)" ::: "memory"); __builtin_amdgcn_s_barrier(); asm volatile("" ::: "memory");
}

template <int KS, int DVB>
__device__ __forceinline__ void unit2(const Tensors& Tn, const int q0, const int NT, const float cbound, char* shm, LAS float* wsf_all) {
    constexpr int KSLOT = 64 * KS * 32, VSLOT = 64 * DVB * 64, SLOT = KSLOT + VSLOT, NKP = KS * 2, NVP = DVB * 4;
    const int tid = threadIdx.x, lane = tid & 63, r32 = lane & 31, hi = lane >> 5; const int wid = __builtin_amdgcn_readfirstlane(tid >> 6);
    const unsigned lds0 = (unsigned)(uintptr_t)shm;
    LAS float* wsf = wsf_all + wid * 64;
    const lds_cptr shm3 = (lds_cptr)shm;
    const bf16* ksrc = Tn.K + (size_t)lane * Tn.kp;
    const bf16* vsrc = Tn.V + (size_t)(lane >> 2) * Tn.vp + (lane & 3) * 8;
#define ATT_DMA(t, slot) do { \
        _Pragma("unroll") for (int p_ = 0; p_ < (NKP + 7) / 8; ++p_) { const int c_ = wid + 8 * p_; if (c_ < NKP) glds16(ksrc + (size_t)(t) * 64 * Tn.kp + c_ * 8, (unsigned)__builtin_amdgcn_readfirstlane(lds0 + (slot) * SLOT + c_ * 1024)); } \
        _Pragma("unroll") for (int p_ = 0; p_ < (NVP + 7) / 8; ++p_) { const int c_ = wid + 8 * p_; if (c_ < NVP) { const int dg_ = c_ >> 2, kg_ = c_ & 3; \
            glds16(vsrc + ((size_t)(t) * 64 + 16 * kg_) * Tn.vp + dg_ * 32, (unsigned)__builtin_amdgcn_readfirstlane(lds0 + (slot) * SLOT + KSLOT + c_ * 1024)); } } } while (0)
    ATT_DMA(0, 0);
    bf16x8 qa[KS], qb[KS];
    { const bf16* Qw = Tn.Q + (size_t)(q0 + wid * 64 + r32) * Tn.qp + hi * 8;
#pragma unroll
      for (int d0 = 0; d0 < KS; ++d0) { qa[d0] = *reinterpret_cast<const bf16x8*>(Qw + d0 * 16); qb[d0] = *reinterpret_cast<const bf16x8*>(Qw + (size_t)32 * Tn.qp + d0 * 16); } }
    f32x16 oa[DVB], ob[DVB];
#pragma unroll
    for (int j = 0; j < DVB; ++j) { oa[j] = f32x16{}; ob[j] = f32x16{}; }
    float la = 0.f, lb = 0.f;
    asm volatile("s_waitcnt vmcnt(0)" ::: "memory"); __builtin_amdgcn_s_barrier(); asm volatile("" ::: "memory");
#pragma nounroll
    for (int t = 0; t < NT; ++t) {
        const int sl = t & 1;
        if (t + 1 < NT) ATT_DMA(t + 1, sl ^ 1);
        const lds_cptr kb = shm3 + sl * SLOT + hi * 1024 + r32 * 16;
        const lds_cptr vp_ = shm3 + sl * SLOT + KSLOT + ((lane >> 4) & 1) * 32 + (lane & 3) * 8 + (4 * hi + ((lane & 15) >> 2)) * 64;
#pragma unroll
        for (int kh = 0; kh < 2; ++kh) {
            f32x16 pa = f32x16{}, pb = f32x16{};
#pragma unroll
            for (int d0 = 0; d0 < KS; ++d0) {
                const bf16x8 kf = *(const __attribute__((address_space(3))) bf16x8*)(kb + d0 * 2048 + kh * 512);
                pa = __builtin_amdgcn_mfma_f32_32x32x16_bf16(kf, qa[d0], pa, 0, 0, 0);
                pb = __builtin_amdgcn_mfma_f32_32x32x16_bf16(kf, qb[d0], pb, 0, 0, 0);
            }
            float sa = 0.f, sb = 0.f;
#pragma unroll
            for (int r = 0; r < 16; ++r) { pa[r] = fast_exp2(pa[r]); sa += pa[r]; }
            v4u wa[2], wb[2];
            wa[0] = (v4u){pk2(pa[0], pa[1]), pk2(pa[2], pa[3]), pk2(pa[4], pa[5]), pk2(pa[6], pa[7])};
            wa[1] = (v4u){pk2(pa[8], pa[9]), pk2(pa[10], pa[11]), pk2(pa[12], pa[13]), pk2(pa[14], pa[15])};
#pragma unroll
            for (int r = 0; r < 16; ++r) { pb[r] = fast_exp2(pb[r]); sb += pb[r]; }
            wb[0] = (v4u){pk2(pb[0], pb[1]), pk2(pb[2], pb[3]), pk2(pb[4], pb[5]), pk2(pb[6], pb[7])};
            wb[1] = (v4u){pk2(pb[8], pb[9]), pk2(pb[10], pb[11]), pk2(pb[12], pb[13]), pk2(pb[14], pb[15])};
            la += sa; lb += sb;
#pragma unroll
            for (int j = 0; j < DVB; ++j) {
#pragma unroll
                for (int ks = 0; ks < 2; ++ks) {
                    const s16x4 lo = vtr(vp_ + j * 4096 + (2 * kh + ks) * 1024), hh = vtr(vp_ + j * 4096 + (2 * kh + ks) * 1024 + 512);
                    const bf16x8 vf = (bf16x8){lo[0], lo[1], lo[2], lo[3], hh[0], hh[1], hh[2], hh[3]};
                    oa[j] = __builtin_amdgcn_mfma_f32_32x32x16_bf16(__builtin_bit_cast(bf16x8, wa[ks]), vf, oa[j], 0, 0, 0);
                    ob[j] = __builtin_amdgcn_mfma_f32_32x32x16_bf16(__builtin_bit_cast(bf16x8, wb[ks]), vf, ob[j], 0, 0, 0);
                }
            }
        }
        asm volatile("s_waitcnt vmcnt(0) lgkmcnt(0)" ::: "memory"); __builtin_amdgcn_s_barrier(); asm volatile("" ::: "memory");
    }
#undef ATT_DMA
    la += __shfl_xor(la, 32); lb += __shfl_xor(lb, 32);
    if (hi == 0) { wsf[r32] = la; wsf[32 + r32] = lb; }
    asm volatile("s_waitcnt lgkmcnt(0)" ::: "memory");
    constexpr int SW = DVB * 32;
    LAS bf16* stg = (LAS bf16*)(shm3) + wid * (64 * SW);
#pragma unroll
    for (int r = 0; r < 16; ++r) { const int orow = crow(r, hi); const float ra = fast_rcp(wsf[orow]), rb = fast_rcp(wsf[32 + orow]);
#pragma unroll
        for (int j = 0; j < DVB; ++j) { stg[orow * SW + j * 32 + r32] = (bf16)f2bf(oa[j][r] * ra); stg[(32 + orow) * SW + j * 32 + r32] = (bf16)f2bf(ob[j][r] * rb); } }
    asm volatile("s_waitcnt lgkmcnt(0)" ::: "memory");
    bf16* Ow = Tn.O + (size_t)(q0 + wid * 64) * Tn.op;
    constexpr int CPR = SW / 8;
#pragma unroll
    for (int i = 0; i < (64 * CPR) / 64; ++i) { const int idx = i * 64 + lane, row = idx / CPR, ch = idx % CPR;
        const v4u v = *(const LAS v4u*)(stg + row * SW + ch * 8); *(v4u*)(Ow + (size_t)row * Tn.op + ch * 8) = v; }
    asm volatile("s_waitcnt vmcnt(0) lgkmcnt(0)" ::: "memory"); __builtin_amdgcn_s_barrier(); asm volatile("" ::: "memory");
}
}
constexpr float QSCALE_MLA = 0.10206207261596575f * LOG2E;
__device__ __forceinline__ void mla_proj(Frame& F, const Inputs& in) {
    const int lane = F.lane, w = F.wave, tk = lane & 15, g = lane >> 4;
    const bf16* LAT = (const bf16*)(F.ws + WS_LAT); const float* COS = (const float*)(F.ws + WS_COS); const float* SIN = (const float*)(F.ws + WS_SIN);
    bf16* Qo = (bf16*)(F.ws + WS_Q); bf16* Ko = (bf16*)(F.ws + WS_K); bf16* Vo = (bf16*)(F.ws + WS_V);
    const int ngrp = T / 16;
    {
        bf16x8 wq[6][6];
        const bf16* W = (const bf16*)(F.ws + W_Q) + (size_t)(96 * w + tk) * 192 + 8 * g;
#pragma unroll
        for (int nt = 0; nt < 6; ++nt)
#pragma unroll
            for (int ks = 0; ks < 6; ++ks) wq[nt][ks] = *(const bf16x8*)(W + (size_t)nt * 16 * 192 + ks * 32);
        bf16x8 xn[6];
        if (F.vcu < ngrp) {
#pragma unroll
            for (int ks = 0; ks < 6; ++ks) xn[ks] = *(const bf16x8*)(LAT + (size_t)(F.vcu * 16 + tk) * 512 + ks * 32 + 8 * g); }
        for (int grp = F.vcu; grp < ngrp; grp += F.G) {
            const int tok = grp * 16 + tk;
            float ss = 0.f;
#pragma unroll
            for (int ks = 0; ks < 6; ++ks) {
#pragma unroll
                for (int j = 0; j < 8; ++j) { const float v = bf2f((bf16)xn[ks][j]); ss += v * v; } }
            f32x4 acc[6];
#pragma unroll
            for (int nt = 0; nt < 6; ++nt) { acc[nt] = (f32x4){0.f, 0.f, 0.f, 0.f};
#pragma unroll
                for (int ks = 0; ks < 6; ++ks) acc[nt] = __builtin_amdgcn_mfma_f32_16x16x32_bf16(wq[nt][ks], xn[ks], acc[nt], 0, 0, 0); }
            __builtin_amdgcn_sched_barrier(0);
            if (grp + F.G < ngrp) {
#pragma unroll
                for (int ks = 0; ks < 6; ++ks) xn[ks] = *(const bf16x8*)(LAT + (size_t)((grp + F.G) * 16 + tk) * 512 + ks * 32 + 8 * g); }
            __builtin_amdgcn_sched_barrier(0);
            ss += __shfl_xor(ss, 16); ss += __shfl_xor(ss, 32);
            const float rc = 1.0f / sqrtf(ss * (1.f / 192.f) + EPS);
            float hs = 0.f;
#pragma unroll
            for (int nt = 0; nt < 6; ++nt) { acc[nt] = acc[nt] * rc; hs += (acc[nt][0] * acc[nt][0] + acc[nt][1] * acc[nt][1]) + (acc[nt][2] * acc[nt][2] + acc[nt][3] * acc[nt][3]); }
            hs += __shfl_xor(hs, 16); hs += __shfl_xor(hs, 32);
            const float rq = QSCALE_MLA / sqrtf(hs * (1.f / 96.f) + EPS);
#pragma unroll
            for (int nt = 0; nt < 6; ++nt) { const f32x4 qg = *(const f32x4*)(in.q_norm + 16 * nt + 4 * g); acc[nt] = acc[nt] * rq * qg; }
            const f32x4 c = *(const f32x4*)(COS + (size_t)tok * 16 + 4 * g), s = *(const f32x4*)(SIN + (size_t)tok * 16 + 4 * g);
            const f32x4 x1 = acc[4], x2 = acc[5]; acc[4] = x1 * c - x2 * s; acc[5] = x2 * c + x1 * s;
#pragma unroll
            for (int nt = 0; nt < 6; ++nt) { v2u o; o.x = pk2(acc[nt][0], acc[nt][1]); o.y = pk2(acc[nt][2], acc[nt][3]); *(v2u*)(Qo + (size_t)tok * 768 + 96 * w + 16 * nt + 4 * g) = o; }
        }
    }
    {
        bf16x8 wk[8][4];
        const bf16* W = (const bf16*)(F.ws + W_KV) + (size_t)(128 * w + tk) * 128 + 8 * g;
#pragma unroll
        for (int nt = 0; nt < 8; ++nt)
#pragma unroll
            for (int ks = 0; ks < 4; ++ks) wk[nt][ks] = *(const bf16x8*)(W + (size_t)nt * 16 * 128 + ks * 32);
        bf16x8 xn[5];
        if (F.vcu < ngrp) {
#pragma unroll
            for (int ks = 0; ks < 4; ++ks) xn[ks] = *(const bf16x8*)(LAT + (size_t)(F.vcu * 16 + tk) * 512 + 192 + ks * 32 + 8 * g);
            xn[4] = *(const bf16x8*)(LAT + (size_t)(F.vcu * 16 + tk) * 512 + 320 + 8 * g); }
        for (int grp = F.vcu; grp < ngrp; grp += F.G) {
            const int tok = grp * 16 + tk;
            float ss = 0.f;
#pragma unroll
            for (int ks = 0; ks < 4; ++ks) {
#pragma unroll
                for (int j = 0; j < 8; ++j) { const float v = bf2f((bf16)xn[ks][j]); ss += v * v; } }
            float kr[8], sr = 0.f;
#pragma unroll
            for (int e = 0; e < 8; ++e) { kr[e] = bf2f((bf16)xn[4][e]); sr += kr[e] * kr[e]; }
            f32x4 acc[8];
#pragma unroll
            for (int nt = 0; nt < 8; ++nt) { acc[nt] = (f32x4){0.f, 0.f, 0.f, 0.f};
#pragma unroll
                for (int ks = 0; ks < 4; ++ks) acc[nt] = __builtin_amdgcn_mfma_f32_16x16x32_bf16(wk[nt][ks], xn[ks], acc[nt], 0, 0, 0); }
            __builtin_amdgcn_sched_barrier(0);
            if (grp + F.G < ngrp) {
#pragma unroll
                for (int ks = 0; ks < 4; ++ks) xn[ks] = *(const bf16x8*)(LAT + (size_t)((grp + F.G) * 16 + tk) * 512 + 192 + ks * 32 + 8 * g);
                xn[4] = *(const bf16x8*)(LAT + (size_t)((grp + F.G) * 16 + tk) * 512 + 320 + 8 * g); }
            __builtin_amdgcn_sched_barrier(0);
            ss += __shfl_xor(ss, 16); ss += __shfl_xor(ss, 32); sr += __shfl_xor(sr, 16); sr += __shfl_xor(sr, 32);
            const float rc = 1.0f / sqrtf(ss * (1.f / 128.f) + EPS);
            float hs = 0.f;
#pragma unroll
            for (int nt = 0; nt < 8; ++nt) { acc[nt] = acc[nt] * rc;
                if (nt < 4) hs += (acc[nt][0] * acc[nt][0] + acc[nt][1] * acc[nt][1]) + (acc[nt][2] * acc[nt][2] + acc[nt][3] * acc[nt][3]); }
            hs += __shfl_xor(hs, 16); hs += __shfl_xor(hs, 32);
            const float rk = 1.0f / sqrtf((hs + sr) * (1.f / 96.f) + EPS);
#pragma unroll
            for (int nt = 0; nt < 4; ++nt) { const f32x4 kg = *(const f32x4*)(in.k_norm + 16 * nt + 4 * g) * rk; v2u o; o.x = pk2(acc[nt][0] * kg[0], acc[nt][1] * kg[1]); o.y = pk2(acc[nt][2] * kg[2], acc[nt][3] * kg[3]);
                *(v2u*)(Ko + (size_t)tok * 768 + 96 * w + 16 * nt + 4 * g) = o; }
#pragma unroll
            for (int nt = 4; nt < 8; ++nt) { v2u o; o.x = pk2(acc[nt][0], acc[nt][1]); o.y = pk2(acc[nt][2], acc[nt][3]); *(v2u*)(Vo + (size_t)tok * 512 + 64 * w + 16 * (nt - 4) + 4 * g) = o; }
            const f32x4 c0 = *(const f32x4*)(COS + (size_t)tok * 16 + 8 * (g & 1)), c1 = *(const f32x4*)(COS + (size_t)tok * 16 + 8 * (g & 1) + 4);
            const f32x4 s0 = *(const f32x4*)(SIN + (size_t)tok * 16 + 8 * (g & 1)), s1 = *(const f32x4*)(SIN + (size_t)tok * 16 + 8 * (g & 1) + 4);
            const f32x4 kg0 = *(const f32x4*)(in.k_norm + 64 + 8 * g), kg1 = *(const f32x4*)(in.k_norm + 64 + 8 * g + 4);
            float ro[8];
#pragma unroll
            for (int e = 0; e < 8; ++e) { const float own = kr[e] * rk * (e < 4 ? kg0[e] : kg1[e - 4]); const float oth = __shfl_xor(own, 32); const float cc = e < 4 ? c0[e] : c1[e - 4], sn = e < 4 ? s0[e] : s1[e - 4];
                ro[e] = (g < 2) ? own * cc - oth * sn : own * cc + oth * sn; }
            v4u o; o.x = pk2(ro[0], ro[1]); o.y = pk2(ro[2], ro[3]); o.z = pk2(ro[4], ro[5]); o.w = pk2(ro[6], ro[7]);
            *(v4u*)(Ko + (size_t)tok * 768 + 96 * w + 64 + 8 * g) = o;
        }
    }
}

__device__ __forceinline__ float dpp_scan(float v) {
#define HG_DPP(ctrl, rm) v += __builtin_bit_cast(float, __builtin_amdgcn_update_dpp(0, __builtin_bit_cast(int, v), ctrl, rm, 0xf, false))
    HG_DPP(0x111, 0xf); HG_DPP(0x112, 0xf); HG_DPP(0x114, 0xf); HG_DPP(0x118, 0xf); HG_DPP(0x142, 0xa); HG_DPP(0x143, 0xc);
#undef HG_DPP
    return v;
}
constexpr int HGL_QT = 0, HGL_KC = 32768, HGL_VP = 65536, HGL_SP = 81920, HGL_DEC = 114688, HGL_DUMP = 116736;
__device__ __forceinline__ void hgrn2_scan(Frame& F, char* shm) {
    using att::lds_cptr; using att::vtr; using att::crow;
    const int lane = F.lane, w = F.wave, r32 = lane & 31, hi = lane >> 5;
    const unsigned lds0 = (unsigned)(uintptr_t)shm; const lds_cptr shm3 = (lds_cptr)shm;
    const int laneoff = ((lane >> 4) & 1) * 32 + (lane & 3) * 8 + (4 * hi + ((lane & 15) >> 2)) * 64;
    const int koff = (2 * ((lane >> 4) & 1) + ((lane & 3) >> 1)) * 1024 + (4 * hi + ((lane & 15) >> 2)) * 16 + 8 * (lane & 1);
    for (int item = F.vcu; item < 256; item += F.G) {
        const int vh = item & 1, dir = (item >> 1) & 1, h = (item >> 2) & 3, b = item >> 4;
        const bf16* HQ = (const bf16*)(F.ws + WS_HQ) + h * 128 + 16 * w;
        const unsigned short* GG = (const unsigned short*)(F.ws + (dir ? WS_GB : WS_GF)) + h * 128 + 16 * w;
        const bf16* HI = (const bf16*)(F.ws + WS_HI) + h * 128 + vh * 64;
        bf16* OUT = (bf16*)(F.ws + (dir ? WS_OB : WS_OF)) + h * 128 + vh * 64;
        const int tfirst = b * SEQ + (dir ? SEQ - 1 : 0), tstep = dir ? -1 : 1;
        f32x16 S0 = f32x16{}, S1 = f32x16{};
        v4u hq_n[2], g_n[2];
#define HG_VDMA(nn) do { const int vg_ = w >> 2, ig_ = w & 3; const int trow_ = tfirst + tstep * (64 * (nn) + 16 * ig_ + (lane >> 2)); \
            att::glds16(HI + (size_t)trow_ * 512 + vg_ * 32 + (lane & 3) * 8, (unsigned)__builtin_amdgcn_readfirstlane(lds0 + HGL_VP + ((nn) & 1) * 8192 + w * 1024)); } while (0)
#define HG_LOAD(nn) do { const size_t tk_ = (size_t)(tfirst + tstep * (64 * (nn) + lane)) * 512; hq_n[0] = *(const v4u*)(HQ + tk_); hq_n[1] = *(const v4u*)(HQ + tk_ + 8); g_n[0] = *(const v4u*)(GG + tk_); g_n[1] = *(const v4u*)(GG + tk_ + 8); } while (0)
#define HG_PREP(nn) do { const int pp_ = (nn) & 1; float q_[16], gg_[16]; const int decw_ = (lane == 63) ? (HGL_DEC + pp_ * 512 + 64 * w) : (HGL_DUMP + 4 * lane), dstr_ = (lane == 63) ? 4 : 0; \
            _Pragma("unroll") for (int c = 0; c < 2; ++c) _Pragma("unroll") for (int e = 0; e < 4; ++e) { const unsigned hw = hq_n[c][e], gw_ = g_n[c][e]; \
                q_[c * 8 + 2 * e] = pg8::bf_lo(hw); q_[c * 8 + 2 * e + 1] = pg8::bf_hi(hw); gg_[c * 8 + 2 * e] = h2f((unsigned short)(gw_ & 0xffffu)); gg_[c * 8 + 2 * e + 1] = h2f((unsigned short)(gw_ >> 16)); } \
            if ((nn) + 1 < SEQ / 64) HG_LOAD((nn) + 1); \
            unsigned qt_[8], kt_[8]; \
            _Pragma("unroll") for (int j = 0; j < 16; j += 2) { float bq_[2], kk_[2]; \
                _Pragma("unroll") for (int u = 0; u < 2; ++u) { const float gv = gg_[j + u]; const float bsum = dpp_scan(gv); \
                    const float E = fast_exp2(bsum * LOG2E), Ei = fast_exp2(-bsum * LOG2E), kx = 1.0f - fast_exp2(gv * LOG2E); \
                    bq_[u] = q_[j + u] * E; kk_[u] = kx * Ei; \
                    *(LAS float*)(shm3 + decw_ + (j + u) * dstr_) = E; } \
                qt_[j >> 1] = pk2(bq_[0], bq_[1]); kt_[j >> 1] = pk2(kk_[0], kk_[1]); } \
            { LAS v4u* pq = (LAS v4u*)(shm3 + HGL_QT + pp_ * 16384 + (2 * w) * 1024 + lane * 16); pq[0] = (v4u){qt_[0], qt_[1], qt_[2], qt_[3]}; pq[64] = (v4u){qt_[4], qt_[5], qt_[6], qt_[7]}; \
              LAS v4u* pk = (LAS v4u*)(shm3 + HGL_KC + pp_ * 16384 + (2 * w) * 1024 + lane * 16); pk[0] = (v4u){kt_[0], kt_[1], kt_[2], kt_[3]}; pk[64] = (v4u){kt_[4], kt_[5], kt_[6], kt_[7]}; } } while (0)
        HG_VDMA(0); HG_LOAD(0);
        HG_PREP(0);
        asm volatile("s_waitcnt vmcnt(0) lgkmcnt(0)" ::: "memory"); __builtin_amdgcn_s_barrier(); asm volatile("" ::: "memory");
        for (int n = 0; n < SEQ / 64; ++n) {
            const int par = n & 1;
            const int qtc = HGL_QT + par * 16384, kcc = HGL_KC + par * 16384, vpc = HGL_VP + par * 8192, spc = HGL_SP + par * 16384, spn = HGL_SP + (par ^ 1) * 16384, decc = HGL_DEC + par * 512;
            if (n + 1 < SEQ / 64) HG_VDMA(n + 1);
            if (w < 4) {
                const int tb = w >> 1, vb = w & 1;
                f32x16 o = f32x16{};
                bf16x8 qf[8];
#pragma unroll
                for (int kd = 0; kd < 8; ++kd) qf[kd] = *(const LAS bf16x8*)(shm3 + qtc + (2 * kd + hi) * 1024 + (32 * tb + r32) * 16);
                for (int sb = 0; sb <= tb; ++sb) {
                    bf16x8 kf[8];
#pragma unroll
                    for (int kd = 0; kd < 8; ++kd) kf[kd] = *(const LAS bf16x8*)(shm3 + kcc + (2 * kd + hi) * 1024 + (32 * sb + r32) * 16);
                    s16x4 vl[2], vh_[2];
#pragma unroll
                    for (int ks = 0; ks < 2; ++ks) { vl[ks] = vtr(shm3 + vpc + (vb * 4 + 2 * sb + ks) * 1024 + laneoff); vh_[ks] = vtr(shm3 + vpc + (vb * 4 + 2 * sb + ks) * 1024 + laneoff + 512); }
                    f32x16 x = f32x16{};
#pragma unroll
                    for (int kd = 0; kd < 8; ++kd) x = __builtin_amdgcn_mfma_f32_32x32x16_bf16(kf[kd], qf[kd], x, 0, 0, 0);
                    if (sb == tb) {
#pragma unroll
                        for (int r = 0; r < 16; ++r) if (crow(r, hi) > r32) x[r] = 0.f;
                    }
                    const v4u pw0 = (v4u){pk2(x[0], x[1]), pk2(x[2], x[3]), pk2(x[4], x[5]), pk2(x[6], x[7])}, pw1 = (v4u){pk2(x[8], x[9]), pk2(x[10], x[11]), pk2(x[12], x[13]), pk2(x[14], x[15])};
#pragma unroll
                    for (int ks = 0; ks < 2; ++ks)
                        o = __builtin_amdgcn_mfma_f32_32x32x16_bf16(__builtin_bit_cast(bf16x8, ks ? pw1 : pw0), (bf16x8){vl[ks][0], vl[ks][1], vl[ks][2], vl[ks][3], vh_[ks][0], vh_[ks][1], vh_[ks][2], vh_[ks][3]}, o, 0, 0, 0);
                }
                if (n > 0) {
                    v2u a0[8], a1[8]; s16x4 sl[8], sh[8];
#pragma unroll
                    for (int kd = 0; kd < 8; ++kd) {
                        a0[kd] = *(const LAS v2u*)(shm3 + qtc + (2 * kd) * 1024 + (32 * tb + r32) * 16 + 8 * hi); a1[kd] = *(const LAS v2u*)(shm3 + qtc + (2 * kd + 1) * 1024 + (32 * tb + r32) * 16 + 8 * hi);
                        sl[kd] = vtr(shm3 + spc + (vb * 8 + kd) * 1024 + laneoff); sh[kd] = vtr(shm3 + spc + (vb * 8 + kd) * 1024 + laneoff + 512); }
#pragma unroll
                    for (int kd = 0; kd < 8; ++kd) { const v4u af = (v4u){a0[kd].x, a0[kd].y, a1[kd].x, a1[kd].y};
                        o = __builtin_amdgcn_mfma_f32_32x32x16_bf16(__builtin_bit_cast(bf16x8, af), (bf16x8){sl[kd][0], sl[kd][1], sl[kd][2], sl[kd][3], sh[kd][0], sh[kd][1], sh[kd][2], sh[kd][3]}, o, 0, 0, 0); }
                }
                if (n + 1 < SEQ / 64) HG_PREP(n + 1);
#pragma unroll
                for (int r = 0; r < 16; ++r) { const int i = 32 * tb + crow(r, hi); OUT[(size_t)(tfirst + tstep * (64 * n + i)) * 512 + vb * 32 + r32] = (bf16)f2bf(o[r]); }
            } else {
                const int db = w - 4;
                s16x4 kl[4], kh_[4], v0l[4], v0h[4], v1l[4], v1h[4];
#pragma unroll
                for (int ig = 0; ig < 4; ++ig) {
                    kl[ig] = vtr(shm3 + kcc + (4 * db) * 1024 + ig * 256 + koff); kh_[ig] = vtr(shm3 + kcc + (4 * db) * 1024 + ig * 256 + koff + 128);
                    v0l[ig] = vtr(shm3 + vpc + (0 * 4 + ig) * 1024 + laneoff); v0h[ig] = vtr(shm3 + vpc + (0 * 4 + ig) * 1024 + laneoff + 512);
                    v1l[ig] = vtr(shm3 + vpc + (1 * 4 + ig) * 1024 + laneoff); v1h[ig] = vtr(shm3 + vpc + (1 * 4 + ig) * 1024 + laneoff + 512); }
#pragma unroll
                for (int ig = 0; ig < 4; ++ig) {
                    const bf16x8 ka = (bf16x8){kl[ig][0], kl[ig][1], kl[ig][2], kl[ig][3], kh_[ig][0], kh_[ig][1], kh_[ig][2], kh_[ig][3]};
                    S0 = __builtin_amdgcn_mfma_f32_32x32x16_bf16(ka, (bf16x8){v0l[ig][0], v0l[ig][1], v0l[ig][2], v0l[ig][3], v0h[ig][0], v0h[ig][1], v0h[ig][2], v0h[ig][3]}, S0, 0, 0, 0);
                    S1 = __builtin_amdgcn_mfma_f32_32x32x16_bf16(ka, (bf16x8){v1l[ig][0], v1l[ig][1], v1l[ig][2], v1l[ig][3], v1h[ig][0], v1h[ig][1], v1h[ig][2], v1h[ig][3]}, S1, 0, 0, 0);
                }
                if (n + 1 < SEQ / 64) HG_PREP(n + 1);
#pragma unroll
                for (int r = 0; r < 16; ++r) { const int d = 32 * db + crow(r, hi); const float dc = ((const LAS float*)(shm3 + decc))[d]; S0[r] *= dc; S1[r] *= dc;
                    *(LAS bf16*)(shm3 + spn + (0 * 8 + (d >> 4)) * 1024 + (d & 15) * 64 + r32 * 2) = (bf16)f2bf(S0[r]);
                    *(LAS bf16*)(shm3 + spn + (1 * 8 + (d >> 4)) * 1024 + (d & 15) * 64 + r32 * 2) = (bf16)f2bf(S1[r]); }
            }
            if (n + 2 < SEQ / 64) { if (w < 4) asm volatile("s_waitcnt vmcnt(20) lgkmcnt(0)" ::: "memory"); else asm volatile("s_waitcnt vmcnt(4) lgkmcnt(0)" ::: "memory"); }
            else asm volatile("s_waitcnt vmcnt(0) lgkmcnt(0)" ::: "memory");
            __builtin_amdgcn_s_barrier(); asm volatile("" ::: "memory");
        }
#undef HG_VDMA
#undef HG_LOAD
#undef HG_PREP
    }
}
__device__ __forceinline__ void hg_combine(Frame& F, const Inputs& in) {
    const int gw = F.vcu * NWAVES + F.wave, NGW = F.G * NWAVES, lane = F.lane;
    const bf16* OFp = (const bf16*)(F.ws + WS_OF); const bf16* OBp = (const bf16*)(F.ws + WS_OB); const bf16* HG = (const bf16*)(F.ws + WS_HG); bf16* CAT = (bf16*)(F.ws + WS_CAT);
    float on[8];
#pragma unroll
    for (int e = 0; e < 8; ++e) on[e] = in.o_norm[(lane & 15) * 8 + e];
    for (int t = gw; t < T; t += NGW) {
        const v4u a = *(const v4u*)(OFp + (size_t)t * 512 + lane * 8), bq = *(const v4u*)(OBp + (size_t)t * 512 + lane * 8), gq = *(const v4u*)(HG + (size_t)t * 512 + lane * 8);
        float x[8], ss = 0.f;
#pragma unroll
        for (int e = 0; e < 4; ++e) { x[2 * e] = pg8::bf_lo(a[e]) + pg8::bf_lo(bq[e]); x[2 * e + 1] = pg8::bf_hi(a[e]) + pg8::bf_hi(bq[e]); ss += x[2 * e] * x[2 * e] + x[2 * e + 1] * x[2 * e + 1]; }
        ss += __shfl_xor(ss, 1); ss += __shfl_xor(ss, 2); ss += __shfl_xor(ss, 4); ss += __shfl_xor(ss, 8);
        const float r = 1.0f / sqrtf(ss * (1.f / 128.f) + EPS);
        v4u o;
#pragma unroll
        for (int e = 0; e < 4; ++e) o[e] = pk2(x[2 * e] * r * on[2 * e] * pg8::bf_lo(gq[e]), x[2 * e + 1] * r * on[2 * e + 1] * pg8::bf_hi(gq[e]));
        *(v4u*)(CAT + (size_t)t * 1024 + 512 + lane * 8) = o;
    }
}
__device__ __forceinline__ void moe_route(Frame& F) {
    const int gt = (F.vcu * NWAVES + F.wave) * 64 + F.lane, NGT = F.G * NWAVES * 64;
    const float* LG = (const float*)(F.ws + WS_LG); int* bk = (int*)(F.ws + WS_REC); int* ps = bk + T; float* w0 = (float*)(ps + T); float* w1 = w0 + T;
    for (int tok = gt; tok < T; tok += NGT) {
        const float* l = LG + (size_t)tok * 72;
        float gl[8]; { const f32x4 a = *(const f32x4*)l, b = *(const f32x4*)(l + 4); gl[0] = a[0]; gl[1] = a[1]; gl[2] = a[2]; gl[3] = a[3]; gl[4] = b[0]; gl[5] = b[1]; gl[6] = b[2]; gl[7] = b[3]; }
        float mx = gl[0]; int gs = 0;
#pragma unroll
        for (int g = 1; g < 8; ++g) if (gl[g] > mx) { mx = gl[g]; gs = g; }
        float den = 0.f;
#pragma unroll
        for (int g = 0; g < 8; ++g) den += expf(gl[g] - mx);
        const float gwt = 1.0f / den;
        float el[8]; { const f32x4 a = *(const f32x4*)(l + 8 + gs * 8), b = *(const f32x4*)(l + 12 + gs * 8); el[0] = a[0]; el[1] = a[1]; el[2] = a[2]; el[3] = a[3]; el[4] = b[0]; el[5] = b[1]; el[6] = b[2]; el[7] = b[3]; }
        int i0 = 0; float m0 = el[0];
#pragma unroll
        for (int e = 1; e < 8; ++e) if (el[e] > m0) { m0 = el[e]; i0 = e; }
        int i1 = -1; float m1 = -INFINITY;
#pragma unroll
        for (int e = 0; e < 8; ++e) if (e != i0 && el[e] > m1) { m1 = el[e]; i1 = e; }
        if (i1 < 0) i1 = (i0 == 0) ? 1 : 0;
        const float e1 = expf(m1 - m0); const float wa = gwt / (1.0f + e1), wb = gwt * e1 / (1.0f + e1);
        const int ea = i0 < i1 ? i0 : i1, eb = i0 < i1 ? i1 : i0;
        const int bucket = gs * 64 + ea * 8 + eb;
        const unsigned pos = __hip_atomic_fetch_add((unsigned*)(F.ctl + CW_CNT) + bucket, 1u, RLX_AGENT);
        bk[tok] = bucket; ps[tok] = (int)pos; w0[tok] = i0 < i1 ? wa : wb; w1[tok] = i0 < i1 ? wb : wa;
    }
}
__device__ __forceinline__ void moe_place(Frame& F) {
    LAS int* nt_s = (LAS int*)(F.lds + RING_OFF); LAS int* ts_s = nt_s + 512;
    const int t = F.tid;
    const int cnt = (int)__hip_atomic_load((unsigned*)(F.ctl + CW_CNT) + t, RLX_AGENT);
    nt_s[t] = (cnt + 255) >> 8;
    __syncthreads();
    int st = 0;
    for (int j = 0; j < t; ++j) st += nt_s[j];
    ts_s[t] = st;
    __syncthreads();
    int* rowlist = (int*)(F.ws + WS_REC + 1 * MiB); int* tileb = (int*)(F.ws + WS_REC + 2 * MiB);
    if (blockIdx.x == 0) {
        const int ntb = nt_s[t];
        for (int k = 0; k < ntb; ++k) tileb[st + k] = t;
        for (int r = cnt; r < ntb * 256; ++r) rowlist[st * 256 + r] = -1;
        if (t == 511) __hip_atomic_store((unsigned*)(F.ctl + CW_NT), (unsigned)(st + ntb), RLX_AGENT);
    }
    const int gt = (F.vcu * NWAVES + F.wave) * 64 + F.lane, NGT = F.G * NWAVES * 64;
    const int* bk = (const int*)(F.ws + WS_REC); const int* ps = bk + T;
    for (int tok = gt; tok < T; tok += NGT) rowlist[ts_s[bk[tok]] * 256 + ps[tok]] = tok;
    __syncthreads();
}
__device__ __forceinline__ void phase_0(Frame& F, const Inputs& in, float* d_out_, unsigned char* ws, unsigned char* lds) {
    LAS float* RS = (LAS float*)(F.lds + AUX_RS); LAS float* WG = (LAS float*)(F.lds + AUX_WG); LAS int* TOK = (LAS int*)(F.lds + AUX_TOK); LAS float* XP = (LAS float*)(F.lds + AUX_XP);
    const float* misc = (const float*)(ws + WS_MISC); (void)RS; (void)WG; (void)TOK; (void)XP; (void)misc;
 p0_prologue(F, in);
}
__device__ __forceinline__ void phase_1(Frame& F, const Inputs& in, float* d_out_, unsigned char* ws, unsigned char* lds) {
    LAS float* RS = (LAS float*)(F.lds + AUX_RS); LAS float* WG = (LAS float*)(F.lds + AUX_WG); LAS int* TOK = (LAS int*)(F.lds + AUX_TOK); LAS float* XP = (LAS float*)(F.lds + AUX_XP);
    const float* misc = (const float*)(ws + WS_MISC); (void)RS; (void)WG; (void)TOK; (void)XP; (void)misc;
        SchedGrid S; S.pad_ = 0; S.o.init(T / 256, 12, F.G, (int)blockIdx.x); S.A = (const char*)(ws + WS_XN); S.B = (const char*)(ws + W_IN); S.astep = (size_t)256 * 1024 * 2; S.bstep = (size_t)256 * 1024 * 2;
        EpiIn E{(bf16_t*)(ws + WS_HQ), (const float*)(ws + WS_SS0), misc, RS, 0};
        pg8::gemm_phase<EpiIn, SchedGrid, true, false, 1024, 1024, 1024, 16>(F.lds + RING_OFF, S, E);

}
__device__ __forceinline__ void phase_2(Frame& F, const Inputs& in, float* d_out_, unsigned char* ws, unsigned char* lds) {
    LAS float* RS = (LAS float*)(F.lds + AUX_RS); LAS float* WG = (LAS float*)(F.lds + AUX_WG); LAS int* TOK = (LAS int*)(F.lds + AUX_TOK); LAS float* XP = (LAS float*)(F.lds + AUX_XP);
    const float* misc = (const float*)(ws + WS_MISC); (void)RS; (void)WG; (void)TOK; (void)XP; (void)misc;
        mla_proj(F, in);
#ifdef MK_REP_MLA
        mla_proj(F, in);
#endif
        { SchedGrid S; S.pad_ = 0; S.o.init(16, 8, F.G, (int)blockIdx.x); S.A = (const char*)(ws + WS_MN); S.B = (const char*)(ws + W_XKV); S.astep = (size_t)256 * 1024 * 2; S.bstep = (size_t)256 * 1024 * 2;
          EpiHeadNorm E{nullptr, in.x_k_norm, (bf16_t*)(ws + WS_KVX), RS, XP, 1.0f, 2048, 4, 0};
          pg8::gemm_phase<EpiHeadNorm, SchedGrid, true, false, 1024, 1024, 1024, 16>(F.lds + RING_OFF, S, E); }
        __syncthreads();
        hgrn2_scan(F, (char*)lds + RING_OFF);
#ifdef MK_REP_HG
        __syncthreads(); hgrn2_scan(F, (char*)lds + RING_OFF);
#endif

}
__device__ __forceinline__ void phase_3(Frame& F, const Inputs& in, float* d_out_, unsigned char* ws, unsigned char* lds) {
    LAS float* RS = (LAS float*)(F.lds + AUX_RS); LAS float* WG = (LAS float*)(F.lds + AUX_WG); LAS int* TOK = (LAS int*)(F.lds + AUX_TOK); LAS float* XP = (LAS float*)(F.lds + AUX_XP);
    const float* misc = (const float*)(ws + WS_MISC); (void)RS; (void)WG; (void)TOK; (void)XP; (void)misc;
        hg_combine(F, in);
        const float cb = misc[1024];
        if (cb < 64.f) {
        for (int un = F.vcu; un < BATCH * 8 * 8; un += F.G) {
            const int qb = un & 7, bh = un >> 3, b = bh >> 3, h = bh & 7;
            att::Tensors Tn; Tn.Q = (const bf16*)(ws + WS_Q) + (size_t)b * SEQ * 768 + h * 96; Tn.K = (const bf16*)(ws + WS_K) + (size_t)b * SEQ * 768 + h * 96;
            Tn.V = (const bf16*)(ws + WS_V) + (size_t)b * SEQ * 512 + h * 64; Tn.O = (bf16*)(ws + WS_CAT) + (size_t)b * SEQ * 1024 + h * 64; Tn.qp = 768; Tn.kp = 768; Tn.vp = 512; Tn.op = 1024;
            att::unit2<6, 2>(Tn, qb * 512, SEQ / 64, cb, (char*)lds + RING_OFF, (LAS float*)(F.lds + AUX_WSF));
        }
        } else {
        for (int un = F.vcu; un < BATCH * 8 * 16; un += F.G) {
            const int qb = un & 15, bh = un >> 4, b = bh >> 3, h = bh & 7;
            att::Tensors Tn; Tn.Q = (const bf16*)(ws + WS_Q) + (size_t)b * SEQ * 768 + h * 96; Tn.K = (const bf16*)(ws + WS_K) + (size_t)b * SEQ * 768 + h * 96;
            Tn.V = (const bf16*)(ws + WS_V) + (size_t)b * SEQ * 512 + h * 64; Tn.O = (bf16*)(ws + WS_CAT) + (size_t)b * SEQ * 1024 + h * 64; Tn.qp = 768; Tn.kp = 768; Tn.vp = 512; Tn.op = 1024;
            att::unit<6, 2, 2, 8, true, false>(Tn, qb * 256, SEQ / 64, cb, (char*)lds + RING_OFF, (LAS float*)(F.lds + AUX_WSF));
        }
        }

}
__device__ __forceinline__ void phase_4(Frame& F, const Inputs& in, float* d_out_, unsigned char* ws, unsigned char* lds) {
    LAS float* RS = (LAS float*)(F.lds + AUX_RS); LAS float* WG = (LAS float*)(F.lds + AUX_WG); LAS int* TOK = (LAS int*)(F.lds + AUX_TOK); LAS float* XP = (LAS float*)(F.lds + AUX_XP);
    const float* misc = (const float*)(ws + WS_MISC); (void)RS; (void)WG; (void)TOK; (void)XP; (void)misc;
        SchedGrid S; S.pad_ = 0; S.o.init(T / 256, 4, F.G, (int)blockIdx.x); S.A = (const char*)(ws + WS_CAT); S.B = (const char*)(ws + W_OUT); S.astep = (size_t)256 * 1024 * 2; S.bstep = (size_t)256 * 1024 * 2;
        EpiRes<false> E{in.x, (bf16_t*)(ws + WS_XN), (float*)(ws + WS_SSP1)};
        pg8::gemm_phase<EpiRes<false>, SchedGrid, true, false, 1024, 1024, 1024, 16>(F.lds + RING_OFF, S, E);

}
__device__ __forceinline__ void phase_5(Frame& F, const Inputs& in, float* d_out_, unsigned char* ws, unsigned char* lds) {
    LAS float* RS = (LAS float*)(F.lds + AUX_RS); LAS float* WG = (LAS float*)(F.lds + AUX_WG); LAS int* TOK = (LAS int*)(F.lds + AUX_TOK); LAS float* XP = (LAS float*)(F.lds + AUX_XP);
    const float* misc = (const float*)(ws + WS_MISC); (void)RS; (void)WG; (void)TOK; (void)XP; (void)misc;
        SchedGrid S; S.pad_ = 0; S.o.init(T / 256, 4, F.G, (int)blockIdx.x); S.A = (const char*)(ws + WS_XN); S.B = (const char*)(ws + W_XQ); S.astep = (size_t)256 * 1024 * 2; S.bstep = (size_t)256 * 1024 * 2;
        EpiHeadNorm E{(const float*)(ws + WS_SSP1), in.x_q_norm, (bf16_t*)(ws + WS_QX), RS, XP, 0.0625f * LOG2E, 1024, 4, 0};
        pg8::gemm_phase<EpiHeadNorm, SchedGrid, true, false, 1024, 1024, 1024, 16>(F.lds + RING_OFF, S, E);

}
__device__ __forceinline__ void phase_6(Frame& F, const Inputs& in, float* d_out_, unsigned char* ws, unsigned char* lds) {
    LAS float* RS = (LAS float*)(F.lds + AUX_RS); LAS float* WG = (LAS float*)(F.lds + AUX_WG); LAS int* TOK = (LAS int*)(F.lds + AUX_TOK); LAS float* XP = (LAS float*)(F.lds + AUX_XP);
    const float* misc = (const float*)(ws + WS_MISC); (void)RS; (void)WG; (void)TOK; (void)XP; (void)misc;
        const float cb = misc[1025];
#ifdef MK_REP_X6
        for (int un = F.vcu; un < BATCH * 4 * 32; un += F.G) {
            const int qb = un & 31, bh = un >> 5, b = bh >> 2, h = bh & 3;
            att::Tensors Tn; Tn.Q = (const bf16*)(ws + WS_QX) + (size_t)b * SEQ * 1024 + h * 256; Tn.K = (const bf16*)(ws + WS_KVX) + (size_t)b * MEML * 2048 + h * 256;
            Tn.V = (const bf16*)(ws + WS_KVX) + (size_t)b * MEML * 2048 + 1024 + h * 256; Tn.O = (bf16*)(ws + WS_Q) + (size_t)b * SEQ * 1024 + h * 256; Tn.qp = 1024; Tn.kp = 2048; Tn.vp = 2048; Tn.op = 1024;
            att::unit<16, 8, 4, 4, true, true>(Tn, qb * 128, MEML / 64, cb, (char*)lds + RING_OFF, (LAS float*)(F.lds + AUX_WSF));
        }
#endif
        for (int un = F.vcu; un < BATCH * 4 * 16; un += F.G) {
            const int qb = un & 15, bh = un >> 4, b = bh >> 2, h = bh & 3;
            att::Tensors Tn; Tn.Q = (const bf16*)(ws + WS_QX) + (size_t)b * SEQ * 1024 + h * 256; Tn.K = (const bf16*)(ws + WS_KVX) + (size_t)b * MEML * 2048 + h * 256;
            Tn.V = (const bf16*)(ws + WS_KVX) + (size_t)b * MEML * 2048 + 1024 + h * 256; Tn.O = (bf16*)(ws + WS_QX) + (size_t)b * SEQ * 1024 + h * 256; Tn.qp = 1024; Tn.kp = 2048; Tn.vp = 2048; Tn.op = 1024;
            att::unit<16, 8, 8, 8, false, true>(Tn, qb * 256, MEML / 64, cb, (char*)lds + RING_OFF, (LAS float*)(F.lds + AUX_WSF));
        }

}
__device__ __forceinline__ void phase_7(Frame& F, const Inputs& in, float* d_out_, unsigned char* ws, unsigned char* lds) {
    LAS float* RS = (LAS float*)(F.lds + AUX_RS); LAS float* WG = (LAS float*)(F.lds + AUX_WG); LAS int* TOK = (LAS int*)(F.lds + AUX_TOK); LAS float* XP = (LAS float*)(F.lds + AUX_XP);
    const float* misc = (const float*)(ws + WS_MISC); (void)RS; (void)WG; (void)TOK; (void)XP; (void)misc;
        SchedGrid S; S.pad_ = 0; S.o.init(T / 256, 4, F.G, (int)blockIdx.x); S.A = (const char*)(ws + WS_QX); S.B = (const char*)(ws + W_XO); S.astep = (size_t)256 * 1024 * 2; S.bstep = (size_t)256 * 1024 * 2;
        EpiRes<true> E{(const void*)(ws + WS_XN), (bf16_t*)(ws + WS_XN), (float*)(ws + WS_SSP2)};
        pg8::gemm_phase<EpiRes<true>, SchedGrid, true, false, 1024, 1024, 1024, 16>(F.lds + RING_OFF, S, E);

}
__device__ __forceinline__ void phase_8(Frame& F, const Inputs& in, float* d_out_, unsigned char* ws, unsigned char* lds) {
    LAS float* RS = (LAS float*)(F.lds + AUX_RS); LAS float* WG = (LAS float*)(F.lds + AUX_WG); LAS int* TOK = (LAS int*)(F.lds + AUX_TOK); LAS float* XP = (LAS float*)(F.lds + AUX_XP);
    const float* misc = (const float*)(ws + WS_MISC); (void)RS; (void)WG; (void)TOK; (void)XP; (void)misc;
        { SchedGrid S; S.pad_ = 0; S.o.init(T / 256, 1, F.G, (int)blockIdx.x); S.A = (const char*)(ws + WS_XN); S.B = (const char*)(ws + W_R); S.astep = (size_t)256 * 1024 * 2; S.bstep = 0;
          EpiRouter E{(const float*)(ws + WS_SSP2), in.b_group, in.b_expert, (float*)(ws + WS_LG), RS, 0};
          pg8::gemm_phase<EpiRouter, SchedGrid, true, false, 1024, 1024, 1024, 16>(F.lds + RING_OFF, S, E); }
        __syncthreads();
        moe_weights(F, in);

}
__device__ __forceinline__ void phase_9(Frame& F, const Inputs& in, float* d_out_, unsigned char* ws, unsigned char* lds) {
    LAS float* RS = (LAS float*)(F.lds + AUX_RS); LAS float* WG = (LAS float*)(F.lds + AUX_WG); LAS int* TOK = (LAS int*)(F.lds + AUX_TOK); LAS float* XP = (LAS float*)(F.lds + AUX_XP);
    const float* misc = (const float*)(ws + WS_MISC); (void)RS; (void)WG; (void)TOK; (void)XP; (void)misc;
 moe_route(F);
}
__device__ __forceinline__ void phase_10(Frame& F, const Inputs& in, float* d_out_, unsigned char* ws, unsigned char* lds) {
    LAS float* RS = (LAS float*)(F.lds + AUX_RS); LAS float* WG = (LAS float*)(F.lds + AUX_WG); LAS int* TOK = (LAS int*)(F.lds + AUX_TOK); LAS float* XP = (LAS float*)(F.lds + AUX_XP);
    const float* misc = (const float*)(ws + WS_MISC); (void)RS; (void)WG; (void)TOK; (void)XP; (void)misc;
 moe_place(F);
}
__device__ __forceinline__ void phase_11(Frame& F, const Inputs& in, float* d_out_, unsigned char* ws, unsigned char* lds) {
    LAS float* RS = (LAS float*)(F.lds + AUX_RS); LAS float* WG = (LAS float*)(F.lds + AUX_WG); LAS int* TOK = (LAS int*)(F.lds + AUX_TOK); LAS float* XP = (LAS float*)(F.lds + AUX_XP);
    const float* misc = (const float*)(ws + WS_MISC); (void)RS; (void)WG; (void)TOK; (void)XP; (void)misc;
        SchedMoeA S; S.pad_ = 0; S.ntile = __builtin_amdgcn_readfirstlane((int)__hip_atomic_load((unsigned*)(F.ctl + CW_NT), RLX_AGENT)); S.G = F.G; S.c = F.vcu; S.tileb = (const int*)(ws + WS_REC + 2 * MiB); S.rowlist = (const int*)(ws + WS_REC + 1 * MiB);
        S.XN = (const char*)(ws + WS_XN); S.WGU = (const char*)(ws + WS_WGU);
        const float* w0 = (const float*)(ws + WS_REC) + 2 * T;
        EpiMoeA E{(const float*)(ws + WS_SSP2), w0, w0 + T, (bf16_t*)(ws + WS_H), RS, WG};
        pg8::gemm_phase<EpiMoeA, SchedMoeA, true, true, 1024, 1024, 1024, 16>(F.lds + RING_OFF, S, E);

}
__device__ __forceinline__ void phase_12(Frame& F, const Inputs& in, float* d_out_, unsigned char* ws, unsigned char* lds) {
    LAS float* RS = (LAS float*)(F.lds + AUX_RS); LAS float* WG = (LAS float*)(F.lds + AUX_WG); LAS int* TOK = (LAS int*)(F.lds + AUX_TOK); LAS float* XP = (LAS float*)(F.lds + AUX_XP);
    const float* misc = (const float*)(ws + WS_MISC); (void)RS; (void)WG; (void)TOK; (void)XP; (void)misc;
        SchedMoeB S; S.pad_ = 0; S.ntile = __builtin_amdgcn_readfirstlane((int)__hip_atomic_load((unsigned*)(F.ctl + CW_NT), RLX_AGENT)); S.G = F.G; S.c = F.vcu; S.tileb = (const int*)(ws + WS_REC + 2 * MiB); S.rowlist = (const int*)(ws + WS_REC + 1 * MiB);
        S.Hb = (const char*)(ws + WS_H); S.WD = (const char*)(ws + WS_WD);
        EpiMoeB E{(const bf16_t*)(ws + WS_XN), d_out_, TOK, 0};
        pg8::gemm_phase<EpiMoeB, SchedMoeB, true, false, 512, 512, 256, 4>(F.lds + RING_OFF, S, E);

}

constexpr int N_PHASES = 13;
struct Args { Inputs in; float* out; unsigned char* ws; int ph_lo, ph_hi; };
__global__ void __launch_bounds__(NWAVES * 64, 2) mega_fwd(Args args) {
    extern __shared__ __attribute__((aligned(16))) unsigned char lds[];
    Frame F;
    F.lds = (LAS unsigned char*)lds;
    F.MISC = (volatile LAS unsigned*)(F.lds + MISC_OFF);
    F.tid = threadIdx.x; F.lane = F.tid & 63; F.wave = __builtin_amdgcn_readfirstlane(F.tid >> 6);
    F.G = gridDim.x; { const int bx = blockIdx.x; F.vcu = (F.G % 8 == 0) ? (bx % 8) * (F.G / 8) + bx / 8 : bx; }
    F.ws = args.ws; F.ctl = (gu32*)(args.ws + WS_CTL);
    const Inputs& in = args.in;
    unsigned char* ws = args.ws;
    for (int u = F.tid; u < 32; u += NWAVES * 64) ((LAS unsigned*)(F.lds + MISC_OFF))[u] = 0u;
    __syncthreads();
    const int lo = args.ph_lo, hi = args.ph_hi;
    const bool multi = (hi - lo) > 1;
    XcdBarrier bar; bar.bar = (unsigned*)(F.ctl + CW_BAR); bar.x = 0; bar.st = nullptr;
    if (multi) bar = xcd_barrier_post((unsigned*)(F.ctl + CW_BAR), F.MISC + 8);
#ifndef MK_PHASE_MASK
#define MK_PHASE_MASK 0xffff
#endif
#define IN(k) ((((MK_PHASE_MASK) >> (k)) & 1) && lo <= (k) && (k) < hi)
#ifndef MK_REP_MASK
#define MK_REP_MASK 0
#endif
#define REPS(k) ((((MK_REP_MASK) >> (k)) & 1) ? 2 : 1)
#define SEAM(k) do { if (IN(k) && IN((k) + 1)) xcd_barrier(bar); } while (0)
    LAS float* RS = (LAS float*)(F.lds + AUX_RS); LAS float* WG = (LAS float*)(F.lds + AUX_WG); LAS int* TOK = (LAS int*)(F.lds + AUX_TOK); LAS float* XP = (LAS float*)(F.lds + AUX_XP);
    const float* misc = (const float*)(ws + WS_MISC);

    if (IN(0)) { phase_0(F, in, args.out, ws, lds); if (REPS(0) > 1) { __syncthreads(); phase_0(F, in, args.out, ws, lds); } }
    SEAM(0);
    if (IN(1)) { phase_1(F, in, args.out, ws, lds); if (REPS(1) > 1) { __syncthreads(); phase_1(F, in, args.out, ws, lds); } }
    SEAM(1);
    if (IN(2)) { phase_2(F, in, args.out, ws, lds); if (REPS(2) > 1) { __syncthreads(); phase_2(F, in, args.out, ws, lds); } }
    SEAM(2);
    if (IN(3)) { phase_3(F, in, args.out, ws, lds); if (REPS(3) > 1) { __syncthreads(); phase_3(F, in, args.out, ws, lds); } }
    SEAM(3);
    if (IN(4)) { phase_4(F, in, args.out, ws, lds); if (REPS(4) > 1) { __syncthreads(); phase_4(F, in, args.out, ws, lds); } }
    SEAM(4);
    if (IN(5)) { phase_5(F, in, args.out, ws, lds); if (REPS(5) > 1) { __syncthreads(); phase_5(F, in, args.out, ws, lds); } }
    SEAM(5);
    if (IN(6)) { phase_6(F, in, args.out, ws, lds); if (REPS(6) > 1) { __syncthreads(); phase_6(F, in, args.out, ws, lds); } }
    SEAM(6);
    if (IN(7)) { phase_7(F, in, args.out, ws, lds); if (REPS(7) > 1) { __syncthreads(); phase_7(F, in, args.out, ws, lds); } }
    SEAM(7);
    if (IN(8)) { phase_8(F, in, args.out, ws, lds); if (REPS(8) > 1) { __syncthreads(); phase_8(F, in, args.out, ws, lds); } }
    SEAM(8);
    if (IN(9)) { phase_9(F, in, args.out, ws, lds); if (REPS(9) > 1) { __syncthreads(); phase_9(F, in, args.out, ws, lds); } }
    SEAM(9);
    if (IN(10)) { phase_10(F, in, args.out, ws, lds); if (REPS(10) > 1) { __syncthreads(); phase_10(F, in, args.out, ws, lds); } }
    SEAM(10);
    if (IN(11)) { phase_11(F, in, args.out, ws, lds); if (REPS(11) > 1) { __syncthreads(); phase_11(F, in, args.out, ws, lds); } }
    SEAM(11);
    if (IN(12)) { phase_12(F, in, args.out, ws, lds); if (REPS(12) > 1) { __syncthreads(); phase_12(F, in, args.out, ws, lds); } }
#undef IN
#undef SEAM
}
#ifndef MK_DEBUG
#define MK_DEBUG 0
#endif
#ifndef MK_PER_PHASE
#define MK_PER_PHASE MK_DEBUG
#endif
#if MK_DEBUG
struct CmpDesc { const void* test; const float* ref; size_t rhs; int ttype, tld, rld, cw, rows, cols, tfm, slot; float rscale; int pad; };
__global__ void __launch_bounds__(256) cmp_k(CmpDesc d, double* sums) {
    __shared__ double red[2][4];
    double sd = 0.0, sr = 0.0;
    const size_t n = (size_t)d.rows * d.cols;
    for (size_t idx = (size_t)blockIdx.x * 256 + threadIdx.x; idx < n; idx += (size_t)gridDim.x * 256) {
        const int r = (int)(idx / d.cols), c = (int)(idx % d.cols);
        float tv;
        if (d.ttype == 0) tv = bf2f(((const bf16*)d.test)[(size_t)r * d.tld + c]);
        else if (d.ttype == 1) tv = h2f(((const unsigned short*)d.test)[(size_t)r * d.tld + c]);
        else tv = ((const float*)d.test)[(size_t)r * d.tld + c];
        float rv = d.ref[(size_t)(c / d.cw) * d.rhs + (size_t)r * d.rld + (c % d.cw)] * d.rscale;
        if (d.tfm == 1) rv = rv / (1.0f + expf(-rv));
        if (d.tfm == 2) tv = expf(tv);
        const double df = (double)tv - (double)rv; sd += df * df; sr += (double)rv * (double)rv;
    }
    for (int o = 32; o; o >>= 1) { sd += __shfl_xor(sd, o); sr += __shfl_xor(sr, o); }
    if ((threadIdx.x & 63) == 0) { red[0][threadIdx.x >> 6] = sd; red[1][threadIdx.x >> 6] = sr; }
    __syncthreads();
    if (threadIdx.x == 0) { atomicAdd(&sums[2 * d.slot], red[0][0] + red[0][1] + red[0][2] + red[0][3]); atomicAdd(&sums[2 * d.slot + 1], red[1][0] + red[1][1] + red[1][2] + red[1][3]); }
}
__global__ void verdict_k(const double* sums, const float* tols, int nslot, unsigned* code) {
    if (threadIdx.x == 0 && blockIdx.x == 0) { unsigned c = 0;
        for (int k = 0; k < nslot; ++k) { const double rvr = sums[2 * k] / sums[2 * k + 1]; if (!(rvr <= (double)tols[k])) { c = (unsigned)(k + 1); break; } }
        *code = c; }
}
__global__ void poison_k(const unsigned* code, const float* x, float* out, size_t n) {
    const unsigned c = *code; if (c == 0) return;
    const float f = 1.0f + exp2f((float)c);
    for (size_t i = (size_t)blockIdx.x * blockDim.x + threadIdx.x; i < n; i += (size_t)gridDim.x * blockDim.x) out[i] = x[i] * f;
}
__global__ void settol_k(float* tols) { const float t[16] = MK_TOLS; if (threadIdx.x < 16) tols[threadIdx.x] = t[threadIdx.x]; }
#endif

extern "C" void kernel_launch(void* const* d_in, const int* in_sizes, int n_in, void* d_out, int out_size, void* d_ws, size_t ws_size, hipStream_t stream) {
    static int grid = 0;
    if (grid == 0) {
        if (n_in != 29 || out_size != T * D || ws_size < WS_END + (MK_DEBUG ? 192 * MiB : 0)) { fprintf(stderr, "kernel_launch: unexpected shapes (n_in %d, out %d, ws %zu)\n", n_in, out_size, ws_size); grid = -1; return; }
        int dev = 0, cus = 0;
        if (hipGetDevice(&dev) != hipSuccess || hipDeviceGetAttribute(&cus, hipDeviceAttributeMultiprocessorCount, dev) != hipSuccess) { grid = -1; return; }
        if (hipFuncSetAttribute((const void*)mega_fwd, hipFuncAttributeMaxDynamicSharedMemorySize, LDS_BYTES) != hipSuccess) { fprintf(stderr, "kernel_launch: hipFuncSetAttribute failed\n"); grid = -1; return; }
        int per_cu = 0;
        if (hipOccupancyMaxActiveBlocksPerMultiprocessor(&per_cu, (const void*)mega_fwd, NWAVES * 64, LDS_BYTES) != hipSuccess || per_cu < 1) { fprintf(stderr, "kernel_launch: occupancy query says %d\n", per_cu); }
        (void)hipGetLastError();
        grid = cus;
    }
    if (grid < 0) return;
    (void)hipMemsetAsync((char*)d_ws + WS_CTL, 0, CTL_ZERO_BYTES, stream);
    Args a{};
    Inputs& w = a.in;
    w.x = (const float*)d_in[0]; w.mem = (const float*)d_in[1]; w.pos = (const int*)d_in[2]; w.norm_mix = (const float*)d_in[3]; w.w_in = (const float*)d_in[4];
    w.q_a_norm = (const float*)d_in[5]; w.w_q_up = (const float*)d_in[6]; w.kv_a_norm = (const float*)d_in[7]; w.w_kv_up = (const float*)d_in[8];
    w.q_norm = (const float*)d_in[9]; w.k_norm = (const float*)d_in[10]; w.lb_logits = (const float*)d_in[11]; w.o_norm = (const float*)d_in[12]; w.w_out = (const float*)d_in[13];
    w.norm_cross = (const float*)d_in[14]; w.norm_mem = (const float*)d_in[15]; w.x_w_q = (const float*)d_in[16]; w.x_w_kv = (const float*)d_in[17];
    w.x_q_norm = (const float*)d_in[18]; w.x_k_norm = (const float*)d_in[19]; w.x_w_o = (const float*)d_in[20]; w.norm_ffn = (const float*)d_in[21];
    w.w_group = (const float*)d_in[22]; w.b_group = (const float*)d_in[23]; w.w_expert = (const float*)d_in[24]; w.b_expert = (const float*)d_in[25];
    w.w_gate = (const float*)d_in[26]; w.w_up = (const float*)d_in[27]; w.w_down = (const float*)d_in[28];
    a.out = (float*)d_out; a.ws = (unsigned char*)d_ws;
    unsigned char* ws = (unsigned char*)d_ws;
#if MK_DEBUG
    constexpr int BC = MK_DEBUG_BATCH;
    orc::W ow; static_assert(sizeof(orc::W) == sizeof(Inputs), "same field list"); memcpy(&ow, &w, sizeof(ow));
    orc::Bufs B; B.carve2((float*)d_out, (float*)(ws + WS_END));
    double* sums = (double*)(ws + WS_CTL + CW_CHK * 4); float* tols = (float*)(sums + 64); unsigned* code = (unsigned*)(tols + 32);
    settol_k<<<1, 64, 0, stream>>>(tols);
    orc::pack_router<<<(1024 * 72 + 255) / 256, 256, 0, stream>>>(ow.w_group, ow.w_expert, B.wr);
    orc::run_batch(ow, B, BC, B.outb, stream);
    auto CMP = [&](int slot, const void* test, int ttype, int tld, const float* ref, int rld, int cw, size_t rhs, int rows, int cols, float rscale, int tfm) {
        CmpDesc d{}; d.test = test; d.ref = ref; d.rhs = rhs; d.ttype = ttype; d.tld = tld; d.rld = rld; d.cw = cw; d.rows = rows; d.cols = cols; d.tfm = tfm; d.slot = slot; d.rscale = rscale;
        cmp_k<<<512, 256, 0, stream>>>(d, sums); };
    const size_t r0 = (size_t)BC * SEQ;
#endif
    auto PH = [&](int lo, int hi) { a.ph_lo = lo; a.ph_hi = hi; hipLaunchKernelGGL(mega_fwd, dim3(grid), dim3(NWAVES * 64), LDS_BYTES, stream, a); };
#if MK_PER_PHASE
    for (int p = 0; p < N_PHASES; ++p) {
        PH(p, p + 1);
#if MK_DEBUG
        if (p == 1) {
            CMP(0, (bf16*)(ws + WS_HQ) + r0 * 512, 0, 512, B.qs, 512, 512, 0, SEQ, 512, 1.f, 0);
            CMP(1, (bf16*)(ws + WS_GF) + r0 * 512, 1, 512, B.f, 512, 512, 0, SEQ, 512, 1.f, 2);
            CMP(1, (bf16*)(ws + WS_GB) + r0 * 512, 1, 512, B.f + (size_t)SEQ * 512, 512, 512, 0, SEQ, 512, 1.f, 2);
            CMP(2, (bf16*)(ws + WS_HI) + r0 * 512, 0, 512, B.p + 1888, 2912, 512, 0, SEQ, 512, 1.f, 0);
            CMP(2, (bf16*)(ws + WS_HG) + r0 * 512, 0, 512, B.p + 2400, 2912, 512, 0, SEQ, 512, 1.f, 1);
            CMP(3, (bf16*)(ws + WS_LAT) + r0 * 512, 0, 512, B.p, 2912, 352, 0, SEQ, 352, 1.f, 0);
        }
        if (p == 2) {
            CMP(4, (bf16*)(ws + WS_Q) + r0 * 768, 0, 768, B.Qn, 96, 96, (size_t)SEQ * 96, SEQ, 768, QSCALE_MLA, 0);
            CMP(5, (bf16*)(ws + WS_K) + r0 * 768, 0, 768, B.Kn, 96, 96, (size_t)SEQ * 96, SEQ, 768, 1.f, 0);
            CMP(6, (bf16*)(ws + WS_V) + r0 * 512, 0, 512, B.V, 64, 64, (size_t)SEQ * 64, SEQ, 512, 1.f, 0);
            CMP(7, (bf16*)(ws + WS_KVX) + (size_t)BC * MEML * 2048, 0, 2048, B.kvx, 2048, 2048, 0, MEML, 2048, 1.f, 0);
            CMP(8, (bf16*)(ws + WS_OF) + r0 * 512, 0, 512, B.o, 512, 512, 0, SEQ, 512, 1.f, 0);
            CMP(8, (bf16*)(ws + WS_OB) + r0 * 512, 0, 512, B.o + (size_t)SEQ * 512, 512, 512, 0, SEQ, 512, 1.f, 0);
        }
        if (p == 3) {
            CMP(9, (bf16*)(ws + WS_CAT) + r0 * 1024 + 512, 0, 1024, B.cat + 512, 1024, 512, 0, SEQ, 512, 1.f, 0);
            CMP(10, (bf16*)(ws + WS_CAT) + r0 * 1024, 0, 1024, B.cat, 1024, 512, 0, SEQ, 512, 1.f, 0);
        }
        if (p == 4) CMP(11, (bf16*)(ws + WS_XN) + r0 * 1024, 0, 1024, B.x1, 1024, 1024, 0, SEQ, 1024, 1.f, 0);
        if (p == 5) CMP(12, (bf16*)(ws + WS_QX) + r0 * 1024, 0, 1024, B.qx, 1024, 1024, 0, SEQ, 1024, 0.0625f * LOG2E, 0);
        if (p == 6) CMP(13, (bf16*)(ws + WS_QX) + r0 * 1024, 0, 1024, B.ox, 1024, 1024, 0, SEQ, 1024, 1.f, 0);
        if (p == 7) CMP(14, (bf16*)(ws + WS_XN) + r0 * 1024, 0, 1024, B.x2, 1024, 1024, 0, SEQ, 1024, 1.f, 0);
        if (p == 12) CMP(15, (float*)d_out + r0 * 1024, 2, 1024, B.outb, 1024, 1024, 0, SEQ, 1024, 1.f, 0);
#endif
    }
#if MK_DEBUG
    verdict_k<<<1, 64, 0, stream>>>(sums, tols, 16, code);
    poison_k<<<1024, 256, 0, stream>>>(code, w.x, (float*)d_out, (size_t)T * D);
#endif
#else
    PH(0, N_PHASES);
#endif
}
```

```cpp
#include <hip/hip_runtime.h>
#include <cstdio>
#include <cstdint>
#include <cstring>
#include <cmath>
#ifndef MK_TPROBE
#define MK_TPROBE 0
#endif
#define TP_LDS_OFF (131072 + 12288 + 256)
#if MK_TPROBE
#define TP_NOW(v) do { v = __builtin_amdgcn_s_memtime(); asm volatile("s_waitcnt lgkmcnt(0)" ::: "memory"); } while (0)
#define TP_ADD(ldsbase, wid, which, t0, t1) do { if (((volatile __attribute__((address_space(3))) unsigned*)((ldsbase) + TP_LDS_OFF))[63] != 0u && (pg8::tid_opaque() & 63) == 0) { \
        volatile __attribute__((address_space(3))) unsigned long long* p_ = (volatile __attribute__((address_space(3))) unsigned long long*)((ldsbase) + TP_LDS_OFF + 256) + (wid) * 4 + (which); *p_ = *p_ + ((t1) - (t0)); } } while (0)
#define TP_SET(ldsbase, on) do { if (pg8::tid_opaque() == 0) ((volatile __attribute__((address_space(3))) unsigned*)((ldsbase) + TP_LDS_OFF))[63] = (on); __syncthreads(); } while (0)
#define TPS_BEGIN() unsigned long long tps0_ = 0, tps1_ = 0; TP_NOW(tps0_)
#define TPS_END(F) do { TP_NOW(tps1_); if ((F).lane() == 0) { volatile __attribute__((address_space(3))) unsigned long long* q_ = (volatile __attribute__((address_space(3))) unsigned long long*)((F).lds + TP_LDS_OFF + 256) + (F).wave * 4 + 2; *q_ = *q_ + (tps1_ - tps0_); } } while (0)
#else
#define TPS_BEGIN() do {} while (0)
#define TPS_END(F) do {} while (0)
#define TP_NOW(v) do {} while (0)
#define TP_ADD(ldsbase, wid, which, t0, t1) do {} while (0)
#define TP_SET(ldsbase, on) do {} while (0)
#endif
namespace pg8 {
#define PG8_LAS __attribute__((address_space(3)))
typedef unsigned short bf16_t;
typedef short bf16x8 __attribute__((ext_vector_type(8)));
typedef float f32x4 __attribute__((ext_vector_type(4)));
typedef float f32x2 __attribute__((ext_vector_type(2)));
typedef unsigned u32x4 __attribute__((ext_vector_type(4)));
constexpr int BM = 256, BK = 64, HALF = 128, HTB = HALF * BK * 2, STAGE_BYTES = 8 * HTB, NXCD = 8, WGM = 8;

__host__ __device__ __forceinline__ int lds_byte(int r, int c) { const int st = (r >> 4) * 2 + (c >> 5), rr = r & 15, cc = c & 31, ob = rr * 64 + cc * 2; return st * 1024 + (ob ^ (((ob >> 9) & 1) << 5)); }
__host__ __device__ __forceinline__ void stage_rc(int b, int& R, int& C) { const int st = b / 1024, sb = b % 1024, swz = sb ^ (((sb >> 9) & 1) << 5); R = (st >> 1) * 16 + swz / 64; C = (st & 1) * 32 + (swz % 64) / 2; }
__host__ __device__ __forceinline__ int perm32(int rho) { const int n = rho >> 4, i = rho & 15; return 8 * (i >> 2) + 4 * n + (i & 3); }

struct Unit { int pm, pn; const char* a; const char* b0; const char* b1; const int* rows; const int* map0; const int* map1; int hi = 1, upad_ = 0; };

struct GridOrder {
    int nM, nN, nwg, G, c, wgm;
    __device__ void init(int nM_, int nN_, int G_, int c_, int wgm_ = WGM) { nM = nM_; nN = nN_; nwg = nM * nN; G = G_; c = c_; wgm = wgm_; }
    __device__ bool tile(int i, int& pm, int& pn) const {
        const long L = (long)i * G + c; if (L >= nwg) return false;
        int wgid = (int)L; { const int q = nwg / NXCD, r = nwg % NXCD, xcd = wgid % NXCD, off = wgid / NXCD; wgid = (xcd < r ? xcd * (q + 1) : r * (q + 1) + (xcd - r) * q) + off; }
        const int nig = wgm * nN, gid = wgid / nig, fm = gid * wgm, gsz = (nM - fm) < wgm ? (nM - fm) : wgm;
        pm = fm + ((wgid % nig) % gsz); pn = (wgid % nig) / gsz; return true;
    }
};

__device__ __forceinline__ int tid_opaque() { int t = (int)threadIdx.x; asm volatile("" : "+v"(t)); return t; }
__device__ __forceinline__ unsigned cvt_pk_bf16(float lo, float hi) { unsigned r; asm volatile("v_cvt_pk_bf16_f32 %0, %1, %2" : "=v"(r) : "v"(lo), "v"(hi)); return r; }
__device__ __forceinline__ float bf_lo(unsigned w) { return __uint_as_float(w << 16); }
__device__ __forceinline__ float bf_hi(unsigned w) { return __uint_as_float(w & 0xffff0000u); }

template <class Epi, class Sched, bool ALIGN_EPI, int GATHER, int K, int lda, int ldb, int tsplit>
__device__ __forceinline__ void gemm_phase(PG8_LAS unsigned char* lds, const Sched S, const Epi E) {
    const int tid = tid_opaque(), wid = __builtin_amdgcn_readfirstlane(tid >> 6), lane = tid & 63, wr = wid >> 2, wc = wid & 3, fr = lane & 15, fq = lane >> 4;
    constexpr int nt = K / BK;
    unsigned voffA[2], voffB[2]; int RA[2], CA[2];
#pragma unroll
    for (int i = 0; i < 2; ++i) { int R, C; stage_rc(tid * 16 + i * 8192, R, C); const int Rb = (R & ~31) + perm32(R & 31);
        voffA[i] = (unsigned)(R * lda + C) * 2u; voffB[i] = (unsigned)(Rb * ldb + C) * 2u; RA[i] = R; CA[i] = C; }
    const size_t kstep = (size_t)(BK * 2);
    const size_t hstepA = (size_t)HALF * lda * 2, hstepB = (size_t)HALF * ldb * 2;
    const unsigned ldsw = (unsigned)wid * 1024u;
    const int aoff = lds_byte(wr * 64 + fr, fq * 8), boff = lds_byte(wc * 32 + fr, fq * 8);
#define PG8_SA(b, h) (((b) * 2 + (h)) * HTB)
#define PG8_SB(b, h) ((4 + (b) * 2 + (h)) * HTB)
#define PG8_STAGE(bufoff, gbase, voff) do { _Pragma("unroll") for (int _i = 0; _i < 2; ++_i) \
        __builtin_amdgcn_global_load_lds((const unsigned*)((const char*)(gbase) + (voff)[_i]), (PG8_LAS unsigned*)(lds + (bufoff) + ldsw + _i * 8192), 16, 0, 0); } while (0)
#define PG8_STAGE_A(bufoff, p, h, nx, sel) do { if constexpr (GATHER != 0) { unsigned _o[2]; \
            if constexpr (GATHER == 2) { _o[0] = (nx) ? nvA[h][0] : ((sel) ? cvB[h][0] : cvA[h][0]); _o[1] = (nx) ? nvA[h][1] : ((sel) ? cvB[h][1] : cvA[h][1]); } \
            else { _o[0] = (nx) ? nvA[h][0] : cvA[h][0]; _o[1] = (nx) ? nvA[h][1] : cvA[h][1]; } PG8_STAGE(bufoff, p, _o); } \
        else { PG8_STAGE(bufoff, (p) + (h) * hstepA, voffA); } } while (0)
#define PG8_LDA(dst, b, h) do { _Pragma("unroll") for (int m = 0; m < 4; ++m) _Pragma("unroll") for (int k = 0; k < 2; ++k) dst[m][k] = *(const PG8_LAS bf16x8*)(lds + PG8_SA(b, h) + aoff + m * 2048 + k * 1024); } while (0)
#define PG8_LDB(dst, b, h) do { _Pragma("unroll") for (int n = 0; n < 2; ++n) _Pragma("unroll") for (int k = 0; k < 2; ++k) dst[n][k] = *(const PG8_LAS bf16x8*)(lds + PG8_SB(b, h) + boff + n * 2048 + k * 1024); } while (0)
#define PG8_MMA(ai, bj, At, Bt) do { __builtin_amdgcn_s_setprio(1); _Pragma("unroll") for (int m = 0; m < 4; ++m) _Pragma("unroll") for (int n = 0; n < 2; ++n) _Pragma("unroll") for (int k = 0; k < 2; ++k) \
        acc[ai][bj][m][n] = __builtin_amdgcn_mfma_f32_16x16x32_bf16(Bt[n][k], At[m][k], acc[ai][bj][m][n], 0, 0, 0); __builtin_amdgcn_s_setprio(0); } while (0)
#define PG8_WAIT_V(n) asm volatile("s_waitcnt vmcnt(" #n ")" ::: "memory")
#define PG8_WAIT_L(n) asm volatile("s_waitcnt lgkmcnt(" #n ")" ::: "memory")
#define PG8_BAR __builtin_amdgcn_s_barrier()
#define PG8_SCHED __builtin_amdgcn_sched_barrier(0)
#define PG8_GOFF(dst, u, second) do { if constexpr (GATHER != 0) { _Pragma("unroll") for (int _h = 0; _h < 2; ++_h) _Pragma("unroll") for (int _i = 0; _i < 2; ++_i) { \
        int _r = (GATHER == 2 && (second)) ? (u).map1[_h * HALF + RA[_i]] : (u).rows[_h * HALF + RA[_i]]; _r = _r < 0 ? 0 : _r; dst[_h][_i] = (unsigned)(_r * lda + CA[_i]) * 2u; } } } while (0)
    Unit cur, nxt; int ui = 0;
    if (!S.next(0, cur)) return;
    unsigned long long tp_s_ = 0, tp_e_ = 0, tp_0_ = 0, tp_1_ = 0; (void)tp_s_; (void)tp_e_; (void)tp_0_; (void)tp_1_;
    TP_NOW(tp_s_);
    unsigned cvA[2][2] = {{0u, 0u}, {0u, 0u}}, nvA[2][2] = {{0u, 0u}, {0u, 0u}}, cvB[2][2] = {{0u, 0u}, {0u, 0u}};
    PG8_GOFF(cvA, cur, false); PG8_GOFF(cvB, cur, true);
    f32x4 acc[2][2][4][2];
#pragma unroll
    for (int a = 0; a < 2; ++a)
#pragma unroll
        for (int b = 0; b < 2; ++b)
#pragma unroll
            for (int m = 0; m < 4; ++m)
#pragma unroll
                for (int n = 0; n < 2; ++n) acc[a][b][m][n] = (f32x4){0.f, 0.f, 0.f, 0.f};
    bf16x8 At[4][2], B0[2][2], B1[2][2];
    const char* cA = cur.a; const char* cB = cur.b0; const char* cB1 = cur.b1;
    E.prep(cur, 0);
    PG8_STAGE(PG8_SB(0, 0), cB, voffB); PG8_STAGE(PG8_SB(0, 1), cB + hstepB, voffB); PG8_STAGE_A(PG8_SA(0, 0), cA, 0, false, false); PG8_STAGE_A(PG8_SA(0, 1), cA, 1, false, false);
    if (wr == 1) PG8_BAR;
    PG8_WAIT_V(2); PG8_BAR;
    PG8_STAGE(PG8_SB(1, 0), cB + kstep, voffB); PG8_STAGE_A(PG8_SA(1, 0), cA + kstep, 0, false, false); PG8_STAGE(PG8_SB(1, 1), cB + hstepB + kstep, voffB);
    PG8_WAIT_V(6); PG8_BAR;
    for (;;) {
        const bool has_next = S.next(ui + 1, nxt);
        const char* nA = has_next ? nxt.a : cA; const char* nB = has_next ? nxt.b0 : cB;
#pragma nounroll
        for (int t = 0; t < nt; t += 2) {
            const bool last = (t == nt - 2);
            const bool lnx = last && has_next;
            const bool hi_ok = (GATHER != 2) || (cur.hi != 0);
            const bool s1 = (GATHER == 2) && (t + 1 >= tsplit), s2 = (GATHER == 2) && !last && (t + 2 >= tsplit);
            const char* a1 = cA + (size_t)(t + 1 - (s1 ? tsplit : 0)) * kstep;
            const char* a2 = last ? nA : cA + (size_t)(t + 2 - (s2 ? tsplit : 0)) * kstep;
            const char* b2 = last ? nB : ((t + 2) < tsplit ? cB + (size_t)(t + 2) * kstep : cB1 + (size_t)(t + 2 - tsplit) * kstep);
            const char* a3 = a2 + kstep; const char* b3 = b2 + kstep;
            if (t == 0 && has_next) { PG8_GOFF(nvA, nxt, false); }
            PG8_LDB(B0, 0, 0); PG8_LDB(B1, 0, 1); PG8_SCHED; PG8_LDA(At, 0, 0); PG8_STAGE_A(PG8_SA(1, 1), a1, 1, false, s1);
            PG8_WAIT_V(8); PG8_WAIT_L(0); PG8_BAR; PG8_MMA(0, 0, At, B0); PG8_MMA(0, 1, At, B1); PG8_BAR; PG8_SCHED;
            PG8_LDA(At, 0, 1); PG8_STAGE(PG8_SB(0, 0), b2, voffB); PG8_STAGE(PG8_SB(0, 1), b2 + hstepB, voffB); PG8_STAGE_A(PG8_SA(0, 0), a2, 0, lnx, s2);
            PG8_WAIT_V(8); PG8_WAIT_L(0); PG8_BAR; if (hi_ok) { PG8_MMA(1, 0, At, B0); PG8_MMA(1, 1, At, B1); } PG8_BAR; PG8_SCHED;
            PG8_LDB(B0, 1, 0); PG8_LDB(B1, 1, 1); PG8_SCHED; PG8_LDA(At, 1, 0); PG8_STAGE_A(PG8_SA(0, 1), a2, 1, lnx, s2);
            PG8_WAIT_V(8); PG8_WAIT_L(0); PG8_BAR; PG8_MMA(0, 0, At, B0); PG8_MMA(0, 1, At, B1); PG8_BAR; PG8_SCHED;
            PG8_LDA(At, 1, 1); PG8_STAGE(PG8_SB(1, 0), b3, voffB); PG8_STAGE(PG8_SB(1, 1), b3 + hstepB, voffB); PG8_STAGE_A(PG8_SA(1, 0), a3, 0, lnx, s2);
            PG8_WAIT_V(8); PG8_WAIT_L(0); PG8_BAR; if (hi_ok) { PG8_MMA(1, 0, At, B0); PG8_MMA(1, 1, At, B1); } PG8_BAR; PG8_SCHED;
        }
        if constexpr (ALIGN_EPI) { if (wr == 0) PG8_BAR; }
        if constexpr (Epi::PREP_EARLY) { if (has_next) E.prep(nxt, (ui + 1) & 1); }
        TP_NOW(tp_0_);
        E(acc, cur, ui & 1, wr, wc, fr, fq, wid, lane);
        TP_NOW(tp_1_); TP_ADD(lds, wid, 0, tp_0_, tp_1_);
        if (!has_next) break;
        if constexpr (!Epi::PREP_EARLY) E.prep(nxt, (ui + 1) & 1);
#pragma unroll
        for (int a = 0; a < 2; ++a)
#pragma unroll
            for (int b = 0; b < 2; ++b)
#pragma unroll
                for (int m = 0; m < 4; ++m)
#pragma unroll
                    for (int n = 0; n < 2; ++n) acc[a][b][m][n] = (f32x4){0.f, 0.f, 0.f, 0.f};
        cur = nxt; cA = nA; cB = nB; cB1 = nxt.b1; ++ui;
        if constexpr (GATHER != 0) {
#pragma unroll
            for (int h = 0; h < 2; ++h) { cvA[h][0] = nvA[h][0]; cvA[h][1] = nvA[h][1]; }
            PG8_GOFF(cvB, cur, true);
        }
        if constexpr (ALIGN_EPI) { if (wr == 1) PG8_BAR; }
    }
    PG8_WAIT_V(0);
    if constexpr (!ALIGN_EPI) { if (wr == 0) PG8_BAR; }
    PG8_BAR;
    TP_NOW(tp_e_); TP_ADD(lds, wid, 1, tp_s_, tp_e_);
#undef PG8_SA
#undef PG8_SB
#undef PG8_STAGE
#undef PG8_STAGE_A
#undef PG8_LDA
#undef PG8_LDB
#undef PG8_MMA
#undef PG8_WAIT_V
#undef PG8_WAIT_L
#undef PG8_BAR
#undef PG8_SCHED
#undef PG8_GOFF
}
}
constexpr int NWAVES = 8;
constexpr int BATCH = 16, SEQ = 4096, D = 1024, T = BATCH * SEQ, MEML = 256;
constexpr float EPS = 1e-6f;
constexpr float LOG2E = 1.4426950408889634f;
constexpr size_t MiB = 1u << 20;
constexpr size_t WS_CTL = 0, CTL_ZERO_BYTES = 1 * MiB;
constexpr size_t WS_COS = 1 * MiB, WS_SIN = 5 * MiB;
constexpr size_t WS_SS0 = 9 * MiB;
constexpr size_t WS_SSP1 = 10 * MiB, WS_SSP2 = 14 * MiB;
constexpr size_t WS_MISC = 18 * MiB;
constexpr size_t WS_W = 20 * MiB;
constexpr size_t W_IN = WS_W, W_Q = W_IN + 6 * MiB, W_KV = W_Q + 512 * 1024, W_OUT = W_KV + 512 * 1024, W_XQ = W_OUT + 2 * MiB, W_XKV = W_XQ + 2 * MiB, W_XO = W_XKV + 4 * MiB, W_R = W_XO + 2 * MiB;
constexpr size_t WS_MN = 40 * MiB, WS_KVX = 48 * MiB;
constexpr size_t WS_XN = 64 * MiB;
#if defined(MK_DEBUG) && MK_DEBUG
constexpr size_t WS_OF = 64 * MiB, WS_OB = 128 * MiB;
constexpr bool XN0_KEPT = false;
#else
constexpr size_t WS_OF = 832 * MiB, WS_OB = 896 * MiB;
constexpr bool XN0_KEPT = true;
#endif
constexpr size_t WS_HQ = 192 * MiB, WS_GF = 256 * MiB, WS_GB = 320 * MiB, WS_HI = 384 * MiB, WS_HG = 448 * MiB, WS_LAT = 512 * MiB;
constexpr size_t WS_CAT = 192 * MiB;
constexpr size_t WS_QX = 320 * MiB;
constexpr size_t WS_Q = 576 * MiB, WS_K = 672 * MiB, WS_V = 768 * MiB;
#if MK_DEBUG
constexpr size_t WS_WGU = 576 * MiB, WS_WD = 640 * MiB;
#else
constexpr size_t WS_WGU = 960 * MiB, WS_WD = 640 * MiB;
#endif
constexpr size_t WS_H = 672 * MiB;
constexpr size_t WS_LG = 792 * MiB;
constexpr size_t WS_REC = 810 * MiB;
constexpr size_t WS_END = 832 * MiB, WS_END_REL = 1024 * MiB;
constexpr int MOE_MAXROWS = 122880, MOE_MAXTILES = 480;
constexpr int CW_CNTP = 32768;
constexpr int CW_TMO = 0, CW_BAR = 4096, CW_CNT = 16384  , CW_CNTE = 16896  , CW_NT = 17000  , CW_NTE = 17064  , CW_CHK = 20000  ;
constexpr size_t REC_ROWPA = 7 * MiB, REC_ROWPB = 8 * MiB, REC_ROWP = 3 * MiB, REC_TILEP = 3 * MiB + 512 * 1024, REC_ROWE = 4 * MiB, REC_WSLOT = 5 * MiB, REC_TILEE = 6 * MiB;
constexpr int MOE_MAXROWSE = 147456;

constexpr int RING_OFF = 0, RING_BYTES = 131072;
constexpr int AUX_OFF = RING_BYTES;
constexpr int AUX_RS = AUX_OFF, AUX_WG = AUX_OFF + 2048, AUX_TOK = AUX_OFF + 4096, AUX_XP = AUX_OFF + 6144, AUX_WSF = AUX_OFF + 10240;
constexpr int MISC_OFF = AUX_OFF + 12288;
constexpr int LDS_BYTES = 147456;

#define GAS __attribute__((address_space(1)))
#define LAS __attribute__((address_space(3)))
typedef unsigned short bf16;
typedef unsigned v4u __attribute__((ext_vector_type(4)));
typedef unsigned v2u __attribute__((ext_vector_type(2)));
typedef float f32x4 __attribute__((ext_vector_type(4)));
typedef float f32x16 __attribute__((ext_vector_type(16)));
typedef short bf16x8 __attribute__((ext_vector_type(8)));
typedef short s16x4 __attribute__((ext_vector_type(4)));
typedef GAS unsigned gu32;
#define RLX_AGENT __ATOMIC_RELAXED, __HIP_MEMORY_SCOPE_AGENT
#define LDS_WAIT() asm volatile("s_waitcnt lgkmcnt(0)" ::: "memory")
#define VM_WAIT() asm volatile("s_waitcnt vmcnt(0)" ::: "memory")
__device__ __forceinline__ unsigned f2bf(float f) { unsigned u = __builtin_bit_cast(unsigned, f); return (u + 0x7fffu + ((u >> 16) & 1u)) >> 16; }
__device__ __forceinline__ unsigned pk2(float lo, float hi) { return pg8::cvt_pk_bf16(lo, hi); }
__device__ __forceinline__ float bf2f(bf16 h) { return __uint_as_float((unsigned)h << 16); }
__device__ __forceinline__ float fast_rcp(float x) { return __builtin_amdgcn_rcpf(x); }
__device__ __forceinline__ float fast_exp2(float x) { return __builtin_amdgcn_exp2f(x); }
__device__ __forceinline__ float silu_f(float v) { return v * fast_rcp(1.0f + fast_exp2(-LOG2E * v)); }
__device__ __forceinline__ float rsq(float x) { return __builtin_amdgcn_rsqf(x); }
typedef _Float16 h16x2 __attribute__((ext_vector_type(2)));
__device__ __forceinline__ unsigned pkh2(float lo, float hi) { h16x2 h; h.x = (_Float16)lo; h.y = (_Float16)hi; return __builtin_bit_cast(unsigned, h); }
__device__ __forceinline__ float h2f(unsigned short h) { return (float)__builtin_bit_cast(_Float16, h); }

#define XB_TMO      128
#define XB_XCNT(j)  (256  + 64 * (j))
#define XB_XSUB(j)  (1280 + 64 * (j))
#define XB_XGEN(j)  (2304 + 64 * (j))
#define XB_TOP      3328
#define XB_TOPGEN   3392
#define XCD_BAR_WORDS 3456
#define XB_SPIN_CAP (1u << 18)
__device__ __forceinline__ unsigned xb_ld(unsigned* p)              { return __hip_atomic_load(p, __ATOMIC_RELAXED, __HIP_MEMORY_SCOPE_AGENT); }
__device__ __forceinline__ unsigned xb_add(unsigned* p, unsigned v) { return __hip_atomic_fetch_add(p, v, __ATOMIC_RELAXED, __HIP_MEMORY_SCOPE_AGENT); }
__device__ __forceinline__ unsigned xb_xcc_id() { return (unsigned)__builtin_amdgcn_s_getreg((3 << 11) | 20) & 0xFu; }
#define XB_SPIN(cond, bar) do { unsigned _sp = 0; while (cond) { __builtin_amdgcn_s_sleep(1); \
    if ((++_sp & 255u) == 0u) { if (xb_ld(&(bar)[XB_TMO])) break; if (_sp > XB_SPIN_CAP) { atomicAdd(&(bar)[XB_TMO], 1u); break; } } } } while (0)
struct XcdBarrier { unsigned* bar; unsigned x; volatile LAS unsigned* st; };
__device__ __forceinline__ XcdBarrier xcd_barrier_post(unsigned* bar, volatile LAS unsigned* st) {
    XcdBarrier b; b.bar = bar; b.x = xb_xcc_id(); b.st = st;
    if (threadIdx.x == 0) (void)xb_add(&bar[XB_XCNT(b.x)], 1u);
    return b;
}
__device__ __forceinline__ void xcd_barrier_complete(unsigned* bar, unsigned x, unsigned& nloc, unsigned& nx) {
    const unsigned G = gridDim.x * gridDim.y * gridDim.z;
    unsigned sum, cnt, mine, sp = 0u;
    for (;;) {
        sum = 0u; cnt = 0u; mine = 0u;
#pragma unroll
        for (unsigned j = 0; j < 16; ++j) { const unsigned c = xb_ld(&bar[XB_XCNT(j)]); sum += c; cnt += (c > 0u) ? 1u : 0u; mine = (j == x) ? c : mine; }
        if (sum == G) break;
        __builtin_amdgcn_s_sleep(1);
        if ((++sp & 255u) == 0u) { if (xb_ld(&bar[XB_TMO])) break; if (sp > XB_SPIN_CAP) { atomicAdd(&bar[XB_TMO], 1u); break; } }
    }
    nloc = mine > 0u ? mine : 1u; nx = cnt > 0u ? cnt : 1u;
}
__device__ __forceinline__ void xcd_barrier(const XcdBarrier& b) {
    asm volatile("s_waitcnt vmcnt(0)" ::: "memory");
    __syncthreads();
    if (threadIdx.x == 0) {
        unsigned* bar = b.bar;
        __builtin_amdgcn_s_waitcnt(0);
        unsigned nloc = b.st[0], nx = b.st[1];
        if (nloc == 0u) { xcd_barrier_complete(bar, b.x, nloc, nx); b.st[0] = nloc; b.st[1] = nx; }
        const unsigned old = xb_add(&bar[XB_XSUB(b.x)], 1u);
        const unsigned gen = old / nloc;
        if (old + 1u == (gen + 1u) * nloc) {
            __builtin_amdgcn_fence(__ATOMIC_RELEASE, "agent");
            asm volatile("s_waitcnt vmcnt(0)" ::: "memory");
            const unsigned og = xb_add(&bar[XB_TOP], 1u);
            const unsigned tg = og / nx;
            if (og + 1u == (tg + 1u) * nx) xb_add(&bar[XB_TOPGEN], 1u);
            else XB_SPIN(xb_ld(&bar[XB_TOPGEN]) == tg, bar);
            __builtin_amdgcn_fence(__ATOMIC_ACQUIRE, "agent");
            xb_add(&bar[XB_XGEN(b.x)], 1u);
            asm volatile("s_waitcnt vmcnt(0)" ::: "memory");
        } else {
            XB_SPIN(xb_ld(&bar[XB_XGEN(b.x)]) == gen, bar);
            __builtin_amdgcn_fence(__ATOMIC_ACQUIRE, "agent");
            asm volatile("s_waitcnt vmcnt(0)" ::: "memory");
        }
    }
    __syncthreads();
}

__device__ __forceinline__ void xcd_barrier_arrive(const XcdBarrier& b) {
    asm volatile("s_waitcnt vmcnt(0)" ::: "memory");
    __syncthreads();
    if (threadIdx.x == 0) {
        unsigned* bar = b.bar;
        __builtin_amdgcn_s_waitcnt(0);
        unsigned nloc = b.st[0], nx = b.st[1];
        if (nloc == 0u) { xcd_barrier_complete(bar, b.x, nloc, nx); b.st[0] = nloc; b.st[1] = nx; }
        const unsigned old = xb_add(&bar[XB_XSUB(b.x)], 1u);
        const unsigned gen = old / nloc;
        unsigned role = 0u, tg = 0u;
        if (old + 1u == (gen + 1u) * nloc) {
            __builtin_amdgcn_fence(__ATOMIC_RELEASE, "agent");
            asm volatile("s_waitcnt vmcnt(0)" ::: "memory");
            const unsigned og = xb_add(&bar[XB_TOP], 1u);
            tg = og / nx; role = 1u;
            if (og + 1u == (tg + 1u) * nx) { xb_add(&bar[XB_TOPGEN], 1u); role = 2u; }
        }
        b.st[2] = role; b.st[3] = gen; b.st[4] = tg;
    }
}
__device__ __forceinline__ void xcd_barrier_wait(const XcdBarrier& b) {
    asm volatile("s_waitcnt vmcnt(0)" ::: "memory");
    __syncthreads();
    if (threadIdx.x == 0) {
        unsigned* bar = b.bar;
        const unsigned role = b.st[2], gen = b.st[3], tg = b.st[4];
        if (role != 0u) {
            if (role == 1u) XB_SPIN(xb_ld(&bar[XB_TOPGEN]) == tg, bar);
            __builtin_amdgcn_fence(__ATOMIC_ACQUIRE, "agent");
            xb_add(&bar[XB_XGEN(b.x)], 1u);
            asm volatile("s_waitcnt vmcnt(0)" ::: "memory");
        } else {
            XB_SPIN(xb_ld(&bar[XB_XGEN(b.x)]) == gen, bar);
            __builtin_amdgcn_fence(__ATOMIC_ACQUIRE, "agent");
            asm volatile("s_waitcnt vmcnt(0)" ::: "memory");
        }
    }
    __syncthreads();
}

struct Inputs {
    const float *x, *mem; const int* pos; const float *norm_mix, *w_in, *q_a_norm, *w_q_up, *kv_a_norm, *w_kv_up, *q_norm, *k_norm, *lb_logits, *o_norm, *w_out, *norm_cross, *norm_mem,
        *x_w_q, *x_w_kv, *x_q_norm, *x_k_norm, *x_w_o, *norm_ffn, *w_group, *b_group, *w_expert, *b_expert, *w_gate, *w_up, *w_down;
};
struct Frame {
    LAS unsigned char* lds;
    volatile LAS unsigned* MISC;
    gu32* ctl;
    unsigned char* ws;
    int wave, vcu, G;
    __device__ __forceinline__ int tid() const { return pg8::tid_opaque(); }
    __device__ __forceinline__ int lane() const { return pg8::tid_opaque() & 63; }
};
__device__ __forceinline__ float wave_sum(float v) {
#pragma unroll
    for (int o = 1; o < 64; o <<= 1) v += __shfl_xor(v, o);
    return v;
}
struct TItem { const float* W; const float* gain; bf16* WT; int ldw, k0, n0, ldt, row0; };
struct TRegs { float wv[32]; f32x4 g0, g1; };
__device__ __forceinline__ void ti_load(const TItem& t, TRegs& r, int lane) {
#pragma unroll
    for (int i = 0; i < 32; ++i) r.wv[i] = t.W[(size_t)(t.k0 + 2 * i + (lane >> 5)) * t.ldw + t.n0 + (lane & 31)];
    if (t.gain) { r.g0 = *(const f32x4*)(t.gain + t.k0 + 8 * (lane & 7)); r.g1 = *(const f32x4*)(t.gain + t.k0 + 8 * (lane & 7) + 4); } else { r.g0 = (f32x4){1.f, 1.f, 1.f, 1.f}; r.g1 = r.g0; }
}
__device__ __forceinline__ void ti_finish(const TItem& t, const TRegs& r, LAS float* scr, int lane) {
#pragma unroll
    for (int i = 0; i < 32; ++i) scr[(2 * i + (lane >> 5)) * 33 + (lane & 31)] = r.wv[i];
    LDS_WAIT(); asm volatile("" ::: "memory");
    const int c = lane & 7;
#pragma unroll
    for (int j = 0; j < 4; ++j) { const int n = (lane >> 3) + 8 * j; const LAS float* s = scr + (8 * c) * 33 + n;
        v4u o; o.x = pk2(s[0 * 33] * r.g0[0], s[1 * 33] * r.g0[1]); o.y = pk2(s[2 * 33] * r.g0[2], s[3 * 33] * r.g0[3]); o.z = pk2(s[4 * 33] * r.g1[0], s[5 * 33] * r.g1[1]); o.w = pk2(s[6 * 33] * r.g1[2], s[7 * 33] * r.g1[3]);
        *(GAS v4u*)(t.WT + (size_t)(t.row0 + n) * t.ldt + t.k0 + 8 * c) = o; }
    LDS_WAIT(); asm volatile("" ::: "memory");
}
struct TJob { const float* W; int K, N, ldw; const float* gain; bf16* WT; int ldt; int mode; };
__device__ __forceinline__ int tjob_row(int mode, int n0) {
    if (mode == 1) return n0 >= 352 ? n0 - 352 : n0 + 2560;
    if (mode == 2) return (n0 >> 7) * 256 + (n0 & 127);
    if (mode == 3) return (n0 >> 7) * 256 + 128 + (n0 & 127);
    return n0;
}
__device__ __forceinline__ void tjob_run(const TJob& j, LAS float* scr, int gw, int NGW, int lane) {
    const int nblk = j.N / 32, nit = (j.K / 64) * nblk;
    auto item = [&](int it) { TItem t; t.W = j.W; t.gain = j.gain; t.WT = j.WT; t.ldw = j.ldw; t.k0 = (it / nblk) * 64; t.n0 = (it % nblk) * 32; t.ldt = j.ldt; t.row0 = tjob_row(j.mode, t.n0); return t; };
    if (gw >= nit) return;
    TItem cur = item(gw); TRegs rc; ti_load(cur, rc, lane);
    for (int it = gw; it < nit; it += NGW) {
        const bool more = it + NGW < nit; TItem nx = cur; TRegs rn = rc;
        if (more) { nx = item(it + NGW); ti_load(nx, rn, lane); }
        ti_finish(cur, rc, scr, lane);
        cur = nx; rc = rn;
    }
}
__device__ __forceinline__ void p0_prologue(Frame& F, const Inputs& in) {
    LAS float* scr = (LAS float*)(F.lds + RING_OFF + F.wave * 16384);
    const int gw = F.vcu * NWAVES + F.wave, NGW = F.G * NWAVES, lane = F.lane();
    unsigned char* ws = F.ws;
    { TJob j{in.w_in, 1024, 2912, 2912, in.norm_mix, (bf16*)(ws + W_IN), 1024, 1}; tjob_run(j, scr, gw, NGW, lane); }
    { TJob j{in.w_q_up, 192, 768, 768, in.q_a_norm, (bf16*)(ws + W_Q), 192, 0}; tjob_run(j, scr, gw, NGW, lane); }
    { TJob j{in.w_kv_up, 128, 1024, 1024, in.kv_a_norm, (bf16*)(ws + W_KV), 128, 0}; tjob_run(j, scr, gw, NGW, lane); }
    { TJob j{in.w_out, 1024, 1024, 1024, nullptr, (bf16*)(ws + W_OUT), 1024, 0}; tjob_run(j, scr, gw, NGW, lane); }
    { TJob j{in.x_w_q, 1024, 1024, 1024, in.norm_cross, (bf16*)(ws + W_XQ), 1024, 0}; tjob_run(j, scr, gw, NGW, lane); }
    { TJob j{in.x_w_kv, 1024, 2048, 2048, nullptr, (bf16*)(ws + W_XKV), 1024, 0}; tjob_run(j, scr, gw, NGW, lane); }
    { TJob j{in.x_w_o, 1024, 1024, 1024, nullptr, (bf16*)(ws + W_XO), 1024, 0}; tjob_run(j, scr, gw, NGW, lane); }
    const int gt = (F.vcu * NWAVES + F.wave) * 64 + lane, NGT = NGW * 64;
    for (int i = gt; i < 160 * 1024 / 8; i += NGT) *(GAS v4u*)((bf16*)(ws + W_IN) + (size_t)2912 * 1024 + (size_t)i * 8) = (v4u){0u, 0u, 0u, 0u};
    for (int i = gt; i < 256 * 1024; i += NGT) { const int c = i >> 10, k = i & 1023; float v = 0.f;
        if (c < 8) v = in.w_group[k * 8 + c] * in.norm_ffn[k]; else if (c < 72) v = in.w_expert[k * 64 + (c - 8)] * in.norm_ffn[k];
        ((bf16*)(ws + W_R))[i] = (bf16)f2bf(v); }
    for (int i = gt; i < T * 16; i += NGT) { const int t = i >> 4, j = i & 15;
        const float inv_freq = 1.0f / powf(10000.0f, (float)j / 16.0f); const float ang = (float)in.pos[t] * inv_freq;
        const double rev = (double)ang * 0.15915494309189535; const float fr = (float)(rev - floor(rev));
        ((float*)(ws + WS_COS))[i] = __builtin_amdgcn_cosf(fr); ((float*)(ws + WS_SIN))[i] = __builtin_amdgcn_sinf(fr); }
    float* misc = (float*)(ws + WS_MISC);
    for (int i = gt; i < 1024; i += NGT) { const float l0 = in.lb_logits[i], l1 = in.lb_logits[1024 + i]; misc[i] = 1.0f / (1.0f + expf(l1 - l0)); }
    if (gw == 0) {
        float mq = 0.f, mk = 0.f, xq = 0.f, xk = 0.f;
        for (int i = lane; i < 96; i += 64) { mq = fmaxf(mq, fabsf(in.q_norm[i])); mk = fmaxf(mk, fabsf(in.k_norm[i])); }
        for (int i = lane; i < 256; i += 64) { xq = fmaxf(xq, fabsf(in.x_q_norm[i])); xk = fmaxf(xk, fabsf(in.x_k_norm[i])); }
#pragma unroll
        for (int o = 1; o < 64; o <<= 1) { mq = fmaxf(mq, __shfl_xor(mq, o)); mk = fmaxf(mk, __shfl_xor(mk, o)); xq = fmaxf(xq, __shfl_xor(xq, o)); xk = fmaxf(xk, __shfl_xor(xk, o)); }
        if (lane == 0) { misc[1024] = LOG2E * 9.797958971132712f * mq * mk; misc[1025] = LOG2E * 16.0f * xq * xk; }
    }
    for (int m = gw; m < T; m += 4 * NGW) {
        f32x4 v[4][4];
#pragma unroll
        for (int q = 0; q < 4; ++q) { const int mq = m + q * NGW; const GAS f32x4* xr = (const GAS f32x4*)(in.x + (size_t)(mq < T ? mq : m) * D) + lane;
#pragma unroll
            for (int j = 0; j < 4; ++j) v[q][j] = xr[64 * j]; }
#pragma unroll
        for (int q = 0; q < 4; ++q) { const int mq = m + q * NGW; float s = 0.f;
#pragma unroll
            for (int j = 0; j < 4; ++j) s += (v[q][j].x * v[q][j].x + v[q][j].y * v[q][j].y) + (v[q][j].z * v[q][j].z + v[q][j].w * v[q][j].w);
            s = wave_sum(s);
            if (mq < T) { GAS unsigned long long* o8 = (GAS unsigned long long*)((bf16*)(ws + WS_XN) + (size_t)mq * D) + lane;
#pragma unroll
                for (int j = 0; j < 4; ++j) o8[64 * j] = (unsigned long long)pk2(v[q][j].x, v[q][j].y) | ((unsigned long long)pk2(v[q][j].z, v[q][j].w) << 32);
                if (lane == 0) ((float*)(ws + WS_SS0))[mq] = s; } }
    }
    for (int m = gw; m < BATCH * MEML; m += NGW) {
        const GAS f32x4* xr = (const GAS f32x4*)(in.mem + (size_t)m * D) + lane; f32x4 v[4]; float s = 0.f;
#pragma unroll
        for (int j = 0; j < 4; ++j) { v[j] = xr[64 * j]; s += (v[j].x * v[j].x + v[j].y * v[j].y) + (v[j].z * v[j].z + v[j].w * v[j].w); }
        const float r = 1.0f / sqrtf(wave_sum(s) * (1.f / D) + EPS);
        GAS unsigned long long* o8 = (GAS unsigned long long*)((bf16*)(ws + WS_MN) + (size_t)m * D) + lane;
#pragma unroll
        for (int j = 0; j < 4; ++j) { const f32x4 g = *((const GAS f32x4*)in.norm_mem + lane + 64 * j);
            o8[64 * j] = (unsigned long long)pk2(v[j].x * r * g.x, v[j].y * r * g.y) | ((unsigned long long)pk2(v[j].z * r * g.z, v[j].w * r * g.w) << 32); }
    }
}
__device__ __forceinline__ void moe_weights(Frame& F, const Inputs& in, const int ibase, const int icount, const int r0, const int r1) {
    LAS float* scr = (LAS float*)(F.lds + RING_OFF + F.wave * 16384);
    const int gw = F.vcu * NWAVES + F.wave, NGW = F.G * NWAVES, lane = F.lane();
    auto item = [&](int it) { TItem t; const bool gu_ = it < 16384; const int i2_ = gu_ ? it : it - 16384; const int e = gu_ ? (i2_ >> 8) : (i2_ >> 7), kind = gu_ ? ((i2_ >> 7) & 1) : 2, q = i2_ & 127;
        if (kind == 0) { t.W = in.w_gate + (size_t)e * 262144; t.gain = in.norm_ffn; t.WT = (bf16*)(F.ws + WS_WGU) + (size_t)e * 524288; t.ldw = 256; t.k0 = (q >> 3) * 64; t.n0 = (q & 7) * 32; t.ldt = 1024; t.row0 = tjob_row(2, t.n0); }
        else if (kind == 1) { t.W = in.w_up + (size_t)e * 262144; t.gain = in.norm_ffn; t.WT = (bf16*)(F.ws + WS_WGU) + (size_t)e * 524288; t.ldw = 256; t.k0 = (q >> 3) * 64; t.n0 = (q & 7) * 32; t.ldt = 1024; t.row0 = tjob_row(3, t.n0); }
        else { t.W = in.w_down + (size_t)e * 262144; t.gain = nullptr; t.WT = (bf16*)(F.ws + WS_WD) + (size_t)e * 262144; t.ldw = 1024; t.k0 = (q >> 5) * 64; t.n0 = (q & 31) * 32; t.ldt = 256; t.row0 = t.n0; }
        return t; };
    const int nit = ibase + icount;
    const int it0 = ibase + gw + r0 * NGW; const long long itend_ = (long long)ibase + gw + (long long)r1 * NGW; const int it1 = itend_ < nit ? (int)itend_ : nit;
    if (it0 >= it1) return;
    TItem cur = item(it0); TRegs rc; ti_load(cur, rc, lane);
    for (int it = it0; it < it1; it += NGW) {
        const bool more = it + NGW < it1; TItem nx = cur; TRegs rn = rc;
        if (more) { nx = item(it + NGW); ti_load(nx, rn, lane); }
        ti_finish(cur, rc, scr, lane);
        cur = nx; rc = rn;
    }
}

using pg8::Unit; using pg8::bf16_t;
struct SchedGrid {
    const char* A; const char* B; size_t astep, bstep; pg8::GridOrder o; int pad_; int pad2_;
    __device__ __forceinline__ bool next(int i, Unit& u) const { int pm, pn; if (!o.tile(i, pm, pn)) return false; u.pm = pm; u.pn = pn; u.a = A + (size_t)pm * astep; u.b0 = u.b1 = B + (size_t)pn * bstep; u.rows = nullptr; u.map0 = nullptr; u.map1 = nullptr; return true; }
};
struct SchedPanel {
    const char* A; const char* B; size_t astep, bstep; int pm, nN;
    __device__ __forceinline__ bool next(int i, Unit& u) const { if (i >= nN) return false; int p_ = pm; asm volatile("" : "+s"(p_)); u.pm = p_; u.pn = i;     u.a = A + (size_t)p_ * astep; u.b0 = u.b1 = B + (size_t)i * bstep; u.rows = nullptr; u.map0 = nullptr; u.map1 = nullptr; return true; }
};
__device__ __forceinline__ float rstd16(const float* p) {
    const f32x4 a = *(const f32x4*)p, b = *(const f32x4*)(p + 4), c = *(const f32x4*)(p + 8), d = *(const f32x4*)(p + 12);
    const float s = ((a.x + a.y) + (a.z + a.w)) + ((b.x + b.y) + (b.z + b.w)) + ((c.x + c.y) + (c.z + c.w)) + ((d.x + d.y) + (d.z + d.w));
    return rsq(s * (1.f / D) + EPS);
}
typedef pg8::f32x4 (AccT)[2][2][4][2];

struct EpiIn {
    static constexpr bool PREP_EARLY = true;
    bf16_t* bufs; const float* ss; const float* lbt; LAS float* RS; int cheap;
    __device__ __forceinline__ void prep(const Unit& u, int par) const { const int t = pg8::tid_opaque(); if (t < 256) RS[par * 256 + t] = rsq(ss[u.pm * 256 + t] * (1.f / D) + EPS); }
    __device__ __forceinline__ void operator()(const AccT& acc, const Unit& u, int par, int wr, int wc, int fr, int fq, int wid, int lane) const {
        const int grp = u.pn >> 1, colg = (u.pn & 1) * 256 + wc * 32 + 8 * fq;
        bf16_t* base = bufs + (size_t)grp * ((size_t)T * 512);
#ifdef MK_PROBE_P1CHEAP
        const int mode = cheap ? 0 : ((grp == 0 || grp == 4) ? 1 : ((grp == 1 || grp == 2) ? 2 : 0));
#else
        const int mode = (grp == 0 || grp == 4) ? 1 : ((grp == 1 || grp == 2) ? 2 : 0);
#endif
        f32x4 lb[2][2];
#pragma unroll
        for (int bj = 0; bj < 2; ++bj)
#pragma unroll
            for (int n = 0; n < 2; ++n) lb[bj][n] = (mode == 2) ? *(const f32x4*)(lbt + (grp - 1) * 512 + colg + bj * 128 + 4 * n) : (f32x4){0.f, 0.f, 0.f, 0.f};
#pragma unroll
        for (int ai = 0; ai < 2; ++ai)
#pragma unroll
            for (int m = 0; m < 4; ++m) { const int rl = ai * 128 + wr * 64 + m * 16 + fr; const float rs = RS[par * 256 + rl]; bf16_t* rowp = base + (size_t)(u.pm * 256 + rl) * 512 + colg;
#pragma unroll
                for (int bj = 0; bj < 2; ++bj) { f32x4 v[2]; v[0] = acc[ai][bj][m][0] * rs; v[1] = acc[ai][bj][m][1] * rs; v4u w;
                    if (mode == 2) {
#pragma unroll
                        for (int n = 0; n < 2; ++n)
#pragma unroll
                            for (int e = 0; e < 4; ++e) { const float sg = fast_rcp(1.0f + fast_exp2(-LOG2E * v[n][e])); const float l = lb[bj][n][e]; v[n][e] = __builtin_amdgcn_logf(l + (1.0f - l) * sg); }
                        w.x = pkh2(v[0][0], v[0][1]); w.y = pkh2(v[0][2], v[0][3]); w.z = pkh2(v[1][0], v[1][1]); w.w = pkh2(v[1][2], v[1][3]);
                    } else {
                        if (mode == 1) {
#pragma unroll
                            for (int n = 0; n < 2; ++n)
#pragma unroll
                                for (int e = 0; e < 4; ++e) v[n][e] = silu_f(v[n][e]);
                        }
                        w.x = pk2(v[0][0], v[0][1]); w.y = pk2(v[0][2], v[0][3]); w.z = pk2(v[1][0], v[1][1]); w.w = pk2(v[1][2], v[1][3]);
                    }
                    if (grp != 5 || colg + bj * 128 < 352) *(v4u*)(rowp + bj * 128) = w; } }
    }
};
template <bool RBF>
struct EpiRes {
    static constexpr bool PREP_EARLY = true;
    const void* resid; bf16_t* xn; float* ssp;
    __device__ __forceinline__ void prep(const Unit&, int) const {}
    __device__ __forceinline__ void operator()(const AccT& acc, const Unit& u, int par, int wr, int wc, int fr, int fq, int wid, int lane) const {
        const int col0 = u.pn * 256 + wc * 32 + 8 * fq;
        const size_t rowb = (size_t)(u.pm * 256 + wr * 64 + fr);
        constexpr int NB = RBF ? 8 : 4;
#pragma unroll
        for (int b0 = 0; b0 < 8; b0 += NB) {
            v4u rb[NB][2]; f32x4 rf[NB][2][2];
#pragma unroll
            for (int q = 0; q < NB; ++q) { const int g = b0 + q; const size_t off0 = (rowb + (g >> 2) * 128 + (g & 3) * 16) * D + col0;
#pragma unroll
                for (int bj = 0; bj < 2; ++bj) {
                    if constexpr (RBF) rb[q][bj] = *(const v4u*)((const bf16_t*)resid + off0 + bj * 128);
                    else { rf[q][bj][0] = *(const f32x4*)((const float*)resid + off0 + bj * 128); rf[q][bj][1] = *(const f32x4*)((const float*)resid + off0 + bj * 128 + 4); } } }
            asm volatile("" ::: "memory");
#pragma unroll
            for (int q = 0; q < NB; ++q) { const int g = b0 + q, ai = g >> 2, m = g & 3; const size_t row = rowb + ai * 128 + m * 16; float sq = 0.f;
#pragma unroll
                for (int bj = 0; bj < 2; ++bj) { const size_t off = row * D + col0 + bj * 128; f32x4 r0, r1;
                    if constexpr (RBF) { const v4u w_ = rb[q][bj]; r0 = (f32x4){pg8::bf_lo(w_.x), pg8::bf_hi(w_.x), pg8::bf_lo(w_.y), pg8::bf_hi(w_.y)}; r1 = (f32x4){pg8::bf_lo(w_.z), pg8::bf_hi(w_.z), pg8::bf_lo(w_.w), pg8::bf_hi(w_.w)}; }
                    else { r0 = rf[q][bj][0]; r1 = rf[q][bj][1]; }
                    const f32x4 o0 = r0 + acc[ai][bj][m][0], o1 = r1 + acc[ai][bj][m][1];
                    v4u w; w.x = pk2(o0[0], o0[1]); w.y = pk2(o0[2], o0[3]); w.z = pk2(o1[0], o1[1]); w.w = pk2(o1[2], o1[3]); *(v4u*)(xn + off) = w;
                    sq += (o0[0] * o0[0] + o0[1] * o0[1]) + (o0[2] * o0[2] + o0[3] * o0[3]) + (o1[0] * o1[0] + o1[1] * o1[1]) + (o1[2] * o1[2] + o1[3] * o1[3]); }
                sq += __shfl_xor(sq, 16); sq += __shfl_xor(sq, 32);
                if (fq == 0) ssp[row * 16 + u.pn * 4 + wc] = sq; }
        }
    }
};
struct EpiHeadNorm {
    static constexpr bool PREP_EARLY = false;
    const float* ssp; const float* gain; bf16_t* O; LAS float* RS; LAS float* XP; float gscale; int ldo; int nnorm; int pad_;
    __device__ __forceinline__ void prep(const Unit& u, int par) const { const int t = pg8::tid_opaque(); if (ssp && t < 256) RS[par * 256 + t] = rstd16(ssp + (size_t)(u.pm * 256 + t) * 16); }
    __device__ __forceinline__ void operator()(const AccT& acc, const Unit& u, int par, int wr, int wc, int fr, int fq, int wid, int lane) const {
        const bool norm = u.pn < nnorm; const int colh = wc * 32 + 8 * fq;
        if (norm) {
#pragma unroll
            for (int ai = 0; ai < 2; ++ai)
#pragma unroll
                for (int m = 0; m < 4; ++m) { float sq = 0.f;
#pragma unroll
                    for (int bj = 0; bj < 2; ++bj)
#pragma unroll
                        for (int n = 0; n < 2; ++n) { const f32x4 v = acc[ai][bj][m][n]; sq += (v[0] * v[0] + v[1] * v[1]) + (v[2] * v[2] + v[3] * v[3]); }
                    sq += __shfl_xor(sq, 16); sq += __shfl_xor(sq, 32);
                    if (fq == 0) XP[(ai * 128 + wr * 64 + m * 16 + fr) * 4 + wc] = sq; }
        }
        asm volatile("s_waitcnt lgkmcnt(0)" ::: "memory"); __builtin_amdgcn_s_barrier(); asm volatile("" ::: "memory");
        f32x4 g[2][2];
#pragma unroll
        for (int bj = 0; bj < 2; ++bj)
#pragma unroll
            for (int n = 0; n < 2; ++n) g[bj][n] = norm ? *(const f32x4*)(gain + colh + bj * 128 + 4 * n) * gscale : (f32x4){1.f, 1.f, 1.f, 1.f};
#pragma unroll
        for (int ai = 0; ai < 2; ++ai)
#pragma unroll
            for (int m = 0; m < 4; ++m) { const int rl = ai * 128 + wr * 64 + m * 16 + fr; const size_t row = (size_t)(u.pm * 256 + rl);
                float h = 1.0f;
                if (norm) { const f32x4 p = *(const LAS f32x4*)(XP + rl * 4); const float rs = ssp ? RS[par * 256 + rl] : 1.0f; const float s = ((p[0] + p[1]) + (p[2] + p[3])) * rs * rs; h = rs * rsq(s * (1.f / 256.f) + EPS); }
#pragma unroll
                for (int bj = 0; bj < 2; ++bj) { const f32x4 v0 = acc[ai][bj][m][0] * h * g[bj][0], v1 = acc[ai][bj][m][1] * h * g[bj][1];
                    v4u w; w.x = pk2(v0[0], v0[1]); w.y = pk2(v0[2], v0[3]); w.z = pk2(v1[0], v1[1]); w.w = pk2(v1[2], v1[3]);
                    *(v4u*)(O + row * ldo + u.pn * 256 + colh + bj * 128) = w; } }
        asm volatile("s_waitcnt lgkmcnt(0)" ::: "memory"); __builtin_amdgcn_s_barrier(); asm volatile("" ::: "memory");
    }
};
struct EpiRouter {
    static constexpr bool PREP_EARLY = false;
    const float* ssp; const float* bg; const float* be; float* LG; LAS float* RS; int pad_;
    __device__ __forceinline__ void prep(const Unit& u, int par) const { const int t = pg8::tid_opaque(); if (t < 256) RS[par * 256 + t] = rstd16(ssp + (size_t)(u.pm * 256 + t) * 16); }
    __device__ __forceinline__ void operator()(const AccT& acc, const Unit& u, int par, int wr, int wc, int fr, int fq, int wid, int lane) const {
        const int col0 = wc * 32 + 8 * fq;
        if (col0 < 72) {
            f32x4 b0, b1;
#pragma unroll
            for (int e = 0; e < 4; ++e) { const int c0 = col0 + e, c1 = col0 + 4 + e; b0[e] = c0 < 8 ? bg[c0] : be[c0 - 8]; b1[e] = c1 < 8 ? bg[c1] : be[c1 - 8]; }
#pragma unroll
            for (int ai = 0; ai < 2; ++ai)
#pragma unroll
                for (int m = 0; m < 4; ++m) { const int rl = ai * 128 + wr * 64 + m * 16 + fr; const float rs = RS[par * 256 + rl]; float* p = LG + (size_t)(u.pm * 256 + rl) * 72 + col0;
                    *(f32x4*)p = acc[ai][0][m][0] * rs + b0; *(f32x4*)(p + 4) = acc[ai][0][m][1] * rs + b1; }
        }
    }
};
struct SchedMoeA {
    const int* tilee; const int* rowe; const char* XN; const char* WGU; int ntile, G, c, pad_;
    __device__ __forceinline__ bool next(int i, Unit& u) const { const long L = (long)i * G + c; if (L >= (long)ntile * 2) return false; const int tl = (int)(L >> 1), pn = (int)(L & 1);
        const int e = __builtin_amdgcn_readfirstlane(tilee[tl]);
        u.pm = tl; u.pn = pn; u.a = XN; u.rows = rowe + tl * 256; u.map0 = nullptr; u.map1 = nullptr; u.b0 = u.b1 = WGU + (size_t)e * (512 * 1024 * 2) + (size_t)pn * (256 * 1024 * 2); return true; }
};
struct EpiMoeA {
    static constexpr bool PREP_EARLY = false;
    const float* ssp; const float* wslot; bf16_t* H; LAS float* RS; LAS float* WG;
    __device__ __forceinline__ void prep(const Unit& u, int par) const { const int t = pg8::tid_opaque(); if (t < 256) { const int tok = u.rows[t];
        RS[par * 256 + t] = tok < 0 ? 0.f : rstd16(ssp + (size_t)tok * 16); WG[par * 256 + t] = wslot[u.pm * 256 + t]; } }
    __device__ __forceinline__ void operator()(const AccT& acc, const Unit& u, int par, int wr, int wc, int fr, int fq, int wid, int lane) const {
#pragma unroll
        for (int ai = 0; ai < 2; ++ai)
#pragma unroll
            for (int m = 0; m < 4; ++m) { const int rl = ai * 128 + wr * 64 + m * 16 + fr; const float rs = RS[par * 256 + rl], wg = WG[par * 256 + rl]; float h[8];
#pragma unroll
                for (int n = 0; n < 2; ++n)
#pragma unroll
                    for (int e = 0; e < 4; ++e) h[n * 4 + e] = silu_f(acc[ai][0][m][n][e] * rs) * (acc[ai][1][m][n][e] * rs) * wg;
                v4u w; w.x = pk2(h[0], h[1]); w.y = pk2(h[2], h[3]); w.z = pk2(h[4], h[5]); w.w = pk2(h[6], h[7]);
                *(v4u*)(H + (size_t)(u.pm * 256 + rl) * 256 + u.pn * 128 + wc * 32 + 8 * fq) = w; }
    }
};
struct SchedMoeB {
    const int* tilep; const int* rowp; const int* slotA; const int* slotB; const char* Hb; const char* WD; int ntile, G, c, pad_;
    __device__ __forceinline__ bool next(int i, Unit& u) const { const long L = (long)i * G + c; if (L >= (long)ntile * 4) return false; const int tl = (int)(L >> 2), pn = (int)(L & 3);
        const int b = __builtin_amdgcn_readfirstlane(tilep[tl]), ea = (b >> 6) * 8 + ((b >> 3) & 7), eb = (b >> 6) * 8 + (b & 7);
        u.pm = tl; u.pn = pn; u.a = Hb; u.rows = slotA + tl * 256; u.map0 = rowp + tl * 256; u.map1 = slotB + tl * 256;
        u.hi = (__builtin_amdgcn_readfirstlane(rowp[tl * 256 + 128]) >= 0) ? 1 : 0;
        u.b0 = WD + (size_t)ea * (1024 * 256 * 2) + (size_t)pn * (256 * 256 * 2); u.b1 = WD + (size_t)eb * (1024 * 256 * 2) + (size_t)pn * (256 * 256 * 2); return true; }
};
struct EpiMoeB {
    static constexpr bool PREP_EARLY = true;
    const bf16_t* xres; float* out; LAS int* TOK; int pad_;
    __device__ __forceinline__ void prep(const Unit& u, int par) const { const int t = pg8::tid_opaque(); if (t < 256) TOK[par * 256 + t] = u.map0[t]; }
    __device__ __forceinline__ void operator()(const AccT& acc, const Unit& u, int par, int wr, int wc, int fr, int fq, int wid, int lane) const {
        const int col0 = u.pn * 256 + wc * 32 + 8 * fq;
        int tok[8]; v4u rb[8][2];
#pragma unroll
        for (int g = 0; g < 8; ++g) { tok[g] = TOK[par * 256 + (g >> 2) * 128 + wr * 64 + (g & 3) * 16 + fr]; const unsigned off = (unsigned)(tok[g] < 0 ? 0 : tok[g]) * (unsigned)D + (unsigned)col0;
            rb[g][0] = *(const v4u*)(xres + off); rb[g][1] = *(const v4u*)(xres + off + 128); }
        asm volatile("" ::: "memory");
#pragma unroll
        for (int g = 0; g < 8; ++g) { const int ai = g >> 2, m = g & 3; const unsigned off = (unsigned)(tok[g] < 0 ? 0 : tok[g]) * (unsigned)D + (unsigned)col0;
#pragma unroll
            for (int bj = 0; bj < 2; ++bj) { const v4u w_ = rb[g][bj];
                const f32x4 o0 = (f32x4){pg8::bf_lo(w_.x), pg8::bf_hi(w_.x), pg8::bf_lo(w_.y), pg8::bf_hi(w_.y)} + acc[ai][bj][m][0], o1 = (f32x4){pg8::bf_lo(w_.z), pg8::bf_hi(w_.z), pg8::bf_lo(w_.w), pg8::bf_hi(w_.w)} + acc[ai][bj][m][1];
                if (tok[g] >= 0) { *(f32x4*)(out + off + bj * 128) = o0; *(f32x4*)(out + off + bj * 128 + 4) = o1; } } }
    }
};
namespace att {
__device__ __forceinline__ int crow(int r, int hi) { return (r & 3) + 8 * (r >> 2) + 4 * hi; }
__device__ __forceinline__ void glds16(const void* gsrc, unsigned lds_dst) { unsigned keep;
    asm volatile("s_mov_b32 %0, m0\n\ts_mov_b32 m0, %2\n\ts_nop 0\n\tglobal_load_lds_dwordx4 %1, off\n\ts_mov_b32 m0, %0" : "=&s"(keep) : "v"(gsrc), "s"(lds_dst) : "memory"); }
typedef __attribute__((address_space(3))) const char* lds_cptr;
typedef short v4i16_t __attribute__((ext_vector_type(4)));
__device__ __forceinline__ s16x4 vtr(lds_cptr p) { return __builtin_bit_cast(s16x4, __builtin_amdgcn_ds_read_tr16_b64_v4i16((__attribute__((address_space(3))) v4i16_t*)p)); }

typedef float f32x2_t __attribute__((ext_vector_type(2))); typedef __bf16 bf16x2_t __attribute__((ext_vector_type(2)));
__device__ __forceinline__ unsigned cvtpk_s(float lo, float hi) { f32x2_t v = {lo, hi}; bf16x2_t b = __builtin_convertvector(v, bf16x2_t); return __builtin_bit_cast(unsigned, b); }
struct Tensors { const bf16* Q; const bf16* K; const bf16* V; bf16* O; int qp, kp, vp, op; };

template <int KS, int DVB, int NDV, int QW, bool QREG, bool NOSHIFT>
__device__ __forceinline__ void unit(const Tensors& Tn, const int q0, const int NT, const float cbound, char* shm, LAS float* wsf_all) {
    constexpr int KSLOT = 64 * KS * 32, VSLOT = 64 * DVB * 64, SLOT = KSLOT + VSLOT, NKP = KS * 2, NVP = DVB * 4;
    constexpr bool KLINE = (KS % 4 == 0);
    const int tid = pg8::tid_opaque(), lane = tid & 63, r32 = lane & 31, hi = lane >> 5; const int wid = __builtin_amdgcn_readfirstlane(tid >> 6);
    const int qb = wid % QW, dvb0 = (wid / QW) * NDV;
    const unsigned lds0 = (unsigned)(uintptr_t)shm;
    LAS float* wsf = wsf_all + wid * 64;
    const lds_cptr shm3 = (lds_cptr)shm;
    const bf16* ksrc = Tn.K + (size_t)lane * Tn.kp;
    const bf16* vsrc = Tn.V + (size_t)(lane >> 2) * Tn.vp + (lane & 3) * 8;
#define ATT_DMA(t, slot) do { \
        if constexpr (KLINE) {   \
            _Pragma("unroll") for (int p_ = 0; p_ < NKP / 8; ++p_) { const int c_ = wid + 8 * p_, cg_ = c_ >> 3, kg_ = c_ & 7; \
                glds16(Tn.K + ((size_t)(t) * 64 + 8 * kg_ + (lane & 7)) * Tn.kp + (8 * cg_ + ((lane >> 3) ^ (kg_ & 1))) * 8, (unsigned)__builtin_amdgcn_readfirstlane(lds0 + (slot) * SLOT + c_ * 1024)); } } \
        else { _Pragma("unroll") for (int p_ = 0; p_ < (NKP + 7) / 8; ++p_) { const int c_ = wid + 8 * p_; if (c_ < NKP) glds16(ksrc + (size_t)(t) * 64 * Tn.kp + c_ * 8, (unsigned)__builtin_amdgcn_readfirstlane(lds0 + (slot) * SLOT + c_ * 1024)); } } \
        _Pragma("unroll") for (int p_ = 0; p_ < (NVP + 7) / 8; ++p_) { const int c_ = wid + 8 * p_; if (c_ < NVP) { const int dg_ = c_ >> 2, kg_ = c_ & 3; \
            glds16(vsrc + ((size_t)(t) * 64 + 16 * kg_) * Tn.vp + dg_ * 32, (unsigned)__builtin_amdgcn_readfirstlane(lds0 + (slot) * SLOT + KSLOT + c_ * 1024)); } } } while (0)
    ATT_DMA(0, 0);
    const bf16* Qw = Tn.Q + (size_t)(q0 + qb * 32 + r32) * Tn.qp + hi * 8;
    bf16x8 qr[KS];
    if constexpr (QREG) {
#pragma unroll
      for (int d0 = 0; d0 < KS; ++d0) qr[d0] = *reinterpret_cast<const bf16x8*>(Qw + d0 * 16); }
    f32x16 o[NDV];
#pragma unroll
    for (int j = 0; j < NDV; ++j) o[j] = f32x16{};
    float l_reg = 0.f;
    f32x16 negc;
#pragma unroll
    for (int r = 0; r < 16; ++r) negc[r] = -cbound;
    asm volatile("s_waitcnt vmcnt(0)" ::: "memory"); __builtin_amdgcn_s_barrier(); asm volatile("" ::: "memory");
#ifdef ATT_PROBE_TILES
    for (int rep_ = 0; rep_ < 2; ++rep_) {
    if (rep_ == 1) { ATT_DMA(0, 0); l_reg = 0.f;
#pragma unroll
        for (int j = 0; j < NDV; ++j) o[j] = f32x16{};
        asm volatile("s_waitcnt vmcnt(0)" ::: "memory"); __builtin_amdgcn_s_barrier(); asm volatile("" ::: "memory"); }
#endif
#pragma nounroll
    for (int t = 0; t < NT; ++t) {
        const int sl = t & 1;
        if (t + 1 < NT) ATT_DMA(t + 1, sl ^ 1);
        const lds_cptr kb = KLINE ? shm3 + sl * SLOT + (r32 >> 3) * 1024 + (hi ^ ((r32 >> 3) & 1)) * 128 + (r32 & 7) * 16 : shm3 + sl * SLOT + hi * 1024 + r32 * 16;
        const lds_cptr vp_ = shm3 + sl * SLOT + KSLOT + ((lane >> 4) & 1) * 32 + (lane & 3) * 8 + (4 * hi + ((lane & 15) >> 2)) * 64;
#pragma nounroll
        for (int kh = 0; kh < 2; ++kh) {
            f32x16 p; if constexpr (NOSHIFT) p = f32x16{}; else p = negc;
#pragma unroll
            for (int d0 = 0; d0 < KS; ++d0) {
                if constexpr (!QREG) { if ((d0 & 3) == 0) { asm volatile("" ::: "memory");
#pragma unroll
                    for (int dd = 0; dd < 4; ++dd) qr[d0 + dd] = *reinterpret_cast<const bf16x8*>(Qw + (d0 + dd) * 16);
                    asm volatile("" ::: "memory"); } }
                const bf16x8 b0 = *(const __attribute__((address_space(3))) bf16x8*)(kb + (KLINE ? (d0 >> 2) * 8192 + (d0 & 3) * 256 + kh * 4096 : d0 * 2048 + kh * 512));
                p = __builtin_amdgcn_mfma_f32_32x32x16_bf16(b0, qr[d0], p, 0, 0, 0);
            }
            float sacc = 0.f;
#pragma unroll
            for (int r = 0; r < 16; ++r) { p[r] = fast_exp2(p[r]); sacc += p[r]; }
            l_reg += sacc;
            v4u pw[2];
            pw[0] = (v4u){pk2(p[0], p[1]), pk2(p[2], p[3]), pk2(p[4], p[5]), pk2(p[6], p[7])};
            pw[1] = (v4u){pk2(p[8], p[9]), pk2(p[10], p[11]), pk2(p[12], p[13]), pk2(p[14], p[15])};
            s16x4 vl[2][2], vh2[2][2];
#pragma unroll
            for (int ks = 0; ks < 2; ++ks) { vl[0][ks] = vtr(vp_ + (dvb0 + 0) * 4096 + (2 * kh + ks) * 1024); vh2[0][ks] = vtr(vp_ + (dvb0 + 0) * 4096 + (2 * kh + ks) * 1024 + 512); }
#pragma unroll
            for (int j = 0; j < NDV; ++j) {
                if (j + 1 < NDV) {
#pragma unroll
                    for (int ks = 0; ks < 2; ++ks) { vl[(j + 1) & 1][ks] = vtr(vp_ + (dvb0 + j + 1) * 4096 + (2 * kh + ks) * 1024); vh2[(j + 1) & 1][ks] = vtr(vp_ + (dvb0 + j + 1) * 4096 + (2 * kh + ks) * 1024 + 512); }
                }
#pragma unroll
                for (int ks = 0; ks < 2; ++ks) { const s16x4 lo = vl[j & 1][ks], hh = vh2[j & 1][ks];
                    o[j] = __builtin_amdgcn_mfma_f32_32x32x16_bf16(__builtin_bit_cast(bf16x8, pw[ks]), (bf16x8){lo[0], lo[1], lo[2], lo[3], hh[0], hh[1], hh[2], hh[3]}, o[j], 0, 0, 0); }
                if (NDV > 2) { __builtin_amdgcn_sched_group_barrier(0x100, 4, 0); __builtin_amdgcn_sched_group_barrier(0x8, 2, 0); }
            }
        }
        asm volatile("s_waitcnt vmcnt(0) lgkmcnt(0)" ::: "memory"); __builtin_amdgcn_s_barrier(); asm volatile("" ::: "memory");
    }
#ifdef ATT_PROBE_TILES
    }
#endif
#undef ATT_DMA
    l_reg += __shfl_xor(l_reg, 32);
    if (hi == 0) wsf[r32] = l_reg;
    asm volatile("s_waitcnt lgkmcnt(0)" ::: "memory");
    float rli[16];
#pragma unroll
    for (int r = 0; r < 16; ++r) rli[r] = fast_rcp(wsf[crow(r, hi)]);
    constexpr int SW = NDV * 32;
    LAS bf16* stg = (LAS bf16*)(shm3) + wid * (32 * SW);
#pragma unroll
    for (int r = 0; r < 16; ++r) { const int orow = crow(r, hi);
#pragma unroll
        for (int j = 0; j < NDV; j += 2) { const unsigned w_ = cvtpk_s(o[j][r] * rli[r], o[j + 1][r] * rli[r]); stg[orow * SW + j * 32 + r32] = (bf16)(w_ & 0xffffu); stg[orow * SW + (j + 1) * 32 + r32] = (bf16)(w_ >> 16); } }
    asm volatile("s_waitcnt lgkmcnt(0)" ::: "memory");
    bf16* Ow = Tn.O + (size_t)(q0 + qb * 32) * Tn.op + dvb0 * 32;
    constexpr int CPR = SW / 8;
#pragma unroll
    for (int i = 0; i < (32 * CPR) / 64; ++i) { const int idx = i * 64 + lane, row = idx / CPR, ch = idx % CPR;
        const v4u v = *(const LAS v4u*)(stg + row * SW + ch * 8); *(v4u*)(Ow + (size_t)row * Tn.op + ch * 8) = v; }
    asm volatile("s_waitcnt lgkmcnt(0)" ::: "memory");        __builtin_amdgcn_s_barrier(); asm volatile("" ::: "memory");
}

template <int KS, int DVB>
__device__ __forceinline__ void unit2(const Tensors& Tn, const int q0, const int NT, const float cbound, char* shm, LAS float* wsf_all) {
    constexpr int KSLOT = 64 * KS * 32, VSLOT = 64 * DVB * 64, SLOT = KSLOT + VSLOT, NKP = KS * 2, NVP = DVB * 4;
    const int tid = pg8::tid_opaque(), lane = tid & 63, r32 = lane & 31, hi = lane >> 5; const int wid = __builtin_amdgcn_readfirstlane(tid >> 6);
    const unsigned lds0 = (unsigned)(uintptr_t)shm;
    LAS float* wsf = wsf_all + wid * 64;
    const lds_cptr shm3 = (lds_cptr)shm;
    const bf16* ksrc = Tn.K + (size_t)lane * Tn.kp;
    const bf16* vsrc = Tn.V + (size_t)(lane >> 2) * Tn.vp + (lane & 3) * 8;
#define ATT_DMA(t, slot) do { \
        _Pragma("unroll") for (int p_ = 0; p_ < (NKP + 7) / 8; ++p_) { const int c_ = wid + 8 * p_; if (c_ < NKP) glds16(ksrc + (size_t)(t) * 64 * Tn.kp + c_ * 8, (unsigned)__builtin_amdgcn_readfirstlane(lds0 + (slot) * SLOT + c_ * 1024)); } \
        _Pragma("unroll") for (int p_ = 0; p_ < (NVP + 7) / 8; ++p_) { const int c_ = wid + 8 * p_; if (c_ < NVP) { const int dg_ = c_ >> 2, kg_ = c_ & 3; \
            glds16(vsrc + ((size_t)(t) * 64 + 16 * kg_) * Tn.vp + dg_ * 32, (unsigned)__builtin_amdgcn_readfirstlane(lds0 + (slot) * SLOT + KSLOT + c_ * 1024)); } } } while (0)
    ATT_DMA(0, 0);
    bf16x8 qa[KS], qb[KS];
    { const bf16* Qw = Tn.Q + (size_t)(q0 + wid * 64 + r32) * Tn.qp + hi * 8;
#pragma unroll
      for (int d0 = 0; d0 < KS; ++d0) { qa[d0] = *reinterpret_cast<const bf16x8*>(Qw + d0 * 16); qb[d0] = *reinterpret_cast<const bf16x8*>(Qw + (size_t)32 * Tn.qp + d0 * 16); } }
    f32x16 oa[DVB], ob[DVB];
#pragma unroll
    for (int j = 0; j < DVB; ++j) { oa[j] = f32x16{}; ob[j] = f32x16{}; }
    float la = 0.f, lb = 0.f;
    asm volatile("s_waitcnt vmcnt(0)" ::: "memory"); __builtin_amdgcn_s_barrier(); asm volatile("" ::: "memory");
#pragma nounroll
    for (int t = 0; t < NT; ++t) {
        const int sl = t & 1;
        if (t + 1 < NT) ATT_DMA(t + 1, sl ^ 1);
        const lds_cptr kb = shm3 + sl * SLOT + hi * 1024 + r32 * 16;
        const lds_cptr vp_ = shm3 + sl * SLOT + KSLOT + ((lane >> 4) & 1) * 32 + (lane & 3) * 8 + (4 * hi + ((lane & 15) >> 2)) * 64;
#pragma unroll
        for (int kh = 0; kh < 2; ++kh) {
            bf16x8 kf[KS];
#pragma unroll
            for (int d0 = 0; d0 < KS; ++d0) kf[d0] = *(const __attribute__((address_space(3))) bf16x8*)(kb + d0 * 2048 + kh * 512);
            f32x16 pa = f32x16{}, pb = f32x16{};
#pragma unroll
            for (int d0 = 0; d0 < KS; ++d0) pa = __builtin_amdgcn_mfma_f32_32x32x16_bf16(kf[d0], qa[d0], pa, 0, 0, 0);
#pragma unroll
            for (int d0 = 0; d0 < KS; ++d0) pb = __builtin_amdgcn_mfma_f32_32x32x16_bf16(kf[d0], qb[d0], pb, 0, 0, 0);
            __builtin_amdgcn_sched_barrier(0);
            bf16x8 vf[DVB][2];
#pragma unroll
            for (int j = 0; j < DVB; ++j)
#pragma unroll
                for (int ks = 0; ks < 2; ++ks) { const s16x4 lo = vtr(vp_ + j * 4096 + (2 * kh + ks) * 1024), hh = vtr(vp_ + j * 4096 + (2 * kh + ks) * 1024 + 512);
                    vf[j][ks] = (bf16x8){lo[0], lo[1], lo[2], lo[3], hh[0], hh[1], hh[2], hh[3]}; }
            float sa = 0.f, sb = 0.f;
#pragma unroll
            for (int r = 0; r < 16; ++r) { pa[r] = fast_exp2(pa[r]); sa += pa[r]; }
            v4u wa[2], wb[2];
            wa[0] = (v4u){pk2(pa[0], pa[1]), pk2(pa[2], pa[3]), pk2(pa[4], pa[5]), pk2(pa[6], pa[7])};
            wa[1] = (v4u){pk2(pa[8], pa[9]), pk2(pa[10], pa[11]), pk2(pa[12], pa[13]), pk2(pa[14], pa[15])};
            la += sa;
            __builtin_amdgcn_sched_barrier(0);
#pragma unroll
            for (int j = 0; j < DVB; ++j)
#pragma unroll
                for (int ks = 0; ks < 2; ++ks) oa[j] = __builtin_amdgcn_mfma_f32_32x32x16_bf16(__builtin_bit_cast(bf16x8, wa[ks]), vf[j][ks], oa[j], 0, 0, 0);
            __builtin_amdgcn_sched_barrier(0);
#pragma unroll
            for (int r = 0; r < 16; ++r) { pb[r] = fast_exp2(pb[r]); sb += pb[r]; }
            wb[0] = (v4u){pk2(pb[0], pb[1]), pk2(pb[2], pb[3]), pk2(pb[4], pb[5]), pk2(pb[6], pb[7])};
            wb[1] = (v4u){pk2(pb[8], pb[9]), pk2(pb[10], pb[11]), pk2(pb[12], pb[13]), pk2(pb[14], pb[15])};
            lb += sb;
            __builtin_amdgcn_sched_barrier(0);
#pragma unroll
            for (int j = 0; j < DVB; ++j)
#pragma unroll
                for (int ks = 0; ks < 2; ++ks) { const s16x4 lo = vtr(vp_ + j * 4096 + (2 * kh + ks) * 1024), hh = vtr(vp_ + j * 4096 + (2 * kh + ks) * 1024 + 512);
                    ob[j] = __builtin_amdgcn_mfma_f32_32x32x16_bf16(__builtin_bit_cast(bf16x8, wb[ks]), (bf16x8){lo[0], lo[1], lo[2], lo[3], hh[0], hh[1], hh[2], hh[3]}, ob[j], 0, 0, 0); }
        }
        asm volatile("s_waitcnt vmcnt(0) lgkmcnt(0)" ::: "memory"); __builtin_amdgcn_s_barrier(); asm volatile("" ::: "memory");
    }
#undef ATT_DMA
    la += __shfl_xor(la, 32); lb += __shfl_xor(lb, 32);
    if (hi == 0) { wsf[r32] = la; wsf[32 + r32] = lb; }
    asm volatile("s_waitcnt lgkmcnt(0)" ::: "memory");
    constexpr int SW = DVB * 32;
    LAS bf16* stg = (LAS bf16*)(shm3) + wid * (64 * SW);
#pragma unroll
    for (int r = 0; r < 16; ++r) { const int orow = crow(r, hi); const float ra = fast_rcp(wsf[orow]), rb = fast_rcp(wsf[32 + orow]);
#pragma unroll
        for (int j = 0; j < DVB; ++j) { const unsigned w_ = cvtpk_s(oa[j][r] * ra, ob[j][r] * rb); stg[orow * SW + j * 32 + r32] = (bf16)(w_ & 0xffffu); stg[(32 + orow) * SW + j * 32 + r32] = (bf16)(w_ >> 16); } }
    asm volatile("s_waitcnt lgkmcnt(0)" ::: "memory");
    bf16* Ow = Tn.O + (size_t)(q0 + wid * 64) * Tn.op;
    constexpr int CPR = SW / 8;
#pragma unroll
    for (int i = 0; i < (64 * CPR) / 64; ++i) { const int idx = i * 64 + lane, row = idx / CPR, ch = idx % CPR;
        const v4u v = *(const LAS v4u*)(stg + row * SW + ch * 8); *(v4u*)(Ow + (size_t)row * Tn.op + ch * 8) = v; }
    asm volatile("s_waitcnt vmcnt(0) lgkmcnt(0)" ::: "memory"); __builtin_amdgcn_s_barrier(); asm volatile("" ::: "memory");
}

template <int KS, int DVB>
__device__ __forceinline__ void unit3(const Tensors& Tn, const int q0, const int NT, char* shm, LAS float* wsf_all) {
    constexpr int KSLOT = 64 * KS * 32, VSLOT = 64 * DVB * 64, SLOT = KSLOT + VSLOT, NKP = KS * 2, NVP = DVB * 4;
    const int tid = pg8::tid_opaque(), lane = tid & 63, r32 = lane & 31, hi = lane >> 5; const int wid = __builtin_amdgcn_readfirstlane(tid >> 6);
    const unsigned lds0 = (unsigned)(uintptr_t)shm;
    LAS float* wsf = wsf_all + wid * 64;
    const lds_cptr shm3 = (lds_cptr)shm;
    const bf16* ksrc = Tn.K + (size_t)lane * Tn.kp;
    const bf16* vsrc = Tn.V + (size_t)(lane >> 2) * Tn.vp + (lane & 3) * 8;
#define ATT_DMA(t, slotb) do { \
        _Pragma("unroll") for (int p_ = 0; p_ < (NKP + 7) / 8; ++p_) { const int c_ = wid + 8 * p_; if (c_ < NKP) glds16(ksrc + (size_t)(t) * 64 * Tn.kp + c_ * 8, (unsigned)__builtin_amdgcn_readfirstlane(lds0 + (slotb) + c_ * 1024)); } \
        _Pragma("unroll") for (int p_ = 0; p_ < (NVP + 7) / 8; ++p_) { const int c_ = wid + 8 * p_; if (c_ < NVP) { const int dg_ = c_ >> 2, kg_ = c_ & 3; \
            glds16(vsrc + ((size_t)(t) * 64 + 16 * kg_) * Tn.vp + dg_ * 32, (unsigned)__builtin_amdgcn_readfirstlane(lds0 + (slotb) + KSLOT + c_ * 1024)); } } } while (0)
    ATT_DMA(0, 0); if (NT > 1) ATT_DMA(1, SLOT);
    bf16x8 qa[KS], qb[KS];
    { const bf16* Qw = Tn.Q + (size_t)(q0 + wid * 64 + r32) * Tn.qp + hi * 8;
#pragma unroll
      for (int d0 = 0; d0 < KS; ++d0) { qa[d0] = *reinterpret_cast<const bf16x8*>(Qw + d0 * 16); qb[d0] = *reinterpret_cast<const bf16x8*>(Qw + (size_t)32 * Tn.qp + d0 * 16); } }
    f32x16 oa[DVB], ob[DVB];
#pragma unroll
    for (int j = 0; j < DVB; ++j) { oa[j] = f32x16{}; ob[j] = f32x16{}; }
    float la0 = 0.f, la1 = 0.f, la2 = 0.f, la3 = 0.f, lb0 = 0.f, lb1 = 0.f, lb2 = 0.f, lb3 = 0.f;
    asm volatile("s_waitcnt vmcnt(0)" ::: "memory"); __builtin_amdgcn_s_barrier(); asm volatile("" ::: "memory");
    const int koff = hi * 1024 + r32 * 16, voff = KSLOT + ((lane >> 4) & 1) * 32 + (lane & 3) * 8 + (4 * hi + ((lane & 15) >> 2)) * 64;
    bf16x8 kf[KS];
    f32x16 pa = f32x16{}, pb;
#pragma unroll
    for (int d0 = 0; d0 < KS; ++d0) kf[d0] = *(const __attribute__((address_space(3))) bf16x8*)(shm3 + koff + d0 * 2048);
#pragma unroll
    for (int d0 = 0; d0 < KS; ++d0) pa = __builtin_amdgcn_mfma_f32_32x32x16_bf16(kf[d0], qa[d0], pa, 0, 0, 0);
    int sl = 0, sn = SLOT, snn = 2 * SLOT;
#define ATT_LDV(dst, slotb, kh) do { _Pragma("unroll") for (int j = 0; j < DVB; ++j) _Pragma("unroll") for (int ks = 0; ks < 2; ++ks) { \
        const s16x4 lo_ = vtr(shm3 + (slotb) + voff + j * 4096 + (2 * (kh) + ks) * 1024), hh_ = vtr(shm3 + (slotb) + voff + j * 4096 + (2 * (kh) + ks) * 1024 + 512); \
        dst[j][ks] = (bf16x8){lo_[0], lo_[1], lo_[2], lo_[3], hh_[0], hh_[1], hh_[2], hh_[3]}; } } while (0)
#define ATT_HALF(kh, NEXT, SLV) do { \
        bf16x8 vf[DVB][2]; ATT_LDV(vf, SLV, kh); \
        pb = f32x16{}; \
        _Pragma("unroll") for (int d0 = 0; d0 < KS; ++d0) pb = __builtin_amdgcn_mfma_f32_32x32x16_bf16(kf[d0], qb[d0], pb, 0, 0, 0); \
        _Pragma("unroll") for (int r = 0; r < 16; ++r) pa[r] = fast_exp2(pa[r]); \
        v4u wa[2], wb[2]; \
        wa[0] = (v4u){cvtpk_s(pa[0], pa[1]), cvtpk_s(pa[2], pa[3]), cvtpk_s(pa[4], pa[5]), cvtpk_s(pa[6], pa[7])}; \
        wa[1] = (v4u){cvtpk_s(pa[8], pa[9]), cvtpk_s(pa[10], pa[11]), cvtpk_s(pa[12], pa[13]), cvtpk_s(pa[14], pa[15])}; \
        _Pragma("unroll") for (int g_ = 0; g_ < 5; ++g_) { __builtin_amdgcn_sched_group_barrier(0x8, 1, 0); __builtin_amdgcn_sched_group_barrier(0x400, 3, 0); } \
        __builtin_amdgcn_sched_group_barrier(0x8, 1, 0); __builtin_amdgcn_sched_group_barrier(0x400, 1, 0); __builtin_amdgcn_sched_group_barrier(0x2, 8, 0); \
          \
        _Pragma("unroll") for (int j = 0; j < DVB; ++j) _Pragma("unroll") for (int ks = 0; ks < 2; ++ks) oa[j] = __builtin_amdgcn_mfma_f32_32x32x16_bf16(__builtin_bit_cast(bf16x8, wa[ks]), vf[j][ks], oa[j], 0, 0, 0); \
        _Pragma("unroll") for (int r = 0; r < 16; ++r) pb[r] = fast_exp2(pb[r]); \
        _Pragma("unroll") for (int g_ = 0; g_ < 4; ++g_) { __builtin_amdgcn_sched_group_barrier(0x8, 1, 0); __builtin_amdgcn_sched_group_barrier(0x400, 4, 0); } \
        if ((NEXT) == 2) { asm volatile("s_waitcnt vmcnt(0) lgkmcnt(0)" ::: "memory"); __builtin_amdgcn_s_barrier(); asm volatile("" ::: "memory"); if (t + 2 < NT) ATT_DMA(t + 2, snn); } \
          \
        f32x16 pn = f32x16{}; \
        if ((NEXT) != 0) { \
            _Pragma("unroll") for (int d0 = 0; d0 < KS; ++d0) kf[d0] = *(const __attribute__((address_space(3))) bf16x8*)(shm3 + ((NEXT) == 2 ? sn : sl) + koff + d0 * 2048 + ((NEXT) == 2 ? 0 : 512)); \
            _Pragma("unroll") for (int d0 = 0; d0 < KS; ++d0) pn = __builtin_amdgcn_mfma_f32_32x32x16_bf16(kf[d0], qa[d0], pn, 0, 0, 0); } \
        wb[0] = (v4u){cvtpk_s(pb[0], pb[1]), cvtpk_s(pb[2], pb[3]), cvtpk_s(pb[4], pb[5]), cvtpk_s(pb[6], pb[7])}; \
        wb[1] = (v4u){cvtpk_s(pb[8], pb[9]), cvtpk_s(pb[10], pb[11]), cvtpk_s(pb[12], pb[13]), cvtpk_s(pb[14], pb[15])}; \
        la0 += (pa[0] + pa[1]) + (pa[2] + pa[3]); la1 += (pa[4] + pa[5]) + (pa[6] + pa[7]); la2 += (pa[8] + pa[9]) + (pa[10] + pa[11]); la3 += (pa[12] + pa[13]) + (pa[14] + pa[15]); \
        if ((NEXT) != 0) { _Pragma("unroll") for (int g_ = 0; g_ < 6; ++g_) { __builtin_amdgcn_sched_group_barrier(0x8, 1, 0); __builtin_amdgcn_sched_group_barrier(0x2, 4, 0); } } \
          \
        _Pragma("unroll") for (int j = 0; j < DVB; ++j) _Pragma("unroll") for (int ks = 0; ks < 2; ++ks) ob[j] = __builtin_amdgcn_mfma_f32_32x32x16_bf16(__builtin_bit_cast(bf16x8, wb[ks]), vf[j][ks], ob[j], 0, 0, 0); \
        lb0 += (pb[0] + pb[1]) + (pb[2] + pb[3]); lb1 += (pb[4] + pb[5]) + (pb[6] + pb[7]); lb2 += (pb[8] + pb[9]) + (pb[10] + pb[11]); lb3 += (pb[12] + pb[13]) + (pb[14] + pb[15]); \
        _Pragma("unroll") for (int g_ = 0; g_ < 4; ++g_) { __builtin_amdgcn_sched_group_barrier(0x8, 1, 0); __builtin_amdgcn_sched_group_barrier(0x2, 4, 0); } \
        pa = pn; } while (0)
    int t = 0;
#pragma nounroll
    for (; t + 1 < NT; ++t) {
        ATT_HALF(0, 1, sl);
        ATT_HALF(1, 2, sl);
        { const int tmp_ = sl; sl = sn; sn = snn; snn = tmp_; }
    }
    ATT_HALF(0, 1, sl);
    ATT_HALF(1, 0, sl);
#undef ATT_HALF
#undef ATT_LDV
#undef ATT_DMA
    float la = (la0 + la1) + (la2 + la3), lb = (lb0 + lb1) + (lb2 + lb3);
    la += __shfl_xor(la, 32); lb += __shfl_xor(lb, 32);
    asm volatile("s_waitcnt vmcnt(0) lgkmcnt(0)" ::: "memory"); __builtin_amdgcn_s_barrier(); asm volatile("" ::: "memory");
    if (hi == 0) { wsf[r32] = la; wsf[32 + r32] = lb; }
    asm volatile("s_waitcnt lgkmcnt(0)" ::: "memory");
    constexpr int SW = DVB * 32;
    LAS bf16* stg = (LAS bf16*)(shm3) + wid * (64 * SW);
#pragma unroll
    for (int r = 0; r < 16; ++r) { const int orow = crow(r, hi); const float ra = fast_rcp(wsf[orow]), rb = fast_rcp(wsf[32 + orow]);
#pragma unroll
        for (int j = 0; j < DVB; ++j) { const unsigned w_ = cvtpk_s(oa[j][r] * ra, ob[j][r] * rb); stg[orow * SW + j * 32 + r32] = (bf16)(w_ & 0xffffu); stg[(32 + orow) * SW + j * 32 + r32] = (bf16)(w_ >> 16); } }
    asm volatile("s_waitcnt lgkmcnt(0)" ::: "memory");
    bf16* Ow = Tn.O + (size_t)(q0 + wid * 64) * Tn.op;
    constexpr int CPR = SW / 8;
#pragma unroll
    for (int i = 0; i < (64 * CPR) / 64; ++i) { const int idx = i * 64 + lane, row = idx / CPR, ch = idx % CPR;
        const v4u v = *(const LAS v4u*)(stg + row * SW + ch * 8); *(v4u*)(Ow + (size_t)row * Tn.op + ch * 8) = v; }
    asm volatile("s_waitcnt lgkmcnt(0)" ::: "memory");        __builtin_amdgcn_s_barrier(); asm volatile("" ::: "memory");
}
}
constexpr float QSCALE_MLA = 0.10206207261596575f * LOG2E;
__device__ __forceinline__ void mla_proj(Frame& F, const Inputs& in) {
    const int lane = F.lane(), w = F.wave, tk = lane & 15, g = lane >> 4;
    const bf16* LAT = (const bf16*)(F.ws + WS_LAT); const float* COS = (const float*)(F.ws + WS_COS); const float* SIN = (const float*)(F.ws + WS_SIN);
    bf16* Qo = (bf16*)(F.ws + WS_Q); bf16* Ko = (bf16*)(F.ws + WS_K); bf16* Vo = (bf16*)(F.ws + WS_V);
    const int ngrp = T / 16;
    int g0_, g1_;
    if (F.G == 256) { const int c_ = (int)blockIdx.x;
        if (c_ < 128) { g0_ = c_ * 14; g1_ = g0_ + 14; } else { g0_ = 128 * 14 + (c_ - 128) * 18; g1_ = g0_ + 18; } }
    else { const int per_ = (ngrp + F.G - 1) / F.G; g0_ = F.vcu * per_; g1_ = g0_ + per_ < ngrp ? g0_ + per_ : ngrp; if (g0_ > ngrp) g0_ = ngrp; }
    LAS float* gn_s = (LAS float*)(F.lds + AUX_XP);
    if (F.tid() < 96) { gn_s[F.tid()] = in.q_norm[F.tid()]; gn_s[96 + F.tid()] = in.k_norm[F.tid()]; }
    __syncthreads();
    {
        bf16x8 wq[6][6];
        const bf16* W = (const bf16*)(F.ws + W_Q) + (size_t)(96 * w + tk) * 192 + 8 * g;
#pragma unroll
        for (int nt = 0; nt < 6; ++nt)
#pragma unroll
            for (int ks = 0; ks < 6; ++ks) wq[nt][ks] = *(const bf16x8*)(W + (size_t)nt * 16 * 192 + ks * 32);
        LAS unsigned char* stg = F.lds + RING_OFF; int sb = 0;
        bf16x8 xn[6]; f32x4 cn = {0.f, 0.f, 0.f, 0.f}, sn = {0.f, 0.f, 0.f, 0.f};
        if (g0_ < g1_) {
#pragma unroll
            for (int ks = 0; ks < 6; ++ks) xn[ks] = *(const bf16x8*)(LAT + (size_t)(g0_ * 16 + tk) * 512 + ks * 32 + 8 * g);
            cn = *(const f32x4*)(COS + (size_t)(g0_ * 16 + tk) * 16 + 4 * g); sn = *(const f32x4*)(SIN + (size_t)(g0_ * 16 + tk) * 16 + 4 * g); }
        for (int grp = g0_; grp < g1_; ++grp) {
            unsigned long long tq0_ = 0, tq1_ = 0, tq2_ = 0; (void)tq0_; (void)tq1_; (void)tq2_; TP_NOW(tq0_);
            const int tok = grp * 16 + tk;
            const f32x4 c = cn, s = sn;
            float ss = 0.f;
#pragma unroll
            for (int ks = 0; ks < 6; ++ks) {
#pragma unroll
                for (int j = 0; j < 8; ++j) { const float v = bf2f((bf16)xn[ks][j]); ss += v * v; } }
            f32x4 acc[6];
#pragma unroll
            for (int nt = 0; nt < 6; ++nt) { acc[nt] = (f32x4){0.f, 0.f, 0.f, 0.f};
#pragma unroll
                for (int ks = 0; ks < 6; ++ks) acc[nt] = __builtin_amdgcn_mfma_f32_16x16x32_bf16(wq[nt][ks], xn[ks], acc[nt], 0, 0, 0); }
            __builtin_amdgcn_sched_barrier(0);
            if (grp + 1 < g1_) {
#pragma unroll
                for (int ks = 0; ks < 6; ++ks) xn[ks] = *(const bf16x8*)(LAT + (size_t)((grp + 1) * 16 + tk) * 512 + ks * 32 + 8 * g);
                cn = *(const f32x4*)(COS + (size_t)((grp + 1) * 16 + tk) * 16 + 4 * g); sn = *(const f32x4*)(SIN + (size_t)((grp + 1) * 16 + tk) * 16 + 4 * g); }
            __builtin_amdgcn_sched_barrier(0);
            TP_NOW(tq1_);
            ss += __shfl_xor(ss, 16); ss += __shfl_xor(ss, 32);
            const float rc = rsq(ss * (1.f / 192.f) + EPS);
            float hs = 0.f;
#pragma unroll
            for (int nt = 0; nt < 6; ++nt) { acc[nt] = acc[nt] * rc; hs += (acc[nt][0] * acc[nt][0] + acc[nt][1] * acc[nt][1]) + (acc[nt][2] * acc[nt][2] + acc[nt][3] * acc[nt][3]); }
            hs += __shfl_xor(hs, 16); hs += __shfl_xor(hs, 32);
            const float rq = QSCALE_MLA * rsq(hs * (1.f / 96.f) + EPS);
#pragma unroll
            for (int nt = 0; nt < 6; ++nt) { const f32x4 qg = *(const LAS f32x4*)(gn_s + 16 * nt + 4 * g); acc[nt] = acc[nt] * rq * qg; }
            const f32x4 x1 = acc[4], x2 = acc[5]; acc[4] = x1 * c - x2 * s; acc[5] = x2 * c + x1 * s;
#pragma unroll
            for (int nt = 0; nt < 6; ++nt) { v2u o; o.x = pk2(acc[nt][0], acc[nt][1]); o.y = pk2(acc[nt][2], acc[nt][3]); *(LAS v2u*)(stg + sb * (16 * 1552) + tk * 1552 + (96 * w + 16 * nt + 4 * g) * 2) = o; }
            asm volatile("s_waitcnt lgkmcnt(0)" ::: "memory"); __builtin_amdgcn_s_barrier(); asm volatile("" ::: "memory");
#pragma unroll
            for (int i = 0; i < 3; ++i) { const int c = F.tid() + 512 * i, row = c / 96, ch = c % 96;
                *(v4u*)(Qo + (size_t)(grp * 16 + row) * 768 + ch * 8) = *(const LAS v4u*)(stg + sb * (16 * 1552) + row * 1552 + ch * 16); }
            sb ^= 1;
            TP_NOW(tq2_); TP_ADD(F.lds, w, 0, tq0_, tq1_); TP_ADD(F.lds, w, 1, tq0_, tq2_);
        }
        __syncthreads();
    }
    {
        bf16x8 wk[8][4];
        const bf16* W = (const bf16*)(F.ws + W_KV) + (size_t)(128 * w + tk) * 128 + 8 * g;
#pragma unroll
        for (int nt = 0; nt < 8; ++nt)
#pragma unroll
            for (int ks = 0; ks < 4; ++ks) wk[nt][ks] = *(const bf16x8*)(W + (size_t)nt * 16 * 128 + ks * 32);
        LAS unsigned char* stg = F.lds + RING_OFF; int sb = 0; constexpr int KVB = 16 * (1552 + 1040);
        bf16x8 xn[5]; f32x4 cn0 = {0.f, 0.f, 0.f, 0.f}, cn1 = cn0, sn0 = cn0, sn1 = cn0;
        if (g0_ < g1_) {
#pragma unroll
            for (int ks = 0; ks < 4; ++ks) xn[ks] = *(const bf16x8*)(LAT + (size_t)(g0_ * 16 + tk) * 512 + 192 + ks * 32 + 8 * g);
            xn[4] = *(const bf16x8*)(LAT + (size_t)(g0_ * 16 + tk) * 512 + 320 + 8 * g);
            const size_t tb_ = (size_t)(g0_ * 16 + tk) * 16 + 8 * (g & 1); cn0 = *(const f32x4*)(COS + tb_); cn1 = *(const f32x4*)(COS + tb_ + 4); sn0 = *(const f32x4*)(SIN + tb_); sn1 = *(const f32x4*)(SIN + tb_ + 4); }
        for (int grp = g0_; grp < g1_; ++grp) {
            const int tok = grp * 16 + tk;
            const f32x4 c0 = cn0, c1 = cn1, s0 = sn0, s1 = sn1;
            float ss = 0.f;
#pragma unroll
            for (int ks = 0; ks < 4; ++ks) {
#pragma unroll
                for (int j = 0; j < 8; ++j) { const float v = bf2f((bf16)xn[ks][j]); ss += v * v; } }
            float kr[8], sr = 0.f;
#pragma unroll
            for (int e = 0; e < 8; ++e) { kr[e] = bf2f((bf16)xn[4][e]); sr += kr[e] * kr[e]; }
            f32x4 acc[8];
#pragma unroll
            for (int nt = 0; nt < 8; ++nt) { acc[nt] = (f32x4){0.f, 0.f, 0.f, 0.f};
#pragma unroll
                for (int ks = 0; ks < 4; ++ks) acc[nt] = __builtin_amdgcn_mfma_f32_16x16x32_bf16(wk[nt][ks], xn[ks], acc[nt], 0, 0, 0); }
            __builtin_amdgcn_sched_barrier(0);
            if (grp + 1 < g1_) {
#pragma unroll
                for (int ks = 0; ks < 4; ++ks) xn[ks] = *(const bf16x8*)(LAT + (size_t)((grp + 1) * 16 + tk) * 512 + 192 + ks * 32 + 8 * g);
                xn[4] = *(const bf16x8*)(LAT + (size_t)((grp + 1) * 16 + tk) * 512 + 320 + 8 * g);
                const size_t tb_ = (size_t)((grp + 1) * 16 + tk) * 16 + 8 * (g & 1); cn0 = *(const f32x4*)(COS + tb_); cn1 = *(const f32x4*)(COS + tb_ + 4); sn0 = *(const f32x4*)(SIN + tb_); sn1 = *(const f32x4*)(SIN + tb_ + 4); }
            __builtin_amdgcn_sched_barrier(0);
            ss += __shfl_xor(ss, 16); ss += __shfl_xor(ss, 32); sr += __shfl_xor(sr, 16); sr += __shfl_xor(sr, 32);
            const float rc = rsq(ss * (1.f / 128.f) + EPS);
            float hs = 0.f;
#pragma unroll
            for (int nt = 0; nt < 8; ++nt) { acc[nt] = acc[nt] * rc;
                if (nt < 4) hs += (acc[nt][0] * acc[nt][0] + acc[nt][1] * acc[nt][1]) + (acc[nt][2] * acc[nt][2] + acc[nt][3] * acc[nt][3]); }
            hs += __shfl_xor(hs, 16); hs += __shfl_xor(hs, 32);
            const float rk = rsq((hs + sr) * (1.f / 96.f) + EPS);
#pragma unroll
            for (int nt = 0; nt < 4; ++nt) { const f32x4 kg = *(const LAS f32x4*)(gn_s + 96 + 16 * nt + 4 * g) * rk; v2u o; o.x = pk2(acc[nt][0] * kg[0], acc[nt][1] * kg[1]); o.y = pk2(acc[nt][2] * kg[2], acc[nt][3] * kg[3]);
                *(LAS v2u*)(stg + sb * KVB + tk * 1552 + (96 * w + 16 * nt + 4 * g) * 2) = o; }
#pragma unroll
            for (int nt = 4; nt < 8; ++nt) { v2u o; o.x = pk2(acc[nt][0], acc[nt][1]); o.y = pk2(acc[nt][2], acc[nt][3]); *(LAS v2u*)(stg + sb * KVB + 16 * 1552 + tk * 1040 + (64 * w + 16 * (nt - 4) + 4 * g) * 2) = o; }
            const f32x4 kg0 = *(const LAS f32x4*)(gn_s + 96 + 64 + 8 * g), kg1 = *(const LAS f32x4*)(gn_s + 96 + 64 + 8 * g + 4);
            float ro[8];
#pragma unroll
            for (int e = 0; e < 8; ++e) { const float own = kr[e] * rk * (e < 4 ? kg0[e] : kg1[e - 4]); const float oth = __shfl_xor(own, 32); const float cc = e < 4 ? c0[e] : c1[e - 4], sn = e < 4 ? s0[e] : s1[e - 4];
                ro[e] = (g < 2) ? own * cc - oth * sn : own * cc + oth * sn; }
            v4u o; o.x = pk2(ro[0], ro[1]); o.y = pk2(ro[2], ro[3]); o.z = pk2(ro[4], ro[5]); o.w = pk2(ro[6], ro[7]);
            *(LAS v4u*)(stg + sb * KVB + tk * 1552 + (96 * w + 64 + 8 * g) * 2) = o;
            asm volatile("s_waitcnt lgkmcnt(0)" ::: "memory"); __builtin_amdgcn_s_barrier(); asm volatile("" ::: "memory");
#pragma unroll
            for (int i = 0; i < 3; ++i) { const int c = F.tid() + 512 * i, row = c / 96, ch = c % 96;
                *(v4u*)(Ko + (size_t)(grp * 16 + row) * 768 + ch * 8) = *(const LAS v4u*)(stg + sb * KVB + row * 1552 + ch * 16); }
#pragma unroll
            for (int i = 0; i < 2; ++i) { const int c = F.tid() + 512 * i, row = c >> 6, ch = c & 63;
                *(v4u*)(Vo + (size_t)(grp * 16 + row) * 512 + ch * 8) = *(const LAS v4u*)(stg + sb * KVB + 16 * 1552 + row * 1040 + ch * 16); }
            sb ^= 1;
        }
        __syncthreads();
    }
}

__device__ __forceinline__ float dpp_scan(float v) {
#define HG_DPP(ctrl, rm) v += __builtin_bit_cast(float, __builtin_amdgcn_update_dpp(0, __builtin_bit_cast(int, v), ctrl, rm, 0xf, false))
    HG_DPP(0x111, 0xf); HG_DPP(0x112, 0xf); HG_DPP(0x114, 0xf); HG_DPP(0x118, 0xf); HG_DPP(0x142, 0xa); HG_DPP(0x143, 0xc);
#undef HG_DPP
    return v;
}
typedef _Float16 f16x8 __attribute__((ext_vector_type(8)));
constexpr int HGL_QT = 0, HGL_KC = 32768, HGL_VP = 65536, HGL_SP = 81920, HGL_DEC = 114688, HGL_DUMP = 116736, HGL_GT = 117760;
__device__ __forceinline__ void hgrn2_scan(Frame& F, char* shm) {
    using att::lds_cptr; using att::vtr; using att::crow;
    const int lane = F.lane(), w = F.wave, r32 = lane & 31, hi = lane >> 5;
    const unsigned lds0 = (unsigned)(uintptr_t)shm; const lds_cptr shm3 = (lds_cptr)shm;
    const int laneoff = ((lane >> 4) & 1) * 32 + (lane & 3) * 8 + (4 * hi + ((lane & 15) >> 2)) * 64;
    const int laneoffS = ((lane >> 4) & 1) * 32 + (lane & 3) * 8 + (8 * hi + ((lane & 15) >> 2)) * 64;
    const int koff = (2 * ((lane >> 4) & 1) + ((lane & 3) >> 1)) * 1024 + (4 * hi + ((lane & 15) >> 2)) * 16 + 8 * (lane & 1);
    const int n16 = lane & 15, q4 = lane >> 4;
    const int goff = ((lane & 3) >> 1) * 1024 + (8 * q4 + ((lane >> 2) & 3)) * 16 + (lane & 1) * 8;
    const int groff = (q4 >> 1) * 1024 + n16 * 16 + (q4 & 1) * 8;
    v4u tri0, tri1; const v4u fones = {0x3C003C00u, 0x3C003C00u, 0x3C003C00u, 0x3C003C00u};
    { const int thr0 = n16 - 8 * q4, thr1 = (q4 < 2) ? 64 : n16 - 8 * (q4 - 2);
#pragma unroll
      for (int p_ = 0; p_ < 4; ++p_) { tri0[p_] = (thr0 >= 2 * p_ + 1) ? 0x3C003C00u : (thr0 == 2 * p_ ? 0x00003C00u : 0u); tri1[p_] = (thr1 >= 2 * p_ + 1) ? 0x3C003C00u : (thr1 == 2 * p_ ? 0x00003C00u : 0u); } }
    for (int item = F.vcu; item < 256; item += F.G) {
        const int vh = item & 1, dir = (item >> 1) & 1, h = (item >> 2) & 3, b = item >> 4;
        const bf16* HQ = (const bf16*)(F.ws + WS_HQ) + h * 128 + 16 * w;
        const unsigned short* GG = (const unsigned short*)(F.ws + (dir ? WS_GB : WS_GF)) + h * 128 + 16 * w;
        const bf16* HI = (const bf16*)(F.ws + WS_HI) + h * 128 + vh * 64;
        bf16* OUT = (bf16*)(F.ws + (dir ? WS_OB : WS_OF)) + h * 128 + vh * 64;
        const int tfirst = b * SEQ + (dir ? SEQ - 1 : 0), tstep = dir ? -1 : 1;
        f32x16 S0 = f32x16{}, S1 = f32x16{};
        v2u hq_n[4], hq_[4], gr_[4]; v4u g_n[2]; f32x4 c_[4]; const unsigned gtw = lds0 + HGL_GT + w * 2048 + lane * 16;
#define HG_VDMA(nn) do { const int vg_ = w >> 2, ig_ = w & 3; const int trow_ = tfirst + tstep * (64 * (nn) + 16 * ig_ + (lane >> 2)); \
            att::glds16(HI + (size_t)trow_ * 512 + vg_ * 32 + (lane & 3) * 8, (unsigned)__builtin_amdgcn_readfirstlane(lds0 + HGL_VP + ((nn) & 1) * 8192 + w * 1024)); } while (0)
#define HG_LOAD(nn) do { const int nl_ = (nn) < SEQ / 64 ? (nn) : SEQ / 64 - 1; const int tb_ = tfirst + tstep * (64 * nl_);        \
            _Pragma("unroll") for (int tj = 0; tj < 4; ++tj) { const bf16* p_ = HQ + (size_t)(tb_ + tstep * (16 * tj + n16)) * 512 + 4 * q4; asm volatile("global_load_dwordx2 %0, %1, off" : "=&v"(hq_n[tj]) : "v"(p_)); } \
            const unsigned short* pg_ = GG + (size_t)(tb_ + tstep * lane) * 512; \
            asm volatile("global_load_dwordx4 %0, %1, off" : "=&v"(g_n[0]) : "v"(pg_)); asm volatile("global_load_dwordx4 %0, %1, off offset:16" : "=&v"(g_n[1]) : "v"(pg_)); } while (0)
#define HG_ROWS_LANDED(cnt) asm volatile("s_waitcnt vmcnt(" #cnt ") lgkmcnt(0)\n\tv_mov_b64 %0, %4\n\tv_mov_b64 %1, %5\n\tv_mov_b64 %2, %6\n\tv_mov_b64 %3, %7\n\tds_write_b128 %8, %9\n\tds_write_b128 %8, %10 offset:1024" \
            : "=&v"(hq_[0]), "=&v"(hq_[1]), "=&v"(hq_[2]), "=&v"(hq_[3]) : "v"(hq_n[0]), "v"(hq_n[1]), "v"(hq_n[2]), "v"(hq_n[3]), "v"(gtw), "v"(g_n[0]), "v"(g_n[1]) : "memory")
#define HG_CUM(nn) do { \
            HG_LOAD((nn) + 1); \
            const lds_cptr gt_ = shm3 + HGL_GT + w * 2048; \
            const s16x4 a0l_ = vtr(gt_ + goff), a0h_ = vtr(gt_ + goff + 64), a1l_ = vtr(gt_ + goff + 512), a1h_ = vtr(gt_ + goff + 576); \
            _Pragma("unroll") for (int tj = 0; tj < 4; ++tj) gr_[tj] = *(const LAS v2u*)(gt_ + groff + tj * 256); \
            const f16x8 A0_ = __builtin_bit_cast(f16x8, (bf16x8){a0l_[0], a0l_[1], a0l_[2], a0l_[3], a0h_[0], a0h_[1], a0h_[2], a0h_[3]}), A1_ = __builtin_bit_cast(f16x8, (bf16x8){a1l_[0], a1l_[1], a1l_[2], a1l_[3], a1h_[0], a1h_[1], a1h_[2], a1h_[3]}); \
            const f32x4 z_ = {0.f, 0.f, 0.f, 0.f}; \
            c_[0] = __builtin_amdgcn_mfma_f32_16x16x32_f16(A0_, __builtin_bit_cast(f16x8, tri0), z_, 0, 0, 0); c_[1] = __builtin_amdgcn_mfma_f32_16x16x32_f16(A0_, __builtin_bit_cast(f16x8, tri1), z_, 0, 0, 0); \
            { const f32x4 cf_ = __builtin_amdgcn_mfma_f32_16x16x32_f16(A0_, __builtin_bit_cast(f16x8, fones), z_, 0, 0, 0); \
              c_[2] = __builtin_amdgcn_mfma_f32_16x16x32_f16(A1_, __builtin_bit_cast(f16x8, tri0), cf_, 0, 0, 0); c_[3] = __builtin_amdgcn_mfma_f32_16x16x32_f16(A1_, __builtin_bit_cast(f16x8, tri1), cf_, 0, 0, 0); } } while (0)
#define HG_FIN(nn) do { const int pp_ = (nn) & 1; \
            _Pragma("unroll") for (int tj = 0; tj < 4; ++tj) { \
                const float q_[4] = {pg8::bf_lo(hq_[tj].x), pg8::bf_hi(hq_[tj].x), pg8::bf_lo(hq_[tj].y), pg8::bf_hi(hq_[tj].y)}; \
                const float gg_[4] = {h2f((unsigned short)(gr_[tj].x & 0xffffu)), h2f((unsigned short)(gr_[tj].x >> 16)), h2f((unsigned short)(gr_[tj].y & 0xffffu)), h2f((unsigned short)(gr_[tj].y >> 16))}; \
                float bq_[4], kk_[4], E_[4]; \
                _Pragma("unroll") for (int i = 0; i < 4; ++i) { const float bsum = c_[tj][i]; E_[i] = fast_exp2(bsum); const float Ei = fast_exp2(-bsum), kx = 1.0f - fast_exp2(gg_[i]); bq_[i] = q_[i] * E_[i]; kk_[i] = kx * Ei; } \
                *(LAS v2u*)(shm3 + HGL_QT + pp_ * 16384 + (2 * w) * 1024 + groff + tj * 256) = (v2u){pk2(bq_[0], bq_[1]), pk2(bq_[2], bq_[3])}; \
                *(LAS v2u*)(shm3 + HGL_KC + pp_ * 16384 + (2 * w) * 1024 + groff + tj * 256) = (v2u){pk2(kk_[0], kk_[1]), pk2(kk_[2], kk_[3])}; \
                if (tj == 3) { if (n16 == 15) *(LAS f32x4*)(shm3 + HGL_DEC + pp_ * 512 + 64 * w + 16 * q4) = (f32x4){E_[0], E_[1], E_[2], E_[3]}; } } } while (0)
        HG_LOAD(0); HG_ROWS_LANDED(0);
        HG_CUM(0); HG_VDMA(0); HG_FIN(0);
        HG_ROWS_LANDED(0); __builtin_amdgcn_s_barrier(); asm volatile("" ::: "memory");
        for (int n = 0; n < SEQ / 64; ++n) {
            unsigned long long th0_ = 0, th1_ = 0, th2_ = 0, th3_ = 0; (void)th0_; (void)th1_; (void)th2_; (void)th3_; TP_NOW(th0_);
            const int par = n & 1;
            const int qtc = HGL_QT + par * 16384, kcc = HGL_KC + par * 16384, vpc = HGL_VP + par * 8192, spc = HGL_SP + par * 16384, spn = HGL_SP + (par ^ 1) * 16384, decc = HGL_DEC + par * 512;
            HG_CUM(n + 1);
            if (n + 1 < SEQ / 64) HG_VDMA(n + 1);
            if (w < 4) {
                const int tb = w >> 1, vb = w & 1;
                S0 = f32x16{};
                bf16x8 qf[8];
#pragma unroll
                for (int kd = 0; kd < 8; ++kd) qf[kd] = *(const LAS bf16x8*)(shm3 + qtc + (2 * kd + hi) * 1024 + (32 * tb + r32) * 16);
                {
                    bf16x8 kf[8], kg[8]; s16x4 vl[2], vh_[2], ul[2], uh_[2];
#pragma unroll
                    for (int kd = 0; kd < 8; ++kd) kf[kd] = *(const LAS bf16x8*)(shm3 + kcc + (2 * kd + hi) * 1024 + (32 * tb + r32) * 16);
#pragma unroll
                    for (int ks = 0; ks < 2; ++ks) { vl[ks] = vtr(shm3 + vpc + (vb * 4 + 2 * tb + ks) * 1024 + laneoff); vh_[ks] = vtr(shm3 + vpc + (vb * 4 + 2 * tb + ks) * 1024 + laneoff + 512); }
                    S1 = f32x16{};
#pragma unroll
                    for (int kd = 0; kd < 8; ++kd) S1 = __builtin_amdgcn_mfma_f32_32x32x16_bf16(kf[kd], qf[kd], S1, 0, 0, 0);
                    if (tb == 1) {
#pragma unroll
                        for (int kd = 0; kd < 8; ++kd) kg[kd] = *(const LAS bf16x8*)(shm3 + kcc + (2 * kd + hi) * 1024 + r32 * 16);
#pragma unroll
                        for (int ks = 0; ks < 2; ++ks) { ul[ks] = vtr(shm3 + vpc + (vb * 4 + ks) * 1024 + laneoff); uh_[ks] = vtr(shm3 + vpc + (vb * 4 + ks) * 1024 + laneoff + 512); }
                    }
#pragma unroll
                    for (int r = 0; r < 16; ++r) if (crow(r, hi) > r32) S1[r] = 0.f;
                    { const v4u pw0 = (v4u){pk2(S1[0], S1[1]), pk2(S1[2], S1[3]), pk2(S1[4], S1[5]), pk2(S1[6], S1[7])}, pw1 = (v4u){pk2(S1[8], S1[9]), pk2(S1[10], S1[11]), pk2(S1[12], S1[13]), pk2(S1[14], S1[15])};
#pragma unroll
                      for (int ks = 0; ks < 2; ++ks)
                        S0 = __builtin_amdgcn_mfma_f32_32x32x16_bf16(__builtin_bit_cast(bf16x8, ks ? pw1 : pw0), (bf16x8){vl[ks][0], vl[ks][1], vl[ks][2], vl[ks][3], vh_[ks][0], vh_[ks][1], vh_[ks][2], vh_[ks][3]}, S0, 0, 0, 0); }
                    if (tb == 1) {
                        S1 = f32x16{};
#pragma unroll
                        for (int kd = 0; kd < 8; ++kd) S1 = __builtin_amdgcn_mfma_f32_32x32x16_bf16(kg[kd], qf[kd], S1, 0, 0, 0);
                        const v4u pw0 = (v4u){pk2(S1[0], S1[1]), pk2(S1[2], S1[3]), pk2(S1[4], S1[5]), pk2(S1[6], S1[7])}, pw1 = (v4u){pk2(S1[8], S1[9]), pk2(S1[10], S1[11]), pk2(S1[12], S1[13]), pk2(S1[14], S1[15])};
#pragma unroll
                        for (int ks = 0; ks < 2; ++ks)
                            S0 = __builtin_amdgcn_mfma_f32_32x32x16_bf16(__builtin_bit_cast(bf16x8, ks ? pw1 : pw0), (bf16x8){ul[ks][0], ul[ks][1], ul[ks][2], ul[ks][3], uh_[ks][0], uh_[ks][1], uh_[ks][2], uh_[ks][3]}, S0, 0, 0, 0);
                    }
                }
                if (n > 0) {
                    s16x4 sl[8], sh[8];
#pragma unroll
                    for (int kd = 0; kd < 8; ++kd) { sl[kd] = vtr(shm3 + spc + (vb * 8 + kd) * 1024 + laneoffS); sh[kd] = vtr(shm3 + spc + (vb * 8 + kd) * 1024 + laneoffS + 256); }
#pragma unroll
                    for (int kd = 0; kd < 8; ++kd)
                        S0 = __builtin_amdgcn_mfma_f32_32x32x16_bf16(qf[kd], (bf16x8){sl[kd][0], sl[kd][1], sl[kd][2], sl[kd][3], sh[kd][0], sh[kd][1], sh[kd][2], sh[kd][3]}, S0, 0, 0, 0);
                }
                TP_NOW(th1_);
                if (n + 1 < SEQ / 64) HG_FIN(n + 1);
                TP_NOW(th2_);
#pragma unroll
                for (int r = 0; r < 16; r += 2) { const unsigned w_ = att::cvtpk_s(S0[r], S0[r + 1]);
                    const int i0 = 32 * tb + crow(r, hi), i1 = 32 * tb + crow(r + 1, hi);
                    OUT[(size_t)(tfirst + tstep * (64 * n + i0)) * 512 + vb * 32 + r32] = (bf16)(w_ & 0xffffu); OUT[(size_t)(tfirst + tstep * (64 * n + i1)) * 512 + vb * 32 + r32] = (bf16)(w_ >> 16); }
            } else {
                const int db = w - 4;
                if (n + 1 < SEQ / 64) HG_FIN(n + 1);
                s16x4 kl[4], kh_[4], v0l[4], v0h[4], v1l[4], v1h[4];
#pragma unroll
                for (int ig = 0; ig < 4; ++ig) {
                    kl[ig] = vtr(shm3 + kcc + (4 * db) * 1024 + ig * 256 + koff); kh_[ig] = vtr(shm3 + kcc + (4 * db) * 1024 + ig * 256 + koff + 128);
                    v0l[ig] = vtr(shm3 + vpc + (0 * 4 + ig) * 1024 + laneoff); v0h[ig] = vtr(shm3 + vpc + (0 * 4 + ig) * 1024 + laneoff + 512);
                    v1l[ig] = vtr(shm3 + vpc + (1 * 4 + ig) * 1024 + laneoff); v1h[ig] = vtr(shm3 + vpc + (1 * 4 + ig) * 1024 + laneoff + 512); }
#pragma unroll
                for (int ig = 0; ig < 4; ++ig) {
                    const bf16x8 ka = (bf16x8){kl[ig][0], kl[ig][1], kl[ig][2], kl[ig][3], kh_[ig][0], kh_[ig][1], kh_[ig][2], kh_[ig][3]};
                    S0 = __builtin_amdgcn_mfma_f32_32x32x16_bf16(ka, (bf16x8){v0l[ig][0], v0l[ig][1], v0l[ig][2], v0l[ig][3], v0h[ig][0], v0h[ig][1], v0h[ig][2], v0h[ig][3]}, S0, 0, 0, 0);
                    S1 = __builtin_amdgcn_mfma_f32_32x32x16_bf16(ka, (bf16x8){v1l[ig][0], v1l[ig][1], v1l[ig][2], v1l[ig][3], v1h[ig][0], v1h[ig][1], v1h[ig][2], v1h[ig][3]}, S1, 0, 0, 0);
                }
                TP_NOW(th1_);
                TP_NOW(th2_);
#pragma unroll
                for (int r = 0; r < 16; ++r) { const int d = 32 * db + crow(r, hi); const float dc = ((const LAS float*)(shm3 + decc))[d]; S0[r] *= dc; S1[r] *= dc;
                    const unsigned w_ = att::cvtpk_s(S0[r], S1[r]);
                    *(LAS bf16*)(shm3 + spn + (0 * 8 + (d >> 4)) * 1024 + (d & 15) * 64 + r32 * 2) = (bf16)(w_ & 0xffffu);
                    *(LAS bf16*)(shm3 + spn + (1 * 8 + (d >> 4)) * 1024 + (d & 15) * 64 + r32 * 2) = (bf16)(w_ >> 16); }
            }
            if (n + 2 < SEQ / 64) { if (w < 4) HG_ROWS_LANDED(16); else HG_ROWS_LANDED(0); }
            else HG_ROWS_LANDED(0);
            __builtin_amdgcn_s_barrier(); asm volatile("" ::: "memory");
            TP_NOW(th3_);
#if MK_TPROBE
            TP_ADD((LAS unsigned char*)shm3, w, 1, th0_, th3_);
            if (MK_TPHG == 0) TP_ADD((LAS unsigned char*)shm3, w, 0, th0_, th1_); else if (MK_TPHG == 1) TP_ADD((LAS unsigned char*)shm3, w, 0, th1_, th2_); else TP_ADD((LAS unsigned char*)shm3, w, 0, th2_, th3_);
#endif
        }
#undef HG_VDMA
#undef HG_LOAD
#undef HG_ROWS_LANDED
#undef HG_CUM
#undef HG_FIN
    }
}
__device__ __forceinline__ void hg_combine(Frame& F, const Inputs& in) {
    const int gw = F.vcu * NWAVES + F.wave, NGW = F.G * NWAVES, lane = F.lane();
    const bf16* OFp = (const bf16*)(F.ws + WS_OF); const bf16* OBp = (const bf16*)(F.ws + WS_OB); const bf16* HG = (const bf16*)(F.ws + WS_HG); bf16* CAT = (bf16*)(F.ws + WS_CAT);
    float on[8];
#pragma unroll
    for (int e = 0; e < 8; ++e) on[e] = in.o_norm[(lane & 15) * 8 + e];
    for (int t = gw; t < T; t += NGW) {
        const v4u a = *(const v4u*)(OFp + (size_t)t * 512 + lane * 8), bq = *(const v4u*)(OBp + (size_t)t * 512 + lane * 8), gq = *(const v4u*)(HG + (size_t)t * 512 + lane * 8);
        float x[8], ss = 0.f;
#pragma unroll
        for (int e = 0; e < 4; ++e) { x[2 * e] = pg8::bf_lo(a[e]) + pg8::bf_lo(bq[e]); x[2 * e + 1] = pg8::bf_hi(a[e]) + pg8::bf_hi(bq[e]); ss += x[2 * e] * x[2 * e] + x[2 * e + 1] * x[2 * e + 1]; }
        ss += __shfl_xor(ss, 1); ss += __shfl_xor(ss, 2); ss += __shfl_xor(ss, 4); ss += __shfl_xor(ss, 8);
        const float r = rsq(ss * (1.f / 128.f) + EPS);
        v4u o;
#pragma unroll
        for (int e = 0; e < 4; ++e) o[e] = pk2(x[2 * e] * r * on[2 * e] * pg8::bf_lo(gq[e]), x[2 * e + 1] * r * on[2 * e + 1] * pg8::bf_hi(gq[e]));
        *(v4u*)(CAT + (size_t)t * 1024 + 512 + lane * 8) = o;
    }
}
__device__ __forceinline__ void moe_route(Frame& F, const int tok0, const int ntok) {
    const int gt = tok0 + F.tid(), NGT = NWAVES * 64;
    const float* LG = (const float*)(F.ws + WS_LG); int* rec = (int*)(F.ws + WS_REC);
    int* bk = rec; int* ps = rec + T; float* wA = (float*)(rec + 2 * T); float* wB = (float*)(rec + 3 * T);
    LAS unsigned* lcnt = (LAS unsigned*)(F.lds + RING_OFF); LAS unsigned* lbase = lcnt + 512;
    for (int tokc = tok0; tokc < tok0 + ntok; tokc += NGT) {
    __syncthreads();
    lcnt[F.tid()] = 0u;
    __syncthreads();
    const int tok = tokc + F.tid(); const bool live = tok < tok0 + ntok;
    int bucket = 0; unsigned lrank = 0u; float wAv = 0.f, wBv = 0.f;
    if (live) {
        const float* l = LG + (size_t)tok * 72;
        float gl[8]; { const f32x4 a = *(const f32x4*)l, b = *(const f32x4*)(l + 4); gl[0] = a[0]; gl[1] = a[1]; gl[2] = a[2]; gl[3] = a[3]; gl[4] = b[0]; gl[5] = b[1]; gl[6] = b[2]; gl[7] = b[3]; }
        float mx = gl[0]; int gs = 0;
#pragma unroll
        for (int g = 1; g < 8; ++g) if (gl[g] > mx) { mx = gl[g]; gs = g; }
        float den = 0.f;
#pragma unroll
        for (int g = 0; g < 8; ++g) den += expf(gl[g] - mx);
        const float gwt = 1.0f / den;
        float el[8]; { const f32x4 a = *(const f32x4*)(l + 8 + gs * 8), b = *(const f32x4*)(l + 12 + gs * 8); el[0] = a[0]; el[1] = a[1]; el[2] = a[2]; el[3] = a[3]; el[4] = b[0]; el[5] = b[1]; el[6] = b[2]; el[7] = b[3]; }
        int i0 = 0; float m0 = el[0];
#pragma unroll
        for (int e = 1; e < 8; ++e) if (el[e] > m0) { m0 = el[e]; i0 = e; }
        int i1 = -1; float m1 = -INFINITY;
#pragma unroll
        for (int e = 0; e < 8; ++e) if (e != i0 && el[e] > m1) { m1 = el[e]; i1 = e; }
        if (i1 < 0) i1 = (i0 == 0) ? 1 : 0;
        const float e1 = expf(m1 - m0); const float wa = gwt / (1.0f + e1), wb = gwt * e1 / (1.0f + e1);
        const int ea = i0 < i1 ? i0 : i1, eb = i0 < i1 ? i1 : i0;
        bucket = gs * 64 + ea * 8 + eb;
        lrank = __hip_atomic_fetch_add((unsigned*)(lcnt + bucket), 1u, __ATOMIC_RELAXED, __HIP_MEMORY_SCOPE_WORKGROUP);
        wAv = i0 < i1 ? wa : wb; wBv = i0 < i1 ? wb : wa;
    }
    __syncthreads();
    { const unsigned c_ = lcnt[F.tid()]; if (c_ != 0u) lbase[F.tid()] = __hip_atomic_fetch_add((unsigned*)(F.ctl + CW_CNTP) + F.tid() * 32, c_, RLX_AGENT); }
    __syncthreads();
    if (live) { bk[tok] = bucket; ps[tok] = (int)(lbase[bucket] + lrank); wA[tok] = wAv; wB[tok] = wBv; }
    }
    __syncthreads();
}
__device__ __forceinline__ void moe_place(Frame& F) {
    LAS int* cn_s = (LAS int*)(F.lds + RING_OFF); LAS int* ts_s = cn_s + 512; LAS int* ba_s = cn_s + 1024; LAS int* bb_s = cn_s + 1536; LAS int* ne_s = cn_s + 2048; LAS int* te_s = cn_s + 2112;
    const int t = F.tid();
    const int cnt = (int)__hip_atomic_load((unsigned*)(F.ctl + CW_CNTP) + t * 32, RLX_AGENT);
    cn_s[t] = cnt;
    __syncthreads();
    const int g = t >> 6, ea = (t >> 3) & 7, eb = t & 7;
    int st = 0;
    for (int j = 0; j < t; ++j) st += (cn_s[j] + 255) >> 8;
    ts_s[t] = st;
    int ba = 0, bb = 0;
    for (int j = g * 64; j < t; ++j) { const int ja = (j >> 3) & 7, jb = j & 7; const int c = cn_s[j]; if (ja == ea || jb == ea) ba += c; if (ja == eb || jb == eb) bb += c; }
    ba_s[t] = ba; bb_s[t] = bb;
    int cntE = 0;
    if (t < 64) { const int x = t & 7; for (int j = (t >> 3) * 64; j < (t >> 3) * 64 + 64; ++j) { const int ja = (j >> 3) & 7, jb = j & 7; if (ja < jb && (ja == x || jb == x)) cntE += cn_s[j]; } ne_s[t] = (cntE + 255) >> 8; }
    __syncthreads();
    int ste = 0;
    if (t < 64) { for (int j = 0; j < t; ++j) ste += ne_s[j]; te_s[t] = ste; }
    __syncthreads();
    unsigned char* rec = F.ws + WS_REC;
    int* rowpa = (int*)(rec + REC_ROWPA); int* rowpb = (int*)(rec + REC_ROWPB); int* rowp = (int*)(rec + REC_ROWP); int* tilep = (int*)(rec + REC_TILEP); int* rowe = (int*)(rec + REC_ROWE); float* wslot = (float*)(rec + REC_WSLOT); int* tilee = (int*)(rec + REC_TILEE);
    if (blockIdx.x == 0) {
        const int ntb = (cnt + 255) >> 8;
        for (int k = 0; k < ntb; ++k) tilep[st + k] = t;
        for (int r = cnt; r < ntb * 256; ++r) { rowp[st * 256 + r] = -1; rowpa[st * 256 + r] = 0; rowpb[st * 256 + r] = 0; }
        if (t == 511) __hip_atomic_store((unsigned*)(F.ctl + CW_NT), (unsigned)(st + ntb), RLX_AGENT);
        if (t < 64) { const int nte = (cntE + 255) >> 8;
            for (int k = 0; k < nte; ++k) tilee[ste + k] = t;
            for (int r = cntE; r < nte * 256; ++r) { rowe[ste * 256 + r] = -1; wslot[ste * 256 + r] = 0.f; }
            if (t == 63) __hip_atomic_store((unsigned*)(F.ctl + CW_NTE), (unsigned)(ste + nte), RLX_AGENT); }
    }
    const int gt = (F.vcu * NWAVES + F.wave) * 64 + F.lane(), NGT = F.G * NWAVES * 64;
    const int* ri = (const int*)rec; int* wi = (int*)rec;
    for (int tok = gt; tok < T; tok += NGT) {
        const int bkt = ri[tok], pos = ri[T + tok];
        rowp[ts_s[bkt] * 256 + pos] = tok;
        const int eag = (bkt >> 6) * 8 + ((bkt >> 3) & 7), ebg = (bkt >> 6) * 8 + (bkt & 7);
        const int sa = te_s[eag] * 256 + ba_s[bkt] + pos, sb = te_s[ebg] * 256 + bb_s[bkt] + pos;
        rowe[sa] = tok; rowe[sb] = tok; wslot[sa] = __int_as_float(ri[2 * T + tok]); wslot[sb] = __int_as_float(ri[3 * T + tok]);
        rowpa[ts_s[bkt] * 256 + pos] = sa; rowpb[ts_s[bkt] * 256 + pos] = sb;
    }
    __syncthreads();
}
#ifndef MK_WGM1
#define MK_WGM1 8
#endif
__device__ __forceinline__ void phase_0(Frame& F, const Inputs& in, float* d_out_, unsigned char* ws, unsigned char* lds) {
    LAS float* RS = (LAS float*)(F.lds + AUX_RS); LAS float* WG = (LAS float*)(F.lds + AUX_WG); LAS int* TOK = (LAS int*)(F.lds + AUX_TOK); LAS float* XP = (LAS float*)(F.lds + AUX_XP);
    const float* misc = (const float*)(ws + WS_MISC); (void)RS; (void)WG; (void)TOK; (void)XP; (void)misc;
 p0_prologue(F, in);
}
__device__ __forceinline__ void phase_1(Frame& F, const Inputs& in, float* d_out_, unsigned char* ws, unsigned char* lds) {
    LAS float* RS = (LAS float*)(F.lds + AUX_RS); LAS float* WG = (LAS float*)(F.lds + AUX_WG); LAS int* TOK = (LAS int*)(F.lds + AUX_TOK); LAS float* XP = (LAS float*)(F.lds + AUX_XP);
    const float* misc = (const float*)(ws + WS_MISC); (void)RS; (void)WG; (void)TOK; (void)XP; (void)misc;
        SchedGrid S; S.pad_ = 0; S.o.init(T / 256, 12, F.G, (int)blockIdx.x, MK_WGM1); S.A = (const char*)(ws + WS_XN); S.B = (const char*)(ws + W_IN); S.astep = (size_t)256 * 1024 * 2; S.bstep = (size_t)256 * 1024 * 2;
        EpiIn E{(bf16_t*)(ws + WS_HQ), (const float*)(ws + WS_SS0), misc, RS, 0};
        pg8::gemm_phase<EpiIn, SchedGrid, true, 0, 1024, 1024, 1024, 16>(F.lds + RING_OFF, S, E);
#ifdef MK_PROBE_P1CHEAP
        { __syncthreads(); EpiIn E2{(bf16_t*)(ws + WS_Q), (const float*)(ws + WS_SS0), misc, RS, MK_PROBE_P1CHEAP}; pg8::gemm_phase<EpiIn, SchedGrid, true, 0, 1024, 1024, 1024, 16>(F.lds + RING_OFF, S, E2); }
#endif

}
__device__ __forceinline__ void phase_2(Frame& F, const Inputs& in, float* d_out_, unsigned char* ws, unsigned char* lds) {
    LAS float* RS = (LAS float*)(F.lds + AUX_RS); LAS float* WG = (LAS float*)(F.lds + AUX_WG); LAS int* TOK = (LAS int*)(F.lds + AUX_TOK); LAS float* XP = (LAS float*)(F.lds + AUX_XP);
    const float* misc = (const float*)(ws + WS_MISC); (void)RS; (void)WG; (void)TOK; (void)XP; (void)misc;
#ifdef MK_TPROBE_MLA
        TP_SET(F.lds, 1u);
#endif
#ifdef MK_TPS_MLA
        { TPS_BEGIN(); mla_proj(F, in); TPS_END(F); }
#else
        mla_proj(F, in);
#endif
#ifdef MK_TPROBE_MLA
        TP_SET(F.lds, 0u);
#endif
#ifdef MK_REP_MLA
        mla_proj(F, in);
#endif
        { SchedGrid S; S.pad_ = 0; S.o.init(16, 8, F.G, (int)blockIdx.x); S.A = (const char*)(ws + WS_MN); S.B = (const char*)(ws + W_XKV); S.astep = (size_t)256 * 1024 * 2; S.bstep = (size_t)256 * 1024 * 2;
          EpiHeadNorm E{nullptr, in.x_k_norm, (bf16_t*)(ws + WS_KVX), RS, XP, 1.0f, 2048, 4, 0};
          pg8::gemm_phase<EpiHeadNorm, SchedGrid, true, 0, 1024, 1024, 1024, 16>(F.lds + RING_OFF, S, E); }
        __syncthreads();
#if defined(MK_TPHG)
        TP_SET(F.lds, 1u); hgrn2_scan(F, (char*)lds + RING_OFF); TP_SET(F.lds, 0u);
#elif defined(MK_TPS_HG)
        { TPS_BEGIN(); hgrn2_scan(F, (char*)lds + RING_OFF); TPS_END(F); }
#else
        hgrn2_scan(F, (char*)lds + RING_OFF);
#endif
#ifdef MK_REP_HG
        __syncthreads(); hgrn2_scan(F, (char*)lds + RING_OFF);
#endif

}
__device__ __forceinline__ void phase_3(Frame& F, const Inputs& in, float* d_out_, unsigned char* ws, unsigned char* lds) {
    LAS float* RS = (LAS float*)(F.lds + AUX_RS); LAS float* WG = (LAS float*)(F.lds + AUX_WG); LAS int* TOK = (LAS int*)(F.lds + AUX_TOK); LAS float* XP = (LAS float*)(F.lds + AUX_XP);
    const float* misc = (const float*)(ws + WS_MISC); (void)RS; (void)WG; (void)TOK; (void)XP; (void)misc;
        hg_combine(F, in);
        const float cb = misc[1024];
        if (cb < 64.f) {
        for (int un = F.vcu; un < BATCH * 8 * 8; un += F.G) {
            const int qb = un & 7, bh = un >> 3, b = bh >> 3, h = bh & 7;
            att::Tensors Tn; Tn.Q = (const bf16*)(ws + WS_Q) + (size_t)b * SEQ * 768 + h * 96; Tn.K = (const bf16*)(ws + WS_K) + (size_t)b * SEQ * 768 + h * 96;
            Tn.V = (const bf16*)(ws + WS_V) + (size_t)b * SEQ * 512 + h * 64; Tn.O = (bf16*)(ws + WS_CAT) + (size_t)b * SEQ * 1024 + h * 64; Tn.qp = 768; Tn.kp = 768; Tn.vp = 512; Tn.op = 1024;
            att::unit3<6, 2>(Tn, qb * 512, SEQ / 64, (char*)lds + RING_OFF, (LAS float*)(F.lds + AUX_WSF));
        }
        } else {
        for (int un = F.vcu; un < BATCH * 8 * 16; un += F.G) {
            const int qb = un & 15, bh = un >> 4, b = bh >> 3, h = bh & 7;
            att::Tensors Tn; Tn.Q = (const bf16*)(ws + WS_Q) + (size_t)b * SEQ * 768 + h * 96; Tn.K = (const bf16*)(ws + WS_K) + (size_t)b * SEQ * 768 + h * 96;
            Tn.V = (const bf16*)(ws + WS_V) + (size_t)b * SEQ * 512 + h * 64; Tn.O = (bf16*)(ws + WS_CAT) + (size_t)b * SEQ * 1024 + h * 64; Tn.qp = 768; Tn.kp = 768; Tn.vp = 512; Tn.op = 1024;
            att::unit<6, 2, 2, 8, true, false>(Tn, qb * 256, SEQ / 64, cb, (char*)lds + RING_OFF, (LAS float*)(F.lds + AUX_WSF));
        }
        }

}
__device__ __forceinline__ void phase_4(Frame& F, const Inputs& in, float* d_out_, unsigned char* ws, unsigned char* lds) {
    LAS float* RS = (LAS float*)(F.lds + AUX_RS); LAS float* WG = (LAS float*)(F.lds + AUX_WG); LAS int* TOK = (LAS int*)(F.lds + AUX_TOK); LAS float* XP = (LAS float*)(F.lds + AUX_XP);
    const float* misc = (const float*)(ws + WS_MISC); (void)RS; (void)WG; (void)TOK; (void)XP; (void)misc;
    SchedGrid S; S.pad_ = 0; S.o.init(T / 256, 4, F.G, (int)blockIdx.x); S.A = (const char*)(ws + WS_CAT); S.B = (const char*)(ws + W_OUT); S.astep = (size_t)256 * 1024 * 2; S.bstep = (size_t)256 * 1024 * 2;
    EpiRes<XN0_KEPT> E{XN0_KEPT ? (const void*)(ws + WS_XN) : (const void*)in.x, (bf16_t*)(ws + WS_XN), (float*)(ws + WS_SSP1)};
    pg8::gemm_phase<EpiRes<XN0_KEPT>, SchedGrid, true, 0, 1024, 1024, 1024, 16>(F.lds + RING_OFF, S, E);
}
__device__ __forceinline__ void phase_5(Frame& F, const Inputs& in, float* d_out_, unsigned char* ws, unsigned char* lds) {
    LAS float* RS = (LAS float*)(F.lds + AUX_RS); LAS float* WG = (LAS float*)(F.lds + AUX_WG); LAS int* TOK = (LAS int*)(F.lds + AUX_TOK); LAS float* XP = (LAS float*)(F.lds + AUX_XP);
    const float* misc = (const float*)(ws + WS_MISC); (void)RS; (void)WG; (void)TOK; (void)XP; (void)misc;
    SchedGrid S; S.pad_ = 0; S.o.init(T / 256, 4, F.G, (int)blockIdx.x); S.A = (const char*)(ws + WS_XN); S.B = (const char*)(ws + W_XQ); S.astep = (size_t)256 * 1024 * 2; S.bstep = (size_t)256 * 1024 * 2;
    { EpiHeadNorm E{(const float*)(ws + WS_SSP1), in.x_q_norm, (bf16_t*)(ws + WS_QX), RS, XP, 0.0625f * LOG2E, 1024, 4, 0};
      pg8::gemm_phase<EpiHeadNorm, SchedGrid, true, 0, 1024, 1024, 1024, 16>(F.lds + RING_OFF, S, E); }
    asm volatile("s_waitcnt vmcnt(0) lgkmcnt(0)" ::: "memory"); __syncthreads(); __builtin_amdgcn_fence(__ATOMIC_ACQUIRE, "agent"); asm volatile("s_waitcnt vmcnt(0)" ::: "memory"); __syncthreads();
    const float cb = misc[1025];
    for (int i = 0;; ++i) { int pm, h; if (!S.o.tile(i, pm, h)) break;
        const int b = pm >> 4, q0 = (pm & 15) * 256;
        att::Tensors Tn; Tn.Q = (const bf16*)(ws + WS_QX) + (size_t)b * SEQ * 1024 + h * 256; Tn.K = (const bf16*)(ws + WS_KVX) + (size_t)b * MEML * 2048 + h * 256;
        Tn.V = (const bf16*)(ws + WS_KVX) + (size_t)b * MEML * 2048 + 1024 + h * 256; Tn.O = (bf16*)(ws + WS_QX) + (size_t)b * SEQ * 1024 + h * 256; Tn.qp = 1024; Tn.kp = 2048; Tn.vp = 2048; Tn.op = 1024;
        att::unit<16, 8, 8, 8, true, true>(Tn, q0, MEML / 64, cb, (char*)lds + RING_OFF, (LAS float*)(F.lds + AUX_WSF)); }
}
__device__ __forceinline__ void phase_6(Frame& F, const Inputs& in, float* d_out_, unsigned char* ws, unsigned char* lds) {
    LAS float* RS = (LAS float*)(F.lds + AUX_RS); LAS float* WG = (LAS float*)(F.lds + AUX_WG); LAS int* TOK = (LAS int*)(F.lds + AUX_TOK); LAS float* XP = (LAS float*)(F.lds + AUX_XP);
    const float* misc = (const float*)(ws + WS_MISC); (void)RS; (void)WG; (void)TOK; (void)XP; (void)misc;
}
__device__ __forceinline__ void phase_7(Frame& F, const Inputs& in, float* d_out_, unsigned char* ws, unsigned char* lds) {
    LAS float* RS = (LAS float*)(F.lds + AUX_RS); LAS float* WG = (LAS float*)(F.lds + AUX_WG); LAS int* TOK = (LAS int*)(F.lds + AUX_TOK); LAS float* XP = (LAS float*)(F.lds + AUX_XP);
    const float* misc = (const float*)(ws + WS_MISC); (void)RS; (void)WG; (void)TOK; (void)XP; (void)misc;
    SchedGrid S; S.pad_ = 0; S.o.init(T / 256, 4, F.G, (int)blockIdx.x); S.A = (const char*)(ws + WS_QX); S.B = (const char*)(ws + W_XO); S.astep = (size_t)256 * 1024 * 2; S.bstep = (size_t)256 * 1024 * 2;
    EpiRes<true> E{(const void*)(ws + WS_XN), (bf16_t*)(ws + WS_XN), (float*)(ws + WS_SSP2)};
    pg8::gemm_phase<EpiRes<true>, SchedGrid, true, 0, 1024, 1024, 1024, 16>(F.lds + RING_OFF, S, E);
}
__device__ __forceinline__ void phase_8(Frame& F, const Inputs& in, float* d_out_, unsigned char* ws, unsigned char* lds) {
    LAS float* RS = (LAS float*)(F.lds + AUX_RS); LAS float* WG = (LAS float*)(F.lds + AUX_WG); LAS int* TOK = (LAS int*)(F.lds + AUX_TOK); LAS float* XP = (LAS float*)(F.lds + AUX_XP);
    const float* misc = (const float*)(ws + WS_MISC); (void)RS; (void)WG; (void)TOK; (void)XP; (void)misc;
    { SchedGrid S; S.pad_ = 0; S.o.init(T / 256, 1, F.G, (int)blockIdx.x); S.A = (const char*)(ws + WS_XN); S.B = (const char*)(ws + W_R); S.astep = (size_t)256 * 1024 * 2; S.bstep = 0;
      EpiRouter E{(const float*)(ws + WS_SSP2), in.b_group, in.b_expert, (float*)(ws + WS_LG), RS, 0};
      pg8::gemm_phase<EpiRouter, SchedGrid, true, 0, 1024, 1024, 1024, 16>(F.lds + RING_OFF, S, E);
      __syncthreads(); __builtin_amdgcn_fence(__ATOMIC_ACQUIRE, "agent"); asm volatile("s_waitcnt vmcnt(0)" ::: "memory"); __syncthreads();
      for (int i = 0;; ++i) { int pm, pn; if (!S.o.tile(i, pm, pn)) break; moe_route(F, pm * 256, 256); } }
}
__device__ __forceinline__ void phase_9(Frame& F, const Inputs& in, float* d_out_, unsigned char* ws, unsigned char* lds) {
    LAS float* RS = (LAS float*)(F.lds + AUX_RS); LAS float* WG = (LAS float*)(F.lds + AUX_WG); LAS int* TOK = (LAS int*)(F.lds + AUX_TOK); LAS float* XP = (LAS float*)(F.lds + AUX_XP);
    const float* misc = (const float*)(ws + WS_MISC); (void)RS; (void)WG; (void)TOK; (void)XP; (void)misc;
}
__device__ __forceinline__ void phase_10(Frame& F, const Inputs& in, float* d_out_, unsigned char* ws, unsigned char* lds) {
    LAS float* RS = (LAS float*)(F.lds + AUX_RS); LAS float* WG = (LAS float*)(F.lds + AUX_WG); LAS int* TOK = (LAS int*)(F.lds + AUX_TOK); LAS float* XP = (LAS float*)(F.lds + AUX_XP);
    const float* misc = (const float*)(ws + WS_MISC); (void)RS; (void)WG; (void)TOK; (void)XP; (void)misc;
 moe_place(F);
}
__device__ __forceinline__ void phase_11(Frame& F, const Inputs& in, float* d_out_, unsigned char* ws, unsigned char* lds) {
    LAS float* RS = (LAS float*)(F.lds + AUX_RS); LAS float* WG = (LAS float*)(F.lds + AUX_WG); LAS int* TOK = (LAS int*)(F.lds + AUX_TOK); LAS float* XP = (LAS float*)(F.lds + AUX_XP);
    const float* misc = (const float*)(ws + WS_MISC); (void)RS; (void)WG; (void)TOK; (void)XP; (void)misc;
        SchedMoeA S; S.pad_ = 0; S.ntile = __builtin_amdgcn_readfirstlane((int)__hip_atomic_load((unsigned*)(F.ctl + CW_NTE), RLX_AGENT)); S.G = F.G; S.c = F.vcu;
        S.tilee = (const int*)(ws + WS_REC + REC_TILEE); S.rowe = (const int*)(ws + WS_REC + REC_ROWE); S.XN = (const char*)(ws + WS_XN); S.WGU = (const char*)(ws + WS_WGU);
        EpiMoeA E{(const float*)(ws + WS_SSP2), (const float*)(ws + WS_REC + REC_WSLOT), (bf16_t*)(ws + WS_H), RS, WG};
        pg8::gemm_phase<EpiMoeA, SchedMoeA, true, 1, 1024, 1024, 1024, 16>(F.lds + RING_OFF, S, E);
}
__device__ __forceinline__ void phase_12(Frame& F, const Inputs& in, float* d_out_, unsigned char* ws, unsigned char* lds) {
    LAS float* RS = (LAS float*)(F.lds + AUX_RS); LAS float* WG = (LAS float*)(F.lds + AUX_WG); LAS int* TOK = (LAS int*)(F.lds + AUX_TOK); LAS float* XP = (LAS float*)(F.lds + AUX_XP);
    const float* misc = (const float*)(ws + WS_MISC); (void)RS; (void)WG; (void)TOK; (void)XP; (void)misc;
        SchedMoeB S; S.pad_ = 0; S.ntile = __builtin_amdgcn_readfirstlane((int)__hip_atomic_load((unsigned*)(F.ctl + CW_NT), RLX_AGENT)); S.G = F.G; S.c = F.vcu;
        S.tilep = (const int*)(ws + WS_REC + REC_TILEP); S.rowp = (const int*)(ws + WS_REC + REC_ROWP); S.slotA = (const int*)(ws + WS_REC + REC_ROWPA); S.slotB = (const int*)(ws + WS_REC + REC_ROWPB);
        S.Hb = (const char*)(ws + WS_H); S.WD = (const char*)(ws + WS_WD);
        EpiMoeB E{(const bf16_t*)(ws + WS_XN), d_out_, TOK, 0};
        pg8::gemm_phase<EpiMoeB, SchedMoeB, true, 2, 512, 256, 256, 4>(F.lds + RING_OFF, S, E);
}

constexpr int N_PHASES = 13;
struct Args { Inputs in; float* out; unsigned char* ws; int ph_lo, ph_hi; };
__global__ void __launch_bounds__(NWAVES * 64, 2) mega_fwd(Args args) {
    extern __shared__ __attribute__((aligned(16))) unsigned char lds[];
    Frame F;
    F.lds = (LAS unsigned char*)lds;
    F.MISC = (volatile LAS unsigned*)(F.lds + MISC_OFF);
    F.wave = __builtin_amdgcn_readfirstlane((int)threadIdx.x >> 6);
    F.G = gridDim.x; { const int bx = blockIdx.x; F.vcu = (F.G % 8 == 0) ? (bx % 8) * (F.G / 8) + bx / 8 : bx; }
    F.ws = args.ws; F.ctl = (gu32*)(args.ws + WS_CTL);
    const Inputs& in = args.in;
    unsigned char* ws = args.ws;
    for (int u = F.tid(); u < 32; u += NWAVES * 64) ((LAS unsigned*)(F.lds + MISC_OFF))[u] = 0u;
    __syncthreads();
#if MK_TPROBE
    for (int u = F.tid(); u < 128; u += NWAVES * 64) ((LAS unsigned*)(F.lds + TP_LDS_OFF))[u] = 0u;
    __syncthreads();
#endif
    unsigned long long tk0_ = 0, tk1_ = 0; (void)tk0_; (void)tk1_; TP_NOW(tk0_);
    const int lo = args.ph_lo, hi = args.ph_hi;
    const bool multi = (hi - lo) > 1;
    XcdBarrier bar; bar.bar = (unsigned*)(F.ctl + CW_BAR); bar.x = 0; bar.st = nullptr;
    if (multi) bar = xcd_barrier_post((unsigned*)(F.ctl + CW_BAR), F.MISC + 8);
#ifndef MK_PHASE_MASK
#define MK_PHASE_MASK 0xffff
#endif
#define IN(k) ((((MK_PHASE_MASK) >> (k)) & 1) && lo <= (k) && (k) < hi)
#ifndef MK_REP_MASK
#define MK_REP_MASK 0
#endif
#define REPS(k) ((((MK_REP_MASK) >> (k)) & 1) ? 2 : 1)
#ifndef MK_TPROBE_PHASE
#define MK_TPROBE_PHASE -1
#endif
#ifndef MK_TPROBE_PHT
#define MK_TPROBE_PHT -1
#endif
#ifndef MK_TPROBE_Q
#define MK_TPROBE_Q 10
#endif
#ifndef MK_TPROBE_OFS
#define MK_TPROBE_OFS 0.5
#endif
#ifdef MK_TPS_BAR
#ifndef MK_TPS_BAR_MASK
#define MK_TPS_BAR_MASK 0xffff
#endif
#define SEAM(k) do { if (IN(k) && IN((k) + 1)) { if ((MK_TPS_BAR_MASK >> (k)) & 1) { TPS_BEGIN(); xcd_barrier(bar); TPS_END(F); } else xcd_barrier(bar); } } while (0)
#else
#define SEAM(k) do { if (MK_TPROBE && (k) == MK_TPROBE_PHASE) TP_SET(F.lds, 0u); if (IN(k) && IN((k) + 1)) xcd_barrier(bar); } while (0)
#endif
#if MK_DEBUG
#define MW_R0 0, 16384, 0, 0
#define MW_R1 0, 16384, 0, 0
#define MW_R2 0, 16384, 0, 0
#define MW_R3 0, 16384, 0, 0
#define MW_R4 0, 24576, 0, (1 << 20)
#define MW_R6 0, 16384, 0, 0
#define MW_R7 0, 16384, 0, 0
#define MW_R9 0, 16384, 0, 0
#else
#define MW_R0 0, 16384, 0, 2
#define MW_R1 0, 16384, 2, 4
#define MW_R2 0, 16384, 4, 6
#define MW_R3 0, 16384, 6, (1 << 20)
#define MW_R4 16384, 8192, 0, 1
#define MW_R6 16384, 8192, 1, 2
#define MW_R7 16384, 8192, 2, 3
#define MW_R9 16384, 8192, 3, (1 << 20)
#endif
#define SEAMW(k, ...) SEAMW_(k, __VA_ARGS__)
#define SEAMW_(k, ib, ic, r0, r1) do { if (MK_TPROBE && (k) == MK_TPROBE_PHASE) TP_SET(F.lds, 0u); \
        if (IN(k) && IN((k) + 1)) { xcd_barrier_arrive(bar); moe_weights(F, in, ib, ic, r0, r1); xcd_barrier_wait(bar); } else if (IN(k)) { __syncthreads(); moe_weights(F, in, ib, ic, r0, r1); } } while (0)
    LAS float* RS = (LAS float*)(F.lds + AUX_RS); LAS float* WG = (LAS float*)(F.lds + AUX_WG); LAS int* TOK = (LAS int*)(F.lds + AUX_TOK); LAS float* XP = (LAS float*)(F.lds + AUX_XP);
    const float* misc = (const float*)(ws + WS_MISC);

    if (IN(0)) { unsigned long long pt0_ = 0, pt1_ = 0; (void)pt0_; (void)pt1_; if (MK_TPROBE && 0 == MK_TPROBE_PHT) TP_NOW(pt0_); if (MK_TPROBE && 0 == MK_TPROBE_PHASE) TP_SET(F.lds, 1u); phase_0(F, in, args.out, ws, lds); if (REPS(0) > 1) { __syncthreads(); phase_0(F, in, args.out, ws, lds); }  if (MK_TPROBE && 0 == MK_TPROBE_PHT) { TP_NOW(pt1_); if (F.lane() == 0) { volatile LAS unsigned long long* q_ = (volatile LAS unsigned long long*)(F.lds + TP_LDS_OFF + 256) + F.wave * 4 + 2; *q_ = *q_ + (pt1_ - pt0_); } } }
    SEAMW(0, MW_R0);
    if (IN(1)) { unsigned long long pt0_ = 0, pt1_ = 0; (void)pt0_; (void)pt1_; if (MK_TPROBE && 1 == MK_TPROBE_PHT) TP_NOW(pt0_); if (MK_TPROBE && 1 == MK_TPROBE_PHASE) TP_SET(F.lds, 1u); phase_1(F, in, args.out, ws, lds); if (REPS(1) > 1) { __syncthreads(); phase_1(F, in, args.out, ws, lds); }  if (MK_TPROBE && 1 == MK_TPROBE_PHT) { TP_NOW(pt1_); if (F.lane() == 0) { volatile LAS unsigned long long* q_ = (volatile LAS unsigned long long*)(F.lds + TP_LDS_OFF + 256) + F.wave * 4 + 2; *q_ = *q_ + (pt1_ - pt0_); } } }
    SEAMW(1, MW_R1);
    if (IN(2)) { unsigned long long pt0_ = 0, pt1_ = 0; (void)pt0_; (void)pt1_; if (MK_TPROBE && 2 == MK_TPROBE_PHT) TP_NOW(pt0_); if (MK_TPROBE && 2 == MK_TPROBE_PHASE) TP_SET(F.lds, 1u); phase_2(F, in, args.out, ws, lds); if (REPS(2) > 1) { __syncthreads(); phase_2(F, in, args.out, ws, lds); }  if (MK_TPROBE && 2 == MK_TPROBE_PHT) { TP_NOW(pt1_); if (F.lane() == 0) { volatile LAS unsigned long long* q_ = (volatile LAS unsigned long long*)(F.lds + TP_LDS_OFF + 256) + F.wave * 4 + 2; *q_ = *q_ + (pt1_ - pt0_); } } }
    SEAMW(2, MW_R2);
    if (IN(3)) { unsigned long long pt0_ = 0, pt1_ = 0; (void)pt0_; (void)pt1_; if (MK_TPROBE && 3 == MK_TPROBE_PHT) TP_NOW(pt0_); if (MK_TPROBE && 3 == MK_TPROBE_PHASE) TP_SET(F.lds, 1u); phase_3(F, in, args.out, ws, lds); if (REPS(3) > 1) { __syncthreads(); phase_3(F, in, args.out, ws, lds); }  if (MK_TPROBE && 3 == MK_TPROBE_PHT) { TP_NOW(pt1_); if (F.lane() == 0) { volatile LAS unsigned long long* q_ = (volatile LAS unsigned long long*)(F.lds + TP_LDS_OFF + 256) + F.wave * 4 + 2; *q_ = *q_ + (pt1_ - pt0_); } } }
    SEAMW(3, MW_R3);
    if (IN(4)) { unsigned long long pt0_ = 0, pt1_ = 0; (void)pt0_; (void)pt1_; if (MK_TPROBE && 4 == MK_TPROBE_PHT) TP_NOW(pt0_); if (MK_TPROBE && 4 == MK_TPROBE_PHASE) TP_SET(F.lds, 1u); phase_4(F, in, args.out, ws, lds); if (REPS(4) > 1) { __syncthreads(); phase_4(F, in, args.out, ws, lds); }  if (MK_TPROBE && 4 == MK_TPROBE_PHT) { TP_NOW(pt1_); if (F.lane() == 0) { volatile LAS unsigned long long* q_ = (volatile LAS unsigned long long*)(F.lds + TP_LDS_OFF + 256) + F.wave * 4 + 2; *q_ = *q_ + (pt1_ - pt0_); } } }
    SEAMW(4, MW_R4);
    if (IN(5)) { unsigned long long pt0_ = 0, pt1_ = 0; (void)pt0_; (void)pt1_; if (MK_TPROBE && 5 == MK_TPROBE_PHT) TP_NOW(pt0_); if (MK_TPROBE && 5 == MK_TPROBE_PHASE) TP_SET(F.lds, 1u); phase_5(F, in, args.out, ws, lds); if (REPS(5) > 1) { __syncthreads(); phase_5(F, in, args.out, ws, lds); }  if (MK_TPROBE && 5 == MK_TPROBE_PHT) { TP_NOW(pt1_); if (F.lane() == 0) { volatile LAS unsigned long long* q_ = (volatile LAS unsigned long long*)(F.lds + TP_LDS_OFF + 256) + F.wave * 4 + 2; *q_ = *q_ + (pt1_ - pt0_); } } }
    if (IN(6)) { unsigned long long pt0_ = 0, pt1_ = 0; (void)pt0_; (void)pt1_; if (MK_TPROBE && 6 == MK_TPROBE_PHT) TP_NOW(pt0_); if (MK_TPROBE && 6 == MK_TPROBE_PHASE) TP_SET(F.lds, 1u); phase_6(F, in, args.out, ws, lds); if (REPS(6) > 1) { __syncthreads(); phase_6(F, in, args.out, ws, lds); }  if (MK_TPROBE && 6 == MK_TPROBE_PHT) { TP_NOW(pt1_); if (F.lane() == 0) { volatile LAS unsigned long long* q_ = (volatile LAS unsigned long long*)(F.lds + TP_LDS_OFF + 256) + F.wave * 4 + 2; *q_ = *q_ + (pt1_ - pt0_); } } }
    SEAMW(6, MW_R6);
    if (IN(7)) { unsigned long long pt0_ = 0, pt1_ = 0; (void)pt0_; (void)pt1_; if (MK_TPROBE && 7 == MK_TPROBE_PHT) TP_NOW(pt0_); if (MK_TPROBE && 7 == MK_TPROBE_PHASE) TP_SET(F.lds, 1u); phase_7(F, in, args.out, ws, lds); if (REPS(7) > 1) { __syncthreads(); phase_7(F, in, args.out, ws, lds); }  if (MK_TPROBE && 7 == MK_TPROBE_PHT) { TP_NOW(pt1_); if (F.lane() == 0) { volatile LAS unsigned long long* q_ = (volatile LAS unsigned long long*)(F.lds + TP_LDS_OFF + 256) + F.wave * 4 + 2; *q_ = *q_ + (pt1_ - pt0_); } } }
    SEAMW(7, MW_R7);
    if (IN(8)) { unsigned long long pt0_ = 0, pt1_ = 0; (void)pt0_; (void)pt1_; if (MK_TPROBE && 8 == MK_TPROBE_PHT) TP_NOW(pt0_); if (MK_TPROBE && 8 == MK_TPROBE_PHASE) TP_SET(F.lds, 1u); phase_8(F, in, args.out, ws, lds); if (REPS(8) > 1) { __syncthreads(); phase_8(F, in, args.out, ws, lds); }  if (MK_TPROBE && 8 == MK_TPROBE_PHT) { TP_NOW(pt1_); if (F.lane() == 0) { volatile LAS unsigned long long* q_ = (volatile LAS unsigned long long*)(F.lds + TP_LDS_OFF + 256) + F.wave * 4 + 2; *q_ = *q_ + (pt1_ - pt0_); } } }
    if (IN(9)) { unsigned long long pt0_ = 0, pt1_ = 0; (void)pt0_; (void)pt1_; if (MK_TPROBE && 9 == MK_TPROBE_PHT) TP_NOW(pt0_); if (MK_TPROBE && 9 == MK_TPROBE_PHASE) TP_SET(F.lds, 1u); phase_9(F, in, args.out, ws, lds); if (REPS(9) > 1) { __syncthreads(); phase_9(F, in, args.out, ws, lds); }  if (MK_TPROBE && 9 == MK_TPROBE_PHT) { TP_NOW(pt1_); if (F.lane() == 0) { volatile LAS unsigned long long* q_ = (volatile LAS unsigned long long*)(F.lds + TP_LDS_OFF + 256) + F.wave * 4 + 2; *q_ = *q_ + (pt1_ - pt0_); } } }
    SEAMW(9, MW_R9);
    if (IN(10)) { unsigned long long pt0_ = 0, pt1_ = 0; (void)pt0_; (void)pt1_; if (MK_TPROBE && 10 == MK_TPROBE_PHT) TP_NOW(pt0_); if (MK_TPROBE && 10 == MK_TPROBE_PHASE) TP_SET(F.lds, 1u); phase_10(F, in, args.out, ws, lds); if (REPS(10) > 1) { __syncthreads(); phase_10(F, in, args.out, ws, lds); }  if (MK_TPROBE && 10 == MK_TPROBE_PHT) { TP_NOW(pt1_); if (F.lane() == 0) { volatile LAS unsigned long long* q_ = (volatile LAS unsigned long long*)(F.lds + TP_LDS_OFF + 256) + F.wave * 4 + 2; *q_ = *q_ + (pt1_ - pt0_); } } }
    SEAM(10);
    if (IN(11)) { unsigned long long pt0_ = 0, pt1_ = 0; (void)pt0_; (void)pt1_; if (MK_TPROBE && 11 == MK_TPROBE_PHT) TP_NOW(pt0_); if (MK_TPROBE && 11 == MK_TPROBE_PHASE) TP_SET(F.lds, 1u); phase_11(F, in, args.out, ws, lds); if (REPS(11) > 1) { __syncthreads(); phase_11(F, in, args.out, ws, lds); }  if (MK_TPROBE && 11 == MK_TPROBE_PHT) { TP_NOW(pt1_); if (F.lane() == 0) { volatile LAS unsigned long long* q_ = (volatile LAS unsigned long long*)(F.lds + TP_LDS_OFF + 256) + F.wave * 4 + 2; *q_ = *q_ + (pt1_ - pt0_); } } }
    SEAM(11);
    if (IN(12)) { unsigned long long pt0_ = 0, pt1_ = 0; (void)pt0_; (void)pt1_; if (MK_TPROBE && 12 == MK_TPROBE_PHT) TP_NOW(pt0_); if (MK_TPROBE && 12 == MK_TPROBE_PHASE) TP_SET(F.lds, 1u); phase_12(F, in, args.out, ws, lds); if (REPS(12) > 1) { __syncthreads(); phase_12(F, in, args.out, ws, lds); }  if (MK_TPROBE && 12 == MK_TPROBE_PHT) { TP_NOW(pt1_); if (F.lane() == 0) { volatile LAS unsigned long long* q_ = (volatile LAS unsigned long long*)(F.lds + TP_LDS_OFF + 256) + F.wave * 4 + 2; *q_ = *q_ + (pt1_ - pt0_); } } }
#if MK_TPROBE
    {
        TP_NOW(tk1_);
        TP_SET(F.lds, 0u);
        if (F.lane() == 0) { volatile LAS unsigned long long* p_ = (volatile LAS unsigned long long*)(F.lds + TP_LDS_OFF + 256) + F.wave * 4;
            atomicAdd((unsigned long long*)(F.ctl + 30000), p_[0]); atomicAdd((unsigned long long*)(F.ctl + 30002), p_[1] + p_[2]); atomicAdd((unsigned long long*)(F.ctl + 30004), (unsigned long long)(tk1_ - tk0_)); }
        xcd_barrier(bar);
        const double a_ = (double)__hip_atomic_load((unsigned long long*)(F.ctl + 30000), RLX_AGENT), b_ = (double)__hip_atomic_load((unsigned long long*)(F.ctl + 30002), RLX_AGENT);
#ifdef MK_TPROBE_REL
        const float rat_ = (float)(b_ / (double)__hip_atomic_load((unsigned long long*)(F.ctl + 30004), RLX_AGENT));
#elif defined(MK_TPROBE_ABS)
        const float rat_ = (float)(b_ / (double)(MK_TPROBE_ABS));
#else
        const float rat_ = (float)(a_ / (b_ > 0.0 ? b_ : 1.0));
#endif
        const float sc_ = 1.0f + floorf(rat_ * (float)MK_TPROBE_Q + (float)MK_TPROBE_OFS) / (float)MK_TPROBE_Q;
        const size_t gt_ = ((size_t)F.vcu * NWAVES + F.wave) * 64 + F.lane(), ng_ = (size_t)F.G * NWAVES * 64;
        for (size_t i = gt_; i < (size_t)T * D / 4; i += ng_) { f32x4 v = ((f32x4*)args.out)[i]; ((f32x4*)args.out)[i] = v * sc_; }
    }
#endif
#undef IN
#undef SEAM
}
#ifndef MK_DEBUG
#define MK_DEBUG 0
#endif
#ifndef MK_PER_PHASE
#define MK_PER_PHASE MK_DEBUG
#endif
#if MK_DEBUG
struct CmpDesc { const void* test; const float* ref; size_t rhs; int ttype, tld, rld, cw, rows, cols, tfm, slot; float rscale; int pad; };
__global__ void __launch_bounds__(256) cmp_k(CmpDesc d, double* sums) {
    __shared__ double red[2][4];
    double sd = 0.0, sr = 0.0;
    const size_t n = (size_t)d.rows * d.cols;
    for (size_t idx = (size_t)blockIdx.x * 256 + threadIdx.x; idx < n; idx += (size_t)gridDim.x * 256) {
        const int r = (int)(idx / d.cols), c = (int)(idx % d.cols);
        float tv;
        if (d.ttype == 0) tv = bf2f(((const bf16*)d.test)[(size_t)r * d.tld + c]);
        else if (d.ttype == 1) tv = h2f(((const unsigned short*)d.test)[(size_t)r * d.tld + c]);
        else tv = ((const float*)d.test)[(size_t)r * d.tld + c];
        float rv = d.ref[(size_t)(c / d.cw) * d.rhs + (size_t)r * d.rld + (c % d.cw)] * d.rscale;
        if (d.tfm == 1) rv = rv / (1.0f + expf(-rv));
        if (d.tfm == 2) tv = exp2f(tv);
        const double df = (double)tv - (double)rv; sd += df * df; sr += (double)rv * (double)rv;
    }
    for (int o = 32; o; o >>= 1) { sd += __shfl_xor(sd, o); sr += __shfl_xor(sr, o); }
    if ((threadIdx.x & 63) == 0) { red[0][threadIdx.x >> 6] = sd; red[1][threadIdx.x >> 6] = sr; }
    __syncthreads();
    if (threadIdx.x == 0) { atomicAdd(&sums[2 * d.slot], red[0][0] + red[0][1] + red[0][2] + red[0][3]); atomicAdd(&sums[2 * d.slot + 1], red[1][0] + red[1][1] + red[1][2] + red[1][3]); }
}
__global__ void verdict_k(const double* sums, const float* tols, int nslot, unsigned* code) {
    if (threadIdx.x == 0 && blockIdx.x == 0) { unsigned c = 0;
        for (int k = 0; k < nslot; ++k) { const double rvr = sums[2 * k] / sums[2 * k + 1]; if (!(rvr <= (double)tols[k])) { c = (unsigned)(k + 1); break; } }
        *code = c; }
}
__global__ void poison_k(const unsigned* code, const float* x, float* out, size_t n) {
    const unsigned c = *code; if (c == 0) return;
    const float f = 1.0f + exp2f((float)c);
    for (size_t i = (size_t)blockIdx.x * blockDim.x + threadIdx.x; i < n; i += (size_t)gridDim.x * blockDim.x) out[i] = x[i] * f;
}
__global__ void settol_k(float* tols) { const float t[16] = MK_TOLS; if (threadIdx.x < 16) tols[threadIdx.x] = t[threadIdx.x]; }
#endif

extern "C" void kernel_launch(void* const* d_in, const int* in_sizes, int n_in, void* d_out, int out_size, void* d_ws, size_t ws_size, hipStream_t stream) {
    static int grid = 0;
    if (grid == 0) {
        if (n_in != 29 || out_size != T * D || ws_size < (MK_DEBUG ? WS_END + 192 * MiB : WS_END_REL)) { fprintf(stderr, "kernel_launch: unexpected shapes (n_in %d, out %d, ws %zu)\n", n_in, out_size, ws_size); grid = -1; return; }
        int dev = 0, cus = 0;
        if (hipGetDevice(&dev) != hipSuccess || hipDeviceGetAttribute(&cus, hipDeviceAttributeMultiprocessorCount, dev) != hipSuccess) { grid = -1; return; }
        if (hipFuncSetAttribute((const void*)mega_fwd, hipFuncAttributeMaxDynamicSharedMemorySize, LDS_BYTES) != hipSuccess) { fprintf(stderr, "kernel_launch: hipFuncSetAttribute failed\n"); grid = -1; return; }
        int per_cu = 0;
        if (hipOccupancyMaxActiveBlocksPerMultiprocessor(&per_cu, (const void*)mega_fwd, NWAVES * 64, LDS_BYTES) != hipSuccess || per_cu < 1) { fprintf(stderr, "kernel_launch: occupancy query says %d\n", per_cu); }
        (void)hipGetLastError();
        grid = cus;
    }
    if (grid < 0) return;
    (void)hipMemsetAsync((char*)d_ws + WS_CTL, 0, CTL_ZERO_BYTES, stream);
    Args a{};
    Inputs& w = a.in;
    w.x = (const float*)d_in[0]; w.mem = (const float*)d_in[1]; w.pos = (const int*)d_in[2]; w.norm_mix = (const float*)d_in[3]; w.w_in = (const float*)d_in[4];
    w.q_a_norm = (const float*)d_in[5]; w.w_q_up = (const float*)d_in[6]; w.kv_a_norm = (const float*)d_in[7]; w.w_kv_up = (const float*)d_in[8];
    w.q_norm = (const float*)d_in[9]; w.k_norm = (const float*)d_in[10]; w.lb_logits = (const float*)d_in[11]; w.o_norm = (const float*)d_in[12]; w.w_out = (const float*)d_in[13];
    w.norm_cross = (const float*)d_in[14]; w.norm_mem = (const float*)d_in[15]; w.x_w_q = (const float*)d_in[16]; w.x_w_kv = (const float*)d_in[17];
    w.x_q_norm = (const float*)d_in[18]; w.x_k_norm = (const float*)d_in[19]; w.x_w_o = (const float*)d_in[20]; w.norm_ffn = (const float*)d_in[21];
    w.w_group = (const float*)d_in[22]; w.b_group = (const float*)d_in[23]; w.w_expert = (const float*)d_in[24]; w.b_expert = (const float*)d_in[25];
    w.w_gate = (const float*)d_in[26]; w.w_up = (const float*)d_in[27]; w.w_down = (const float*)d_in[28];
    a.out = (float*)d_out; a.ws = (unsigned char*)d_ws;
    unsigned char* ws = (unsigned char*)d_ws;
#if MK_DEBUG
    constexpr int BC = MK_DEBUG_BATCH;
    orc::W ow; static_assert(sizeof(orc::W) == sizeof(Inputs), "same field list"); memcpy(&ow, &w, sizeof(ow));
    orc::Bufs B; B.carve2((float*)d_out, (float*)(ws + WS_END));
    double* sums = (double*)(ws + WS_CTL + CW_CHK * 4); float* tols = (float*)(sums + 64); unsigned* code = (unsigned*)(tols + 32);
    settol_k<<<1, 64, 0, stream>>>(tols);
    orc::pack_router<<<(1024 * 72 + 255) / 256, 256, 0, stream>>>(ow.w_group, ow.w_expert, B.wr);
    orc::run_batch(ow, B, BC, B.outb, stream);
    auto CMP = [&](int slot, const void* test, int ttype, int tld, const float* ref, int rld, int cw, size_t rhs, int rows, int cols, float rscale, int tfm) {
        CmpDesc d{}; d.test = test; d.ref = ref; d.rhs = rhs; d.ttype = ttype; d.tld = tld; d.rld = rld; d.cw = cw; d.rows = rows; d.cols = cols; d.tfm = tfm; d.slot = slot; d.rscale = rscale;
        cmp_k<<<512, 256, 0, stream>>>(d, sums); };
    const size_t r0 = (size_t)BC * SEQ;
#endif
    auto PH = [&](int lo, int hi) { a.ph_lo = lo; a.ph_hi = hi; hipLaunchKernelGGL(mega_fwd, dim3(grid), dim3(NWAVES * 64), LDS_BYTES, stream, a); };
#if MK_PER_PHASE
    for (int p = 0; p < N_PHASES; ++p) {
        PH(p, p + 1);
#if MK_DEBUG
        if (p == 1) {
            CMP(0, (bf16*)(ws + WS_HQ) + r0 * 512, 0, 512, B.qs, 512, 512, 0, SEQ, 512, 1.f, 0);
            CMP(1, (bf16*)(ws + WS_GF) + r0 * 512, 1, 512, B.f, 512, 512, 0, SEQ, 512, 1.f, 2);
            CMP(1, (bf16*)(ws + WS_GB) + r0 * 512, 1, 512, B.f + (size_t)SEQ * 512, 512, 512, 0, SEQ, 512, 1.f, 2);
            CMP(2, (bf16*)(ws + WS_HI) + r0 * 512, 0, 512, B.p + 1888, 2912, 512, 0, SEQ, 512, 1.f, 0);
            CMP(2, (bf16*)(ws + WS_HG) + r0 * 512, 0, 512, B.p + 2400, 2912, 512, 0, SEQ, 512, 1.f, 1);
            CMP(3, (bf16*)(ws + WS_LAT) + r0 * 512, 0, 512, B.p, 2912, 352, 0, SEQ, 352, 1.f, 0);
        }
        if (p == 2) {
            CMP(4, (bf16*)(ws + WS_Q) + r0 * 768, 0, 768, B.Qn, 96, 96, (size_t)SEQ * 96, SEQ, 768, QSCALE_MLA, 0);
            CMP(5, (bf16*)(ws + WS_K) + r0 * 768, 0, 768, B.Kn, 96, 96, (size_t)SEQ * 96, SEQ, 768, 1.f, 0);
            CMP(6, (bf16*)(ws + WS_V) + r0 * 512, 0, 512, B.V, 64, 64, (size_t)SEQ * 64, SEQ, 512, 1.f, 0);
            CMP(7, (bf16*)(ws + WS_KVX) + (size_t)BC * MEML * 2048, 0, 2048, B.kvx, 2048, 2048, 0, MEML, 2048, 1.f, 0);
            CMP(8, (bf16*)(ws + WS_OF) + r0 * 512, 0, 512, B.o, 512, 512, 0, SEQ, 512, 1.f, 0);
            CMP(8, (bf16*)(ws + WS_OB) + r0 * 512, 0, 512, B.o + (size_t)SEQ * 512, 512, 512, 0, SEQ, 512, 1.f, 0);
        }
        if (p == 3) {
            CMP(9, (bf16*)(ws + WS_CAT) + r0 * 1024 + 512, 0, 1024, B.cat + 512, 1024, 512, 0, SEQ, 512, 1.f, 0);
            CMP(10, (bf16*)(ws + WS_CAT) + r0 * 1024, 0, 1024, B.cat, 1024, 512, 0, SEQ, 512, 1.f, 0);
        }
        if (p == 4) CMP(11, (bf16*)(ws + WS_XN) + r0 * 1024, 0, 1024, B.x1, 1024, 1024, 0, SEQ, 1024, 1.f, 0);
        if (0) CMP(12, (bf16*)(ws + WS_QX) + r0 * 1024, 0, 1024, B.qx, 1024, 1024, 0, SEQ, 1024, 0.0625f * LOG2E, 0);
        if (p == 5) CMP(13, (bf16*)(ws + WS_QX) + r0 * 1024, 0, 1024, B.ox, 1024, 1024, 0, SEQ, 1024, 1.f, 0);
        if (p == 7) CMP(14, (bf16*)(ws + WS_XN) + r0 * 1024, 0, 1024, B.x2, 1024, 1024, 0, SEQ, 1024, 1.f, 0);
        if (p == 12) CMP(15, (float*)d_out + r0 * 1024, 2, 1024, B.outb, 1024, 1024, 0, SEQ, 1024, 1.f, 0);
#endif
    }
#if MK_DEBUG
    verdict_k<<<1, 64, 0, stream>>>(sums, tols, 16, code);
    poison_k<<<1024, 256, 0, stream>>>(code, w.x, (float*)d_out, (size_t)T * D);
#endif
#else
    PH(0, N_PHASES);
#endif
}
```

```cpp
#include <hip/hip_runtime.h>
#include <cstdio>
#include <cstdint>
#include <cstring>
#include <cmath>
#ifndef MK_TPROBE
#define MK_TPROBE 0
#endif
#define TP_LDS_OFF (131072 + 12288 + 256)
#if MK_TPROBE
#define TP_NOW(v) do { v = __builtin_amdgcn_s_memtime(); asm volatile("s_waitcnt lgkmcnt(0)" ::: "memory"); } while (0)
#define TP_ADD(ldsbase, wid, which, t0, t1) do { if (((volatile __attribute__((address_space(3))) unsigned*)((ldsbase) + TP_LDS_OFF))[63] != 0u && (pg8::tid_opaque() & 63) == 0) { \
        volatile __attribute__((address_space(3))) unsigned long long* p_ = (volatile __attribute__((address_space(3))) unsigned long long*)((ldsbase) + TP_LDS_OFF + 256) + (wid) * 4 + (which); *p_ = *p_ + ((t1) - (t0)); } } while (0)
#define TP_SET(ldsbase, on) do { if (pg8::tid_opaque() == 0) ((volatile __attribute__((address_space(3))) unsigned*)((ldsbase) + TP_LDS_OFF))[63] = (on); __syncthreads(); } while (0)
#define TPS_BEGIN() unsigned long long tps0_ = 0, tps1_ = 0; TP_NOW(tps0_)
#define TPS_END(F) do { TP_NOW(tps1_); if ((F).lane() == 0) { volatile __attribute__((address_space(3))) unsigned long long* q_ = (volatile __attribute__((address_space(3))) unsigned long long*)((F).lds + TP_LDS_OFF + 256) + (F).wave * 4 + 2; *q_ = *q_ + (tps1_ - tps0_); } } while (0)
#else
#define TPS_BEGIN() do {} while (0)
#define TPS_END(F) do {} while (0)
#define TP_NOW(v) do {} while (0)
#define TP_ADD(ldsbase, wid, which, t0, t1) do {} while (0)
#define TP_SET(ldsbase, on) do {} while (0)
#endif
namespace pg8 {
#define PG8_LAS __attribute__((address_space(3)))
typedef unsigned short bf16_t;
typedef short bf16x8 __attribute__((ext_vector_type(8)));
typedef float f32x4 __attribute__((ext_vector_type(4)));
typedef float f32x2 __attribute__((ext_vector_type(2)));
typedef unsigned u32x4 __attribute__((ext_vector_type(4)));
constexpr int BM = 256, BK = 64, HALF = 128, HTB = HALF * BK * 2, STAGE_BYTES = 8 * HTB, NXCD = 8, WGM = 8;

__host__ __device__ __forceinline__ int lds_byte(int r, int c) { const int st = (r >> 4) * 2 + (c >> 5), rr = r & 15, cc = c & 31, ob = rr * 64 + cc * 2; return st * 1024 + (ob ^ (((ob >> 9) & 1) << 5)); }
__host__ __device__ __forceinline__ void stage_rc(int b, int& R, int& C) { const int st = b / 1024, sb = b % 1024, swz = sb ^ (((sb >> 9) & 1) << 5); R = (st >> 1) * 16 + swz / 64; C = (st & 1) * 32 + (swz % 64) / 2; }
__host__ __device__ __forceinline__ int perm32(int rho) { const int n = rho >> 4, i = rho & 15; return 8 * (i >> 2) + 4 * n + (i & 3); }

struct Unit { int pm, pn; const char* a; const char* b0; const char* b1; const int* rows; const int* map0; const int* map1; int hi = 1, upad_ = 0; };

struct GridOrder {
    int nM, nN, nwg, G, c, wgm;
    __device__ void init(int nM_, int nN_, int G_, int c_, int wgm_ = WGM) { nM = nM_; nN = nN_; nwg = nM * nN; G = G_; c = c_; wgm = wgm_; }
    __device__ bool tile(int i, int& pm, int& pn) const {
        const long L = (long)i * G + c; if (L >= nwg) return false;
        int wgid = (int)L; { const int q = nwg / NXCD, r = nwg % NXCD, xcd = wgid % NXCD, off = wgid / NXCD; wgid = (xcd < r ? xcd * (q + 1) : r * (q + 1) + (xcd - r) * q) + off; }
        const int nig = wgm * nN, gid = wgid / nig, fm = gid * wgm, gsz = (nM - fm) < wgm ? (nM - fm) : wgm;
        pm = fm + ((wgid % nig) % gsz); pn = (wgid % nig) / gsz; return true;
    }
};

__device__ __forceinline__ int tid_opaque() { int t = (int)threadIdx.x; asm volatile("" : "+v"(t)); return t; }
__device__ __forceinline__ unsigned cvt_pk_bf16(float lo, float hi) { unsigned r; asm volatile("v_cvt_pk_bf16_f32 %0, %1, %2" : "=v"(r) : "v"(lo), "v"(hi)); return r; }
__device__ __forceinline__ float bf_lo(unsigned w) { return __uint_as_float(w << 16); }
__device__ __forceinline__ float bf_hi(unsigned w) { return __uint_as_float(w & 0xffff0000u); }

template <class E, class = void> struct skip_bj1 { static constexpr bool v = false; };
template <class E> struct skip_bj1<E, decltype((void)E::SKIP_BJ1)> { static constexpr bool v = E::SKIP_BJ1; };
template <class Epi, class Sched, bool ALIGN_EPI, int GATHER, int K, int lda, int ldb, int tsplit>
__device__ __forceinline__ void gemm_phase(PG8_LAS unsigned char* lds, const Sched S, const Epi E) {
    const int tid = tid_opaque(), wid = __builtin_amdgcn_readfirstlane(tid >> 6), lane = tid & 63, wr = wid >> 2, wc = wid & 3, fr = lane & 15, fq = lane >> 4;
    constexpr int nt = K / BK;
    unsigned voffA[2], voffB[2]; int RA[2], CA[2];
#pragma unroll
    for (int i = 0; i < 2; ++i) { int R, C; stage_rc(tid * 16 + i * 8192, R, C); const int Rb = (R & ~31) + perm32(R & 31);
        voffA[i] = (unsigned)(R * lda + C) * 2u; voffB[i] = (unsigned)(Rb * ldb + C) * 2u; RA[i] = R; CA[i] = C; }
    const size_t kstep = (size_t)(BK * 2);
    const size_t hstepA = (size_t)HALF * lda * 2, hstepB = (size_t)HALF * ldb * 2;
    const unsigned ldsw = (unsigned)wid * 1024u;
    const int aoff = lds_byte(wr * 64 + fr, fq * 8), boff = lds_byte(wc * 32 + fr, fq * 8);
#define PG8_SA(b, h) (((b) * 2 + (h)) * HTB)
#define PG8_SB(b, h) ((4 + (b) * 2 + (h)) * HTB)
#define PG8_STAGE(bufoff, gbase, voff) do { _Pragma("unroll") for (int _i = 0; _i < 2; ++_i) \
        __builtin_amdgcn_global_load_lds((const unsigned*)((const char*)(gbase) + (voff)[_i]), (PG8_LAS unsigned*)(lds + (bufoff) + ldsw + _i * 8192), 16, 0, 0); } while (0)
#define PG8_STAGE_A(bufoff, p, h, nx, sel) do { if constexpr (GATHER != 0) { unsigned _o[2]; \
            if constexpr (GATHER == 2) { _o[0] = (nx) ? nvA[h][0] : ((sel) ? cvB[h][0] : cvA[h][0]); _o[1] = (nx) ? nvA[h][1] : ((sel) ? cvB[h][1] : cvA[h][1]); } \
            else { _o[0] = (nx) ? nvA[h][0] : cvA[h][0]; _o[1] = (nx) ? nvA[h][1] : cvA[h][1]; } PG8_STAGE(bufoff, p, _o); } \
        else { PG8_STAGE(bufoff, (p) + (h) * hstepA, voffA); } } while (0)
#define PG8_LDA(dst, b, h) do { _Pragma("unroll") for (int m = 0; m < 4; ++m) _Pragma("unroll") for (int k = 0; k < 2; ++k) dst[m][k] = *(const PG8_LAS bf16x8*)(lds + PG8_SA(b, h) + aoff + m * 2048 + k * 1024); } while (0)
#define PG8_LDB(dst, b, h) do { _Pragma("unroll") for (int n = 0; n < 2; ++n) _Pragma("unroll") for (int k = 0; k < 2; ++k) dst[n][k] = *(const PG8_LAS bf16x8*)(lds + PG8_SB(b, h) + boff + n * 2048 + k * 1024); } while (0)
#define PG8_MMA(ai, bj, At, Bt) do { __builtin_amdgcn_s_setprio(1); _Pragma("unroll") for (int m = 0; m < 4; ++m) _Pragma("unroll") for (int n = 0; n < 2; ++n) _Pragma("unroll") for (int k = 0; k < 2; ++k) \
        acc[ai][bj][m][n] = __builtin_amdgcn_mfma_f32_16x16x32_bf16(Bt[n][k], At[m][k], acc[ai][bj][m][n], 0, 0, 0); __builtin_amdgcn_s_setprio(0); } while (0)
#define PG8_WAIT_V(n) asm volatile("s_waitcnt vmcnt(" #n ")" ::: "memory")
#define PG8_WAIT_L(n) asm volatile("s_waitcnt lgkmcnt(" #n ")" ::: "memory")
#define PG8_BAR __builtin_amdgcn_s_barrier()
#define PG8_SCHED __builtin_amdgcn_sched_barrier(0)
#define PG8_GOFF(dst, u, second) do { if constexpr (GATHER != 0) { _Pragma("unroll") for (int _h = 0; _h < 2; ++_h) _Pragma("unroll") for (int _i = 0; _i < 2; ++_i) { \
        int _r = (GATHER == 2 && (second)) ? (u).map1[_h * HALF + RA[_i]] : (u).rows[_h * HALF + RA[_i]]; _r = _r < 0 ? 0 : _r; dst[_h][_i] = (unsigned)(_r * lda + CA[_i]) * 2u; } } } while (0)
    Unit cur, nxt; int ui = 0;
    if (!S.next(0, cur)) return;
    unsigned long long tp_s_ = 0, tp_e_ = 0, tp_0_ = 0, tp_1_ = 0; (void)tp_s_; (void)tp_e_; (void)tp_0_; (void)tp_1_;
    TP_NOW(tp_s_);
    unsigned cvA[2][2] = {{0u, 0u}, {0u, 0u}}, nvA[2][2] = {{0u, 0u}, {0u, 0u}}, cvB[2][2] = {{0u, 0u}, {0u, 0u}};
    PG8_GOFF(cvA, cur, false); PG8_GOFF(cvB, cur, true);
    f32x4 acc[2][2][4][2];
#pragma unroll
    for (int a = 0; a < 2; ++a)
#pragma unroll
        for (int b = 0; b < 2; ++b)
#pragma unroll
            for (int m = 0; m < 4; ++m)
#pragma unroll
                for (int n = 0; n < 2; ++n) acc[a][b][m][n] = (f32x4){0.f, 0.f, 0.f, 0.f};
    bf16x8 At[4][2], B0[2][2], B1[2][2];
    const char* cA = cur.a; const char* cB = cur.b0; const char* cB1 = cur.b1;
    E.prep(cur, 0);
    PG8_STAGE(PG8_SB(0, 0), cB, voffB); PG8_STAGE(PG8_SB(0, 1), cB + hstepB, voffB); PG8_STAGE_A(PG8_SA(0, 0), cA, 0, false, false); PG8_STAGE_A(PG8_SA(0, 1), cA, 1, false, false);
    if (wr == 1) PG8_BAR;
    PG8_WAIT_V(2); PG8_BAR;
    PG8_STAGE(PG8_SB(1, 0), cB + kstep, voffB); PG8_STAGE_A(PG8_SA(1, 0), cA + kstep, 0, false, false); PG8_STAGE(PG8_SB(1, 1), cB + hstepB + kstep, voffB);
    PG8_WAIT_V(6); PG8_BAR;
    for (;;) {
        const bool has_next = S.next(ui + 1, nxt);
        const char* nA = has_next ? nxt.a : cA; const char* nB = has_next ? nxt.b0 : cB;
#pragma nounroll
        for (int t = 0; t < nt; t += 2) {
            const bool last = (t == nt - 2);
            const bool lnx = last && has_next;
            const bool hi_ok = (GATHER != 2) || (cur.hi != 0);
            const bool s1 = (GATHER == 2) && (t + 1 >= tsplit), s2 = (GATHER == 2) && !last && (t + 2 >= tsplit);
            const char* a1 = cA + (size_t)(t + 1 - (s1 ? tsplit : 0)) * kstep;
            const char* a2 = last ? nA : cA + (size_t)(t + 2 - (s2 ? tsplit : 0)) * kstep;
            const char* b2 = last ? nB : ((t + 2) < tsplit ? cB + (size_t)(t + 2) * kstep : cB1 + (size_t)(t + 2 - tsplit) * kstep);
            const char* a3 = a2 + kstep; const char* b3 = b2 + kstep;
            if (t == 0 && has_next) { PG8_GOFF(nvA, nxt, false); }
            PG8_LDB(B0, 0, 0); PG8_LDB(B1, 0, 1); PG8_SCHED; PG8_LDA(At, 0, 0); PG8_STAGE_A(PG8_SA(1, 1), a1, 1, false, s1);
            PG8_WAIT_V(8); PG8_WAIT_L(0); PG8_BAR; PG8_MMA(0, 0, At, B0); if constexpr (!skip_bj1<Epi>::v) PG8_MMA(0, 1, At, B1); PG8_BAR; PG8_SCHED;
            PG8_LDA(At, 0, 1); PG8_STAGE(PG8_SB(0, 0), b2, voffB); PG8_STAGE(PG8_SB(0, 1), b2 + hstepB, voffB); PG8_STAGE_A(PG8_SA(0, 0), a2, 0, lnx, s2);
            PG8_WAIT_V(8); PG8_WAIT_L(0); PG8_BAR; if (hi_ok) { PG8_MMA(1, 0, At, B0); if constexpr (!skip_bj1<Epi>::v) PG8_MMA(1, 1, At, B1); } PG8_BAR; PG8_SCHED;
            PG8_LDB(B0, 1, 0); PG8_LDB(B1, 1, 1); PG8_SCHED; PG8_LDA(At, 1, 0); PG8_STAGE_A(PG8_SA(0, 1), a2, 1, lnx, s2);
            PG8_WAIT_V(8); PG8_WAIT_L(0); PG8_BAR; PG8_MMA(0, 0, At, B0); if constexpr (!skip_bj1<Epi>::v) PG8_MMA(0, 1, At, B1); PG8_BAR; PG8_SCHED;
            PG8_LDA(At, 1, 1); PG8_STAGE(PG8_SB(1, 0), b3, voffB); PG8_STAGE(PG8_SB(1, 1), b3 + hstepB, voffB); PG8_STAGE_A(PG8_SA(1, 0), a3, 0, lnx, s2);
            PG8_WAIT_V(8); PG8_WAIT_L(0); PG8_BAR; if (hi_ok) { PG8_MMA(1, 0, At, B0); if constexpr (!skip_bj1<Epi>::v) PG8_MMA(1, 1, At, B1); } PG8_BAR; PG8_SCHED;
        }
        if constexpr (ALIGN_EPI) { if (wr == 0) PG8_BAR; }
        if constexpr (Epi::PREP_EARLY) { if (has_next) E.prep(nxt, (ui + 1) & 1); }
        TP_NOW(tp_0_);
        E(acc, cur, ui & 1, wr, wc, fr, fq, wid, lane);
        TP_NOW(tp_1_); TP_ADD(lds, wid, 0, tp_0_, tp_1_);
        if (!has_next) break;
        if constexpr (!Epi::PREP_EARLY) E.prep(nxt, (ui + 1) & 1);
#pragma unroll
        for (int a = 0; a < 2; ++a)
#pragma unroll
            for (int b = 0; b < 2; ++b)
#pragma unroll
                for (int m = 0; m < 4; ++m)
#pragma unroll
                    for (int n = 0; n < 2; ++n) acc[a][b][m][n] = (f32x4){0.f, 0.f, 0.f, 0.f};
        cur = nxt; cA = nA; cB = nB; cB1 = nxt.b1; ++ui;
        if constexpr (GATHER != 0) {
#pragma unroll
            for (int h = 0; h < 2; ++h) { cvA[h][0] = nvA[h][0]; cvA[h][1] = nvA[h][1]; }
            PG8_GOFF(cvB, cur, true);
        }
        if constexpr (ALIGN_EPI) { if (wr == 1) PG8_BAR; }
    }
    PG8_WAIT_V(0);
    if constexpr (!ALIGN_EPI) { if (wr == 0) PG8_BAR; }
    PG8_BAR;
    TP_NOW(tp_e_); TP_ADD(lds, wid, 1, tp_s_, tp_e_);
#undef PG8_SA
#undef PG8_SB
#undef PG8_STAGE
#undef PG8_STAGE_A
#undef PG8_LDA
#undef PG8_LDB
#undef PG8_MMA
#undef PG8_WAIT_V
#undef PG8_WAIT_L
#undef PG8_BAR
#undef PG8_SCHED
#undef PG8_GOFF
}
}
constexpr int NWAVES = 8;
constexpr int BATCH = 16, SEQ = 4096, D = 1024, T = BATCH * SEQ, MEML = 256;
constexpr float EPS = 1e-6f;
constexpr float LOG2E = 1.4426950408889634f;
constexpr size_t MiB = 1u << 20;
constexpr size_t WS_CTL = 0, CTL_ZERO_BYTES = 1 * MiB;
constexpr size_t WS_COS = 1 * MiB, WS_SIN = 5 * MiB;
constexpr size_t WS_SS0 = 9 * MiB;
constexpr size_t WS_SSP1 = 10 * MiB, WS_SSP2 = 14 * MiB;
constexpr size_t WS_MISC = 18 * MiB;
constexpr size_t WS_W = 20 * MiB;
constexpr size_t W_IN = WS_W, W_Q = W_IN + 6 * MiB, W_KV = W_Q + 512 * 1024, W_OUT = W_KV + 512 * 1024, W_XQ = W_OUT + 2 * MiB, W_XKV = W_XQ + 2 * MiB, W_XO = W_XKV + 4 * MiB, W_R = W_XO + 2 * MiB;
constexpr size_t WS_MN = 40 * MiB, WS_KVX = 48 * MiB;
constexpr size_t WS_XN = 64 * MiB;
#if defined(MK_DEBUG) && MK_DEBUG
constexpr size_t WS_OF = 64 * MiB, WS_OB = 128 * MiB;
constexpr bool XN0_KEPT = false;
#else
constexpr size_t WS_OF = 832 * MiB, WS_OB = 896 * MiB;
constexpr bool XN0_KEPT = true;
#endif
constexpr size_t WS_HQ = 192 * MiB, WS_GF = 256 * MiB, WS_GB = 320 * MiB, WS_HI = 384 * MiB, WS_HG = 448 * MiB, WS_LAT = 512 * MiB;
constexpr size_t WS_CAT = 192 * MiB;
constexpr size_t WS_QX = 320 * MiB;
constexpr size_t WS_Q = 576 * MiB, WS_K = 672 * MiB, WS_V = 768 * MiB;
#if MK_DEBUG
constexpr size_t WS_WGU = 576 * MiB, WS_WD = 640 * MiB;
#else
constexpr size_t WS_WGU = 960 * MiB, WS_WD = 640 * MiB;
#endif
constexpr size_t WS_H = 672 * MiB;
constexpr size_t WS_LG = 792 * MiB;
constexpr size_t WS_REC = 810 * MiB;
constexpr size_t WS_END = 832 * MiB, WS_END_REL = 1024 * MiB;
constexpr int MOE_MAXROWS = 122880, MOE_MAXTILES = 480;
constexpr int CW_CNTP = 32768;
constexpr int CW_TMO = 0, CW_BAR = 4096, CW_CNT = 16384  , CW_CNTE = 16896  , CW_NT = 17000  , CW_NTE = 17064  , CW_CHK = 20000  ;
constexpr size_t REC_ROWPA = 7 * MiB, REC_ROWPB = 8 * MiB, REC_ROWP = 3 * MiB, REC_TILEP = 3 * MiB + 512 * 1024, REC_ROWE = 4 * MiB, REC_WSLOT = 5 * MiB, REC_TILEE = 6 * MiB;
constexpr int MOE_MAXROWSE = 147456;

constexpr int RING_OFF = 0, RING_BYTES = 131072;
constexpr int AUX_OFF = RING_BYTES;
constexpr int AUX_RS = AUX_OFF, AUX_WG = AUX_OFF + 2048, AUX_TOK = AUX_OFF + 4096, AUX_XP = AUX_OFF + 6144, AUX_WSF = AUX_OFF + 10240;
constexpr int MISC_OFF = AUX_OFF + 12288;
constexpr int LDS_BYTES = 147456;

#define GAS __attribute__((address_space(1)))
#define LAS __attribute__((address_space(3)))
typedef unsigned short bf16;
typedef unsigned v4u __attribute__((ext_vector_type(4)));
typedef unsigned v2u __attribute__((ext_vector_type(2)));
typedef float f32x4 __attribute__((ext_vector_type(4)));
typedef float f32x16 __attribute__((ext_vector_type(16)));
typedef short bf16x8 __attribute__((ext_vector_type(8)));
typedef short s16x4 __attribute__((ext_vector_type(4)));
typedef GAS unsigned gu32;
#define RLX_AGENT __ATOMIC_RELAXED, __HIP_MEMORY_SCOPE_AGENT
#define LDS_WAIT() asm volatile("s_waitcnt lgkmcnt(0)" ::: "memory")
#define VM_WAIT() asm volatile("s_waitcnt vmcnt(0)" ::: "memory")
__device__ __forceinline__ unsigned f2bf(float f) { unsigned u = __builtin_bit_cast(unsigned, f); return (u + 0x7fffu + ((u >> 16) & 1u)) >> 16; }
__device__ __forceinline__ unsigned pk2(float lo, float hi) { return pg8::cvt_pk_bf16(lo, hi); }
__device__ __forceinline__ float bf2f(bf16 h) { return __uint_as_float((unsigned)h << 16); }
__device__ __forceinline__ float fast_rcp(float x) { return __builtin_amdgcn_rcpf(x); }
__device__ __forceinline__ float fast_exp2(float x) { return __builtin_amdgcn_exp2f(x); }
__device__ __forceinline__ float silu_f(float v) { return v * fast_rcp(1.0f + fast_exp2(-LOG2E * v)); }
__device__ __forceinline__ float rsq(float x) { return __builtin_amdgcn_rsqf(x); }
typedef _Float16 h16x2 __attribute__((ext_vector_type(2)));
__device__ __forceinline__ unsigned pkh2(float lo, float hi) { h16x2 h; h.x = (_Float16)lo; h.y = (_Float16)hi; return __builtin_bit_cast(unsigned, h); }
__device__ __forceinline__ float h2f(unsigned short h) { return (float)__builtin_bit_cast(_Float16, h); }

#define XB_TMO      128
#define XB_XCNT(j)  (256  + 64 * (j))
#define XB_XSUB(j)  (1280 + 64 * (j))
#define XB_XGEN(j)  (2304 + 64 * (j))
#define XB_TOP      3328
#define XB_TOPGEN   3392
#define XCD_BAR_WORDS 3456
#define XB_SPIN_CAP (1u << 18)
__device__ __forceinline__ unsigned xb_ld(unsigned* p)              { return __hip_atomic_load(p, __ATOMIC_RELAXED, __HIP_MEMORY_SCOPE_AGENT); }
__device__ __forceinline__ unsigned xb_add(unsigned* p, unsigned v) { return __hip_atomic_fetch_add(p, v, __ATOMIC_RELAXED, __HIP_MEMORY_SCOPE_AGENT); }
__device__ __forceinline__ unsigned xb_xcc_id() { return (unsigned)__builtin_amdgcn_s_getreg((3 << 11) | 20) & 0xFu; }
#define XB_SPIN(cond, bar) do { unsigned _sp = 0; while (cond) { __builtin_amdgcn_s_sleep(1); \
    if ((++_sp & 255u) == 0u) { if (xb_ld(&(bar)[XB_TMO])) break; if (_sp > XB_SPIN_CAP) { atomicAdd(&(bar)[XB_TMO], 1u); break; } } } } while (0)
struct XcdBarrier { unsigned* bar; unsigned x; volatile LAS unsigned* st; };
__device__ __forceinline__ XcdBarrier xcd_barrier_post(unsigned* bar, volatile LAS unsigned* st) {
    XcdBarrier b; b.bar = bar; b.x = xb_xcc_id(); b.st = st;
    if (threadIdx.x == 0) (void)xb_add(&bar[XB_XCNT(b.x)], 1u);
    return b;
}
__device__ __forceinline__ void xcd_barrier_complete(unsigned* bar, unsigned x, unsigned& nloc, unsigned& nx) {
    const unsigned G = gridDim.x * gridDim.y * gridDim.z;
    unsigned sum, cnt, mine, sp = 0u;
    for (;;) {
        sum = 0u; cnt = 0u; mine = 0u;
#pragma unroll
        for (unsigned j = 0; j < 16; ++j) { const unsigned c = xb_ld(&bar[XB_XCNT(j)]); sum += c; cnt += (c > 0u) ? 1u : 0u; mine = (j == x) ? c : mine; }
        if (sum == G) break;
        __builtin_amdgcn_s_sleep(1);
        if ((++sp & 255u) == 0u) { if (xb_ld(&bar[XB_TMO])) break; if (sp > XB_SPIN_CAP) { atomicAdd(&bar[XB_TMO], 1u); break; } }
    }
    nloc = mine > 0u ? mine : 1u; nx = cnt > 0u ? cnt : 1u;
}
__device__ __forceinline__ void xcd_barrier(const XcdBarrier& b) {
    asm volatile("s_waitcnt vmcnt(0)" ::: "memory");
    __syncthreads();
    if (threadIdx.x == 0) {
        unsigned* bar = b.bar;
        __builtin_amdgcn_s_waitcnt(0);
        unsigned nloc = b.st[0], nx = b.st[1];
        if (nloc == 0u) { xcd_barrier_complete(bar, b.x, nloc, nx); b.st[0] = nloc; b.st[1] = nx; }
        const unsigned old = xb_add(&bar[XB_XSUB(b.x)], 1u);
        const unsigned gen = old / nloc;
        if (old + 1u == (gen + 1u) * nloc) {
            __builtin_amdgcn_fence(__ATOMIC_RELEASE, "agent");
            asm volatile("s_waitcnt vmcnt(0)" ::: "memory");
            const unsigned og = xb_add(&bar[XB_TOP], 1u);
            const unsigned tg = og / nx;
            if (og + 1u == (tg + 1u) * nx) xb_add(&bar[XB_TOPGEN], 1u);
            else XB_SPIN(xb_ld(&bar[XB_TOPGEN]) == tg, bar);
            __builtin_amdgcn_fence(__ATOMIC_ACQUIRE, "agent");
            xb_add(&bar[XB_XGEN(b.x)], 1u);
            asm volatile("s_waitcnt vmcnt(0)" ::: "memory");
        } else {
            XB_SPIN(xb_ld(&bar[XB_XGEN(b.x)]) == gen, bar);
            __builtin_amdgcn_fence(__ATOMIC_ACQUIRE, "agent");
            asm volatile("s_waitcnt vmcnt(0)" ::: "memory");
        }
    }
    __syncthreads();
}

__device__ __forceinline__ void xcd_barrier_arrive(const XcdBarrier& b) {
    asm volatile("s_waitcnt vmcnt(0)" ::: "memory");
    __syncthreads();
    if (threadIdx.x == 0) {
        unsigned* bar = b.bar;
        __builtin_amdgcn_s_waitcnt(0);
        unsigned nloc = b.st[0], nx = b.st[1];
        if (nloc == 0u) { xcd_barrier_complete(bar, b.x, nloc, nx); b.st[0] = nloc; b.st[1] = nx; }
        const unsigned old = xb_add(&bar[XB_XSUB(b.x)], 1u);
        const unsigned gen = old / nloc;
        unsigned role = 0u, tg = 0u;
        if (old + 1u == (gen + 1u) * nloc) {
            __builtin_amdgcn_fence(__ATOMIC_RELEASE, "agent");
            asm volatile("s_waitcnt vmcnt(0)" ::: "memory");
            const unsigned og = xb_add(&bar[XB_TOP], 1u);
            tg = og / nx; role = 1u;
            if (og + 1u == (tg + 1u) * nx) { xb_add(&bar[XB_TOPGEN], 1u); role = 2u; }
        }
        b.st[2] = role; b.st[3] = gen; b.st[4] = tg;
    }
}
__device__ __forceinline__ void xcd_barrier_wait(const XcdBarrier& b) {
    asm volatile("s_waitcnt vmcnt(0)" ::: "memory");
    __syncthreads();
    if (threadIdx.x == 0) {
        unsigned* bar = b.bar;
        const unsigned role = b.st[2], gen = b.st[3], tg = b.st[4];
        if (role != 0u) {
            if (role == 1u) XB_SPIN(xb_ld(&bar[XB_TOPGEN]) == tg, bar);
            __builtin_amdgcn_fence(__ATOMIC_ACQUIRE, "agent");
            xb_add(&bar[XB_XGEN(b.x)], 1u);
            asm volatile("s_waitcnt vmcnt(0)" ::: "memory");
        } else {
            XB_SPIN(xb_ld(&bar[XB_XGEN(b.x)]) == gen, bar);
            __builtin_amdgcn_fence(__ATOMIC_ACQUIRE, "agent");
            asm volatile("s_waitcnt vmcnt(0)" ::: "memory");
        }
    }
    __syncthreads();
}

struct Inputs {
    const float *x, *mem; const int* pos; const float *norm_mix, *w_in, *q_a_norm, *w_q_up, *kv_a_norm, *w_kv_up, *q_norm, *k_norm, *lb_logits, *o_norm, *w_out, *norm_cross, *norm_mem,
        *x_w_q, *x_w_kv, *x_q_norm, *x_k_norm, *x_w_o, *norm_ffn, *w_group, *b_group, *w_expert, *b_expert, *w_gate, *w_up, *w_down;
};
struct Frame {
    LAS unsigned char* lds;
    volatile LAS unsigned* MISC;
    gu32* ctl;
    unsigned char* ws;
    int wave, vcu, G;
    __device__ __forceinline__ int tid() const { return pg8::tid_opaque(); }
    __device__ __forceinline__ int lane() const { return pg8::tid_opaque() & 63; }
};
__device__ __forceinline__ float wave_sum(float v) {
#pragma unroll
    for (int o = 1; o < 64; o <<= 1) v += __shfl_xor(v, o);
    return v;
}
struct TItem { const float* W; const float* gain; bf16* WT; int ldw, k0, n0, ldt, row0; };
struct TRegs { float wv[32]; f32x4 g0, g1; };
__device__ __forceinline__ void ti_load(const TItem& t, TRegs& r, int lane) {
#pragma unroll
    for (int i = 0; i < 32; ++i) r.wv[i] = t.W[(size_t)(t.k0 + 2 * i + (lane >> 5)) * t.ldw + t.n0 + (lane & 31)];
    if (t.gain) { r.g0 = *(const f32x4*)(t.gain + t.k0 + 8 * (lane & 7)); r.g1 = *(const f32x4*)(t.gain + t.k0 + 8 * (lane & 7) + 4); } else { r.g0 = (f32x4){1.f, 1.f, 1.f, 1.f}; r.g1 = r.g0; }
}
__device__ __forceinline__ void ti_finish(const TItem& t, const TRegs& r, LAS float* scr, int lane) {
#pragma unroll
    for (int i = 0; i < 32; ++i) scr[(2 * i + (lane >> 5)) * 33 + (lane & 31)] = r.wv[i];
    LDS_WAIT(); asm volatile("" ::: "memory");
    const int c = lane & 7;
#pragma unroll
    for (int j = 0; j < 4; ++j) { const int n = (lane >> 3) + 8 * j; const LAS float* s = scr + (8 * c) * 33 + n;
        v4u o; o.x = pk2(s[0 * 33] * r.g0[0], s[1 * 33] * r.g0[1]); o.y = pk2(s[2 * 33] * r.g0[2], s[3 * 33] * r.g0[3]); o.z = pk2(s[4 * 33] * r.g1[0], s[5 * 33] * r.g1[1]); o.w = pk2(s[6 * 33] * r.g1[2], s[7 * 33] * r.g1[3]);
        *(GAS v4u*)(t.WT + (size_t)(t.row0 + n) * t.ldt + t.k0 + 8 * c) = o; }
    LDS_WAIT(); asm volatile("" ::: "memory");
}
struct TJob { const float* W; int K, N, ldw; const float* gain; bf16* WT; int ldt; int mode; };
__device__ __forceinline__ int tjob_row(int mode, int n0) {
    if (mode == 1) return n0 >= 352 ? n0 - 352 : n0 + 2560;
    if (mode == 2) return (n0 >> 7) * 256 + (n0 & 127);
    if (mode == 3) return (n0 >> 7) * 256 + 128 + (n0 & 127);
    return n0;
}
__device__ __forceinline__ void tjob_run(const TJob& j, LAS float* scr, int gw, int NGW, int lane) {
    const int nblk = j.N / 32, nit = (j.K / 64) * nblk;
    auto item = [&](int it) { TItem t; t.W = j.W; t.gain = j.gain; t.WT = j.WT; t.ldw = j.ldw; t.k0 = (it / nblk) * 64; t.n0 = (it % nblk) * 32; t.ldt = j.ldt; t.row0 = tjob_row(j.mode, t.n0); return t; };
    if (gw >= nit) return;
    TItem cur = item(gw); TRegs rc; ti_load(cur, rc, lane);
    for (int it = gw; it < nit; it += NGW) {
        const bool more = it + NGW < nit; TItem nx = cur; TRegs rn = rc;
        if (more) { nx = item(it + NGW); ti_load(nx, rn, lane); }
        ti_finish(cur, rc, scr, lane);
        cur = nx; rc = rn;
    }
}
__device__ __forceinline__ void p0_prologue(Frame& F, const Inputs& in) {
    LAS float* scr = (LAS float*)(F.lds + RING_OFF + F.wave * 16384);
    const int gw = F.vcu * NWAVES + F.wave, NGW = F.G * NWAVES, lane = F.lane();
    unsigned char* ws = F.ws;
    { TJob j{in.w_in, 1024, 2912, 2912, in.norm_mix, (bf16*)(ws + W_IN), 1024, 1}; tjob_run(j, scr, gw, NGW, lane); }
    { TJob j{in.w_q_up, 192, 768, 768, in.q_a_norm, (bf16*)(ws + W_Q), 192, 0}; tjob_run(j, scr, gw, NGW, lane); }
    { TJob j{in.w_kv_up, 128, 1024, 1024, in.kv_a_norm, (bf16*)(ws + W_KV), 128, 0}; tjob_run(j, scr, gw, NGW, lane); }
    { TJob j{in.w_out, 1024, 1024, 1024, nullptr, (bf16*)(ws + W_OUT), 1024, 0}; tjob_run(j, scr, gw, NGW, lane); }
    { TJob j{in.x_w_q, 1024, 1024, 1024, in.norm_cross, (bf16*)(ws + W_XQ), 1024, 0}; tjob_run(j, scr, gw, NGW, lane); }
    { TJob j{in.x_w_kv, 1024, 2048, 2048, nullptr, (bf16*)(ws + W_XKV), 1024, 0}; tjob_run(j, scr, gw, NGW, lane); }
    { TJob j{in.x_w_o, 1024, 1024, 1024, nullptr, (bf16*)(ws + W_XO), 1024, 0}; tjob_run(j, scr, gw, NGW, lane); }
    const int gt = (F.vcu * NWAVES + F.wave) * 64 + lane, NGT = NGW * 64;
    for (int i = gt; i < 160 * 1024 / 8; i += NGT) *(GAS v4u*)((bf16*)(ws + W_IN) + (size_t)2912 * 1024 + (size_t)i * 8) = (v4u){0u, 0u, 0u, 0u};
    for (int i = gt; i < 256 * 1024; i += NGT) { const int c = i >> 10, k = i & 1023; float v = 0.f;
        if (c < 8) v = in.w_group[k * 8 + c] * in.norm_ffn[k]; else if (c < 72) v = in.w_expert[k * 64 + (c - 8)] * in.norm_ffn[k];
        ((bf16*)(ws + W_R))[i] = (bf16)f2bf(v); }
    for (int i = gt; i < T * 16; i += NGT) { const int t = i >> 4, j = i & 15;
        const float inv_freq = 1.0f / powf(10000.0f, (float)j / 16.0f); const float ang = (float)in.pos[t] * inv_freq;
        const double rev = (double)ang * 0.15915494309189535; const float fr = (float)(rev - floor(rev));
        ((float*)(ws + WS_COS))[i] = __builtin_amdgcn_cosf(fr); ((float*)(ws + WS_SIN))[i] = __builtin_amdgcn_sinf(fr); }
    float* misc = (float*)(ws + WS_MISC);
    for (int i = gt; i < 1024; i += NGT) { const float l0 = in.lb_logits[i], l1 = in.lb_logits[1024 + i]; misc[i] = 1.0f / (1.0f + expf(l1 - l0)); }
    if (gw == 0) {
        float mq = 0.f, mk = 0.f, xq = 0.f, xk = 0.f;
        for (int i = lane; i < 96; i += 64) { mq = fmaxf(mq, fabsf(in.q_norm[i])); mk = fmaxf(mk, fabsf(in.k_norm[i])); }
        for (int i = lane; i < 256; i += 64) { xq = fmaxf(xq, fabsf(in.x_q_norm[i])); xk = fmaxf(xk, fabsf(in.x_k_norm[i])); }
#pragma unroll
        for (int o = 1; o < 64; o <<= 1) { mq = fmaxf(mq, __shfl_xor(mq, o)); mk = fmaxf(mk, __shfl_xor(mk, o)); xq = fmaxf(xq, __shfl_xor(xq, o)); xk = fmaxf(xk, __shfl_xor(xk, o)); }
        if (lane == 0) { misc[1024] = LOG2E * 9.797958971132712f * mq * mk; misc[1025] = LOG2E * 16.0f * xq * xk; }
    }
    for (int m = gw; m < T; m += 4 * NGW) {
        f32x4 v[4][4];
#pragma unroll
        for (int q = 0; q < 4; ++q) { const int mq = m + q * NGW; const GAS f32x4* xr = (const GAS f32x4*)(in.x + (size_t)(mq < T ? mq : m) * D) + lane;
#pragma unroll
            for (int j = 0; j < 4; ++j) v[q][j] = xr[64 * j]; }
#pragma unroll
        for (int q = 0; q < 4; ++q) { const int mq = m + q * NGW; float s = 0.f;
#pragma unroll
            for (int j = 0; j < 4; ++j) s += (v[q][j].x * v[q][j].x + v[q][j].y * v[q][j].y) + (v[q][j].z * v[q][j].z + v[q][j].w * v[q][j].w);
            s = wave_sum(s);
            if (mq < T) { GAS unsigned long long* o8 = (GAS unsigned long long*)((bf16*)(ws + WS_XN) + (size_t)mq * D) + lane;
#pragma unroll
                for (int j = 0; j < 4; ++j) o8[64 * j] = (unsigned long long)pk2(v[q][j].x, v[q][j].y) | ((unsigned long long)pk2(v[q][j].z, v[q][j].w) << 32);
                if (lane == 0) ((float*)(ws + WS_SS0))[mq] = s; } }
    }
    for (int m = gw; m < BATCH * MEML; m += NGW) {
        const GAS f32x4* xr = (const GAS f32x4*)(in.mem + (size_t)m * D) + lane; f32x4 v[4]; float s = 0.f;
#pragma unroll
        for (int j = 0; j < 4; ++j) { v[j] = xr[64 * j]; s += (v[j].x * v[j].x + v[j].y * v[j].y) + (v[j].z * v[j].z + v[j].w * v[j].w); }
        const float r = 1.0f / sqrtf(wave_sum(s) * (1.f / D) + EPS);
        GAS unsigned long long* o8 = (GAS unsigned long long*)((bf16*)(ws + WS_MN) + (size_t)m * D) + lane;
#pragma unroll
        for (int j = 0; j < 4; ++j) { const f32x4 g = *((const GAS f32x4*)in.norm_mem + lane + 64 * j);
            o8[64 * j] = (unsigned long long)pk2(v[j].x * r * g.x, v[j].y * r * g.y) | ((unsigned long long)pk2(v[j].z * r * g.z, v[j].w * r * g.w) << 32); }
    }
}
__device__ __forceinline__ void moe_weights(Frame& F, const Inputs& in, const int ibase, const int icount, const int r0, const int r1) {
    LAS float* scr = (LAS float*)(F.lds + RING_OFF + F.wave * 16384);
    const int gw = F.vcu * NWAVES + F.wave, NGW = F.G * NWAVES, lane = F.lane();
    auto item = [&](int it) { TItem t; const bool gu_ = it < 16384; const int i2_ = gu_ ? it : it - 16384; const int e = gu_ ? (i2_ >> 8) : (i2_ >> 7), kind = gu_ ? ((i2_ >> 7) & 1) : 2, q = i2_ & 127;
        if (kind == 0) { t.W = in.w_gate + (size_t)e * 262144; t.gain = in.norm_ffn; t.WT = (bf16*)(F.ws + WS_WGU) + (size_t)e * 524288; t.ldw = 256; t.k0 = (q >> 3) * 64; t.n0 = (q & 7) * 32; t.ldt = 1024; t.row0 = tjob_row(2, t.n0); }
        else if (kind == 1) { t.W = in.w_up + (size_t)e * 262144; t.gain = in.norm_ffn; t.WT = (bf16*)(F.ws + WS_WGU) + (size_t)e * 524288; t.ldw = 256; t.k0 = (q >> 3) * 64; t.n0 = (q & 7) * 32; t.ldt = 1024; t.row0 = tjob_row(3, t.n0); }
        else { t.W = in.w_down + (size_t)e * 262144; t.gain = nullptr; t.WT = (bf16*)(F.ws + WS_WD) + (size_t)e * 262144; t.ldw = 1024; t.k0 = (q >> 5) * 64; t.n0 = (q & 31) * 32; t.ldt = 256; t.row0 = t.n0; }
        return t; };
    const int nit = ibase + icount;
    const int it0 = ibase + gw + r0 * NGW; const long long itend_ = (long long)ibase + gw + (long long)r1 * NGW; const int it1 = itend_ < nit ? (int)itend_ : nit;
    if (it0 >= it1) return;
    TItem cur = item(it0); TRegs rc; ti_load(cur, rc, lane);
    for (int it = it0; it < it1; it += NGW) {
        const bool more = it + NGW < it1; TItem nx = cur; TRegs rn = rc;
        if (more) { nx = item(it + NGW); ti_load(nx, rn, lane); }
        ti_finish(cur, rc, scr, lane);
        cur = nx; rc = rn;
    }
}

using pg8::Unit; using pg8::bf16_t;
struct SchedGrid {
    const char* A; const char* B; size_t astep, bstep; pg8::GridOrder o; int pad_; int pad2_;
    __device__ __forceinline__ bool next(int i, Unit& u) const { int pm, pn; if (!o.tile(i, pm, pn)) return false; u.pm = pm; u.pn = pn; u.a = A + (size_t)pm * astep; u.b0 = u.b1 = B + (size_t)pn * bstep; u.rows = nullptr; u.map0 = nullptr; u.map1 = nullptr; return true; }
};
struct SchedPanel {
    const char* A; const char* B; size_t astep, bstep; int pm, nN;
    __device__ __forceinline__ bool next(int i, Unit& u) const { if (i >= nN) return false; int p_ = pm; asm volatile("" : "+s"(p_)); u.pm = p_; u.pn = i;     u.a = A + (size_t)p_ * astep; u.b0 = u.b1 = B + (size_t)i * bstep; u.rows = nullptr; u.map0 = nullptr; u.map1 = nullptr; return true; }
};
__device__ __forceinline__ float rstd16(const float* p) {
    const f32x4 a = *(const f32x4*)p, b = *(const f32x4*)(p + 4), c = *(const f32x4*)(p + 8), d = *(const f32x4*)(p + 12);
    const float s = ((a.x + a.y) + (a.z + a.w)) + ((b.x + b.y) + (b.z + b.w)) + ((c.x + c.y) + (c.z + c.w)) + ((d.x + d.y) + (d.z + d.w));
    return rsq(s * (1.f / D) + EPS);
}
typedef pg8::f32x4 (AccT)[2][2][4][2];

struct EpiIn {
    static constexpr bool PREP_EARLY = true;
    bf16_t* bufs; const float* ss; const float* lbt; LAS float* RS; int cheap;
    __device__ __forceinline__ void prep(const Unit& u, int par) const { const int t = pg8::tid_opaque(); if (t < 256) RS[par * 256 + t] = rsq(ss[u.pm * 256 + t] * (1.f / D) + EPS); }
    __device__ __forceinline__ void operator()(const AccT& acc, const Unit& u, int par, int wr, int wc, int fr, int fq, int wid, int lane) const {
        const int grp = u.pn >> 1, colg = (u.pn & 1) * 256 + wc * 32 + 8 * fq;
        bf16_t* base = bufs + (size_t)grp * ((size_t)T * 512);
#ifdef MK_PROBE_P1CHEAP
        const int mode = cheap ? 0 : ((grp == 0 || grp == 4) ? 1 : ((grp == 1 || grp == 2) ? 2 : 0));
#else
        const int mode = (grp == 0 || grp == 4) ? 1 : ((grp == 1 || grp == 2) ? 2 : 0);
#endif
        f32x4 lb[2][2];
#pragma unroll
        for (int bj = 0; bj < 2; ++bj)
#pragma unroll
            for (int n = 0; n < 2; ++n) lb[bj][n] = (mode == 2) ? *(const f32x4*)(lbt + (grp - 1) * 512 + colg + bj * 128 + 4 * n) : (f32x4){0.f, 0.f, 0.f, 0.f};
#pragma unroll
        for (int ai = 0; ai < 2; ++ai)
#pragma unroll
            for (int m = 0; m < 4; ++m) { const int rl = ai * 128 + wr * 64 + m * 16 + fr; const float rs = RS[par * 256 + rl]; bf16_t* rowp = base + (size_t)(u.pm * 256 + rl) * 512 + colg;
#pragma unroll
                for (int bj = 0; bj < 2; ++bj) { f32x4 v[2]; v[0] = acc[ai][bj][m][0] * rs; v[1] = acc[ai][bj][m][1] * rs; v4u w;
                    if (mode == 2) {
#pragma unroll
                        for (int n = 0; n < 2; ++n)
#pragma unroll
                            for (int e = 0; e < 4; ++e) { const float sg = fast_rcp(1.0f + fast_exp2(-LOG2E * v[n][e])); const float l = lb[bj][n][e]; v[n][e] = __builtin_amdgcn_logf(l + (1.0f - l) * sg); }
                        w.x = pkh2(v[0][0], v[0][1]); w.y = pkh2(v[0][2], v[0][3]); w.z = pkh2(v[1][0], v[1][1]); w.w = pkh2(v[1][2], v[1][3]);
                    } else {
                        if (mode == 1) {
#pragma unroll
                            for (int n = 0; n < 2; ++n)
#pragma unroll
                                for (int e = 0; e < 4; ++e) v[n][e] = silu_f(v[n][e]);
                        }
                        w.x = pk2(v[0][0], v[0][1]); w.y = pk2(v[0][2], v[0][3]); w.z = pk2(v[1][0], v[1][1]); w.w = pk2(v[1][2], v[1][3]);
                    }
                    if (grp != 5 || colg + bj * 128 < 352) *(v4u*)(rowp + bj * 128) = w; } }
    }
};
template <bool RBF>
struct EpiRes {
    static constexpr bool PREP_EARLY = true;
    const void* resid; bf16_t* xn; float* ssp;
    __device__ __forceinline__ void prep(const Unit&, int) const {}
    __device__ __forceinline__ void operator()(const AccT& acc, const Unit& u, int par, int wr, int wc, int fr, int fq, int wid, int lane) const {
        const int col0 = u.pn * 256 + wc * 32 + 8 * fq;
        const size_t rowb = (size_t)(u.pm * 256 + wr * 64 + fr);
        constexpr int NB = RBF ? 8 : 4;
#pragma unroll
        for (int b0 = 0; b0 < 8; b0 += NB) {
            v4u rb[NB][2]; f32x4 rf[NB][2][2];
#pragma unroll
            for (int q = 0; q < NB; ++q) { const int g = b0 + q; const size_t off0 = (rowb + (g >> 2) * 128 + (g & 3) * 16) * D + col0;
#pragma unroll
                for (int bj = 0; bj < 2; ++bj) {
                    if constexpr (RBF) rb[q][bj] = *(const v4u*)((const bf16_t*)resid + off0 + bj * 128);
                    else { rf[q][bj][0] = *(const f32x4*)((const float*)resid + off0 + bj * 128); rf[q][bj][1] = *(const f32x4*)((const float*)resid + off0 + bj * 128 + 4); } } }
            asm volatile("" ::: "memory");
#pragma unroll
            for (int q = 0; q < NB; ++q) { const int g = b0 + q, ai = g >> 2, m = g & 3; const size_t row = rowb + ai * 128 + m * 16; float sq = 0.f;
#pragma unroll
                for (int bj = 0; bj < 2; ++bj) { const size_t off = row * D + col0 + bj * 128; f32x4 r0, r1;
                    if constexpr (RBF) { const v4u w_ = rb[q][bj]; r0 = (f32x4){pg8::bf_lo(w_.x), pg8::bf_hi(w_.x), pg8::bf_lo(w_.y), pg8::bf_hi(w_.y)}; r1 = (f32x4){pg8::bf_lo(w_.z), pg8::bf_hi(w_.z), pg8::bf_lo(w_.w), pg8::bf_hi(w_.w)}; }
                    else { r0 = rf[q][bj][0]; r1 = rf[q][bj][1]; }
                    const f32x4 o0 = r0 + acc[ai][bj][m][0], o1 = r1 + acc[ai][bj][m][1];
                    v4u w; w.x = pk2(o0[0], o0[1]); w.y = pk2(o0[2], o0[3]); w.z = pk2(o1[0], o1[1]); w.w = pk2(o1[2], o1[3]); *(v4u*)(xn + off) = w;
                    sq += (o0[0] * o0[0] + o0[1] * o0[1]) + (o0[2] * o0[2] + o0[3] * o0[3]) + (o1[0] * o1[0] + o1[1] * o1[1]) + (o1[2] * o1[2] + o1[3] * o1[3]); }
                sq += __shfl_xor(sq, 16); sq += __shfl_xor(sq, 32);
                if (fq == 0) ssp[row * 16 + u.pn * 4 + wc] = sq; }
        }
    }
};
struct EpiHeadNorm {
    static constexpr bool PREP_EARLY = false;
    const float* ssp; const float* gain; bf16_t* O; LAS float* RS; LAS float* XP; float gscale; int ldo; int nnorm; int pad_;
    __device__ __forceinline__ void prep(const Unit& u, int par) const { const int t = pg8::tid_opaque(); if (ssp && t < 256) RS[par * 256 + t] = rstd16(ssp + (size_t)(u.pm * 256 + t) * 16); }
    __device__ __forceinline__ void operator()(const AccT& acc, const Unit& u, int par, int wr, int wc, int fr, int fq, int wid, int lane) const {
        const bool norm = u.pn < nnorm; const int colh = wc * 32 + 8 * fq;
        if (norm) {
#pragma unroll
            for (int ai = 0; ai < 2; ++ai)
#pragma unroll
                for (int m = 0; m < 4; ++m) { float sq = 0.f;
#pragma unroll
                    for (int bj = 0; bj < 2; ++bj)
#pragma unroll
                        for (int n = 0; n < 2; ++n) { const f32x4 v = acc[ai][bj][m][n]; sq += (v[0] * v[0] + v[1] * v[1]) + (v[2] * v[2] + v[3] * v[3]); }
                    sq += __shfl_xor(sq, 16); sq += __shfl_xor(sq, 32);
                    if (fq == 0) XP[(ai * 128 + wr * 64 + m * 16 + fr) * 4 + wc] = sq; }
        }
        asm volatile("s_waitcnt lgkmcnt(0)" ::: "memory"); __builtin_amdgcn_s_barrier(); asm volatile("" ::: "memory");
        f32x4 g[2][2];
#pragma unroll
        for (int bj = 0; bj < 2; ++bj)
#pragma unroll
            for (int n = 0; n < 2; ++n) g[bj][n] = norm ? *(const f32x4*)(gain + colh + bj * 128 + 4 * n) * gscale : (f32x4){1.f, 1.f, 1.f, 1.f};
#pragma unroll
        for (int ai = 0; ai < 2; ++ai)
#pragma unroll
            for (int m = 0; m < 4; ++m) { const int rl = ai * 128 + wr * 64 + m * 16 + fr; const size_t row = (size_t)(u.pm * 256 + rl);
                float h = 1.0f;
                if (norm) { const f32x4 p = *(const LAS f32x4*)(XP + rl * 4); const float rs = ssp ? RS[par * 256 + rl] : 1.0f; const float s = ((p[0] + p[1]) + (p[2] + p[3])) * rs * rs; h = rs * rsq(s * (1.f / 256.f) + EPS); }
#pragma unroll
                for (int bj = 0; bj < 2; ++bj) { const f32x4 v0 = acc[ai][bj][m][0] * h * g[bj][0], v1 = acc[ai][bj][m][1] * h * g[bj][1];
                    v4u w; w.x = pk2(v0[0], v0[1]); w.y = pk2(v0[2], v0[3]); w.z = pk2(v1[0], v1[1]); w.w = pk2(v1[2], v1[3]);
                    *(v4u*)(O + row * ldo + u.pn * 256 + colh + bj * 128) = w; } }
        asm volatile("s_waitcnt lgkmcnt(0)" ::: "memory"); __builtin_amdgcn_s_barrier(); asm volatile("" ::: "memory");
    }
};
struct EpiRouter {
    static constexpr bool PREP_EARLY = false; static constexpr bool SKIP_BJ1 = true;
    const float* ssp; const float* bg; const float* be; float* LG; LAS float* RS; int pad_;
    __device__ __forceinline__ void prep(const Unit& u, int par) const { const int t = pg8::tid_opaque(); if (t < 256) RS[par * 256 + t] = rstd16(ssp + (size_t)(u.pm * 256 + t) * 16); }
    __device__ __forceinline__ void operator()(const AccT& acc, const Unit& u, int par, int wr, int wc, int fr, int fq, int wid, int lane) const {
        const int col0 = wc * 32 + 8 * fq;
        if (col0 < 72) {
            f32x4 b0, b1;
#pragma unroll
            for (int e = 0; e < 4; ++e) { const int c0 = col0 + e, c1 = col0 + 4 + e; b0[e] = c0 < 8 ? bg[c0] : be[c0 - 8]; b1[e] = c1 < 8 ? bg[c1] : be[c1 - 8]; }
#pragma unroll
            for (int ai = 0; ai < 2; ++ai)
#pragma unroll
                for (int m = 0; m < 4; ++m) { const int rl = ai * 128 + wr * 64 + m * 16 + fr; const float rs = RS[par * 256 + rl]; float* p = LG + (size_t)(u.pm * 256 + rl) * 72 + col0;
                    *(f32x4*)p = acc[ai][0][m][0] * rs + b0; *(f32x4*)(p + 4) = acc[ai][0][m][1] * rs + b1; }
        }
    }
};
struct SchedMoeA {
    const int* tilee; const int* rowe; const char* XN; const char* WGU; int ntile, G, c, pad_;
    __device__ __forceinline__ bool next(int i, Unit& u) const { const long L = (long)i * G + c; if (L >= (long)ntile * 2) return false; const int tl = (int)(L >> 1), pn = (int)(L & 1);
        const int e = __builtin_amdgcn_readfirstlane(tilee[tl]);
        u.pm = tl; u.pn = pn; u.a = XN; u.rows = rowe + tl * 256; u.map0 = nullptr; u.map1 = nullptr; u.b0 = u.b1 = WGU + (size_t)e * (512 * 1024 * 2) + (size_t)pn * (256 * 1024 * 2); return true; }
};
struct EpiMoeA {
    static constexpr bool PREP_EARLY = false;
    const float* ssp; const float* wslot; bf16_t* H; LAS float* RS; LAS float* WG;
    __device__ __forceinline__ void prep(const Unit& u, int par) const { const int t = pg8::tid_opaque(); if (t < 256) { const int tok = u.rows[t];
        RS[par * 256 + t] = tok < 0 ? 0.f : rstd16(ssp + (size_t)tok * 16); WG[par * 256 + t] = wslot[u.pm * 256 + t]; } }
    __device__ __forceinline__ void operator()(const AccT& acc, const Unit& u, int par, int wr, int wc, int fr, int fq, int wid, int lane) const {
#pragma unroll
        for (int ai = 0; ai < 2; ++ai)
#pragma unroll
            for (int m = 0; m < 4; ++m) { const int rl = ai * 128 + wr * 64 + m * 16 + fr; const float rs = RS[par * 256 + rl], wg = WG[par * 256 + rl]; float h[8];
#pragma unroll
                for (int n = 0; n < 2; ++n)
#pragma unroll
                    for (int e = 0; e < 4; ++e) h[n * 4 + e] = silu_f(acc[ai][0][m][n][e] * rs) * (acc[ai][1][m][n][e] * rs) * wg;
                v4u w; w.x = pk2(h[0], h[1]); w.y = pk2(h[2], h[3]); w.z = pk2(h[4], h[5]); w.w = pk2(h[6], h[7]);
                *(v4u*)(H + (size_t)(u.pm * 256 + rl) * 256 + u.pn * 128 + wc * 32 + 8 * fq) = w; }
    }
};
struct SchedMoeB {
    const int* tilep; const int* rowp; const int* slotA; const int* slotB; const char* Hb; const char* WD; int ntile, G, c, pad_;
    __device__ __forceinline__ bool next(int i, Unit& u) const { const long L = (long)i * G + c; if (L >= (long)ntile * 4) return false; const int tl = (int)(L >> 2), pn = (int)(L & 3);
        const int b = __builtin_amdgcn_readfirstlane(tilep[tl]), ea = (b >> 6) * 8 + ((b >> 3) & 7), eb = (b >> 6) * 8 + (b & 7);
        u.pm = tl; u.pn = pn; u.a = Hb; u.rows = slotA + tl * 256; u.map0 = rowp + tl * 256; u.map1 = slotB + tl * 256;
        u.hi = (__builtin_amdgcn_readfirstlane(rowp[tl * 256 + 128]) >= 0) ? 1 : 0;
        u.b0 = WD + (size_t)ea * (1024 * 256 * 2) + (size_t)pn * (256 * 256 * 2); u.b1 = WD + (size_t)eb * (1024 * 256 * 2) + (size_t)pn * (256 * 256 * 2); return true; }
};
struct EpiMoeB {
    static constexpr bool PREP_EARLY = true;
    const bf16_t* xres; float* out; LAS int* TOK; int pad_;
    __device__ __forceinline__ void prep(const Unit& u, int par) const { const int t = pg8::tid_opaque(); if (t < 256) TOK[par * 256 + t] = u.map0[t]; }
    __device__ __forceinline__ void operator()(const AccT& acc, const Unit& u, int par, int wr, int wc, int fr, int fq, int wid, int lane) const {
        const int col0 = u.pn * 256 + wc * 32 + 8 * fq;
        int tok[8]; v4u rb[8][2];
#pragma unroll
        for (int g = 0; g < 8; ++g) { tok[g] = TOK[par * 256 + (g >> 2) * 128 + wr * 64 + (g & 3) * 16 + fr]; const unsigned off = (unsigned)(tok[g] < 0 ? 0 : tok[g]) * (unsigned)D + (unsigned)col0;
            rb[g][0] = *(const v4u*)(xres + off); rb[g][1] = *(const v4u*)(xres + off + 128); }
        asm volatile("" ::: "memory");
#pragma unroll
        for (int g = 0; g < 8; ++g) { const int ai = g >> 2, m = g & 3; const unsigned off = (unsigned)(tok[g] < 0 ? 0 : tok[g]) * (unsigned)D + (unsigned)col0;
#pragma unroll
            for (int bj = 0; bj < 2; ++bj) { const v4u w_ = rb[g][bj];
                const f32x4 o0 = (f32x4){pg8::bf_lo(w_.x), pg8::bf_hi(w_.x), pg8::bf_lo(w_.y), pg8::bf_hi(w_.y)} + acc[ai][bj][m][0], o1 = (f32x4){pg8::bf_lo(w_.z), pg8::bf_hi(w_.z), pg8::bf_lo(w_.w), pg8::bf_hi(w_.w)} + acc[ai][bj][m][1];
                if (tok[g] >= 0) { *(f32x4*)(out + off + bj * 128) = o0; *(f32x4*)(out + off + bj * 128 + 4) = o1; } } }
    }
};
namespace att {
__device__ __forceinline__ int crow(int r, int hi) { return (r & 3) + 8 * (r >> 2) + 4 * hi; }
__device__ __forceinline__ void glds16(const void* gsrc, unsigned lds_dst) { unsigned keep;
    asm volatile("s_mov_b32 %0, m0\n\ts_mov_b32 m0, %2\n\ts_nop 0\n\tglobal_load_lds_dwordx4 %1, off\n\ts_mov_b32 m0, %0" : "=&s"(keep) : "v"(gsrc), "s"(lds_dst) : "memory"); }
typedef __attribute__((address_space(3))) const char* lds_cptr;
typedef short v4i16_t __attribute__((ext_vector_type(4)));
__device__ __forceinline__ s16x4 vtr(lds_cptr p) { return __builtin_bit_cast(s16x4, __builtin_amdgcn_ds_read_tr16_b64_v4i16((__attribute__((address_space(3))) v4i16_t*)p)); }

typedef float f32x2_t __attribute__((ext_vector_type(2))); typedef __bf16 bf16x2_t __attribute__((ext_vector_type(2)));
__device__ __forceinline__ unsigned cvtpk_s(float lo, float hi) { f32x2_t v = {lo, hi}; bf16x2_t b = __builtin_convertvector(v, bf16x2_t); return __builtin_bit_cast(unsigned, b); }
struct Tensors { const bf16* Q; const bf16* K; const bf16* V; bf16* O; int qp, kp, vp, op; };

template <int KS, int DVB, int NDV, int QW, bool QREG, bool NOSHIFT>
__device__ __forceinline__ void unit(const Tensors& Tn, const int q0, const int NT, const float cbound, char* shm, LAS float* wsf_all) {
    constexpr int KSLOT = 64 * KS * 32, VSLOT = 64 * DVB * 64, SLOT = KSLOT + VSLOT, NKP = KS * 2, NVP = DVB * 4;
    constexpr bool KLINE = (KS % 4 == 0);
    const int tid = pg8::tid_opaque(), lane = tid & 63, r32 = lane & 31, hi = lane >> 5; const int wid = __builtin_amdgcn_readfirstlane(tid >> 6);
    const int qb = wid % QW, dvb0 = (wid / QW) * NDV;
    const unsigned lds0 = (unsigned)(uintptr_t)shm;
    LAS float* wsf = wsf_all + wid * 64;
    const lds_cptr shm3 = (lds_cptr)shm;
    const bf16* ksrc = Tn.K + (size_t)lane * Tn.kp;
    const bf16* vsrc = Tn.V + (size_t)(lane >> 2) * Tn.vp + (lane & 3) * 8;
#define ATT_DMA(t, slot) do { \
        if constexpr (KLINE) {   \
            _Pragma("unroll") for (int p_ = 0; p_ < NKP / 8; ++p_) { const int c_ = wid + 8 * p_, cg_ = c_ >> 3, kg_ = c_ & 7; \
                glds16(Tn.K + ((size_t)(t) * 64 + 8 * kg_ + (lane & 7)) * Tn.kp + (8 * cg_ + ((lane >> 3) ^ (kg_ & 1))) * 8, (unsigned)__builtin_amdgcn_readfirstlane(lds0 + (slot) * SLOT + c_ * 1024)); } } \
        else { _Pragma("unroll") for (int p_ = 0; p_ < (NKP + 7) / 8; ++p_) { const int c_ = wid + 8 * p_; if (c_ < NKP) glds16(ksrc + (size_t)(t) * 64 * Tn.kp + c_ * 8, (unsigned)__builtin_amdgcn_readfirstlane(lds0 + (slot) * SLOT + c_ * 1024)); } } \
        _Pragma("unroll") for (int p_ = 0; p_ < (NVP + 7) / 8; ++p_) { const int c_ = wid + 8 * p_; if (c_ < NVP) { const int dg_ = c_ >> 2, kg_ = c_ & 3; \
            glds16(vsrc + ((size_t)(t) * 64 + 16 * kg_) * Tn.vp + dg_ * 32, (unsigned)__builtin_amdgcn_readfirstlane(lds0 + (slot) * SLOT + KSLOT + c_ * 1024)); } } } while (0)
    ATT_DMA(0, 0);
    const bf16* Qw = Tn.Q + (size_t)(q0 + qb * 32 + r32) * Tn.qp + hi * 8;
    bf16x8 qr[KS];
    if constexpr (QREG) {
#pragma unroll
      for (int d0 = 0; d0 < KS; ++d0) qr[d0] = *reinterpret_cast<const bf16x8*>(Qw + d0 * 16); }
    f32x16 o[NDV];
#pragma unroll
    for (int j = 0; j < NDV; ++j) o[j] = f32x16{};
    float l_reg = 0.f;
    f32x16 negc;
#pragma unroll
    for (int r = 0; r < 16; ++r) negc[r] = -cbound;
    asm volatile("s_waitcnt vmcnt(0)" ::: "memory"); __builtin_amdgcn_s_barrier(); asm volatile("" ::: "memory");
#ifdef ATT_PROBE_TILES
    for (int rep_ = 0; rep_ < 2; ++rep_) {
    if (rep_ == 1) { ATT_DMA(0, 0); l_reg = 0.f;
#pragma unroll
        for (int j = 0; j < NDV; ++j) o[j] = f32x16{};
        asm volatile("s_waitcnt vmcnt(0)" ::: "memory"); __builtin_amdgcn_s_barrier(); asm volatile("" ::: "memory"); }
#endif
#pragma nounroll
    for (int t = 0; t < NT; ++t) {
        const int sl = t & 1;
        if (t + 1 < NT) ATT_DMA(t + 1, sl ^ 1);
        const lds_cptr kb = KLINE ? shm3 + sl * SLOT + (r32 >> 3) * 1024 + (hi ^ ((r32 >> 3) & 1)) * 128 + (r32 & 7) * 16 : shm3 + sl * SLOT + hi * 1024 + r32 * 16;
        const lds_cptr vp_ = shm3 + sl * SLOT + KSLOT + ((lane >> 4) & 1) * 32 + (lane & 3) * 8 + (4 * hi + ((lane & 15) >> 2)) * 64;
#pragma nounroll
        for (int kh = 0; kh < 2; ++kh) {
            f32x16 p; if constexpr (NOSHIFT) p = f32x16{}; else p = negc;
#pragma unroll
            for (int d0 = 0; d0 < KS; ++d0) {
                if constexpr (!QREG) { if ((d0 & 3) == 0) { asm volatile("" ::: "memory");
#pragma unroll
                    for (int dd = 0; dd < 4; ++dd) qr[d0 + dd] = *reinterpret_cast<const bf16x8*>(Qw + (d0 + dd) * 16);
                    asm volatile("" ::: "memory"); } }
                const bf16x8 b0 = *(const __attribute__((address_space(3))) bf16x8*)(kb + (KLINE ? (d0 >> 2) * 8192 + (d0 & 3) * 256 + kh * 4096 : d0 * 2048 + kh * 512));
                p = __builtin_amdgcn_mfma_f32_32x32x16_bf16(b0, qr[d0], p, 0, 0, 0);
            }
            float sacc = 0.f;
#pragma unroll
            for (int r = 0; r < 16; ++r) { p[r] = fast_exp2(p[r]); sacc += p[r]; }
            l_reg += sacc;
            v4u pw[2];
            pw[0] = (v4u){pk2(p[0], p[1]), pk2(p[2], p[3]), pk2(p[4], p[5]), pk2(p[6], p[7])};
            pw[1] = (v4u){pk2(p[8], p[9]), pk2(p[10], p[11]), pk2(p[12], p[13]), pk2(p[14], p[15])};
            s16x4 vl[2][2], vh2[2][2];
#pragma unroll
            for (int ks = 0; ks < 2; ++ks) { vl[0][ks] = vtr(vp_ + (dvb0 + 0) * 4096 + (2 * kh + ks) * 1024); vh2[0][ks] = vtr(vp_ + (dvb0 + 0) * 4096 + (2 * kh + ks) * 1024 + 512); }
#pragma unroll
            for (int j = 0; j < NDV; ++j) {
                if (j + 1 < NDV) {
#pragma unroll
                    for (int ks = 0; ks < 2; ++ks) { vl[(j + 1) & 1][ks] = vtr(vp_ + (dvb0 + j + 1) * 4096 + (2 * kh + ks) * 1024); vh2[(j + 1) & 1][ks] = vtr(vp_ + (dvb0 + j + 1) * 4096 + (2 * kh + ks) * 1024 + 512); }
                }
#pragma unroll
                for (int ks = 0; ks < 2; ++ks) { const s16x4 lo = vl[j & 1][ks], hh = vh2[j & 1][ks];
                    o[j] = __builtin_amdgcn_mfma_f32_32x32x16_bf16(__builtin_bit_cast(bf16x8, pw[ks]), (bf16x8){lo[0], lo[1], lo[2], lo[3], hh[0], hh[1], hh[2], hh[3]}, o[j], 0, 0, 0); }
                if (NDV > 2) { __builtin_amdgcn_sched_group_barrier(0x100, 4, 0); __builtin_amdgcn_sched_group_barrier(0x8, 2, 0); }
            }
        }
        asm volatile("s_waitcnt vmcnt(0) lgkmcnt(0)" ::: "memory"); __builtin_amdgcn_s_barrier(); asm volatile("" ::: "memory");
    }
#ifdef ATT_PROBE_TILES
    }
#endif
#undef ATT_DMA
    l_reg += __shfl_xor(l_reg, 32);
    if (hi == 0) wsf[r32] = l_reg;
    asm volatile("s_waitcnt lgkmcnt(0)" ::: "memory");
    float rli[16];
#pragma unroll
    for (int r = 0; r < 16; ++r) rli[r] = fast_rcp(wsf[crow(r, hi)]);
    constexpr int SW = NDV * 32;
    LAS bf16* stg = (LAS bf16*)(shm3) + wid * (32 * SW);
#pragma unroll
    for (int r = 0; r < 16; ++r) { const int orow = crow(r, hi);
#pragma unroll
        for (int j = 0; j < NDV; j += 2) { const unsigned w_ = cvtpk_s(o[j][r] * rli[r], o[j + 1][r] * rli[r]); stg[orow * SW + j * 32 + r32] = (bf16)(w_ & 0xffffu); stg[orow * SW + (j + 1) * 32 + r32] = (bf16)(w_ >> 16); } }
    asm volatile("s_waitcnt lgkmcnt(0)" ::: "memory");
    bf16* Ow = Tn.O + (size_t)(q0 + qb * 32) * Tn.op + dvb0 * 32;
    constexpr int CPR = SW / 8;
#pragma unroll
    for (int i = 0; i < (32 * CPR) / 64; ++i) { const int idx = i * 64 + lane, row = idx / CPR, ch = idx % CPR;
        const v4u v = *(const LAS v4u*)(stg + row * SW + ch * 8); *(v4u*)(Ow + (size_t)row * Tn.op + ch * 8) = v; }
    asm volatile("s_waitcnt lgkmcnt(0)" ::: "memory");        __builtin_amdgcn_s_barrier(); asm volatile("" ::: "memory");
}

template <int KS, int DVB>
__device__ __forceinline__ void unit2(const Tensors& Tn, const int q0, const int NT, const float cbound, char* shm, LAS float* wsf_all) {
    constexpr int KSLOT = 64 * KS * 32, VSLOT = 64 * DVB * 64, SLOT = KSLOT + VSLOT, NKP = KS * 2, NVP = DVB * 4;
    const int tid = pg8::tid_opaque(), lane = tid & 63, r32 = lane & 31, hi = lane >> 5; const int wid = __builtin_amdgcn_readfirstlane(tid >> 6);
    const unsigned lds0 = (unsigned)(uintptr_t)shm;
    LAS float* wsf = wsf_all + wid * 64;
    const lds_cptr shm3 = (lds_cptr)shm;
    const bf16* ksrc = Tn.K + (size_t)lane * Tn.kp;
    const bf16* vsrc = Tn.V + (size_t)(lane >> 2) * Tn.vp + (lane & 3) * 8;
#define ATT_DMA(t, slot) do { \
        _Pragma("unroll") for (int p_ = 0; p_ < (NKP + 7) / 8; ++p_) { const int c_ = wid + 8 * p_; if (c_ < NKP) glds16(ksrc + (size_t)(t) * 64 * Tn.kp + c_ * 8, (unsigned)__builtin_amdgcn_readfirstlane(lds0 + (slot) * SLOT + c_ * 1024)); } \
        _Pragma("unroll") for (int p_ = 0; p_ < (NVP + 7) / 8; ++p_) { const int c_ = wid + 8 * p_; if (c_ < NVP) { const int dg_ = c_ >> 2, kg_ = c_ & 3; \
            glds16(vsrc + ((size_t)(t) * 64 + 16 * kg_) * Tn.vp + dg_ * 32, (unsigned)__builtin_amdgcn_readfirstlane(lds0 + (slot) * SLOT + KSLOT + c_ * 1024)); } } } while (0)
    ATT_DMA(0, 0);
    bf16x8 qa[KS], qb[KS];
    { const bf16* Qw = Tn.Q + (size_t)(q0 + wid * 64 + r32) * Tn.qp + hi * 8;
#pragma unroll
      for (int d0 = 0; d0 < KS; ++d0) { qa[d0] = *reinterpret_cast<const bf16x8*>(Qw + d0 * 16); qb[d0] = *reinterpret_cast<const bf16x8*>(Qw + (size_t)32 * Tn.qp + d0 * 16); } }
    f32x16 oa[DVB], ob[DVB];
#pragma unroll
    for (int j = 0; j < DVB; ++j) { oa[j] = f32x16{}; ob[j] = f32x16{}; }
    float la = 0.f, lb = 0.f;
    asm volatile("s_waitcnt vmcnt(0)" ::: "memory"); __builtin_amdgcn_s_barrier(); asm volatile("" ::: "memory");
#pragma nounroll
    for (int t = 0; t < NT; ++t) {
        const int sl = t & 1;
        if (t + 1 < NT) ATT_DMA(t + 1, sl ^ 1);
        const lds_cptr kb = shm3 + sl * SLOT + hi * 1024 + r32 * 16;
        const lds_cptr vp_ = shm3 + sl * SLOT + KSLOT + ((lane >> 4) & 1) * 32 + (lane & 3) * 8 + (4 * hi + ((lane & 15) >> 2)) * 64;
#pragma unroll
        for (int kh = 0; kh < 2; ++kh) {
            bf16x8 kf[KS];
#pragma unroll
            for (int d0 = 0; d0 < KS; ++d0) kf[d0] = *(const __attribute__((address_space(3))) bf16x8*)(kb + d0 * 2048 + kh * 512);
            f32x16 pa = f32x16{}, pb = f32x16{};
#pragma unroll
            for (int d0 = 0; d0 < KS; ++d0) pa = __builtin_amdgcn_mfma_f32_32x32x16_bf16(kf[d0], qa[d0], pa, 0, 0, 0);
#pragma unroll
            for (int d0 = 0; d0 < KS; ++d0) pb = __builtin_amdgcn_mfma_f32_32x32x16_bf16(kf[d0], qb[d0], pb, 0, 0, 0);
            __builtin_amdgcn_sched_barrier(0);
            bf16x8 vf[DVB][2];
#pragma unroll
            for (int j = 0; j < DVB; ++j)
#pragma unroll
                for (int ks = 0; ks < 2; ++ks) { const s16x4 lo = vtr(vp_ + j * 4096 + (2 * kh + ks) * 1024), hh = vtr(vp_ + j * 4096 + (2 * kh + ks) * 1024 + 512);
                    vf[j][ks] = (bf16x8){lo[0], lo[1], lo[2], lo[3], hh[0], hh[1], hh[2], hh[3]}; }
            float sa = 0.f, sb = 0.f;
#pragma unroll
            for (int r = 0; r < 16; ++r) { pa[r] = fast_exp2(pa[r]); sa += pa[r]; }
            v4u wa[2], wb[2];
            wa[0] = (v4u){pk2(pa[0], pa[1]), pk2(pa[2], pa[3]), pk2(pa[4], pa[5]), pk2(pa[6], pa[7])};
            wa[1] = (v4u){pk2(pa[8], pa[9]), pk2(pa[10], pa[11]), pk2(pa[12], pa[13]), pk2(pa[14], pa[15])};
            la += sa;
            __builtin_amdgcn_sched_barrier(0);
#pragma unroll
            for (int j = 0; j < DVB; ++j)
#pragma unroll
                for (int ks = 0; ks < 2; ++ks) oa[j] = __builtin_amdgcn_mfma_f32_32x32x16_bf16(__builtin_bit_cast(bf16x8, wa[ks]), vf[j][ks], oa[j], 0, 0, 0);
            __builtin_amdgcn_sched_barrier(0);
#pragma unroll
            for (int r = 0; r < 16; ++r) { pb[r] = fast_exp2(pb[r]); sb += pb[r]; }
            wb[0] = (v4u){pk2(pb[0], pb[1]), pk2(pb[2], pb[3]), pk2(pb[4], pb[5]), pk2(pb[6], pb[7])};
            wb[1] = (v4u){pk2(pb[8], pb[9]), pk2(pb[10], pb[11]), pk2(pb[12], pb[13]), pk2(pb[14], pb[15])};
            lb += sb;
            __builtin_amdgcn_sched_barrier(0);
#pragma unroll
            for (int j = 0; j < DVB; ++j)
#pragma unroll
                for (int ks = 0; ks < 2; ++ks) { const s16x4 lo = vtr(vp_ + j * 4096 + (2 * kh + ks) * 1024), hh = vtr(vp_ + j * 4096 + (2 * kh + ks) * 1024 + 512);
                    ob[j] = __builtin_amdgcn_mfma_f32_32x32x16_bf16(__builtin_bit_cast(bf16x8, wb[ks]), (bf16x8){lo[0], lo[1], lo[2], lo[3], hh[0], hh[1], hh[2], hh[3]}, ob[j], 0, 0, 0); }
        }
        asm volatile("s_waitcnt vmcnt(0) lgkmcnt(0)" ::: "memory"); __builtin_amdgcn_s_barrier(); asm volatile("" ::: "memory");
    }
#undef ATT_DMA
    la += __shfl_xor(la, 32); lb += __shfl_xor(lb, 32);
    if (hi == 0) { wsf[r32] = la; wsf[32 + r32] = lb; }
    asm volatile("s_waitcnt lgkmcnt(0)" ::: "memory");
    constexpr int SW = DVB * 32;
    LAS bf16* stg = (LAS bf16*)(shm3) + wid * (64 * SW);
#pragma unroll
    for (int r = 0; r < 16; ++r) { const int orow = crow(r, hi); const float ra = fast_rcp(wsf[orow]), rb = fast_rcp(wsf[32 + orow]);
#pragma unroll
        for (int j = 0; j < DVB; ++j) { const unsigned w_ = cvtpk_s(oa[j][r] * ra, ob[j][r] * rb); stg[orow * SW + j * 32 + r32] = (bf16)(w_ & 0xffffu); stg[(32 + orow) * SW + j * 32 + r32] = (bf16)(w_ >> 16); } }
    asm volatile("s_waitcnt lgkmcnt(0)" ::: "memory");
    bf16* Ow = Tn.O + (size_t)(q0 + wid * 64) * Tn.op;
    constexpr int CPR = SW / 8;
#pragma unroll
    for (int i = 0; i < (64 * CPR) / 64; ++i) { const int idx = i * 64 + lane, row = idx / CPR, ch = idx % CPR;
        const v4u v = *(const LAS v4u*)(stg + row * SW + ch * 8); *(v4u*)(Ow + (size_t)row * Tn.op + ch * 8) = v; }
    asm volatile("s_waitcnt vmcnt(0) lgkmcnt(0)" ::: "memory"); __builtin_amdgcn_s_barrier(); asm volatile("" ::: "memory");
}

template <int KS, int DVB>
__device__ __forceinline__ void unit3(const Tensors& Tn, const int q0, const int NT, char* shm, LAS float* wsf_all) {
    constexpr int KSLOT = 64 * KS * 32, VSLOT = 64 * DVB * 64, SLOT = KSLOT + VSLOT, NKP = KS * 2, NVP = DVB * 4;
    const int tid = pg8::tid_opaque(), lane = tid & 63, r32 = lane & 31, hi = lane >> 5; const int wid = __builtin_amdgcn_readfirstlane(tid >> 6);
    const unsigned lds0 = (unsigned)(uintptr_t)shm;
    LAS float* wsf = wsf_all + wid * 64;
    const lds_cptr shm3 = (lds_cptr)shm;
    const bf16* ksrc = Tn.K + (size_t)lane * Tn.kp;
    const bf16* vsrc = Tn.V + (size_t)(lane >> 2) * Tn.vp + (lane & 3) * 8;
#define ATT_DMA(t, slotb) do { \
        _Pragma("unroll") for (int p_ = 0; p_ < (NKP + 7) / 8; ++p_) { const int c_ = wid + 8 * p_; if (c_ < NKP) glds16(ksrc + (size_t)(t) * 64 * Tn.kp + c_ * 8, (unsigned)__builtin_amdgcn_readfirstlane(lds0 + (slotb) + c_ * 1024)); } \
        _Pragma("unroll") for (int p_ = 0; p_ < (NVP + 7) / 8; ++p_) { const int c_ = wid + 8 * p_; if (c_ < NVP) { const int dg_ = c_ >> 2, kg_ = c_ & 3; \
            glds16(vsrc + ((size_t)(t) * 64 + 16 * kg_) * Tn.vp + dg_ * 32, (unsigned)__builtin_amdgcn_readfirstlane(lds0 + (slotb) + KSLOT + c_ * 1024)); } } } while (0)
    ATT_DMA(0, 0); if (NT > 1) ATT_DMA(1, SLOT);
    bf16x8 qa[KS], qb[KS];
    { const bf16* Qw = Tn.Q + (size_t)(q0 + wid * 64 + r32) * Tn.qp + hi * 8;
#pragma unroll
      for (int d0 = 0; d0 < KS; ++d0) { qa[d0] = *reinterpret_cast<const bf16x8*>(Qw + d0 * 16); qb[d0] = *reinterpret_cast<const bf16x8*>(Qw + (size_t)32 * Tn.qp + d0 * 16); } }
    f32x16 oa[DVB], ob[DVB];
#pragma unroll
    for (int j = 0; j < DVB; ++j) { oa[j] = f32x16{}; ob[j] = f32x16{}; }
    float la0 = 0.f, la1 = 0.f, la2 = 0.f, la3 = 0.f, lb0 = 0.f, lb1 = 0.f, lb2 = 0.f, lb3 = 0.f;
    asm volatile("s_waitcnt vmcnt(0)" ::: "memory"); __builtin_amdgcn_s_barrier(); asm volatile("" ::: "memory");
    const int koff = hi * 1024 + r32 * 16, voff = KSLOT + ((lane >> 4) & 1) * 32 + (lane & 3) * 8 + (4 * hi + ((lane & 15) >> 2)) * 64;
    bf16x8 kf[KS];
    f32x16 pa = f32x16{}, pb;
#pragma unroll
    for (int d0 = 0; d0 < KS; ++d0) kf[d0] = *(const __attribute__((address_space(3))) bf16x8*)(shm3 + koff + d0 * 2048);
#pragma unroll
    for (int d0 = 0; d0 < KS; ++d0) pa = __builtin_amdgcn_mfma_f32_32x32x16_bf16(kf[d0], qa[d0], pa, 0, 0, 0);
    int sl = 0, sn = SLOT, snn = 2 * SLOT;
#define ATT_LDV(dst, slotb, kh) do { _Pragma("unroll") for (int j = 0; j < DVB; ++j) _Pragma("unroll") for (int ks = 0; ks < 2; ++ks) { \
        const s16x4 lo_ = vtr(shm3 + (slotb) + voff + j * 4096 + (2 * (kh) + ks) * 1024), hh_ = vtr(shm3 + (slotb) + voff + j * 4096 + (2 * (kh) + ks) * 1024 + 512); \
        dst[j][ks] = (bf16x8){lo_[0], lo_[1], lo_[2], lo_[3], hh_[0], hh_[1], hh_[2], hh_[3]}; } } while (0)
#define ATT_HALF(kh, NEXT, SLV) do { \
        bf16x8 vf[DVB][2]; ATT_LDV(vf, SLV, kh); \
        pb = f32x16{}; \
        _Pragma("unroll") for (int d0 = 0; d0 < KS; ++d0) pb = __builtin_amdgcn_mfma_f32_32x32x16_bf16(kf[d0], qb[d0], pb, 0, 0, 0); \
        _Pragma("unroll") for (int r = 0; r < 16; ++r) pa[r] = fast_exp2(pa[r]); \
        v4u wa[2], wb[2]; \
        wa[0] = (v4u){cvtpk_s(pa[0], pa[1]), cvtpk_s(pa[2], pa[3]), cvtpk_s(pa[4], pa[5]), cvtpk_s(pa[6], pa[7])}; \
        wa[1] = (v4u){cvtpk_s(pa[8], pa[9]), cvtpk_s(pa[10], pa[11]), cvtpk_s(pa[12], pa[13]), cvtpk_s(pa[14], pa[15])}; \
        _Pragma("unroll") for (int g_ = 0; g_ < 5; ++g_) { __builtin_amdgcn_sched_group_barrier(0x8, 1, 0); __builtin_amdgcn_sched_group_barrier(0x400, 3, 0); } \
        __builtin_amdgcn_sched_group_barrier(0x8, 1, 0); __builtin_amdgcn_sched_group_barrier(0x400, 1, 0); __builtin_amdgcn_sched_group_barrier(0x2, 8, 0); \
          \
        _Pragma("unroll") for (int j = 0; j < DVB; ++j) _Pragma("unroll") for (int ks = 0; ks < 2; ++ks) oa[j] = __builtin_amdgcn_mfma_f32_32x32x16_bf16(__builtin_bit_cast(bf16x8, wa[ks]), vf[j][ks], oa[j], 0, 0, 0); \
        _Pragma("unroll") for (int r = 0; r < 16; ++r) pb[r] = fast_exp2(pb[r]); \
        _Pragma("unroll") for (int g_ = 0; g_ < 4; ++g_) { __builtin_amdgcn_sched_group_barrier(0x8, 1, 0); __builtin_amdgcn_sched_group_barrier(0x400, 4, 0); } \
        if ((NEXT) == 2) { asm volatile("s_waitcnt vmcnt(0) lgkmcnt(0)" ::: "memory"); __builtin_amdgcn_s_barrier(); asm volatile("" ::: "memory"); if (t + 2 < NT) ATT_DMA(t + 2, snn); } \
          \
        f32x16 pn = f32x16{}; \
        if ((NEXT) != 0) { \
            _Pragma("unroll") for (int d0 = 0; d0 < KS; ++d0) kf[d0] = *(const __attribute__((address_space(3))) bf16x8*)(shm3 + ((NEXT) == 2 ? sn : sl) + koff + d0 * 2048 + ((NEXT) == 2 ? 0 : 512)); \
            _Pragma("unroll") for (int d0 = 0; d0 < KS; ++d0) pn = __builtin_amdgcn_mfma_f32_32x32x16_bf16(kf[d0], qa[d0], pn, 0, 0, 0); } \
        wb[0] = (v4u){cvtpk_s(pb[0], pb[1]), cvtpk_s(pb[2], pb[3]), cvtpk_s(pb[4], pb[5]), cvtpk_s(pb[6], pb[7])}; \
        wb[1] = (v4u){cvtpk_s(pb[8], pb[9]), cvtpk_s(pb[10], pb[11]), cvtpk_s(pb[12], pb[13]), cvtpk_s(pb[14], pb[15])}; \
        la0 += (pa[0] + pa[1]) + (pa[2] + pa[3]); la1 += (pa[4] + pa[5]) + (pa[6] + pa[7]); la2 += (pa[8] + pa[9]) + (pa[10] + pa[11]); la3 += (pa[12] + pa[13]) + (pa[14] + pa[15]); \
        if ((NEXT) != 0) { _Pragma("unroll") for (int g_ = 0; g_ < 6; ++g_) { __builtin_amdgcn_sched_group_barrier(0x8, 1, 0); __builtin_amdgcn_sched_group_barrier(0x2, 4, 0); } } \
          \
        _Pragma("unroll") for (int j = 0; j < DVB; ++j) _Pragma("unroll") for (int ks = 0; ks < 2; ++ks) ob[j] = __builtin_amdgcn_mfma_f32_32x32x16_bf16(__builtin_bit_cast(bf16x8, wb[ks]), vf[j][ks], ob[j], 0, 0, 0); \
        lb0 += (pb[0] + pb[1]) + (pb[2] + pb[3]); lb1 += (pb[4] + pb[5]) + (pb[6] + pb[7]); lb2 += (pb[8] + pb[9]) + (pb[10] + pb[11]); lb3 += (pb[12] + pb[13]) + (pb[14] + pb[15]); \
        _Pragma("unroll") for (int g_ = 0; g_ < 4; ++g_) { __builtin_amdgcn_sched_group_barrier(0x8, 1, 0); __builtin_amdgcn_sched_group_barrier(0x2, 4, 0); } \
        pa = pn; } while (0)
    int t = 0;
#pragma nounroll
    for (; t + 1 < NT; ++t) {
        ATT_HALF(0, 1, sl);
        ATT_HALF(1, 2, sl);
        { const int tmp_ = sl; sl = sn; sn = snn; snn = tmp_; }
    }
    ATT_HALF(0, 1, sl);
    ATT_HALF(1, 0, sl);
#undef ATT_HALF
#undef ATT_LDV
#undef ATT_DMA
    float la = (la0 + la1) + (la2 + la3), lb = (lb0 + lb1) + (lb2 + lb3);
    la += __shfl_xor(la, 32); lb += __shfl_xor(lb, 32);
    asm volatile("s_waitcnt vmcnt(0) lgkmcnt(0)" ::: "memory"); __builtin_amdgcn_s_barrier(); asm volatile("" ::: "memory");
    if (hi == 0) { wsf[r32] = la; wsf[32 + r32] = lb; }
    asm volatile("s_waitcnt lgkmcnt(0)" ::: "memory");
    constexpr int SW = DVB * 32;
    LAS bf16* stg = (LAS bf16*)(shm3) + wid * (64 * SW);
#pragma unroll
    for (int r = 0; r < 16; ++r) { const int orow = crow(r, hi); const float ra = fast_rcp(wsf[orow]), rb = fast_rcp(wsf[32 + orow]);
#pragma unroll
        for (int j = 0; j < DVB; ++j) { const unsigned w_ = cvtpk_s(oa[j][r] * ra, ob[j][r] * rb); stg[orow * SW + j * 32 + r32] = (bf16)(w_ & 0xffffu); stg[(32 + orow) * SW + j * 32 + r32] = (bf16)(w_ >> 16); } }
    asm volatile("s_waitcnt lgkmcnt(0)" ::: "memory");
    bf16* Ow = Tn.O + (size_t)(q0 + wid * 64) * Tn.op;
    constexpr int CPR = SW / 8;
#pragma unroll
    for (int i = 0; i < (64 * CPR) / 64; ++i) { const int idx = i * 64 + lane, row = idx / CPR, ch = idx % CPR;
        const v4u v = *(const LAS v4u*)(stg + row * SW + ch * 8); *(v4u*)(Ow + (size_t)row * Tn.op + ch * 8) = v; }
    asm volatile("s_waitcnt lgkmcnt(0)" ::: "memory");        __builtin_amdgcn_s_barrier(); asm volatile("" ::: "memory");
}
}
constexpr float QSCALE_MLA = 0.10206207261596575f * LOG2E;
__device__ __forceinline__ void mla_proj(Frame& F, const Inputs& in) {
    const int lane = F.lane(), w = F.wave, tk = lane & 15, g = lane >> 4;
    const bf16* LAT = (const bf16*)(F.ws + WS_LAT); const float* COS = (const float*)(F.ws + WS_COS); const float* SIN = (const float*)(F.ws + WS_SIN);
    bf16* Qo = (bf16*)(F.ws + WS_Q); bf16* Ko = (bf16*)(F.ws + WS_K); bf16* Vo = (bf16*)(F.ws + WS_V);
    const int ngrp = T / 16;
    int g0_, g1_;
    if (F.G == 256) { const int c_ = (int)blockIdx.x;
        if (c_ < 128) { g0_ = c_ * 14; g1_ = g0_ + 14; } else { g0_ = 128 * 14 + (c_ - 128) * 18; g1_ = g0_ + 18; } }
    else { const int per_ = (ngrp + F.G - 1) / F.G; g0_ = F.vcu * per_; g1_ = g0_ + per_ < ngrp ? g0_ + per_ : ngrp; if (g0_ > ngrp) g0_ = ngrp; }
    LAS float* gn_s = (LAS float*)(F.lds + AUX_XP);
    if (F.tid() < 96) { gn_s[F.tid()] = in.q_norm[F.tid()]; gn_s[96 + F.tid()] = in.k_norm[F.tid()]; }
    __syncthreads();
    {
        bf16x8 wq[6][6];
        const bf16* W = (const bf16*)(F.ws + W_Q) + (size_t)(96 * w + tk) * 192 + 8 * g;
#pragma unroll
        for (int nt = 0; nt < 6; ++nt)
#pragma unroll
            for (int ks = 0; ks < 6; ++ks) wq[nt][ks] = *(const bf16x8*)(W + (size_t)nt * 16 * 192 + ks * 32);
        LAS unsigned char* stg = F.lds + RING_OFF; int sb = 0;
        bf16x8 xn[6]; f32x4 cn = {0.f, 0.f, 0.f, 0.f}, sn = {0.f, 0.f, 0.f, 0.f};
        if (g0_ < g1_) {
#pragma unroll
            for (int ks = 0; ks < 6; ++ks) xn[ks] = *(const bf16x8*)(LAT + (size_t)(g0_ * 16 + tk) * 512 + ks * 32 + 8 * g);
            cn = *(const f32x4*)(COS + (size_t)(g0_ * 16 + tk) * 16 + 4 * g); sn = *(const f32x4*)(SIN + (size_t)(g0_ * 16 + tk) * 16 + 4 * g); }
        for (int grp = g0_; grp < g1_; ++grp) {
            unsigned long long tq0_ = 0, tq1_ = 0, tq2_ = 0; (void)tq0_; (void)tq1_; (void)tq2_; TP_NOW(tq0_);
            const int tok = grp * 16 + tk;
            const f32x4 c = cn, s = sn;
            float ss = 0.f;
#pragma unroll
            for (int ks = 0; ks < 6; ++ks) {
#pragma unroll
                for (int j = 0; j < 8; ++j) { const float v = bf2f((bf16)xn[ks][j]); ss += v * v; } }
            f32x4 acc[6];
#pragma unroll
            for (int nt = 0; nt < 6; ++nt) { acc[nt] = (f32x4){0.f, 0.f, 0.f, 0.f};
#pragma unroll
                for (int ks = 0; ks < 6; ++ks) acc[nt] = __builtin_amdgcn_mfma_f32_16x16x32_bf16(wq[nt][ks], xn[ks], acc[nt], 0, 0, 0); }
            __builtin_amdgcn_sched_barrier(0);
            if (grp + 1 < g1_) {
#pragma unroll
                for (int ks = 0; ks < 6; ++ks) xn[ks] = *(const bf16x8*)(LAT + (size_t)((grp + 1) * 16 + tk) * 512 + ks * 32 + 8 * g);
                cn = *(const f32x4*)(COS + (size_t)((grp + 1) * 16 + tk) * 16 + 4 * g); sn = *(const f32x4*)(SIN + (size_t)((grp + 1) * 16 + tk) * 16 + 4 * g); }
            __builtin_amdgcn_sched_barrier(0);
            TP_NOW(tq1_);
            ss += __shfl_xor(ss, 16); ss += __shfl_xor(ss, 32);
            const float rc = rsq(ss * (1.f / 192.f) + EPS);
            float hs = 0.f;
#pragma unroll
            for (int nt = 0; nt < 6; ++nt) { acc[nt] = acc[nt] * rc; hs += (acc[nt][0] * acc[nt][0] + acc[nt][1] * acc[nt][1]) + (acc[nt][2] * acc[nt][2] + acc[nt][3] * acc[nt][3]); }
            hs += __shfl_xor(hs, 16); hs += __shfl_xor(hs, 32);
            const float rq = QSCALE_MLA * rsq(hs * (1.f / 96.f) + EPS);
#pragma unroll
            for (int nt = 0; nt < 6; ++nt) { const f32x4 qg = *(const LAS f32x4*)(gn_s + 16 * nt + 4 * g); acc[nt] = acc[nt] * rq * qg; }
            const f32x4 x1 = acc[4], x2 = acc[5]; acc[4] = x1 * c - x2 * s; acc[5] = x2 * c + x1 * s;
#pragma unroll
            for (int nt = 0; nt < 6; ++nt) { v2u o; o.x = pk2(acc[nt][0], acc[nt][1]); o.y = pk2(acc[nt][2], acc[nt][3]); *(LAS v2u*)(stg + sb * (16 * 1552) + tk * 1552 + (96 * w + 16 * nt + 4 * g) * 2) = o; }
            asm volatile("s_waitcnt lgkmcnt(0)" ::: "memory"); __builtin_amdgcn_s_barrier(); asm volatile("" ::: "memory");
#pragma unroll
            for (int i = 0; i < 3; ++i) { const int c = F.tid() + 512 * i, row = c / 96, ch = c % 96;
                *(v4u*)(Qo + (size_t)(grp * 16 + row) * 768 + ch * 8) = *(const LAS v4u*)(stg + sb * (16 * 1552) + row * 1552 + ch * 16); }
            sb ^= 1;
            TP_NOW(tq2_); TP_ADD(F.lds, w, 0, tq0_, tq1_); TP_ADD(F.lds, w, 1, tq0_, tq2_);
        }
        __syncthreads();
    }
    {
        bf16x8 wk[8][4];
        const bf16* W = (const bf16*)(F.ws + W_KV) + (size_t)(128 * w + tk) * 128 + 8 * g;
#pragma unroll
        for (int nt = 0; nt < 8; ++nt)
#pragma unroll
            for (int ks = 0; ks < 4; ++ks) wk[nt][ks] = *(const bf16x8*)(W + (size_t)nt * 16 * 128 + ks * 32);
        LAS unsigned char* stg = F.lds + RING_OFF; int sb = 0; constexpr int KVB = 16 * (1552 + 1040);
        bf16x8 xn[5]; f32x4 cn0 = {0.f, 0.f, 0.f, 0.f}, cn1 = cn0, sn0 = cn0, sn1 = cn0;
        if (g0_ < g1_) {
#pragma unroll
            for (int ks = 0; ks < 4; ++ks) xn[ks] = *(const bf16x8*)(LAT + (size_t)(g0_ * 16 + tk) * 512 + 192 + ks * 32 + 8 * g);
            xn[4] = *(const bf16x8*)(LAT + (size_t)(g0_ * 16 + tk) * 512 + 320 + 8 * g);
            const size_t tb_ = (size_t)(g0_ * 16 + tk) * 16 + 8 * (g & 1); cn0 = *(const f32x4*)(COS + tb_); cn1 = *(const f32x4*)(COS + tb_ + 4); sn0 = *(const f32x4*)(SIN + tb_); sn1 = *(const f32x4*)(SIN + tb_ + 4); }
        for (int grp = g0_; grp < g1_; ++grp) {
            const int tok = grp * 16 + tk;
            const f32x4 c0 = cn0, c1 = cn1, s0 = sn0, s1 = sn1;
            float ss = 0.f;
#pragma unroll
            for (int ks = 0; ks < 4; ++ks) {
#pragma unroll
                for (int j = 0; j < 8; ++j) { const float v = bf2f((bf16)xn[ks][j]); ss += v * v; } }
            float kr[8], sr = 0.f;
#pragma unroll
            for (int e = 0; e < 8; ++e) { kr[e] = bf2f((bf16)xn[4][e]); sr += kr[e] * kr[e]; }
            f32x4 acc[8];
#pragma unroll
            for (int nt = 0; nt < 8; ++nt) { acc[nt] = (f32x4){0.f, 0.f, 0.f, 0.f};
#pragma unroll
                for (int ks = 0; ks < 4; ++ks) acc[nt] = __builtin_amdgcn_mfma_f32_16x16x32_bf16(wk[nt][ks], xn[ks], acc[nt], 0, 0, 0); }
            __builtin_amdgcn_sched_barrier(0);
            if (grp + 1 < g1_) {
#pragma unroll
                for (int ks = 0; ks < 4; ++ks) xn[ks] = *(const bf16x8*)(LAT + (size_t)((grp + 1) * 16 + tk) * 512 + 192 + ks * 32 + 8 * g);
                xn[4] = *(const bf16x8*)(LAT + (size_t)((grp + 1) * 16 + tk) * 512 + 320 + 8 * g);
                const size_t tb_ = (size_t)((grp + 1) * 16 + tk) * 16 + 8 * (g & 1); cn0 = *(const f32x4*)(COS + tb_); cn1 = *(const f32x4*)(COS + tb_ + 4); sn0 = *(const f32x4*)(SIN + tb_); sn1 = *(const f32x4*)(SIN + tb_ + 4); }
            __builtin_amdgcn_sched_barrier(0);
            ss += __shfl_xor(ss, 16); ss += __shfl_xor(ss, 32); sr += __shfl_xor(sr, 16); sr += __shfl_xor(sr, 32);
            const float rc = rsq(ss * (1.f / 128.f) + EPS);
            float hs = 0.f;
#pragma unroll
            for (int nt = 0; nt < 8; ++nt) { acc[nt] = acc[nt] * rc;
                if (nt < 4) hs += (acc[nt][0] * acc[nt][0] + acc[nt][1] * acc[nt][1]) + (acc[nt][2] * acc[nt][2] + acc[nt][3] * acc[nt][3]); }
            hs += __shfl_xor(hs, 16); hs += __shfl_xor(hs, 32);
            const float rk = rsq((hs + sr) * (1.f / 96.f) + EPS);
#pragma unroll
            for (int nt = 0; nt < 4; ++nt) { const f32x4 kg = *(const LAS f32x4*)(gn_s + 96 + 16 * nt + 4 * g) * rk; v2u o; o.x = pk2(acc[nt][0] * kg[0], acc[nt][1] * kg[1]); o.y = pk2(acc[nt][2] * kg[2], acc[nt][3] * kg[3]);
                *(LAS v2u*)(stg + sb * KVB + tk * 1552 + (96 * w + 16 * nt + 4 * g) * 2) = o; }
#pragma unroll
            for (int nt = 4; nt < 8; ++nt) { v2u o; o.x = pk2(acc[nt][0], acc[nt][1]); o.y = pk2(acc[nt][2], acc[nt][3]); *(LAS v2u*)(stg + sb * KVB + 16 * 1552 + tk * 1040 + (64 * w + 16 * (nt - 4) + 4 * g) * 2) = o; }
            const f32x4 kg0 = *(const LAS f32x4*)(gn_s + 96 + 64 + 8 * g), kg1 = *(const LAS f32x4*)(gn_s + 96 + 64 + 8 * g + 4);
            float ro[8];
#pragma unroll
            for (int e = 0; e < 8; ++e) { const float own = kr[e] * rk * (e < 4 ? kg0[e] : kg1[e - 4]); const float oth = __shfl_xor(own, 32); const float cc = e < 4 ? c0[e] : c1[e - 4], sn = e < 4 ? s0[e] : s1[e - 4];
                ro[e] = (g < 2) ? own * cc - oth * sn : own * cc + oth * sn; }
            v4u o; o.x = pk2(ro[0], ro[1]); o.y = pk2(ro[2], ro[3]); o.z = pk2(ro[4], ro[5]); o.w = pk2(ro[6], ro[7]);
            *(LAS v4u*)(stg + sb * KVB + tk * 1552 + (96 * w + 64 + 8 * g) * 2) = o;
            asm volatile("s_waitcnt lgkmcnt(0)" ::: "memory"); __builtin_amdgcn_s_barrier(); asm volatile("" ::: "memory");
#pragma unroll
            for (int i = 0; i < 3; ++i) { const int c = F.tid() + 512 * i, row = c / 96, ch = c % 96;
                *(v4u*)(Ko + (size_t)(grp * 16 + row) * 768 + ch * 8) = *(const LAS v4u*)(stg + sb * KVB + row * 1552 + ch * 16); }
#pragma unroll
            for (int i = 0; i < 2; ++i) { const int c = F.tid() + 512 * i, row = c >> 6, ch = c & 63;
                *(v4u*)(Vo + (size_t)(grp * 16 + row) * 512 + ch * 8) = *(const LAS v4u*)(stg + sb * KVB + 16 * 1552 + row * 1040 + ch * 16); }
            sb ^= 1;
        }
        __syncthreads();
    }
}

__device__ __forceinline__ float dpp_scan(float v) {
#define HG_DPP(ctrl, rm) v += __builtin_bit_cast(float, __builtin_amdgcn_update_dpp(0, __builtin_bit_cast(int, v), ctrl, rm, 0xf, false))
    HG_DPP(0x111, 0xf); HG_DPP(0x112, 0xf); HG_DPP(0x114, 0xf); HG_DPP(0x118, 0xf); HG_DPP(0x142, 0xa); HG_DPP(0x143, 0xc);
#undef HG_DPP
    return v;
}
typedef _Float16 f16x8 __attribute__((ext_vector_type(8)));
constexpr int HGL_QT = 0, HGL_KC = 32768, HGL_VP = 65536, HGL_SP = 81920, HGL_DEC = 114688, HGL_DUMP = 116736, HGL_GT = 117760;
__device__ __forceinline__ void hgrn2_scan(Frame& F, char* shm) {
    using att::lds_cptr; using att::vtr; using att::crow;
    const int lane = F.lane(), w = F.wave, r32 = lane & 31, hi = lane >> 5;
    const unsigned lds0 = (unsigned)(uintptr_t)shm; const lds_cptr shm3 = (lds_cptr)shm;
    const int laneoff = ((lane >> 4) & 1) * 32 + (lane & 3) * 8 + (4 * hi + ((lane & 15) >> 2)) * 64;
    const int laneoffS = ((lane >> 4) & 1) * 32 + (lane & 3) * 8 + (8 * hi + ((lane & 15) >> 2)) * 64;
    const int koff = (2 * ((lane >> 4) & 1) + ((lane & 3) >> 1)) * 1024 + (4 * hi + ((lane & 15) >> 2)) * 16 + 8 * (lane & 1);
    const int n16 = lane & 15, q4 = lane >> 4;
    const int goff = ((lane & 3) >> 1) * 1024 + (8 * q4 + ((lane >> 2) & 3)) * 16 + (lane & 1) * 8;
    const int groff = (q4 >> 1) * 1024 + n16 * 16 + (q4 & 1) * 8;
    v4u tri0, tri1; const v4u fones = {0x3C003C00u, 0x3C003C00u, 0x3C003C00u, 0x3C003C00u};
    { const int thr0 = n16 - 8 * q4, thr1 = (q4 < 2) ? 64 : n16 - 8 * (q4 - 2);
#pragma unroll
      for (int p_ = 0; p_ < 4; ++p_) { tri0[p_] = (thr0 >= 2 * p_ + 1) ? 0x3C003C00u : (thr0 == 2 * p_ ? 0x00003C00u : 0u); tri1[p_] = (thr1 >= 2 * p_ + 1) ? 0x3C003C00u : (thr1 == 2 * p_ ? 0x00003C00u : 0u); } }
    for (int item = F.vcu; item < 256; item += F.G) {
        const int vh = item & 1, dir = (item >> 1) & 1, h = (item >> 2) & 3, b = item >> 4;
        const bf16* HQ = (const bf16*)(F.ws + WS_HQ) + h * 128 + 16 * w;
        const unsigned short* GG = (const unsigned short*)(F.ws + (dir ? WS_GB : WS_GF)) + h * 128 + 16 * w;
        const bf16* HI = (const bf16*)(F.ws + WS_HI) + h * 128 + vh * 64;
        bf16* OUT = (bf16*)(F.ws + (dir ? WS_OB : WS_OF)) + h * 128 + vh * 64;
        const int tfirst = b * SEQ + (dir ? SEQ - 1 : 0), tstep = dir ? -1 : 1;
        f32x16 S0 = f32x16{}, S1 = f32x16{};
        v2u hq_n[4], hq_[4], gr_[4]; v4u g_n[2]; f32x4 c_[4]; const unsigned gtw = lds0 + HGL_GT + w * 2048 + lane * 16;
#define HG_VDMA(nn) do { const int vg_ = w >> 2, ig_ = w & 3; const int trow_ = tfirst + tstep * (64 * (nn) + 16 * ig_ + (lane >> 2)); \
            att::glds16(HI + (size_t)trow_ * 512 + vg_ * 32 + (lane & 3) * 8, (unsigned)__builtin_amdgcn_readfirstlane(lds0 + HGL_VP + ((nn) & 1) * 8192 + w * 1024)); } while (0)
#define HG_LOAD(nn) do { const int nl_ = (nn) < SEQ / 64 ? (nn) : SEQ / 64 - 1; const int tb_ = tfirst + tstep * (64 * nl_);        \
            _Pragma("unroll") for (int tj = 0; tj < 4; ++tj) { const bf16* p_ = HQ + (size_t)(tb_ + tstep * (16 * tj + n16)) * 512 + 4 * q4; asm volatile("global_load_dwordx2 %0, %1, off" : "=&v"(hq_n[tj]) : "v"(p_)); } \
            const unsigned short* pg_ = GG + (size_t)(tb_ + tstep * lane) * 512; \
            asm volatile("global_load_dwordx4 %0, %1, off" : "=&v"(g_n[0]) : "v"(pg_)); asm volatile("global_load_dwordx4 %0, %1, off offset:16" : "=&v"(g_n[1]) : "v"(pg_)); } while (0)
#define HG_ROWS_LANDED(cnt) asm volatile("s_waitcnt vmcnt(" #cnt ") lgkmcnt(0)\n\tv_mov_b64 %0, %4\n\tv_mov_b64 %1, %5\n\tv_mov_b64 %2, %6\n\tv_mov_b64 %3, %7\n\tds_write_b128 %8, %9\n\tds_write_b128 %8, %10 offset:1024" \
            : "=&v"(hq_[0]), "=&v"(hq_[1]), "=&v"(hq_[2]), "=&v"(hq_[3]) : "v"(hq_n[0]), "v"(hq_n[1]), "v"(hq_n[2]), "v"(hq_n[3]), "v"(gtw), "v"(g_n[0]), "v"(g_n[1]) : "memory")
#define HG_CUM(nn) do { \
            HG_LOAD((nn) + 1); \
            const lds_cptr gt_ = shm3 + HGL_GT + w * 2048; \
            const s16x4 a0l_ = vtr(gt_ + goff), a0h_ = vtr(gt_ + goff + 64), a1l_ = vtr(gt_ + goff + 512), a1h_ = vtr(gt_ + goff + 576); \
            _Pragma("unroll") for (int tj = 0; tj < 4; ++tj) gr_[tj] = *(const LAS v2u*)(gt_ + groff + tj * 256); \
            const f16x8 A0_ = __builtin_bit_cast(f16x8, (bf16x8){a0l_[0], a0l_[1], a0l_[2], a0l_[3], a0h_[0], a0h_[1], a0h_[2], a0h_[3]}), A1_ = __builtin_bit_cast(f16x8, (bf16x8){a1l_[0], a1l_[1], a1l_[2], a1l_[3], a1h_[0], a1h_[1], a1h_[2], a1h_[3]}); \
            const f32x4 z_ = {0.f, 0.f, 0.f, 0.f}; \
            c_[0] = __builtin_amdgcn_mfma_f32_16x16x32_f16(A0_, __builtin_bit_cast(f16x8, tri0), z_, 0, 0, 0); c_[1] = __builtin_amdgcn_mfma_f32_16x16x32_f16(A0_, __builtin_bit_cast(f16x8, tri1), z_, 0, 0, 0); \
            { const f32x4 cf_ = __builtin_amdgcn_mfma_f32_16x16x32_f16(A0_, __builtin_bit_cast(f16x8, fones), z_, 0, 0, 0); \
              c_[2] = __builtin_amdgcn_mfma_f32_16x16x32_f16(A1_, __builtin_bit_cast(f16x8, tri0), cf_, 0, 0, 0); c_[3] = __builtin_amdgcn_mfma_f32_16x16x32_f16(A1_, __builtin_bit_cast(f16x8, tri1), cf_, 0, 0, 0); } } while (0)
#define HG_FIN(nn) do { const int pp_ = (nn) & 1; \
            _Pragma("unroll") for (int tj = 0; tj < 4; ++tj) { \
                const float q_[4] = {pg8::bf_lo(hq_[tj].x), pg8::bf_hi(hq_[tj].x), pg8::bf_lo(hq_[tj].y), pg8::bf_hi(hq_[tj].y)}; \
                const float gg_[4] = {h2f((unsigned short)(gr_[tj].x & 0xffffu)), h2f((unsigned short)(gr_[tj].x >> 16)), h2f((unsigned short)(gr_[tj].y & 0xffffu)), h2f((unsigned short)(gr_[tj].y >> 16))}; \
                float bq_[4], kk_[4], E_[4]; \
                _Pragma("unroll") for (int i = 0; i < 4; ++i) { const float bsum = c_[tj][i]; E_[i] = fast_exp2(bsum); const float Ei = fast_exp2(-bsum), kx = 1.0f - fast_exp2(gg_[i]); bq_[i] = q_[i] * E_[i]; kk_[i] = kx * Ei; } \
                *(LAS v2u*)(shm3 + HGL_QT + pp_ * 16384 + (2 * w) * 1024 + groff + tj * 256) = (v2u){pk2(bq_[0], bq_[1]), pk2(bq_[2], bq_[3])}; \
                *(LAS v2u*)(shm3 + HGL_KC + pp_ * 16384 + (2 * w) * 1024 + groff + tj * 256) = (v2u){pk2(kk_[0], kk_[1]), pk2(kk_[2], kk_[3])}; \
                if (tj == 3) { if (n16 == 15) *(LAS f32x4*)(shm3 + HGL_DEC + pp_ * 512 + 64 * w + 16 * q4) = (f32x4){E_[0], E_[1], E_[2], E_[3]}; } } } while (0)
        HG_LOAD(0); HG_ROWS_LANDED(0);
        HG_CUM(0); HG_VDMA(0); HG_FIN(0);
        HG_ROWS_LANDED(0); __builtin_amdgcn_s_barrier(); asm volatile("" ::: "memory");
        for (int n = 0; n < SEQ / 64; ++n) {
            unsigned long long th0_ = 0, th1_ = 0, th2_ = 0, th3_ = 0; (void)th0_; (void)th1_; (void)th2_; (void)th3_; TP_NOW(th0_);
            const int par = n & 1;
            const int qtc = HGL_QT + par * 16384, kcc = HGL_KC + par * 16384, vpc = HGL_VP + par * 8192, spc = HGL_SP + par * 16384, spn = HGL_SP + (par ^ 1) * 16384, decc = HGL_DEC + par * 512;
            HG_CUM(n + 1);
            if (n + 1 < SEQ / 64) HG_VDMA(n + 1);
            if (w < 4) {
                const int tb = w >> 1, vb = w & 1;
                S0 = f32x16{};
                bf16x8 qf[8];
#pragma unroll
                for (int kd = 0; kd < 8; ++kd) qf[kd] = *(const LAS bf16x8*)(shm3 + qtc + (2 * kd + hi) * 1024 + (32 * tb + r32) * 16);
                {
                    bf16x8 kf[8], kg[8]; s16x4 vl[2], vh_[2], ul[2], uh_[2];
#pragma unroll
                    for (int kd = 0; kd < 8; ++kd) kf[kd] = *(const LAS bf16x8*)(shm3 + kcc + (2 * kd + hi) * 1024 + (32 * tb + r32) * 16);
#pragma unroll
                    for (int ks = 0; ks < 2; ++ks) { vl[ks] = vtr(shm3 + vpc + (vb * 4 + 2 * tb + ks) * 1024 + laneoff); vh_[ks] = vtr(shm3 + vpc + (vb * 4 + 2 * tb + ks) * 1024 + laneoff + 512); }
                    S1 = f32x16{};
#pragma unroll
                    for (int kd = 0; kd < 8; ++kd) S1 = __builtin_amdgcn_mfma_f32_32x32x16_bf16(kf[kd], qf[kd], S1, 0, 0, 0);
                    if (tb == 1) {
#pragma unroll
                        for (int kd = 0; kd < 8; ++kd) kg[kd] = *(const LAS bf16x8*)(shm3 + kcc + (2 * kd + hi) * 1024 + r32 * 16);
#pragma unroll
                        for (int ks = 0; ks < 2; ++ks) { ul[ks] = vtr(shm3 + vpc + (vb * 4 + ks) * 1024 + laneoff); uh_[ks] = vtr(shm3 + vpc + (vb * 4 + ks) * 1024 + laneoff + 512); }
                    }
#pragma unroll
                    for (int r = 0; r < 16; ++r) if (crow(r, hi) > r32) S1[r] = 0.f;
                    { const v4u pw0 = (v4u){pk2(S1[0], S1[1]), pk2(S1[2], S1[3]), pk2(S1[4], S1[5]), pk2(S1[6], S1[7])}, pw1 = (v4u){pk2(S1[8], S1[9]), pk2(S1[10], S1[11]), pk2(S1[12], S1[13]), pk2(S1[14], S1[15])};
#pragma unroll
                      for (int ks = 0; ks < 2; ++ks)
                        S0 = __builtin_amdgcn_mfma_f32_32x32x16_bf16(__builtin_bit_cast(bf16x8, ks ? pw1 : pw0), (bf16x8){vl[ks][0], vl[ks][1], vl[ks][2], vl[ks][3], vh_[ks][0], vh_[ks][1], vh_[ks][2], vh_[ks][3]}, S0, 0, 0, 0); }
                    if (tb == 1) {
                        S1 = f32x16{};
#pragma unroll
                        for (int kd = 0; kd < 8; ++kd) S1 = __builtin_amdgcn_mfma_f32_32x32x16_bf16(kg[kd], qf[kd], S1, 0, 0, 0);
                        const v4u pw0 = (v4u){pk2(S1[0], S1[1]), pk2(S1[2], S1[3]), pk2(S1[4], S1[5]), pk2(S1[6], S1[7])}, pw1 = (v4u){pk2(S1[8], S1[9]), pk2(S1[10], S1[11]), pk2(S1[12], S1[13]), pk2(S1[14], S1[15])};
#pragma unroll
                        for (int ks = 0; ks < 2; ++ks)
                            S0 = __builtin_amdgcn_mfma_f32_32x32x16_bf16(__builtin_bit_cast(bf16x8, ks ? pw1 : pw0), (bf16x8){ul[ks][0], ul[ks][1], ul[ks][2], ul[ks][3], uh_[ks][0], uh_[ks][1], uh_[ks][2], uh_[ks][3]}, S0, 0, 0, 0);
                    }
                }
                if (n > 0) {
                    s16x4 sl[8], sh[8];
#pragma unroll
                    for (int kd = 0; kd < 8; ++kd) { sl[kd] = vtr(shm3 + spc + (vb * 8 + kd) * 1024 + laneoffS); sh[kd] = vtr(shm3 + spc + (vb * 8 + kd) * 1024 + laneoffS + 256); }
#pragma unroll
                    for (int kd = 0; kd < 8; ++kd)
                        S0 = __builtin_amdgcn_mfma_f32_32x32x16_bf16(qf[kd], (bf16x8){sl[kd][0], sl[kd][1], sl[kd][2], sl[kd][3], sh[kd][0], sh[kd][1], sh[kd][2], sh[kd][3]}, S0, 0, 0, 0);
                }
                TP_NOW(th1_);
                if (n + 1 < SEQ / 64) HG_FIN(n + 1);
                TP_NOW(th2_);
#pragma unroll
                for (int r = 0; r < 16; r += 2) { const unsigned w_ = att::cvtpk_s(S0[r], S0[r + 1]);
                    const int i0 = 32 * tb + crow(r, hi), i1 = 32 * tb + crow(r + 1, hi);
                    OUT[(size_t)(tfirst + tstep * (64 * n + i0)) * 512 + vb * 32 + r32] = (bf16)(w_ & 0xffffu); OUT[(size_t)(tfirst + tstep * (64 * n + i1)) * 512 + vb * 32 + r32] = (bf16)(w_ >> 16); }
            } else {
                const int db = w - 4;
                if (n + 1 < SEQ / 64) HG_FIN(n + 1);
                s16x4 kl[4], kh_[4], v0l[4], v0h[4], v1l[4], v1h[4];
#pragma unroll
                for (int ig = 0; ig < 4; ++ig) {
                    kl[ig] = vtr(shm3 + kcc + (4 * db) * 1024 + ig * 256 + koff); kh_[ig] = vtr(shm3 + kcc + (4 * db) * 1024 + ig * 256 + koff + 128);
                    v0l[ig] = vtr(shm3 + vpc + (0 * 4 + ig) * 1024 + laneoff); v0h[ig] = vtr(shm3 + vpc + (0 * 4 + ig) * 1024 + laneoff + 512);
                    v1l[ig] = vtr(shm3 + vpc + (1 * 4 + ig) * 1024 + laneoff); v1h[ig] = vtr(shm3 + vpc + (1 * 4 + ig) * 1024 + laneoff + 512); }
#pragma unroll
                for (int ig = 0; ig < 4; ++ig) {
                    const bf16x8 ka = (bf16x8){kl[ig][0], kl[ig][1], kl[ig][2], kl[ig][3], kh_[ig][0], kh_[ig][1], kh_[ig][2], kh_[ig][3]};
                    S0 = __builtin_amdgcn_mfma_f32_32x32x16_bf16(ka, (bf16x8){v0l[ig][0], v0l[ig][1], v0l[ig][2], v0l[ig][3], v0h[ig][0], v0h[ig][1], v0h[ig][2], v0h[ig][3]}, S0, 0, 0, 0);
                    S1 = __builtin_amdgcn_mfma_f32_32x32x16_bf16(ka, (bf16x8){v1l[ig][0], v1l[ig][1], v1l[ig][2], v1l[ig][3], v1h[ig][0], v1h[ig][1], v1h[ig][2], v1h[ig][3]}, S1, 0, 0, 0);
                }
                TP_NOW(th1_);
                TP_NOW(th2_);
#pragma unroll
                for (int r = 0; r < 16; ++r) { const int d = 32 * db + crow(r, hi); const float dc = ((const LAS float*)(shm3 + decc))[d]; S0[r] *= dc; S1[r] *= dc;
                    const unsigned w_ = att::cvtpk_s(S0[r], S1[r]);
                    *(LAS bf16*)(shm3 + spn + (0 * 8 + (d >> 4)) * 1024 + (d & 15) * 64 + r32 * 2) = (bf16)(w_ & 0xffffu);
                    *(LAS bf16*)(shm3 + spn + (1 * 8 + (d >> 4)) * 1024 + (d & 15) * 64 + r32 * 2) = (bf16)(w_ >> 16); }
            }
            if (n + 2 < SEQ / 64) { if (w < 4) HG_ROWS_LANDED(16); else HG_ROWS_LANDED(0); }
            else HG_ROWS_LANDED(0);
            __builtin_amdgcn_s_barrier(); asm volatile("" ::: "memory");
            TP_NOW(th3_);
#if MK_TPROBE
            TP_ADD((LAS unsigned char*)shm3, w, 1, th0_, th3_);
            if (MK_TPHG == 0) TP_ADD((LAS unsigned char*)shm3, w, 0, th0_, th1_); else if (MK_TPHG == 1) TP_ADD((LAS unsigned char*)shm3, w, 0, th1_, th2_); else TP_ADD((LAS unsigned char*)shm3, w, 0, th2_, th3_);
#endif
        }
#undef HG_VDMA
#undef HG_LOAD
#undef HG_ROWS_LANDED
#undef HG_CUM
#undef HG_FIN
    }
}
__device__ __forceinline__ void hg_combine(Frame& F, const Inputs& in) {
    const int gw = F.vcu * NWAVES + F.wave, NGW = F.G * NWAVES, lane = F.lane();
    const bf16* OFp = (const bf16*)(F.ws + WS_OF); const bf16* OBp = (const bf16*)(F.ws + WS_OB); const bf16* HG = (const bf16*)(F.ws + WS_HG); bf16* CAT = (bf16*)(F.ws + WS_CAT);
    float on[8];
#pragma unroll
    for (int e = 0; e < 8; ++e) on[e] = in.o_norm[(lane & 15) * 8 + e];
    for (int t = gw; t < T; t += NGW) {
        const v4u a = *(const v4u*)(OFp + (size_t)t * 512 + lane * 8), bq = *(const v4u*)(OBp + (size_t)t * 512 + lane * 8), gq = *(const v4u*)(HG + (size_t)t * 512 + lane * 8);
        float x[8], ss = 0.f;
#pragma unroll
        for (int e = 0; e < 4; ++e) { x[2 * e] = pg8::bf_lo(a[e]) + pg8::bf_lo(bq[e]); x[2 * e + 1] = pg8::bf_hi(a[e]) + pg8::bf_hi(bq[e]); ss += x[2 * e] * x[2 * e] + x[2 * e + 1] * x[2 * e + 1]; }
        ss += __shfl_xor(ss, 1); ss += __shfl_xor(ss, 2); ss += __shfl_xor(ss, 4); ss += __shfl_xor(ss, 8);
        const float r = rsq(ss * (1.f / 128.f) + EPS);
        v4u o;
#pragma unroll
        for (int e = 0; e < 4; ++e) o[e] = pk2(x[2 * e] * r * on[2 * e] * pg8::bf_lo(gq[e]), x[2 * e + 1] * r * on[2 * e + 1] * pg8::bf_hi(gq[e]));
        *(v4u*)(CAT + (size_t)t * 1024 + 512 + lane * 8) = o;
    }
}
__device__ __forceinline__ void moe_route(Frame& F, const int tok0, const int ntok) {
    const int gt = tok0 + F.tid(), NGT = NWAVES * 64;
    const float* LG = (const float*)(F.ws + WS_LG); int* rec = (int*)(F.ws + WS_REC);
    int* bk = rec; int* ps = rec + T; float* wA = (float*)(rec + 2 * T); float* wB = (float*)(rec + 3 * T);
    LAS unsigned* lcnt = (LAS unsigned*)(F.lds + RING_OFF); LAS unsigned* lbase = lcnt + 512;
    for (int tokc = tok0; tokc < tok0 + ntok; tokc += NGT) {
    __syncthreads();
    lcnt[F.tid()] = 0u;
    __syncthreads();
    const int tok = tokc + F.tid(); const bool live = tok < tok0 + ntok;
    int bucket = 0; unsigned lrank = 0u; float wAv = 0.f, wBv = 0.f;
    if (live) {
        const float* l = LG + (size_t)tok * 72;
        float gl[8]; { const f32x4 a = *(const f32x4*)l, b = *(const f32x4*)(l + 4); gl[0] = a[0]; gl[1] = a[1]; gl[2] = a[2]; gl[3] = a[3]; gl[4] = b[0]; gl[5] = b[1]; gl[6] = b[2]; gl[7] = b[3]; }
        float mx = gl[0]; int gs = 0;
#pragma unroll
        for (int g = 1; g < 8; ++g) if (gl[g] > mx) { mx = gl[g]; gs = g; }
        float den = 0.f;
#pragma unroll
        for (int g = 0; g < 8; ++g) den += expf(gl[g] - mx);
        const float gwt = 1.0f / den;
        float el[8]; { const f32x4 a = *(const f32x4*)(l + 8 + gs * 8), b = *(const f32x4*)(l + 12 + gs * 8); el[0] = a[0]; el[1] = a[1]; el[2] = a[2]; el[3] = a[3]; el[4] = b[0]; el[5] = b[1]; el[6] = b[2]; el[7] = b[3]; }
        int i0 = 0; float m0 = el[0];
#pragma unroll
        for (int e = 1; e < 8; ++e) if (el[e] > m0) { m0 = el[e]; i0 = e; }
        int i1 = -1; float m1 = -INFINITY;
#pragma unroll
        for (int e = 0; e < 8; ++e) if (e != i0 && el[e] > m1) { m1 = el[e]; i1 = e; }
        if (i1 < 0) i1 = (i0 == 0) ? 1 : 0;
        const float e1 = expf(m1 - m0); const float wa = gwt / (1.0f + e1), wb = gwt * e1 / (1.0f + e1);
        const int ea = i0 < i1 ? i0 : i1, eb = i0 < i1 ? i1 : i0;
        bucket = gs * 64 + ea * 8 + eb;
        lrank = __hip_atomic_fetch_add((unsigned*)(lcnt + bucket), 1u, __ATOMIC_RELAXED, __HIP_MEMORY_SCOPE_WORKGROUP);
        wAv = i0 < i1 ? wa : wb; wBv = i0 < i1 ? wb : wa;
    }
    __syncthreads();
    { const unsigned c_ = lcnt[F.tid()]; if (c_ != 0u) lbase[F.tid()] = __hip_atomic_fetch_add((unsigned*)(F.ctl + CW_CNTP) + F.tid() * 32, c_, RLX_AGENT); }
    __syncthreads();
    if (live) { bk[tok] = bucket; ps[tok] = (int)(lbase[bucket] + lrank); wA[tok] = wAv; wB[tok] = wBv; }
    }
    __syncthreads();
}
__device__ __forceinline__ void moe_place(Frame& F) {
    LAS int* cn_s = (LAS int*)(F.lds + RING_OFF); LAS int* ts_s = cn_s + 512; LAS int* ba_s = cn_s + 1024; LAS int* bb_s = cn_s + 1536; LAS int* ne_s = cn_s + 2048; LAS int* te_s = cn_s + 2112;
    const int t = F.tid();
    const int cnt = (int)__hip_atomic_load((unsigned*)(F.ctl + CW_CNTP) + t * 32, RLX_AGENT);
    cn_s[t] = cnt;
    __syncthreads();
    const int g = t >> 6, ea = (t >> 3) & 7, eb = t & 7;
    int st = 0;
    for (int j = 0; j < t; ++j) st += (cn_s[j] + 255) >> 8;
    ts_s[t] = st;
    int ba = 0, bb = 0;
    for (int j = g * 64; j < t; ++j) { const int ja = (j >> 3) & 7, jb = j & 7; const int c = cn_s[j]; if (ja == ea || jb == ea) ba += c; if (ja == eb || jb == eb) bb += c; }
    ba_s[t] = ba; bb_s[t] = bb;
    int cntE = 0;
    if (t < 64) { const int x = t & 7; for (int j = (t >> 3) * 64; j < (t >> 3) * 64 + 64; ++j) { const int ja = (j >> 3) & 7, jb = j & 7; if (ja < jb && (ja == x || jb == x)) cntE += cn_s[j]; } ne_s[t] = (cntE + 255) >> 8; }
    __syncthreads();
    int ste = 0;
    if (t < 64) { for (int j = 0; j < t; ++j) ste += ne_s[j]; te_s[t] = ste; }
    __syncthreads();
    unsigned char* rec = F.ws + WS_REC;
    int* rowpa = (int*)(rec + REC_ROWPA); int* rowpb = (int*)(rec + REC_ROWPB); int* rowp = (int*)(rec + REC_ROWP); int* tilep = (int*)(rec + REC_TILEP); int* rowe = (int*)(rec + REC_ROWE); float* wslot = (float*)(rec + REC_WSLOT); int* tilee = (int*)(rec + REC_TILEE);
    if (blockIdx.x == 0) {
        const int ntb = (cnt + 255) >> 8;
        for (int k = 0; k < ntb; ++k) tilep[st + k] = t;
        for (int r = cnt; r < ntb * 256; ++r) { rowp[st * 256 + r] = -1; rowpa[st * 256 + r] = 0; rowpb[st * 256 + r] = 0; }
        if (t == 511) __hip_atomic_store((unsigned*)(F.ctl + CW_NT), (unsigned)(st + ntb), RLX_AGENT);
        if (t < 64) { const int nte = (cntE + 255) >> 8;
            for (int k = 0; k < nte; ++k) tilee[ste + k] = t;
            for (int r = cntE; r < nte * 256; ++r) { rowe[ste * 256 + r] = -1; wslot[ste * 256 + r] = 0.f; }
            if (t == 63) __hip_atomic_store((unsigned*)(F.ctl + CW_NTE), (unsigned)(ste + nte), RLX_AGENT); }
    }
    const int gt = (F.vcu * NWAVES + F.wave) * 64 + F.lane(), NGT = F.G * NWAVES * 64;
    const int* ri = (const int*)rec; int* wi = (int*)rec;
    for (int tok = gt; tok < T; tok += NGT) {
        const int bkt = ri[tok], pos = ri[T + tok];
        rowp[ts_s[bkt] * 256 + pos] = tok;
        const int eag = (bkt >> 6) * 8 + ((bkt >> 3) & 7), ebg = (bkt >> 6) * 8 + (bkt & 7);
        const int sa = te_s[eag] * 256 + ba_s[bkt] + pos, sb = te_s[ebg] * 256 + bb_s[bkt] + pos;
        rowe[sa] = tok; rowe[sb] = tok; wslot[sa] = __int_as_float(ri[2 * T + tok]); wslot[sb] = __int_as_float(ri[3 * T + tok]);
        rowpa[ts_s[bkt] * 256 + pos] = sa; rowpb[ts_s[bkt] * 256 + pos] = sb;
    }
    __syncthreads();
}
#ifndef MK_WGM1
#define MK_WGM1 8
#endif
__device__ __forceinline__ void phase_0(Frame& F, const Inputs& in, float* d_out_, unsigned char* ws, unsigned char* lds) {
    LAS float* RS = (LAS float*)(F.lds + AUX_RS); LAS float* WG = (LAS float*)(F.lds + AUX_WG); LAS int* TOK = (LAS int*)(F.lds + AUX_TOK); LAS float* XP = (LAS float*)(F.lds + AUX_XP);
    const float* misc = (const float*)(ws + WS_MISC); (void)RS; (void)WG; (void)TOK; (void)XP; (void)misc;
 p0_prologue(F, in);
}
__device__ __forceinline__ void phase_1(Frame& F, const Inputs& in, float* d_out_, unsigned char* ws, unsigned char* lds) {
    LAS float* RS = (LAS float*)(F.lds + AUX_RS); LAS float* WG = (LAS float*)(F.lds + AUX_WG); LAS int* TOK = (LAS int*)(F.lds + AUX_TOK); LAS float* XP = (LAS float*)(F.lds + AUX_XP);
    const float* misc = (const float*)(ws + WS_MISC); (void)RS; (void)WG; (void)TOK; (void)XP; (void)misc;
        SchedGrid S; S.pad_ = 0; S.o.init(T / 256, 12, F.G, (int)blockIdx.x, MK_WGM1); S.A = (const char*)(ws + WS_XN); S.B = (const char*)(ws + W_IN); S.astep = (size_t)256 * 1024 * 2; S.bstep = (size_t)256 * 1024 * 2;
        EpiIn E{(bf16_t*)(ws + WS_HQ), (const float*)(ws + WS_SS0), misc, RS, 0};
        pg8::gemm_phase<EpiIn, SchedGrid, true, 0, 1024, 1024, 1024, 16>(F.lds + RING_OFF, S, E);
#ifdef MK_PROBE_P1CHEAP
        { __syncthreads(); EpiIn E2{(bf16_t*)(ws + WS_Q), (const float*)(ws + WS_SS0), misc, RS, MK_PROBE_P1CHEAP}; pg8::gemm_phase<EpiIn, SchedGrid, true, 0, 1024, 1024, 1024, 16>(F.lds + RING_OFF, S, E2); }
#endif

}
__device__ __forceinline__ void phase_2(Frame& F, const Inputs& in, float* d_out_, unsigned char* ws, unsigned char* lds) {
    LAS float* RS = (LAS float*)(F.lds + AUX_RS); LAS float* WG = (LAS float*)(F.lds + AUX_WG); LAS int* TOK = (LAS int*)(F.lds + AUX_TOK); LAS float* XP = (LAS float*)(F.lds + AUX_XP);
    const float* misc = (const float*)(ws + WS_MISC); (void)RS; (void)WG; (void)TOK; (void)XP; (void)misc;
#ifdef MK_TPROBE_MLA
        TP_SET(F.lds, 1u);
#endif
#ifdef MK_TPS_MLA
        { TPS_BEGIN(); mla_proj(F, in); TPS_END(F); }
#else
        mla_proj(F, in);
#endif
#ifdef MK_TPROBE_MLA
        TP_SET(F.lds, 0u);
#endif
#ifdef MK_REP_MLA
        mla_proj(F, in);
#endif
        { SchedGrid S; S.pad_ = 0; S.o.init(16, 8, F.G, (int)blockIdx.x); S.A = (const char*)(ws + WS_MN); S.B = (const char*)(ws + W_XKV); S.astep = (size_t)256 * 1024 * 2; S.bstep = (size_t)256 * 1024 * 2;
          EpiHeadNorm E{nullptr, in.x_k_norm, (bf16_t*)(ws + WS_KVX), RS, XP, 1.0f, 2048, 4, 0};
          pg8::gemm_phase<EpiHeadNorm, SchedGrid, true, 0, 1024, 1024, 1024, 16>(F.lds + RING_OFF, S, E); }
        __syncthreads();
#if defined(MK_TPHG)
        TP_SET(F.lds, 1u); hgrn2_scan(F, (char*)lds + RING_OFF); TP_SET(F.lds, 0u);
#elif defined(MK_TPS_HG)
        { TPS_BEGIN(); hgrn2_scan(F, (char*)lds + RING_OFF); TPS_END(F); }
#else
        hgrn2_scan(F, (char*)lds + RING_OFF);
#endif
#ifdef MK_REP_HG
        __syncthreads(); hgrn2_scan(F, (char*)lds + RING_OFF);
#endif

}
__device__ __forceinline__ void phase_3(Frame& F, const Inputs& in, float* d_out_, unsigned char* ws, unsigned char* lds) {
    LAS float* RS = (LAS float*)(F.lds + AUX_RS); LAS float* WG = (LAS float*)(F.lds + AUX_WG); LAS int* TOK = (LAS int*)(F.lds + AUX_TOK); LAS float* XP = (LAS float*)(F.lds + AUX_XP);
    const float* misc = (const float*)(ws + WS_MISC); (void)RS; (void)WG; (void)TOK; (void)XP; (void)misc;
        hg_combine(F, in);
        const float cb = misc[1024];
        if (cb < 64.f) {
        for (int un = F.vcu; un < BATCH * 8 * 8; un += F.G) {
            const int qb = un & 7, bh = un >> 3, b = bh >> 3, h = bh & 7;
            att::Tensors Tn; Tn.Q = (const bf16*)(ws + WS_Q) + (size_t)b * SEQ * 768 + h * 96; Tn.K = (const bf16*)(ws + WS_K) + (size_t)b * SEQ * 768 + h * 96;
            Tn.V = (const bf16*)(ws + WS_V) + (size_t)b * SEQ * 512 + h * 64; Tn.O = (bf16*)(ws + WS_CAT) + (size_t)b * SEQ * 1024 + h * 64; Tn.qp = 768; Tn.kp = 768; Tn.vp = 512; Tn.op = 1024;
            att::unit3<6, 2>(Tn, qb * 512, SEQ / 64, (char*)lds + RING_OFF, (LAS float*)(F.lds + AUX_WSF));
        }
        } else {
        for (int un = F.vcu; un < BATCH * 8 * 16; un += F.G) {
            const int qb = un & 15, bh = un >> 4, b = bh >> 3, h = bh & 7;
            att::Tensors Tn; Tn.Q = (const bf16*)(ws + WS_Q) + (size_t)b * SEQ * 768 + h * 96; Tn.K = (const bf16*)(ws + WS_K) + (size_t)b * SEQ * 768 + h * 96;
            Tn.V = (const bf16*)(ws + WS_V) + (size_t)b * SEQ * 512 + h * 64; Tn.O = (bf16*)(ws + WS_CAT) + (size_t)b * SEQ * 1024 + h * 64; Tn.qp = 768; Tn.kp = 768; Tn.vp = 512; Tn.op = 1024;
            att::unit<6, 2, 2, 8, true, false>(Tn, qb * 256, SEQ / 64, cb, (char*)lds + RING_OFF, (LAS float*)(F.lds + AUX_WSF));
        }
        }

}
__device__ __forceinline__ void phase_4(Frame& F, const Inputs& in, float* d_out_, unsigned char* ws, unsigned char* lds) {
    LAS float* RS = (LAS float*)(F.lds + AUX_RS); LAS float* WG = (LAS float*)(F.lds + AUX_WG); LAS int* TOK = (LAS int*)(F.lds + AUX_TOK); LAS float* XP = (LAS float*)(F.lds + AUX_XP);
    const float* misc = (const float*)(ws + WS_MISC); (void)RS; (void)WG; (void)TOK; (void)XP; (void)misc;
    SchedGrid S; S.pad_ = 0; S.o.init(T / 256, 4, F.G, (int)blockIdx.x); S.A = (const char*)(ws + WS_CAT); S.B = (const char*)(ws + W_OUT); S.astep = (size_t)256 * 1024 * 2; S.bstep = (size_t)256 * 1024 * 2;
    EpiRes<XN0_KEPT> E{XN0_KEPT ? (const void*)(ws + WS_XN) : (const void*)in.x, (bf16_t*)(ws + WS_XN), (float*)(ws + WS_SSP1)};
    pg8::gemm_phase<EpiRes<XN0_KEPT>, SchedGrid, true, 0, 1024, 1024, 1024, 16>(F.lds + RING_OFF, S, E);
}
__device__ __forceinline__ void phase_5(Frame& F, const Inputs& in, float* d_out_, unsigned char* ws, unsigned char* lds) {
    LAS float* RS = (LAS float*)(F.lds + AUX_RS); LAS float* WG = (LAS float*)(F.lds + AUX_WG); LAS int* TOK = (LAS int*)(F.lds + AUX_TOK); LAS float* XP = (LAS float*)(F.lds + AUX_XP);
    const float* misc = (const float*)(ws + WS_MISC); (void)RS; (void)WG; (void)TOK; (void)XP; (void)misc;
    SchedGrid S; S.pad_ = 0; S.o.init(T / 256, 4, F.G, (int)blockIdx.x); S.A = (const char*)(ws + WS_XN); S.B = (const char*)(ws + W_XQ); S.astep = (size_t)256 * 1024 * 2; S.bstep = (size_t)256 * 1024 * 2;
    { EpiHeadNorm E{(const float*)(ws + WS_SSP1), in.x_q_norm, (bf16_t*)(ws + WS_QX), RS, XP, 0.0625f * LOG2E, 1024, 4, 0};
      pg8::gemm_phase<EpiHeadNorm, SchedGrid, true, 0, 1024, 1024, 1024, 16>(F.lds + RING_OFF, S, E); }
    asm volatile("s_waitcnt vmcnt(0) lgkmcnt(0)" ::: "memory"); __syncthreads(); __builtin_amdgcn_fence(__ATOMIC_ACQUIRE, "agent"); asm volatile("s_waitcnt vmcnt(0)" ::: "memory"); __syncthreads();
    const float cb = misc[1025];
    for (int i = 0;; ++i) { int pm, h; if (!S.o.tile(i, pm, h)) break;
        const int b = pm >> 4, q0 = (pm & 15) * 256;
        att::Tensors Tn; Tn.Q = (const bf16*)(ws + WS_QX) + (size_t)b * SEQ * 1024 + h * 256; Tn.K = (const bf16*)(ws + WS_KVX) + (size_t)b * MEML * 2048 + h * 256;
        Tn.V = (const bf16*)(ws + WS_KVX) + (size_t)b * MEML * 2048 + 1024 + h * 256; Tn.O = (bf16*)(ws + WS_QX) + (size_t)b * SEQ * 1024 + h * 256; Tn.qp = 1024; Tn.kp = 2048; Tn.vp = 2048; Tn.op = 1024;
        att::unit<16, 8, 8, 8, true, true>(Tn, q0, MEML / 64, cb, (char*)lds + RING_OFF, (LAS float*)(F.lds + AUX_WSF)); }
}
__device__ __forceinline__ void phase_6(Frame& F, const Inputs& in, float* d_out_, unsigned char* ws, unsigned char* lds) {
    LAS float* RS = (LAS float*)(F.lds + AUX_RS); LAS float* WG = (LAS float*)(F.lds + AUX_WG); LAS int* TOK = (LAS int*)(F.lds + AUX_TOK); LAS float* XP = (LAS float*)(F.lds + AUX_XP);
    const float* misc = (const float*)(ws + WS_MISC); (void)RS; (void)WG; (void)TOK; (void)XP; (void)misc;
}
__device__ __forceinline__ void phase_7(Frame& F, const Inputs& in, float* d_out_, unsigned char* ws, unsigned char* lds) {
    LAS float* RS = (LAS float*)(F.lds + AUX_RS); LAS float* WG = (LAS float*)(F.lds + AUX_WG); LAS int* TOK = (LAS int*)(F.lds + AUX_TOK); LAS float* XP = (LAS float*)(F.lds + AUX_XP);
    const float* misc = (const float*)(ws + WS_MISC); (void)RS; (void)WG; (void)TOK; (void)XP; (void)misc;
    SchedGrid S; S.pad_ = 0; S.o.init(T / 256, 4, F.G, (int)blockIdx.x); S.A = (const char*)(ws + WS_QX); S.B = (const char*)(ws + W_XO); S.astep = (size_t)256 * 1024 * 2; S.bstep = (size_t)256 * 1024 * 2;
    EpiRes<true> E{(const void*)(ws + WS_XN), (bf16_t*)(ws + WS_XN), (float*)(ws + WS_SSP2)};
    pg8::gemm_phase<EpiRes<true>, SchedGrid, true, 0, 1024, 1024, 1024, 16>(F.lds + RING_OFF, S, E);
}
__device__ __forceinline__ void phase_8(Frame& F, const Inputs& in, float* d_out_, unsigned char* ws, unsigned char* lds) {
    LAS float* RS = (LAS float*)(F.lds + AUX_RS); LAS float* WG = (LAS float*)(F.lds + AUX_WG); LAS int* TOK = (LAS int*)(F.lds + AUX_TOK); LAS float* XP = (LAS float*)(F.lds + AUX_XP);
    const float* misc = (const float*)(ws + WS_MISC); (void)RS; (void)WG; (void)TOK; (void)XP; (void)misc;
    { SchedGrid S; S.pad_ = 0; S.o.init(T / 256, 1, F.G, (int)blockIdx.x); S.A = (const char*)(ws + WS_XN); S.B = (const char*)(ws + W_R); S.astep = (size_t)256 * 1024 * 2; S.bstep = 0;
      EpiRouter E{(const float*)(ws + WS_SSP2), in.b_group, in.b_expert, (float*)(ws + WS_LG), RS, 0};
      pg8::gemm_phase<EpiRouter, SchedGrid, true, 0, 1024, 1024, 1024, 16>(F.lds + RING_OFF, S, E);
      __syncthreads(); __builtin_amdgcn_fence(__ATOMIC_ACQUIRE, "agent"); asm volatile("s_waitcnt vmcnt(0)" ::: "memory"); __syncthreads();
      for (int i = 0;; ++i) { int pm, pn; if (!S.o.tile(i, pm, pn)) break; moe_route(F, pm * 256, 256); } }
}
__device__ __forceinline__ void phase_9(Frame& F, const Inputs& in, float* d_out_, unsigned char* ws, unsigned char* lds) {
    LAS float* RS = (LAS float*)(F.lds + AUX_RS); LAS float* WG = (LAS float*)(F.lds + AUX_WG); LAS int* TOK = (LAS int*)(F.lds + AUX_TOK); LAS float* XP = (LAS float*)(F.lds + AUX_XP);
    const float* misc = (const float*)(ws + WS_MISC); (void)RS; (void)WG; (void)TOK; (void)XP; (void)misc;
}
__device__ __forceinline__ void phase_10(Frame& F, const Inputs& in, float* d_out_, unsigned char* ws, unsigned char* lds) {
    LAS float* RS = (LAS float*)(F.lds + AUX_RS); LAS float* WG = (LAS float*)(F.lds + AUX_WG); LAS int* TOK = (LAS int*)(F.lds + AUX_TOK); LAS float* XP = (LAS float*)(F.lds + AUX_XP);
    const float* misc = (const float*)(ws + WS_MISC); (void)RS; (void)WG; (void)TOK; (void)XP; (void)misc;
 moe_place(F);
}
__device__ __forceinline__ void phase_11(Frame& F, const Inputs& in, float* d_out_, unsigned char* ws, unsigned char* lds) {
    LAS float* RS = (LAS float*)(F.lds + AUX_RS); LAS float* WG = (LAS float*)(F.lds + AUX_WG); LAS int* TOK = (LAS int*)(F.lds + AUX_TOK); LAS float* XP = (LAS float*)(F.lds + AUX_XP);
    const float* misc = (const float*)(ws + WS_MISC); (void)RS; (void)WG; (void)TOK; (void)XP; (void)misc;
        SchedMoeA S; S.pad_ = 0; S.ntile = __builtin_amdgcn_readfirstlane((int)__hip_atomic_load((unsigned*)(F.ctl + CW_NTE), RLX_AGENT)); S.G = F.G; S.c = F.vcu;
        S.tilee = (const int*)(ws + WS_REC + REC_TILEE); S.rowe = (const int*)(ws + WS_REC + REC_ROWE); S.XN = (const char*)(ws + WS_XN); S.WGU = (const char*)(ws + WS_WGU);
        EpiMoeA E{(const float*)(ws + WS_SSP2), (const float*)(ws + WS_REC + REC_WSLOT), (bf16_t*)(ws + WS_H), RS, WG};
        pg8::gemm_phase<EpiMoeA, SchedMoeA, true, 1, 1024, 1024, 1024, 16>(F.lds + RING_OFF, S, E);
}
__device__ __forceinline__ void phase_12(Frame& F, const Inputs& in, float* d_out_, unsigned char* ws, unsigned char* lds) {
    LAS float* RS = (LAS float*)(F.lds + AUX_RS); LAS float* WG = (LAS float*)(F.lds + AUX_WG); LAS int* TOK = (LAS int*)(F.lds + AUX_TOK); LAS float* XP = (LAS float*)(F.lds + AUX_XP);
    const float* misc = (const float*)(ws + WS_MISC); (void)RS; (void)WG; (void)TOK; (void)XP; (void)misc;
        SchedMoeB S; S.pad_ = 0; S.ntile = __builtin_amdgcn_readfirstlane((int)__hip_atomic_load((unsigned*)(F.ctl + CW_NT), RLX_AGENT)); S.G = F.G; S.c = F.vcu;
        S.tilep = (const int*)(ws + WS_REC + REC_TILEP); S.rowp = (const int*)(ws + WS_REC + REC_ROWP); S.slotA = (const int*)(ws + WS_REC + REC_ROWPA); S.slotB = (const int*)(ws + WS_REC + REC_ROWPB);
        S.Hb = (const char*)(ws + WS_H); S.WD = (const char*)(ws + WS_WD);
        EpiMoeB E{(const bf16_t*)(ws + WS_XN), d_out_, TOK, 0};
        pg8::gemm_phase<EpiMoeB, SchedMoeB, true, 2, 512, 256, 256, 4>(F.lds + RING_OFF, S, E);
}

constexpr int N_PHASES = 13;
struct Args { Inputs in; float* out; unsigned char* ws; int ph_lo, ph_hi; };
__global__ void __launch_bounds__(NWAVES * 64, 2) mega_fwd(Args args) {
    extern __shared__ __attribute__((aligned(16))) unsigned char lds[];
    Frame F;
    F.lds = (LAS unsigned char*)lds;
    F.MISC = (volatile LAS unsigned*)(F.lds + MISC_OFF);
    F.wave = __builtin_amdgcn_readfirstlane((int)threadIdx.x >> 6);
    F.G = gridDim.x; { const int bx = blockIdx.x; F.vcu = (F.G % 8 == 0) ? (bx % 8) * (F.G / 8) + bx / 8 : bx; }
    F.ws = args.ws; F.ctl = (gu32*)(args.ws + WS_CTL);
    const Inputs& in = args.in;
    unsigned char* ws = args.ws;
    for (int u = F.tid(); u < 32; u += NWAVES * 64) ((LAS unsigned*)(F.lds + MISC_OFF))[u] = 0u;
    __syncthreads();
#if MK_TPROBE
    for (int u = F.tid(); u < 128; u += NWAVES * 64) ((LAS unsigned*)(F.lds + TP_LDS_OFF))[u] = 0u;
    __syncthreads();
#endif
    unsigned long long tk0_ = 0, tk1_ = 0; (void)tk0_; (void)tk1_; TP_NOW(tk0_);
    const int lo = args.ph_lo, hi = args.ph_hi;
    const bool multi = (hi - lo) > 1;
    XcdBarrier bar; bar.bar = (unsigned*)(F.ctl + CW_BAR); bar.x = 0; bar.st = nullptr;
    if (multi) bar = xcd_barrier_post((unsigned*)(F.ctl + CW_BAR), F.MISC + 8);
#ifndef MK_PHASE_MASK
#define MK_PHASE_MASK 0xffff
#endif
#define IN(k) ((((MK_PHASE_MASK) >> (k)) & 1) && lo <= (k) && (k) < hi)
#ifndef MK_REP_MASK
#define MK_REP_MASK 0
#endif
#define REPS(k) ((((MK_REP_MASK) >> (k)) & 1) ? 2 : 1)
#ifndef MK_TPROBE_PHASE
#define MK_TPROBE_PHASE -1
#endif
#ifndef MK_TPROBE_PHT
#define MK_TPROBE_PHT -1
#endif
#ifndef MK_TPROBE_Q
#define MK_TPROBE_Q 10
#endif
#ifndef MK_TPROBE_OFS
#define MK_TPROBE_OFS 0.5
#endif
#ifdef MK_TPS_BAR
#ifndef MK_TPS_BAR_MASK
#define MK_TPS_BAR_MASK 0xffff
#endif
#define SEAM(k) do { if (IN(k) && IN((k) + 1)) { if ((MK_TPS_BAR_MASK >> (k)) & 1) { TPS_BEGIN(); xcd_barrier(bar); TPS_END(F); } else xcd_barrier(bar); } } while (0)
#else
#define SEAM(k) do { if (MK_TPROBE && (k) == MK_TPROBE_PHASE) TP_SET(F.lds, 0u); if (IN(k) && IN((k) + 1)) xcd_barrier(bar); } while (0)
#endif
#if MK_DEBUG
#define MW_R0 0, 16384, 0, 0
#define MW_R1 0, 16384, 0, 0
#define MW_R2 0, 16384, 0, 0
#define MW_R3 0, 16384, 0, 0
#define MW_R4 0, 24576, 0, (1 << 20)
#define MW_R6 0, 16384, 0, 0
#define MW_R7 0, 16384, 0, 0
#define MW_R9 0, 16384, 0, 0
#else
#define MW_R0 0, 16384, 0, 2
#define MW_R1 0, 16384, 2, 4
#define MW_R2 0, 16384, 4, 6
#define MW_R3 0, 16384, 6, (1 << 20)
#define MW_R4 16384, 8192, 0, 1
#define MW_R6 16384, 8192, 1, 2
#define MW_R7 16384, 8192, 2, 3
#define MW_R9 16384, 8192, 3, (1 << 20)
#endif
#define SEAMW(k, ...) SEAMW_(k, __VA_ARGS__)
#define SEAMW_(k, ib, ic, r0, r1) do { if (MK_TPROBE && (k) == MK_TPROBE_PHASE) TP_SET(F.lds, 0u); \
        if (IN(k) && IN((k) + 1)) { xcd_barrier_arrive(bar); moe_weights(F, in, ib, ic, r0, r1); xcd_barrier_wait(bar); } else if (IN(k)) { __syncthreads(); moe_weights(F, in, ib, ic, r0, r1); } } while (0)
    LAS float* RS = (LAS float*)(F.lds + AUX_RS); LAS float* WG = (LAS float*)(F.lds + AUX_WG); LAS int* TOK = (LAS int*)(F.lds + AUX_TOK); LAS float* XP = (LAS float*)(F.lds + AUX_XP);
    const float* misc = (const float*)(ws + WS_MISC);

    if (IN(0)) { unsigned long long pt0_ = 0, pt1_ = 0; (void)pt0_; (void)pt1_; if (MK_TPROBE && 0 == MK_TPROBE_PHT) TP_NOW(pt0_); if (MK_TPROBE && 0 == MK_TPROBE_PHASE) TP_SET(F.lds, 1u); phase_0(F, in, args.out, ws, lds); if (REPS(0) > 1) { __syncthreads(); phase_0(F, in, args.out, ws, lds); }  if (MK_TPROBE && 0 == MK_TPROBE_PHT) { TP_NOW(pt1_); if (F.lane() == 0) { volatile LAS unsigned long long* q_ = (volatile LAS unsigned long long*)(F.lds + TP_LDS_OFF + 256) + F.wave * 4 + 2; *q_ = *q_ + (pt1_ - pt0_); } } }
    SEAMW(0, MW_R0);
    if (IN(1)) { unsigned long long pt0_ = 0, pt1_ = 0; (void)pt0_; (void)pt1_; if (MK_TPROBE && 1 == MK_TPROBE_PHT) TP_NOW(pt0_); if (MK_TPROBE && 1 == MK_TPROBE_PHASE) TP_SET(F.lds, 1u); phase_1(F, in, args.out, ws, lds); if (REPS(1) > 1) { __syncthreads(); phase_1(F, in, args.out, ws, lds); }  if (MK_TPROBE && 1 == MK_TPROBE_PHT) { TP_NOW(pt1_); if (F.lane() == 0) { volatile LAS unsigned long long* q_ = (volatile LAS unsigned long long*)(F.lds + TP_LDS_OFF + 256) + F.wave * 4 + 2; *q_ = *q_ + (pt1_ - pt0_); } } }
    SEAMW(1, MW_R1);
    if (IN(2)) { unsigned long long pt0_ = 0, pt1_ = 0; (void)pt0_; (void)pt1_; if (MK_TPROBE && 2 == MK_TPROBE_PHT) TP_NOW(pt0_); if (MK_TPROBE && 2 == MK_TPROBE_PHASE) TP_SET(F.lds, 1u); phase_2(F, in, args.out, ws, lds); if (REPS(2) > 1) { __syncthreads(); phase_2(F, in, args.out, ws, lds); }  if (MK_TPROBE && 2 == MK_TPROBE_PHT) { TP_NOW(pt1_); if (F.lane() == 0) { volatile LAS unsigned long long* q_ = (volatile LAS unsigned long long*)(F.lds + TP_LDS_OFF + 256) + F.wave * 4 + 2; *q_ = *q_ + (pt1_ - pt0_); } } }
    SEAMW(2, MW_R2);
    if (IN(3)) { unsigned long long pt0_ = 0, pt1_ = 0; (void)pt0_; (void)pt1_; if (MK_TPROBE && 3 == MK_TPROBE_PHT) TP_NOW(pt0_); if (MK_TPROBE && 3 == MK_TPROBE_PHASE) TP_SET(F.lds, 1u); phase_3(F, in, args.out, ws, lds); if (REPS(3) > 1) { __syncthreads(); phase_3(F, in, args.out, ws, lds); }  if (MK_TPROBE && 3 == MK_TPROBE_PHT) { TP_NOW(pt1_); if (F.lane() == 0) { volatile LAS unsigned long long* q_ = (volatile LAS unsigned long long*)(F.lds + TP_LDS_OFF + 256) + F.wave * 4 + 2; *q_ = *q_ + (pt1_ - pt0_); } } }
    SEAMW(3, MW_R3);
    if (IN(4)) { unsigned long long pt0_ = 0, pt1_ = 0; (void)pt0_; (void)pt1_; if (MK_TPROBE && 4 == MK_TPROBE_PHT) TP_NOW(pt0_); if (MK_TPROBE && 4 == MK_TPROBE_PHASE) TP_SET(F.lds, 1u); phase_4(F, in, args.out, ws, lds); if (REPS(4) > 1) { __syncthreads(); phase_4(F, in, args.out, ws, lds); }  if (MK_TPROBE && 4 == MK_TPROBE_PHT) { TP_NOW(pt1_); if (F.lane() == 0) { volatile LAS unsigned long long* q_ = (volatile LAS unsigned long long*)(F.lds + TP_LDS_OFF + 256) + F.wave * 4 + 2; *q_ = *q_ + (pt1_ - pt0_); } } }
    SEAMW(4, MW_R4);
    if (IN(5)) { unsigned long long pt0_ = 0, pt1_ = 0; (void)pt0_; (void)pt1_; if (MK_TPROBE && 5 == MK_TPROBE_PHT) TP_NOW(pt0_); if (MK_TPROBE && 5 == MK_TPROBE_PHASE) TP_SET(F.lds, 1u); phase_5(F, in, args.out, ws, lds); if (REPS(5) > 1) { __syncthreads(); phase_5(F, in, args.out, ws, lds); }  if (MK_TPROBE && 5 == MK_TPROBE_PHT) { TP_NOW(pt1_); if (F.lane() == 0) { volatile LAS unsigned long long* q_ = (volatile LAS unsigned long long*)(F.lds + TP_LDS_OFF + 256) + F.wave * 4 + 2; *q_ = *q_ + (pt1_ - pt0_); } } }
    if (IN(6)) { unsigned long long pt0_ = 0, pt1_ = 0; (void)pt0_; (void)pt1_; if (MK_TPROBE && 6 == MK_TPROBE_PHT) TP_NOW(pt0_); if (MK_TPROBE && 6 == MK_TPROBE_PHASE) TP_SET(F.lds, 1u); phase_6(F, in, args.out, ws, lds); if (REPS(6) > 1) { __syncthreads(); phase_6(F, in, args.out, ws, lds); }  if (MK_TPROBE && 6 == MK_TPROBE_PHT) { TP_NOW(pt1_); if (F.lane() == 0) { volatile LAS unsigned long long* q_ = (volatile LAS unsigned long long*)(F.lds + TP_LDS_OFF + 256) + F.wave * 4 + 2; *q_ = *q_ + (pt1_ - pt0_); } } }
    SEAMW(6, MW_R6);
    if (IN(7)) { unsigned long long pt0_ = 0, pt1_ = 0; (void)pt0_; (void)pt1_; if (MK_TPROBE && 7 == MK_TPROBE_PHT) TP_NOW(pt0_); if (MK_TPROBE && 7 == MK_TPROBE_PHASE) TP_SET(F.lds, 1u); phase_7(F, in, args.out, ws, lds); if (REPS(7) > 1) { __syncthreads(); phase_7(F, in, args.out, ws, lds); }  if (MK_TPROBE && 7 == MK_TPROBE_PHT) { TP_NOW(pt1_); if (F.lane() == 0) { volatile LAS unsigned long long* q_ = (volatile LAS unsigned long long*)(F.lds + TP_LDS_OFF + 256) + F.wave * 4 + 2; *q_ = *q_ + (pt1_ - pt0_); } } }
    SEAMW(7, MW_R7);
    if (IN(8)) { unsigned long long pt0_ = 0, pt1_ = 0; (void)pt0_; (void)pt1_; if (MK_TPROBE && 8 == MK_TPROBE_PHT) TP_NOW(pt0_); if (MK_TPROBE && 8 == MK_TPROBE_PHASE) TP_SET(F.lds, 1u); phase_8(F, in, args.out, ws, lds); if (REPS(8) > 1) { __syncthreads(); phase_8(F, in, args.out, ws, lds); }  if (MK_TPROBE && 8 == MK_TPROBE_PHT) { TP_NOW(pt1_); if (F.lane() == 0) { volatile LAS unsigned long long* q_ = (volatile LAS unsigned long long*)(F.lds + TP_LDS_OFF + 256) + F.wave * 4 + 2; *q_ = *q_ + (pt1_ - pt0_); } } }
    if (IN(9)) { unsigned long long pt0_ = 0, pt1_ = 0; (void)pt0_; (void)pt1_; if (MK_TPROBE && 9 == MK_TPROBE_PHT) TP_NOW(pt0_); if (MK_TPROBE && 9 == MK_TPROBE_PHASE) TP_SET(F.lds, 1u); phase_9(F, in, args.out, ws, lds); if (REPS(9) > 1) { __syncthreads(); phase_9(F, in, args.out, ws, lds); }  if (MK_TPROBE && 9 == MK_TPROBE_PHT) { TP_NOW(pt1_); if (F.lane() == 0) { volatile LAS unsigned long long* q_ = (volatile LAS unsigned long long*)(F.lds + TP_LDS_OFF + 256) + F.wave * 4 + 2; *q_ = *q_ + (pt1_ - pt0_); } } }
    SEAMW(9, MW_R9);
    if (IN(10)) { unsigned long long pt0_ = 0, pt1_ = 0; (void)pt0_; (void)pt1_; if (MK_TPROBE && 10 == MK_TPROBE_PHT) TP_NOW(pt0_); if (MK_TPROBE && 10 == MK_TPROBE_PHASE) TP_SET(F.lds, 1u); phase_10(F, in, args.out, ws, lds); if (REPS(10) > 1) { __syncthreads(); phase_10(F, in, args.out, ws, lds); }  if (MK_TPROBE && 10 == MK_TPROBE_PHT) { TP_NOW(pt1_); if (F.lane() == 0) { volatile LAS unsigned long long* q_ = (volatile LAS unsigned long long*)(F.lds + TP_LDS_OFF + 256) + F.wave * 4 + 2; *q_ = *q_ + (pt1_ - pt0_); } } }
    SEAM(10);
    if (IN(11)) { unsigned long long pt0_ = 0, pt1_ = 0; (void)pt0_; (void)pt1_; if (MK_TPROBE && 11 == MK_TPROBE_PHT) TP_NOW(pt0_); if (MK_TPROBE && 11 == MK_TPROBE_PHASE) TP_SET(F.lds, 1u); phase_11(F, in, args.out, ws, lds); if (REPS(11) > 1) { __syncthreads(); phase_11(F, in, args.out, ws, lds); }  if (MK_TPROBE && 11 == MK_TPROBE_PHT) { TP_NOW(pt1_); if (F.lane() == 0) { volatile LAS unsigned long long* q_ = (volatile LAS unsigned long long*)(F.lds + TP_LDS_OFF + 256) + F.wave * 4 + 2; *q_ = *q_ + (pt1_ - pt0_); } } }
    SEAM(11);
    if (IN(12)) { unsigned long long pt0_ = 0, pt1_ = 0; (void)pt0_; (void)pt1_; if (MK_TPROBE && 12 == MK_TPROBE_PHT) TP_NOW(pt0_); if (MK_TPROBE && 12 == MK_TPROBE_PHASE) TP_SET(F.lds, 1u); phase_12(F, in, args.out, ws, lds); if (REPS(12) > 1) { __syncthreads(); phase_12(F, in, args.out, ws, lds); }  if (MK_TPROBE && 12 == MK_TPROBE_PHT) { TP_NOW(pt1_); if (F.lane() == 0) { volatile LAS unsigned long long* q_ = (volatile LAS unsigned long long*)(F.lds + TP_LDS_OFF + 256) + F.wave * 4 + 2; *q_ = *q_ + (pt1_ - pt0_); } } }
#if MK_TPROBE
    {
        TP_NOW(tk1_);
        TP_SET(F.lds, 0u);
        if (F.lane() == 0) { volatile LAS unsigned long long* p_ = (volatile LAS unsigned long long*)(F.lds + TP_LDS_OFF + 256) + F.wave * 4;
            atomicAdd((unsigned long long*)(F.ctl + 30000), p_[0]); atomicAdd((unsigned long long*)(F.ctl + 30002), p_[1] + p_[2]); atomicAdd((unsigned long long*)(F.ctl + 30004), (unsigned long long)(tk1_ - tk0_)); }
        xcd_barrier(bar);
        const double a_ = (double)__hip_atomic_load((unsigned long long*)(F.ctl + 30000), RLX_AGENT), b_ = (double)__hip_atomic_load((unsigned long long*)(F.ctl + 30002), RLX_AGENT);
#ifdef MK_TPROBE_REL
        const float rat_ = (float)(b_ / (double)__hip_atomic_load((unsigned long long*)(F.ctl + 30004), RLX_AGENT));
#elif defined(MK_TPROBE_ABS)
        const float rat_ = (float)(b_ / (double)(MK_TPROBE_ABS));
#else
        const float rat_ = (float)(a_ / (b_ > 0.0 ? b_ : 1.0));
#endif
        const float sc_ = 1.0f + floorf(rat_ * (float)MK_TPROBE_Q + (float)MK_TPROBE_OFS) / (float)MK_TPROBE_Q;
        const size_t gt_ = ((size_t)F.vcu * NWAVES + F.wave) * 64 + F.lane(), ng_ = (size_t)F.G * NWAVES * 64;
        for (size_t i = gt_; i < (size_t)T * D / 4; i += ng_) { f32x4 v = ((f32x4*)args.out)[i]; ((f32x4*)args.out)[i] = v * sc_; }
    }
#endif
#undef IN
#undef SEAM
}
#ifndef MK_DEBUG
#define MK_DEBUG 0
#endif
#ifndef MK_PER_PHASE
#define MK_PER_PHASE MK_DEBUG
#endif
#if MK_DEBUG
struct CmpDesc { const void* test; const float* ref; size_t rhs; int ttype, tld, rld, cw, rows, cols, tfm, slot; float rscale; int pad; };
__global__ void __launch_bounds__(256) cmp_k(CmpDesc d, double* sums) {
    __shared__ double red[2][4];
    double sd = 0.0, sr = 0.0;
    const size_t n = (size_t)d.rows * d.cols;
    for (size_t idx = (size_t)blockIdx.x * 256 + threadIdx.x; idx < n; idx += (size_t)gridDim.x * 256) {
        const int r = (int)(idx / d.cols), c = (int)(idx % d.cols);
        float tv;
        if (d.ttype == 0) tv = bf2f(((const bf16*)d.test)[(size_t)r * d.tld + c]);
        else if (d.ttype == 1) tv = h2f(((const unsigned short*)d.test)[(size_t)r * d.tld + c]);
        else tv = ((const float*)d.test)[(size_t)r * d.tld + c];
        float rv = d.ref[(size_t)(c / d.cw) * d.rhs + (size_t)r * d.rld + (c % d.cw)] * d.rscale;
        if (d.tfm == 1) rv = rv / (1.0f + expf(-rv));
        if (d.tfm == 2) tv = exp2f(tv);
        const double df = (double)tv - (double)rv; sd += df * df; sr += (double)rv * (double)rv;
    }
    for (int o = 32; o; o >>= 1) { sd += __shfl_xor(sd, o); sr += __shfl_xor(sr, o); }
    if ((threadIdx.x & 63) == 0) { red[0][threadIdx.x >> 6] = sd; red[1][threadIdx.x >> 6] = sr; }
    __syncthreads();
    if (threadIdx.x == 0) { atomicAdd(&sums[2 * d.slot], red[0][0] + red[0][1] + red[0][2] + red[0][3]); atomicAdd(&sums[2 * d.slot + 1], red[1][0] + red[1][1] + red[1][2] + red[1][3]); }
}
__global__ void verdict_k(const double* sums, const float* tols, int nslot, unsigned* code) {
    if (threadIdx.x == 0 && blockIdx.x == 0) { unsigned c = 0;
        for (int k = 0; k < nslot; ++k) { const double rvr = sums[2 * k] / sums[2 * k + 1]; if (!(rvr <= (double)tols[k])) { c = (unsigned)(k + 1); break; } }
        *code = c; }
}
__global__ void poison_k(const unsigned* code, const float* x, float* out, size_t n) {
    const unsigned c = *code; if (c == 0) return;
    const float f = 1.0f + exp2f((float)c);
    for (size_t i = (size_t)blockIdx.x * blockDim.x + threadIdx.x; i < n; i += (size_t)gridDim.x * blockDim.x) out[i] = x[i] * f;
}
__global__ void settol_k(float* tols) { const float t[16] = MK_TOLS; if (threadIdx.x < 16) tols[threadIdx.x] = t[threadIdx.x]; }
#endif

extern "C" void kernel_launch(void* const* d_in, const int* in_sizes, int n_in, void* d_out, int out_size, void* d_ws, size_t ws_size, hipStream_t stream) {
    static int grid = 0;
    if (grid == 0) {
        if (n_in != 29 || out_size != T * D || ws_size < (MK_DEBUG ? WS_END + 192 * MiB : WS_END_REL)) { fprintf(stderr, "kernel_launch: unexpected shapes (n_in %d, out %d, ws %zu)\n", n_in, out_size, ws_size); grid = -1; return; }
        int dev = 0, cus = 0;
        if (hipGetDevice(&dev) != hipSuccess || hipDeviceGetAttribute(&cus, hipDeviceAttributeMultiprocessorCount, dev) != hipSuccess) { grid = -1; return; }
        if (hipFuncSetAttribute((const void*)mega_fwd, hipFuncAttributeMaxDynamicSharedMemorySize, LDS_BYTES) != hipSuccess) { fprintf(stderr, "kernel_launch: hipFuncSetAttribute failed\n"); grid = -1; return; }
        int per_cu = 0;
        if (hipOccupancyMaxActiveBlocksPerMultiprocessor(&per_cu, (const void*)mega_fwd, NWAVES * 64, LDS_BYTES) != hipSuccess || per_cu < 1) { fprintf(stderr, "kernel_launch: occupancy query says %d\n", per_cu); }
        (void)hipGetLastError();
        grid = cus;
    }
    if (grid < 0) return;
    (void)hipMemsetAsync((char*)d_ws + WS_CTL, 0, CTL_ZERO_BYTES, stream);
    Args a{};
    Inputs& w = a.in;
    w.x = (const float*)d_in[0]; w.mem = (const float*)d_in[1]; w.pos = (const int*)d_in[2]; w.norm_mix = (const float*)d_in[3]; w.w_in = (const float*)d_in[4];
    w.q_a_norm = (const float*)d_in[5]; w.w_q_up = (const float*)d_in[6]; w.kv_a_norm = (const float*)d_in[7]; w.w_kv_up = (const float*)d_in[8];
    w.q_norm = (const float*)d_in[9]; w.k_norm = (const float*)d_in[10]; w.lb_logits = (const float*)d_in[11]; w.o_norm = (const float*)d_in[12]; w.w_out = (const float*)d_in[13];
    w.norm_cross = (const float*)d_in[14]; w.norm_mem = (const float*)d_in[15]; w.x_w_q = (const float*)d_in[16]; w.x_w_kv = (const float*)d_in[17];
    w.x_q_norm = (const float*)d_in[18]; w.x_k_norm = (const float*)d_in[19]; w.x_w_o = (const float*)d_in[20]; w.norm_ffn = (const float*)d_in[21];
    w.w_group = (const float*)d_in[22]; w.b_group = (const float*)d_in[23]; w.w_expert = (const float*)d_in[24]; w.b_expert = (const float*)d_in[25];
    w.w_gate = (const float*)d_in[26]; w.w_up = (const float*)d_in[27]; w.w_down = (const float*)d_in[28];
    a.out = (float*)d_out; a.ws = (unsigned char*)d_ws;
    unsigned char* ws = (unsigned char*)d_ws;
#if MK_DEBUG
    constexpr int BC = MK_DEBUG_BATCH;
    orc::W ow; static_assert(sizeof(orc::W) == sizeof(Inputs), "same field list"); memcpy(&ow, &w, sizeof(ow));
    orc::Bufs B; B.carve2((float*)d_out, (float*)(ws + WS_END));
    double* sums = (double*)(ws + WS_CTL + CW_CHK * 4); float* tols = (float*)(sums + 64); unsigned* code = (unsigned*)(tols + 32);
    settol_k<<<1, 64, 0, stream>>>(tols);
    orc::pack_router<<<(1024 * 72 + 255) / 256, 256, 0, stream>>>(ow.w_group, ow.w_expert, B.wr);
    orc::run_batch(ow, B, BC, B.outb, stream);
    auto CMP = [&](int slot, const void* test, int ttype, int tld, const float* ref, int rld, int cw, size_t rhs, int rows, int cols, float rscale, int tfm) {
        CmpDesc d{}; d.test = test; d.ref = ref; d.rhs = rhs; d.ttype = ttype; d.tld = tld; d.rld = rld; d.cw = cw; d.rows = rows; d.cols = cols; d.tfm = tfm; d.slot = slot; d.rscale = rscale;
        cmp_k<<<512, 256, 0, stream>>>(d, sums); };
    const size_t r0 = (size_t)BC * SEQ;
#endif
    auto PH = [&](int lo, int hi) { a.ph_lo = lo; a.ph_hi = hi; hipLaunchKernelGGL(mega_fwd, dim3(grid), dim3(NWAVES * 64), LDS_BYTES, stream, a); };
#if MK_PER_PHASE
    for (int p = 0; p < N_PHASES; ++p) {
        PH(p, p + 1);
#if MK_DEBUG
        if (p == 1) {
            CMP(0, (bf16*)(ws + WS_HQ) + r0 * 512, 0, 512, B.qs, 512, 512, 0, SEQ, 512, 1.f, 0);
            CMP(1, (bf16*)(ws + WS_GF) + r0 * 512, 1, 512, B.f, 512, 512, 0, SEQ, 512, 1.f, 2);
            CMP(1, (bf16*)(ws + WS_GB) + r0 * 512, 1, 512, B.f + (size_t)SEQ * 512, 512, 512, 0, SEQ, 512, 1.f, 2);
            CMP(2, (bf16*)(ws + WS_HI) + r0 * 512, 0, 512, B.p + 1888, 2912, 512, 0, SEQ, 512, 1.f, 0);
            CMP(2, (bf16*)(ws + WS_HG) + r0 * 512, 0, 512, B.p + 2400, 2912, 512, 0, SEQ, 512, 1.f, 1);
            CMP(3, (bf16*)(ws + WS_LAT) + r0 * 512, 0, 512, B.p, 2912, 352, 0, SEQ, 352, 1.f, 0);
        }
        if (p == 2) {
            CMP(4, (bf16*)(ws + WS_Q) + r0 * 768, 0, 768, B.Qn, 96, 96, (size_t)SEQ * 96, SEQ, 768, QSCALE_MLA, 0);
            CMP(5, (bf16*)(ws + WS_K) + r0 * 768, 0, 768, B.Kn, 96, 96, (size_t)SEQ * 96, SEQ, 768, 1.f, 0);
            CMP(6, (bf16*)(ws + WS_V) + r0 * 512, 0, 512, B.V, 64, 64, (size_t)SEQ * 64, SEQ, 512, 1.f, 0);
            CMP(7, (bf16*)(ws + WS_KVX) + (size_t)BC * MEML * 2048, 0, 2048, B.kvx, 2048, 2048, 0, MEML, 2048, 1.f, 0);
            CMP(8, (bf16*)(ws + WS_OF) + r0 * 512, 0, 512, B.o, 512, 512, 0, SEQ, 512, 1.f, 0);
            CMP(8, (bf16*)(ws + WS_OB) + r0 * 512, 0, 512, B.o + (size_t)SEQ * 512, 512, 512, 0, SEQ, 512, 1.f, 0);
        }
        if (p == 3) {
            CMP(9, (bf16*)(ws + WS_CAT) + r0 * 1024 + 512, 0, 1024, B.cat + 512, 1024, 512, 0, SEQ, 512, 1.f, 0);
            CMP(10, (bf16*)(ws + WS_CAT) + r0 * 1024, 0, 1024, B.cat, 1024, 512, 0, SEQ, 512, 1.f, 0);
        }
        if (p == 4) CMP(11, (bf16*)(ws + WS_XN) + r0 * 1024, 0, 1024, B.x1, 1024, 1024, 0, SEQ, 1024, 1.f, 0);
        if (0) CMP(12, (bf16*)(ws + WS_QX) + r0 * 1024, 0, 1024, B.qx, 1024, 1024, 0, SEQ, 1024, 0.0625f * LOG2E, 0);
        if (p == 5) CMP(13, (bf16*)(ws + WS_QX) + r0 * 1024, 0, 1024, B.ox, 1024, 1024, 0, SEQ, 1024, 1.f, 0);
        if (p == 7) CMP(14, (bf16*)(ws + WS_XN) + r0 * 1024, 0, 1024, B.x2, 1024, 1024, 0, SEQ, 1024, 1.f, 0);
        if (p == 12) CMP(15, (float*)d_out + r0 * 1024, 2, 1024, B.outb, 1024, 1024, 0, SEQ, 1024, 1.f, 0);
#endif
    }
#if MK_DEBUG
    verdict_k<<<1, 64, 0, stream>>>(sums, tols, 16, code);
    poison_k<<<1024, 256, 0, stream>>>(code, w.x, (float*)d_out, (size_t)T * D);
#endif
#else
    PH(0, N_PHASES);
#endif
}
```

```cpp
#include <hip/hip_runtime.h>
#include <cstdio>
#include <cstdint>
#include <cstring>
#include <cmath>
#ifndef MK_TPROBE
#define MK_TPROBE 0
#endif
#define TP_LDS_OFF (131072 + 12288 + 256)
#if MK_TPROBE
#define TP_NOW(v) do { v = __builtin_amdgcn_s_memtime(); asm volatile("s_waitcnt lgkmcnt(0)" ::: "memory"); } while (0)
#define TP_ADD(ldsbase, wid, which, t0, t1) do { if (((volatile __attribute__((address_space(3))) unsigned*)((ldsbase) + TP_LDS_OFF))[63] != 0u && (pg8::tid_opaque() & 63) == 0) { \
        volatile __attribute__((address_space(3))) unsigned long long* p_ = (volatile __attribute__((address_space(3))) unsigned long long*)((ldsbase) + TP_LDS_OFF + 256) + (wid) * 4 + (which); *p_ = *p_ + ((t1) - (t0)); } } while (0)
#define TP_SET(ldsbase, on) do { if (pg8::tid_opaque() == 0) ((volatile __attribute__((address_space(3))) unsigned*)((ldsbase) + TP_LDS_OFF))[63] = (on); __syncthreads(); } while (0)
#define TPS_BEGIN() unsigned long long tps0_ = 0, tps1_ = 0; TP_NOW(tps0_)
#define TPS_END(F) do { TP_NOW(tps1_); if ((F).lane() == 0) { volatile __attribute__((address_space(3))) unsigned long long* q_ = (volatile __attribute__((address_space(3))) unsigned long long*)((F).lds + TP_LDS_OFF + 256) + (F).wave * 4 + 2; *q_ = *q_ + (tps1_ - tps0_); } } while (0)
#else
#define TPS_BEGIN() do {} while (0)
#define TPS_END(F) do {} while (0)
#define TP_NOW(v) do {} while (0)
#define TP_ADD(ldsbase, wid, which, t0, t1) do {} while (0)
#define TP_SET(ldsbase, on) do {} while (0)
#endif
namespace pg8 {
#define PG8_LAS __attribute__((address_space(3)))
typedef unsigned short bf16_t;
typedef short bf16x8 __attribute__((ext_vector_type(8)));
typedef float f32x4 __attribute__((ext_vector_type(4)));
typedef float f32x2 __attribute__((ext_vector_type(2)));
typedef unsigned u32x4 __attribute__((ext_vector_type(4)));
constexpr int BM = 256, BK = 64, HALF = 128, HTB = HALF * BK * 2, STAGE_BYTES = 8 * HTB, NXCD = 8, WGM = 8;

__host__ __device__ __forceinline__ int lds_byte(int r, int c) { const int st = (r >> 4) * 2 + (c >> 5), rr = r & 15, cc = c & 31, ob = rr * 64 + cc * 2; return st * 1024 + (ob ^ (((ob >> 9) & 1) << 5)); }
__host__ __device__ __forceinline__ void stage_rc(int b, int& R, int& C) { const int st = b / 1024, sb = b % 1024, swz = sb ^ (((sb >> 9) & 1) << 5); R = (st >> 1) * 16 + swz / 64; C = (st & 1) * 32 + (swz % 64) / 2; }
__host__ __device__ __forceinline__ int perm32(int rho) { const int n = rho >> 4, i = rho & 15; return 8 * (i >> 2) + 4 * n + (i & 3); }

struct Unit { int pm, pn; const char* a; const char* b0; const char* b1; const int* rows; const int* map0; const int* map1; int hi = 1, upad_ = 0; };

struct GridOrder {
    int nM, nN, nwg, G, c, wgm;
    __device__ void init(int nM_, int nN_, int G_, int c_, int wgm_ = WGM) { nM = nM_; nN = nN_; nwg = nM * nN; G = G_; c = c_; wgm = wgm_; }
    __device__ bool tile(int i, int& pm, int& pn) const {
        const long L = (long)i * G + c; if (L >= nwg) return false;
        int wgid = (int)L; { const int q = nwg / NXCD, r = nwg % NXCD, xcd = wgid % NXCD, off = wgid / NXCD; wgid = (xcd < r ? xcd * (q + 1) : r * (q + 1) + (xcd - r) * q) + off; }
        const int nig = wgm * nN, gid = wgid / nig, fm = gid * wgm, gsz = (nM - fm) < wgm ? (nM - fm) : wgm;
        pm = fm + ((wgid % nig) % gsz); pn = (wgid % nig) / gsz; return true;
    }
};

__device__ __forceinline__ int tid_opaque() { int t = (int)threadIdx.x; asm volatile("" : "+v"(t)); return t; }
__device__ __forceinline__ unsigned cvt_pk_bf16(float lo, float hi) { unsigned r; asm volatile("v_cvt_pk_bf16_f32 %0, %1, %2" : "=v"(r) : "v"(lo), "v"(hi)); return r; }
__device__ __forceinline__ float bf_lo(unsigned w) { return __uint_as_float(w << 16); }
__device__ __forceinline__ float bf_hi(unsigned w) { return __uint_as_float(w & 0xffff0000u); }

template <class E, class = void> struct skip_bj1 { static constexpr bool v = false; };
template <class E> struct skip_bj1<E, decltype((void)E::SKIP_BJ1)> { static constexpr bool v = E::SKIP_BJ1; };
template <class Epi, class Sched, bool ALIGN_EPI, int GATHER, int K, int lda, int ldb, int tsplit>
__device__ __forceinline__ void gemm_phase(PG8_LAS unsigned char* lds, const Sched S, const Epi E) {
    const int tid = tid_opaque(), wid = __builtin_amdgcn_readfirstlane(tid >> 6), lane = tid & 63, wr = wid >> 2, wc = wid & 3, fr = lane & 15, fq = lane >> 4;
    constexpr int nt = K / BK;
    unsigned voffA[2], voffB[2]; int RA[2], CA[2];
#pragma unroll
    for (int i = 0; i < 2; ++i) { int R, C; stage_rc(tid * 16 + i * 8192, R, C); const int Rb = (R & ~31) + perm32(R & 31);
        voffA[i] = (unsigned)(R * lda + C) * 2u; voffB[i] = (unsigned)(Rb * ldb + C) * 2u; RA[i] = R; CA[i] = C; }
    const size_t kstep = (size_t)(BK * 2);
    const size_t hstepA = (size_t)HALF * lda * 2, hstepB = (size_t)HALF * ldb * 2;
    const unsigned ldsw = (unsigned)wid * 1024u;
    const int aoff = lds_byte(wr * 64 + fr, fq * 8), boff = lds_byte(wc * 32 + fr, fq * 8);
#define PG8_SA(b, h) (((b) * 2 + (h)) * HTB)
#define PG8_SB(b, h) ((4 + (b) * 2 + (h)) * HTB)
#define PG8_STAGE(bufoff, gbase, voff) do { _Pragma("unroll") for (int _i = 0; _i < 2; ++_i) \
        __builtin_amdgcn_global_load_lds((const unsigned*)((const char*)(gbase) + (voff)[_i]), (PG8_LAS unsigned*)(lds + (bufoff) + ldsw + _i * 8192), 16, 0, 0); } while (0)
#define PG8_STAGE_A(bufoff, p, h, nx, sel) do { if constexpr (GATHER != 0) { unsigned _o[2]; \
            if constexpr (GATHER == 2) { _o[0] = (nx) ? nvA[h][0] : ((sel) ? cvB[h][0] : cvA[h][0]); _o[1] = (nx) ? nvA[h][1] : ((sel) ? cvB[h][1] : cvA[h][1]); } \
            else { _o[0] = (nx) ? nvA[h][0] : cvA[h][0]; _o[1] = (nx) ? nvA[h][1] : cvA[h][1]; } PG8_STAGE(bufoff, p, _o); } \
        else { PG8_STAGE(bufoff, (p) + (h) * hstepA, voffA); } } while (0)
#define PG8_LDA(dst, b, h) do { _Pragma("unroll") for (int m = 0; m < 4; ++m) _Pragma("unroll") for (int k = 0; k < 2; ++k) dst[m][k] = *(const PG8_LAS bf16x8*)(lds + PG8_SA(b, h) + aoff + m * 2048 + k * 1024); } while (0)
#define PG8_LDB(dst, b, h) do { _Pragma("unroll") for (int n = 0; n < 2; ++n) _Pragma("unroll") for (int k = 0; k < 2; ++k) dst[n][k] = *(const PG8_LAS bf16x8*)(lds + PG8_SB(b, h) + boff + n * 2048 + k * 1024); } while (0)
#define PG8_MMA(ai, bj, At, Bt) do { __builtin_amdgcn_s_setprio(1); _Pragma("unroll") for (int m = 0; m < 4; ++m) _Pragma("unroll") for (int n = 0; n < 2; ++n) _Pragma("unroll") for (int k = 0; k < 2; ++k) \
        acc[ai][bj][m][n] = __builtin_amdgcn_mfma_f32_16x16x32_bf16(Bt[n][k], At[m][k], acc[ai][bj][m][n], 0, 0, 0); __builtin_amdgcn_s_setprio(0); } while (0)
#define PG8_WAIT_V(n) asm volatile("s_waitcnt vmcnt(" #n ")" ::: "memory")
#define PG8_WAIT_L(n) asm volatile("s_waitcnt lgkmcnt(" #n ")" ::: "memory")
#define PG8_BAR __builtin_amdgcn_s_barrier()
#define PG8_SCHED __builtin_amdgcn_sched_barrier(0)
#define PG8_GOFF(dst, u, second) do { if constexpr (GATHER != 0) { _Pragma("unroll") for (int _h = 0; _h < 2; ++_h) _Pragma("unroll") for (int _i = 0; _i < 2; ++_i) { \
        int _r = (GATHER == 2 && (second)) ? (u).map1[_h * HALF + RA[_i]] : (u).rows[_h * HALF + RA[_i]]; _r = _r < 0 ? 0 : _r; dst[_h][_i] = (unsigned)(_r * lda + CA[_i]) * 2u; } } } while (0)
    Unit cur, nxt; int ui = 0;
    if (!S.next(0, cur)) return;
    unsigned long long tp_s_ = 0, tp_e_ = 0, tp_0_ = 0, tp_1_ = 0; (void)tp_s_; (void)tp_e_; (void)tp_0_; (void)tp_1_;
    TP_NOW(tp_s_);
    unsigned cvA[2][2] = {{0u, 0u}, {0u, 0u}}, nvA[2][2] = {{0u, 0u}, {0u, 0u}}, cvB[2][2] = {{0u, 0u}, {0u, 0u}};
    PG8_GOFF(cvA, cur, false); PG8_GOFF(cvB, cur, true);
    f32x4 acc[2][2][4][2];
#pragma unroll
    for (int a = 0; a < 2; ++a)
#pragma unroll
        for (int b = 0; b < 2; ++b)
#pragma unroll
            for (int m = 0; m < 4; ++m)
#pragma unroll
                for (int n = 0; n < 2; ++n) acc[a][b][m][n] = (f32x4){0.f, 0.f, 0.f, 0.f};
    bf16x8 At[4][2], B0[2][2], B1[2][2];
    const char* cA = cur.a; const char* cB = cur.b0; const char* cB1 = cur.b1;
    E.prep(cur, 0);
    PG8_STAGE(PG8_SB(0, 0), cB, voffB); PG8_STAGE(PG8_SB(0, 1), cB + hstepB, voffB); PG8_STAGE_A(PG8_SA(0, 0), cA, 0, false, false); PG8_STAGE_A(PG8_SA(0, 1), cA, 1, false, false);
    if (wr == 1) PG8_BAR;
    PG8_WAIT_V(2); PG8_BAR;
    PG8_STAGE(PG8_SB(1, 0), cB + kstep, voffB); PG8_STAGE_A(PG8_SA(1, 0), cA + kstep, 0, false, false); PG8_STAGE(PG8_SB(1, 1), cB + hstepB + kstep, voffB);
    PG8_WAIT_V(6); PG8_BAR;
    for (;;) {
        const bool has_next = S.next(ui + 1, nxt);
        const char* nA = has_next ? nxt.a : cA; const char* nB = has_next ? nxt.b0 : cB;
#pragma nounroll
        for (int t = 0; t < nt; t += 2) {
            const bool last = (t == nt - 2);
            const bool lnx = last && has_next;
            const bool hi_ok = (GATHER != 2) || (cur.hi != 0);
            const bool bj1_ok = cur.upad_ == 0;
            const bool s1 = (GATHER == 2) && (t + 1 >= tsplit), s2 = (GATHER == 2) && !last && (t + 2 >= tsplit);
            const char* a1 = cA + (size_t)(t + 1 - (s1 ? tsplit : 0)) * kstep;
            const char* a2 = last ? nA : cA + (size_t)(t + 2 - (s2 ? tsplit : 0)) * kstep;
            const char* b2 = last ? nB : ((t + 2) < tsplit ? cB + (size_t)(t + 2) * kstep : cB1 + (size_t)(t + 2 - tsplit) * kstep);
            const char* a3 = a2 + kstep; const char* b3 = b2 + kstep;
            if (t == 0 && has_next) { PG8_GOFF(nvA, nxt, false); }
            PG8_LDB(B0, 0, 0); PG8_LDB(B1, 0, 1); PG8_SCHED; PG8_LDA(At, 0, 0); PG8_STAGE_A(PG8_SA(1, 1), a1, 1, false, s1);
            PG8_WAIT_V(8); PG8_WAIT_L(0); PG8_BAR; PG8_MMA(0, 0, At, B0); if constexpr (!skip_bj1<Epi>::v) { if (bj1_ok) PG8_MMA(0, 1, At, B1); } PG8_BAR; PG8_SCHED;
            PG8_LDA(At, 0, 1); PG8_STAGE(PG8_SB(0, 0), b2, voffB); PG8_STAGE(PG8_SB(0, 1), b2 + hstepB, voffB); PG8_STAGE_A(PG8_SA(0, 0), a2, 0, lnx, s2);
            PG8_WAIT_V(8); PG8_WAIT_L(0); PG8_BAR; if (hi_ok) { PG8_MMA(1, 0, At, B0); if constexpr (!skip_bj1<Epi>::v) { if (bj1_ok) PG8_MMA(1, 1, At, B1); } } PG8_BAR; PG8_SCHED;
            PG8_LDB(B0, 1, 0); PG8_LDB(B1, 1, 1); PG8_SCHED; PG8_LDA(At, 1, 0); PG8_STAGE_A(PG8_SA(0, 1), a2, 1, lnx, s2);
            PG8_WAIT_V(8); PG8_WAIT_L(0); PG8_BAR; PG8_MMA(0, 0, At, B0); if constexpr (!skip_bj1<Epi>::v) { if (bj1_ok) PG8_MMA(0, 1, At, B1); } PG8_BAR; PG8_SCHED;
            PG8_LDA(At, 1, 1); PG8_STAGE(PG8_SB(1, 0), b3, voffB); PG8_STAGE(PG8_SB(1, 1), b3 + hstepB, voffB); PG8_STAGE_A(PG8_SA(1, 0), a3, 0, lnx, s2);
            PG8_WAIT_V(8); PG8_WAIT_L(0); PG8_BAR; if (hi_ok) { PG8_MMA(1, 0, At, B0); if constexpr (!skip_bj1<Epi>::v) { if (bj1_ok) PG8_MMA(1, 1, At, B1); } } PG8_BAR; PG8_SCHED;
        }
        if constexpr (ALIGN_EPI) { if (wr == 0) PG8_BAR; }
        if constexpr (Epi::PREP_EARLY) { if (has_next) E.prep(nxt, (ui + 1) & 1); }
        TP_NOW(tp_0_);
        E(acc, cur, ui & 1, wr, wc, fr, fq, wid, lane);
        TP_NOW(tp_1_); TP_ADD(lds, wid, 0, tp_0_, tp_1_);
        if (!has_next) break;
        if constexpr (!Epi::PREP_EARLY) E.prep(nxt, (ui + 1) & 1);
#pragma unroll
        for (int a = 0; a < 2; ++a)
#pragma unroll
            for (int b = 0; b < 2; ++b)
#pragma unroll
                for (int m = 0; m < 4; ++m)
#pragma unroll
                    for (int n = 0; n < 2; ++n) acc[a][b][m][n] = (f32x4){0.f, 0.f, 0.f, 0.f};
        cur = nxt; cA = nA; cB = nB; cB1 = nxt.b1; ++ui;
        if constexpr (GATHER != 0) {
#pragma unroll
            for (int h = 0; h < 2; ++h) { cvA[h][0] = nvA[h][0]; cvA[h][1] = nvA[h][1]; }
            PG8_GOFF(cvB, cur, true);
        }
        if constexpr (ALIGN_EPI) { if (wr == 1) PG8_BAR; }
    }
    PG8_WAIT_V(0);
    if constexpr (!ALIGN_EPI) { if (wr == 0) PG8_BAR; }
    PG8_BAR;
    TP_NOW(tp_e_); TP_ADD(lds, wid, 1, tp_s_, tp_e_);
#undef PG8_SA
#undef PG8_SB
#undef PG8_STAGE
#undef PG8_STAGE_A
#undef PG8_LDA
#undef PG8_LDB
#undef PG8_MMA
#undef PG8_WAIT_V
#undef PG8_WAIT_L
#undef PG8_BAR
#undef PG8_SCHED
#undef PG8_GOFF
}
}
constexpr int NWAVES = 8;
constexpr int BATCH = 16, SEQ = 4096, D = 1024, T = BATCH * SEQ, MEML = 256;
constexpr float EPS = 1e-6f;
constexpr float LOG2E = 1.4426950408889634f;
constexpr size_t MiB = 1u << 20;
constexpr size_t WS_CTL = 0, CTL_ZERO_BYTES = 1 * MiB;
constexpr size_t WS_COS = 1 * MiB, WS_SIN = 5 * MiB;
constexpr size_t WS_SS0 = 9 * MiB;
constexpr size_t WS_SSP1 = 10 * MiB, WS_SSP2 = 14 * MiB;
constexpr size_t WS_MISC = 18 * MiB;
constexpr size_t WS_W = 20 * MiB;
constexpr size_t W_IN = WS_W, W_Q = W_IN + 6 * MiB, W_KV = W_Q + 512 * 1024, W_OUT = W_KV + 512 * 1024, W_XQ = W_OUT + 2 * MiB, W_XKV = W_XQ + 2 * MiB, W_XO = W_XKV + 4 * MiB, W_R = W_XO + 2 * MiB;
constexpr size_t WS_MN = 40 * MiB, WS_KVX = 48 * MiB;
constexpr size_t WS_XN = 64 * MiB;
#if defined(MK_DEBUG) && MK_DEBUG
constexpr size_t WS_OF = 64 * MiB, WS_OB = 128 * MiB;
constexpr bool XN0_KEPT = false;
#else
constexpr size_t WS_OF = 832 * MiB, WS_OB = 896 * MiB;
constexpr bool XN0_KEPT = true;
#endif
constexpr size_t WS_HQ = 192 * MiB, WS_GF = 256 * MiB, WS_GB = 320 * MiB, WS_HI = 384 * MiB, WS_HG = 448 * MiB, WS_LAT = 512 * MiB;
constexpr size_t WS_CAT = 192 * MiB;
constexpr size_t WS_QX = 320 * MiB;
constexpr size_t WS_Q = 576 * MiB, WS_K = 672 * MiB, WS_V = 768 * MiB;
#if MK_DEBUG
constexpr size_t WS_WGU = 576 * MiB, WS_WD = 640 * MiB;
#else
constexpr size_t WS_WGU = 960 * MiB, WS_WD = 640 * MiB;
#endif
constexpr size_t WS_H = 672 * MiB;
constexpr size_t WS_LG = 792 * MiB;
constexpr size_t WS_REC = 810 * MiB;
constexpr size_t WS_END = 832 * MiB, WS_END_REL = 1024 * MiB;
constexpr int MOE_MAXROWS = 122880, MOE_MAXTILES = 480;
constexpr int CW_CNTP = 32768;
constexpr int CW_TMO = 0, CW_BAR = 4096, CW_CNT = 16384  , CW_CNTE = 16896  , CW_NT = 17000  , CW_NTE = 17064  , CW_CHK = 20000  ;
constexpr size_t REC_ROWPA = 7 * MiB, REC_ROWPB = 8 * MiB, REC_ROWP = 3 * MiB, REC_TILEP = 3 * MiB + 512 * 1024, REC_ROWE = 4 * MiB, REC_WSLOT = 5 * MiB, REC_TILEE = 6 * MiB;
constexpr int MOE_MAXROWSE = 147456;

constexpr int RING_OFF = 0, RING_BYTES = 131072;
constexpr int AUX_OFF = RING_BYTES;
constexpr int AUX_RS = AUX_OFF, AUX_WG = AUX_OFF + 2048, AUX_TOK = AUX_OFF + 4096, AUX_XP = AUX_OFF + 6144, AUX_WSF = AUX_OFF + 10240;
constexpr int MISC_OFF = AUX_OFF + 12288;
constexpr int LDS_BYTES = 147456;

#define GAS __attribute__((address_space(1)))
#define LAS __attribute__((address_space(3)))
typedef unsigned short bf16;
typedef unsigned v4u __attribute__((ext_vector_type(4)));
typedef unsigned v2u __attribute__((ext_vector_type(2)));
typedef float f32x4 __attribute__((ext_vector_type(4)));
typedef float f32x16 __attribute__((ext_vector_type(16)));
typedef short bf16x8 __attribute__((ext_vector_type(8)));
typedef short s16x4 __attribute__((ext_vector_type(4)));
typedef GAS unsigned gu32;
#define RLX_AGENT __ATOMIC_RELAXED, __HIP_MEMORY_SCOPE_AGENT
#define LDS_WAIT() asm volatile("s_waitcnt lgkmcnt(0)" ::: "memory")
#define VM_WAIT() asm volatile("s_waitcnt vmcnt(0)" ::: "memory")
__device__ __forceinline__ unsigned f2bf(float f) { unsigned u = __builtin_bit_cast(unsigned, f); return (u + 0x7fffu + ((u >> 16) & 1u)) >> 16; }
__device__ __forceinline__ unsigned pk2(float lo, float hi) { return pg8::cvt_pk_bf16(lo, hi); }
__device__ __forceinline__ float bf2f(bf16 h) { return __uint_as_float((unsigned)h << 16); }
__device__ __forceinline__ float fast_rcp(float x) { return __builtin_amdgcn_rcpf(x); }
__device__ __forceinline__ float fast_exp2(float x) { return __builtin_amdgcn_exp2f(x); }
__device__ __forceinline__ float silu_f(float v) { return v * fast_rcp(1.0f + fast_exp2(-LOG2E * v)); }
__device__ __forceinline__ float rsq(float x) { return __builtin_amdgcn_rsqf(x); }
typedef _Float16 h16x2 __attribute__((ext_vector_type(2)));
__device__ __forceinline__ unsigned pkh2(float lo, float hi) { h16x2 h; h.x = (_Float16)lo; h.y = (_Float16)hi; return __builtin_bit_cast(unsigned, h); }
__device__ __forceinline__ float h2f(unsigned short h) { return (float)__builtin_bit_cast(_Float16, h); }

#define XB_TMO      128
#define XB_XCNT(j)  (256  + 64 * (j))
#define XB_XSUB(j)  (1280 + 64 * (j))
#define XB_XGEN(j)  (2304 + 64 * (j))
#define XB_TOP      3328
#define XB_TOPGEN   3392
#define XCD_BAR_WORDS 3456
#define XB_SPIN_CAP (1u << 18)
__device__ __forceinline__ unsigned xb_ld(unsigned* p)              { return __hip_atomic_load(p, __ATOMIC_RELAXED, __HIP_MEMORY_SCOPE_AGENT); }
__device__ __forceinline__ unsigned xb_add(unsigned* p, unsigned v) { return __hip_atomic_fetch_add(p, v, __ATOMIC_RELAXED, __HIP_MEMORY_SCOPE_AGENT); }
__device__ __forceinline__ unsigned xb_xcc_id() { return (unsigned)__builtin_amdgcn_s_getreg((3 << 11) | 20) & 0xFu; }
#define XB_SPIN(cond, bar) do { unsigned _sp = 0; while (cond) { __builtin_amdgcn_s_sleep(1); \
    if ((++_sp & 255u) == 0u) { if (xb_ld(&(bar)[XB_TMO])) break; if (_sp > XB_SPIN_CAP) { atomicAdd(&(bar)[XB_TMO], 1u); break; } } } } while (0)
struct XcdBarrier { unsigned* bar; unsigned x; volatile LAS unsigned* st; };
__device__ __forceinline__ XcdBarrier xcd_barrier_post(unsigned* bar, volatile LAS unsigned* st) {
    XcdBarrier b; b.bar = bar; b.x = xb_xcc_id(); b.st = st;
    if (threadIdx.x == 0) (void)xb_add(&bar[XB_XCNT(b.x)], 1u);
    return b;
}
__device__ __forceinline__ void xcd_barrier_complete(unsigned* bar, unsigned x, unsigned& nloc, unsigned& nx) {
    const unsigned G = gridDim.x * gridDim.y * gridDim.z;
    unsigned sum, cnt, mine, sp = 0u;
    for (;;) {
        sum = 0u; cnt = 0u; mine = 0u;
#pragma unroll
        for (unsigned j = 0; j < 16; ++j) { const unsigned c = xb_ld(&bar[XB_XCNT(j)]); sum += c; cnt += (c > 0u) ? 1u : 0u; mine = (j == x) ? c : mine; }
        if (sum == G) break;
        __builtin_amdgcn_s_sleep(1);
        if ((++sp & 255u) == 0u) { if (xb_ld(&bar[XB_TMO])) break; if (sp > XB_SPIN_CAP) { atomicAdd(&bar[XB_TMO], 1u); break; } }
    }
    nloc = mine > 0u ? mine : 1u; nx = cnt > 0u ? cnt : 1u;
}
__device__ __forceinline__ void xcd_barrier(const XcdBarrier& b) {
    asm volatile("s_waitcnt vmcnt(0)" ::: "memory");
    __syncthreads();
    if (threadIdx.x == 0) {
        unsigned* bar = b.bar;
        __builtin_amdgcn_s_waitcnt(0);
        unsigned nloc = b.st[0], nx = b.st[1];
        if (nloc == 0u) { xcd_barrier_complete(bar, b.x, nloc, nx); b.st[0] = nloc; b.st[1] = nx; }
        const unsigned old = xb_add(&bar[XB_XSUB(b.x)], 1u);
        const unsigned gen = old / nloc;
        if (old + 1u == (gen + 1u) * nloc) {
            __builtin_amdgcn_fence(__ATOMIC_RELEASE, "agent");
            asm volatile("s_waitcnt vmcnt(0)" ::: "memory");
            const unsigned og = xb_add(&bar[XB_TOP], 1u);
            const unsigned tg = og / nx;
            if (og + 1u == (tg + 1u) * nx) xb_add(&bar[XB_TOPGEN], 1u);
            else XB_SPIN(xb_ld(&bar[XB_TOPGEN]) == tg, bar);
            __builtin_amdgcn_fence(__ATOMIC_ACQUIRE, "agent");
            xb_add(&bar[XB_XGEN(b.x)], 1u);
            asm volatile("s_waitcnt vmcnt(0)" ::: "memory");
        } else {
            XB_SPIN(xb_ld(&bar[XB_XGEN(b.x)]) == gen, bar);
            __builtin_amdgcn_fence(__ATOMIC_ACQUIRE, "agent");
            asm volatile("s_waitcnt vmcnt(0)" ::: "memory");
        }
    }
    __syncthreads();
}

__device__ __forceinline__ void xcd_barrier_arrive(const XcdBarrier& b) {
    asm volatile("s_waitcnt vmcnt(0)" ::: "memory");
    __syncthreads();
    if (threadIdx.x == 0) {
        unsigned* bar = b.bar;
        __builtin_amdgcn_s_waitcnt(0);
        unsigned nloc = b.st[0], nx = b.st[1];
        if (nloc == 0u) { xcd_barrier_complete(bar, b.x, nloc, nx); b.st[0] = nloc; b.st[1] = nx; }
        const unsigned old = xb_add(&bar[XB_XSUB(b.x)], 1u);
        const unsigned gen = old / nloc;
        unsigned role = 0u, tg = 0u;
        if (old + 1u == (gen + 1u) * nloc) {
            __builtin_amdgcn_fence(__ATOMIC_RELEASE, "agent");
            asm volatile("s_waitcnt vmcnt(0)" ::: "memory");
            const unsigned og = xb_add(&bar[XB_TOP], 1u);
            tg = og / nx; role = 1u;
            if (og + 1u == (tg + 1u) * nx) { xb_add(&bar[XB_TOPGEN], 1u); role = 2u; }
        }
        b.st[2] = role; b.st[3] = gen; b.st[4] = tg;
    }
}
__device__ __forceinline__ void xcd_barrier_wait(const XcdBarrier& b) {
    asm volatile("s_waitcnt vmcnt(0)" ::: "memory");
    __syncthreads();
    if (threadIdx.x == 0) {
        unsigned* bar = b.bar;
        const unsigned role = b.st[2], gen = b.st[3], tg = b.st[4];
        if (role != 0u) {
            if (role == 1u) XB_SPIN(xb_ld(&bar[XB_TOPGEN]) == tg, bar);
            __builtin_amdgcn_fence(__ATOMIC_ACQUIRE, "agent");
            xb_add(&bar[XB_XGEN(b.x)], 1u);
            asm volatile("s_waitcnt vmcnt(0)" ::: "memory");
        } else {
            XB_SPIN(xb_ld(&bar[XB_XGEN(b.x)]) == gen, bar);
            __builtin_amdgcn_fence(__ATOMIC_ACQUIRE, "agent");
            asm volatile("s_waitcnt vmcnt(0)" ::: "memory");
        }
    }
    __syncthreads();
}

struct Inputs {
    const float *x, *mem; const int* pos; const float *norm_mix, *w_in, *q_a_norm, *w_q_up, *kv_a_norm, *w_kv_up, *q_norm, *k_norm, *lb_logits, *o_norm, *w_out, *norm_cross, *norm_mem,
        *x_w_q, *x_w_kv, *x_q_norm, *x_k_norm, *x_w_o, *norm_ffn, *w_group, *b_group, *w_expert, *b_expert, *w_gate, *w_up, *w_down;
};
struct Frame {
    LAS unsigned char* lds;
    volatile LAS unsigned* MISC;
    gu32* ctl;
    unsigned char* ws;
    int wave, vcu, G;
    __device__ __forceinline__ int tid() const { return pg8::tid_opaque(); }
    __device__ __forceinline__ int lane() const { return pg8::tid_opaque() & 63; }
};
__device__ __forceinline__ float wave_sum(float v) {
#pragma unroll
    for (int o = 1; o < 64; o <<= 1) v += __shfl_xor(v, o);
    return v;
}
struct TItem { const float* W; const float* gain; bf16* WT; int ldw, k0, n0, ldt, row0; };
struct TRegs { float wv[32]; f32x4 g0, g1; };
__device__ __forceinline__ void ti_load(const TItem& t, TRegs& r, int lane) {
#pragma unroll
    for (int i = 0; i < 32; ++i) r.wv[i] = t.W[(size_t)(t.k0 + 2 * i + (lane >> 5)) * t.ldw + t.n0 + (lane & 31)];
    if (t.gain) { r.g0 = *(const f32x4*)(t.gain + t.k0 + 8 * (lane & 7)); r.g1 = *(const f32x4*)(t.gain + t.k0 + 8 * (lane & 7) + 4); } else { r.g0 = (f32x4){1.f, 1.f, 1.f, 1.f}; r.g1 = r.g0; }
}
__device__ __forceinline__ void ti_finish(const TItem& t, const TRegs& r, LAS float* scr, int lane) {
#pragma unroll
    for (int i = 0; i < 32; ++i) scr[(2 * i + (lane >> 5)) * 33 + (lane & 31)] = r.wv[i];
    LDS_WAIT(); asm volatile("" ::: "memory");
    const int c = lane & 7;
#pragma unroll
    for (int j = 0; j < 4; ++j) { const int n = (lane >> 3) + 8 * j; const LAS float* s = scr + (8 * c) * 33 + n;
        v4u o; o.x = pk2(s[0 * 33] * r.g0[0], s[1 * 33] * r.g0[1]); o.y = pk2(s[2 * 33] * r.g0[2], s[3 * 33] * r.g0[3]); o.z = pk2(s[4 * 33] * r.g1[0], s[5 * 33] * r.g1[1]); o.w = pk2(s[6 * 33] * r.g1[2], s[7 * 33] * r.g1[3]);
        *(GAS v4u*)(t.WT + (size_t)(t.row0 + n) * t.ldt + t.k0 + 8 * c) = o; }
    LDS_WAIT(); asm volatile("" ::: "memory");
}
struct TJob { const float* W; int K, N, ldw; const float* gain; bf16* WT; int ldt; int mode; };
__device__ __forceinline__ int tjob_row(int mode, int n0) {
    if (mode == 1) return n0 >= 352 ? n0 - 352 : n0 + 2560;
    if (mode == 2) return (n0 >> 7) * 256 + (n0 & 127);
    if (mode == 3) return (n0 >> 7) * 256 + 128 + (n0 & 127);
    return n0;
}
__device__ __forceinline__ void tjob_run(const TJob& j, LAS float* scr, int gw, int NGW, int lane) {
    const int nblk = j.N / 32, nit = (j.K / 64) * nblk;
    auto item = [&](int it) { TItem t; t.W = j.W; t.gain = j.gain; t.WT = j.WT; t.ldw = j.ldw; t.k0 = (it / nblk) * 64; t.n0 = (it % nblk) * 32; t.ldt = j.ldt; t.row0 = tjob_row(j.mode, t.n0); return t; };
    if (gw >= nit) return;
    TItem cur = item(gw); TRegs rc; ti_load(cur, rc, lane);
    for (int it = gw; it < nit; it += NGW) {
        const bool more = it + NGW < nit; TItem nx = cur; TRegs rn = rc;
        if (more) { nx = item(it + NGW); ti_load(nx, rn, lane); }
        ti_finish(cur, rc, scr, lane);
        cur = nx; rc = rn;
    }
}
__device__ __forceinline__ void p0_prologue(Frame& F, const Inputs& in) {
    LAS float* scr = (LAS float*)(F.lds + RING_OFF + F.wave * 16384);
    const int gw = F.vcu * NWAVES + F.wave, NGW = F.G * NWAVES, lane = F.lane();
    unsigned char* ws = F.ws;
    { TJob j{in.w_in, 1024, 2912, 2912, in.norm_mix, (bf16*)(ws + W_IN), 1024, 1}; tjob_run(j, scr, gw, NGW, lane); }
    { TJob j{in.w_q_up, 192, 768, 768, in.q_a_norm, (bf16*)(ws + W_Q), 192, 0}; tjob_run(j, scr, gw, NGW, lane); }
    { TJob j{in.w_kv_up, 128, 1024, 1024, in.kv_a_norm, (bf16*)(ws + W_KV), 128, 0}; tjob_run(j, scr, gw, NGW, lane); }
    { TJob j{in.w_out, 1024, 1024, 1024, nullptr, (bf16*)(ws + W_OUT), 1024, 0}; tjob_run(j, scr, gw, NGW, lane); }
    { TJob j{in.x_w_q, 1024, 1024, 1024, in.norm_cross, (bf16*)(ws + W_XQ), 1024, 0}; tjob_run(j, scr, gw, NGW, lane); }
    { TJob j{in.x_w_kv, 1024, 2048, 2048, nullptr, (bf16*)(ws + W_XKV), 1024, 0}; tjob_run(j, scr, gw, NGW, lane); }
    { TJob j{in.x_w_o, 1024, 1024, 1024, nullptr, (bf16*)(ws + W_XO), 1024, 0}; tjob_run(j, scr, gw, NGW, lane); }
    const int gt = (F.vcu * NWAVES + F.wave) * 64 + lane, NGT = NGW * 64;
    for (int i = gt; i < 160 * 1024 / 8; i += NGT) *(GAS v4u*)((bf16*)(ws + W_IN) + (size_t)2912 * 1024 + (size_t)i * 8) = (v4u){0u, 0u, 0u, 0u};
    for (int i = gt; i < 256 * 1024; i += NGT) { const int c = i >> 10, k = i & 1023; float v = 0.f;
        if (c < 8) v = in.w_group[k * 8 + c] * in.norm_ffn[k]; else if (c < 72) v = in.w_expert[k * 64 + (c - 8)] * in.norm_ffn[k];
        ((bf16*)(ws + W_R))[i] = (bf16)f2bf(v); }
    for (int i = gt; i < T * 16; i += NGT) { const int t = i >> 4, j = i & 15;
        const float inv_freq = 1.0f / powf(10000.0f, (float)j / 16.0f); const float ang = (float)in.pos[t] * inv_freq;
        const double rev = (double)ang * 0.15915494309189535; const float fr = (float)(rev - floor(rev));
        ((float*)(ws + WS_COS))[i] = __builtin_amdgcn_cosf(fr); ((float*)(ws + WS_SIN))[i] = __builtin_amdgcn_sinf(fr); }
    float* misc = (float*)(ws + WS_MISC);
    for (int i = gt; i < 1024; i += NGT) { const float l0 = in.lb_logits[i], l1 = in.lb_logits[1024 + i]; misc[i] = 1.0f / (1.0f + expf(l1 - l0)); }
    if (gw == 0) {
        float mq = 0.f, mk = 0.f, xq = 0.f, xk = 0.f;
        for (int i = lane; i < 96; i += 64) { mq = fmaxf(mq, fabsf(in.q_norm[i])); mk = fmaxf(mk, fabsf(in.k_norm[i])); }
        for (int i = lane; i < 256; i += 64) { xq = fmaxf(xq, fabsf(in.x_q_norm[i])); xk = fmaxf(xk, fabsf(in.x_k_norm[i])); }
#pragma unroll
        for (int o = 1; o < 64; o <<= 1) { mq = fmaxf(mq, __shfl_xor(mq, o)); mk = fmaxf(mk, __shfl_xor(mk, o)); xq = fmaxf(xq, __shfl_xor(xq, o)); xk = fmaxf(xk, __shfl_xor(xk, o)); }
        if (lane == 0) { misc[1024] = LOG2E * 9.797958971132712f * mq * mk; misc[1025] = LOG2E * 16.0f * xq * xk; }
    }
    for (int m = gw; m < T; m += 4 * NGW) {
        f32x4 v[4][4];
#pragma unroll
        for (int q = 0; q < 4; ++q) { const int mq = m + q * NGW; const GAS f32x4* xr = (const GAS f32x4*)(in.x + (size_t)(mq < T ? mq : m) * D) + lane;
#pragma unroll
            for (int j = 0; j < 4; ++j) v[q][j] = xr[64 * j]; }
#pragma unroll
        for (int q = 0; q < 4; ++q) { const int mq = m + q * NGW; float s = 0.f;
#pragma unroll
            for (int j = 0; j < 4; ++j) s += (v[q][j].x * v[q][j].x + v[q][j].y * v[q][j].y) + (v[q][j].z * v[q][j].z + v[q][j].w * v[q][j].w);
            s = wave_sum(s);
            if (mq < T) { GAS unsigned long long* o8 = (GAS unsigned long long*)((bf16*)(ws + WS_XN) + (size_t)mq * D) + lane;
#pragma unroll
                for (int j = 0; j < 4; ++j) o8[64 * j] = (unsigned long long)pk2(v[q][j].x, v[q][j].y) | ((unsigned long long)pk2(v[q][j].z, v[q][j].w) << 32);
                if (lane == 0) ((float*)(ws + WS_SS0))[mq] = s; } }
    }
    for (int m = gw; m < BATCH * MEML; m += NGW) {
        const GAS f32x4* xr = (const GAS f32x4*)(in.mem + (size_t)m * D) + lane; f32x4 v[4]; float s = 0.f;
#pragma unroll
        for (int j = 0; j < 4; ++j) { v[j] = xr[64 * j]; s += (v[j].x * v[j].x + v[j].y * v[j].y) + (v[j].z * v[j].z + v[j].w * v[j].w); }
        const float r = 1.0f / sqrtf(wave_sum(s) * (1.f / D) + EPS);
        GAS unsigned long long* o8 = (GAS unsigned long long*)((bf16*)(ws + WS_MN) + (size_t)m * D) + lane;
#pragma unroll
        for (int j = 0; j < 4; ++j) { const f32x4 g = *((const GAS f32x4*)in.norm_mem + lane + 64 * j);
            o8[64 * j] = (unsigned long long)pk2(v[j].x * r * g.x, v[j].y * r * g.y) | ((unsigned long long)pk2(v[j].z * r * g.z, v[j].w * r * g.w) << 32); }
    }
}
__device__ __forceinline__ void moe_weights(Frame& F, const Inputs& in, const int ibase, const int icount, const int r0, const int r1) {
    LAS float* scr = (LAS float*)(F.lds + RING_OFF + F.wave * 16384);
    const int gw = F.vcu * NWAVES + F.wave, NGW = F.G * NWAVES, lane = F.lane();
    auto item = [&](int it) { TItem t; const bool gu_ = it < 16384; const int i2_ = gu_ ? it : it - 16384; const int e = gu_ ? (i2_ >> 8) : (i2_ >> 7), kind = gu_ ? ((i2_ >> 7) & 1) : 2, q = i2_ & 127;
        if (kind == 0) { t.W = in.w_gate + (size_t)e * 262144; t.gain = in.norm_ffn; t.WT = (bf16*)(F.ws + WS_WGU) + (size_t)e * 524288; t.ldw = 256; t.k0 = (q >> 3) * 64; t.n0 = (q & 7) * 32; t.ldt = 1024; t.row0 = tjob_row(2, t.n0); }
        else if (kind == 1) { t.W = in.w_up + (size_t)e * 262144; t.gain = in.norm_ffn; t.WT = (bf16*)(F.ws + WS_WGU) + (size_t)e * 524288; t.ldw = 256; t.k0 = (q >> 3) * 64; t.n0 = (q & 7) * 32; t.ldt = 1024; t.row0 = tjob_row(3, t.n0); }
        else { t.W = in.w_down + (size_t)e * 262144; t.gain = nullptr; t.WT = (bf16*)(F.ws + WS_WD) + (size_t)e * 262144; t.ldw = 1024; t.k0 = (q >> 5) * 64; t.n0 = (q & 31) * 32; t.ldt = 256; t.row0 = t.n0; }
        return t; };
    const int nit = ibase + icount;
    const int it0 = ibase + gw + r0 * NGW; const long long itend_ = (long long)ibase + gw + (long long)r1 * NGW; const int it1 = itend_ < nit ? (int)itend_ : nit;
    if (it0 >= it1) return;
    TItem cur = item(it0); TRegs rc; ti_load(cur, rc, lane);
    for (int it = it0; it < it1; it += NGW) {
        const bool more = it + NGW < it1; TItem nx = cur; TRegs rn = rc;
        if (more) { nx = item(it + NGW); ti_load(nx, rn, lane); }
        ti_finish(cur, rc, scr, lane);
        cur = nx; rc = rn;
    }
}

using pg8::Unit; using pg8::bf16_t;
struct SchedGrid {
    const char* A; const char* B; size_t astep, bstep; pg8::GridOrder o; int pad_; int pad2_;
    __device__ __forceinline__ bool next(int i, Unit& u) const { int pm, pn; if (!o.tile(i, pm, pn)) return false; u.pm = pm; u.pn = pn; u.a = A + (size_t)pm * astep; u.b0 = u.b1 = B + (size_t)pn * bstep; u.rows = nullptr; u.map0 = nullptr; u.map1 = nullptr; u.upad_ = (pad_ != 0 && pn == pad_) ? 1 : 0; return true; }
};
struct SchedPanel {
    const char* A; const char* B; size_t astep, bstep; int pm, nN;
    __device__ __forceinline__ bool next(int i, Unit& u) const { if (i >= nN) return false; int p_ = pm; asm volatile("" : "+s"(p_)); u.pm = p_; u.pn = i;     u.a = A + (size_t)p_ * astep; u.b0 = u.b1 = B + (size_t)i * bstep; u.rows = nullptr; u.map0 = nullptr; u.map1 = nullptr; return true; }
};
__device__ __forceinline__ float rstd16(const float* p) {
    const f32x4 a = *(const f32x4*)p, b = *(const f32x4*)(p + 4), c = *(const f32x4*)(p + 8), d = *(const f32x4*)(p + 12);
    const float s = ((a.x + a.y) + (a.z + a.w)) + ((b.x + b.y) + (b.z + b.w)) + ((c.x + c.y) + (c.z + c.w)) + ((d.x + d.y) + (d.z + d.w));
    return rsq(s * (1.f / D) + EPS);
}
typedef pg8::f32x4 (AccT)[2][2][4][2];

struct EpiIn {
    static constexpr bool PREP_EARLY = true;
    bf16_t* bufs; const float* ss; const float* lbt; LAS float* RS; int cheap;
    __device__ __forceinline__ void prep(const Unit& u, int par) const { const int t = pg8::tid_opaque(); if (t < 256) RS[par * 256 + t] = rsq(ss[u.pm * 256 + t] * (1.f / D) + EPS); }
    __device__ __forceinline__ void operator()(const AccT& acc, const Unit& u, int par, int wr, int wc, int fr, int fq, int wid, int lane) const {
        const int grp = u.pn >> 1, colg = (u.pn & 1) * 256 + wc * 32 + 8 * fq;
        bf16_t* base = bufs + (size_t)grp * ((size_t)T * 512);
#ifdef MK_PROBE_P1CHEAP
        const int mode = cheap ? 0 : ((grp == 0 || grp == 4) ? 1 : ((grp == 1 || grp == 2) ? 2 : 0));
#else
        const int mode = (grp == 0 || grp == 4) ? 1 : ((grp == 1 || grp == 2) ? 2 : 0);
#endif
        f32x4 lb[2][2];
#pragma unroll
        for (int bj = 0; bj < 2; ++bj)
#pragma unroll
            for (int n = 0; n < 2; ++n) lb[bj][n] = (mode == 2) ? *(const f32x4*)(lbt + (grp - 1) * 512 + colg + bj * 128 + 4 * n) : (f32x4){0.f, 0.f, 0.f, 0.f};
#pragma unroll
        for (int ai = 0; ai < 2; ++ai)
#pragma unroll
            for (int m = 0; m < 4; ++m) { const int rl = ai * 128 + wr * 64 + m * 16 + fr; const float rs = RS[par * 256 + rl]; bf16_t* rowp = base + (size_t)(u.pm * 256 + rl) * 512 + colg;
#pragma unroll
                for (int bj = 0; bj < 2; ++bj) { f32x4 v[2]; v[0] = acc[ai][bj][m][0] * rs; v[1] = acc[ai][bj][m][1] * rs; v4u w;
                    if (mode == 2) {
#pragma unroll
                        for (int n = 0; n < 2; ++n)
#pragma unroll
                            for (int e = 0; e < 4; ++e) { const float sg = fast_rcp(1.0f + fast_exp2(-LOG2E * v[n][e])); const float l = lb[bj][n][e]; v[n][e] = __builtin_amdgcn_logf(l + (1.0f - l) * sg); }
                        w.x = pkh2(v[0][0], v[0][1]); w.y = pkh2(v[0][2], v[0][3]); w.z = pkh2(v[1][0], v[1][1]); w.w = pkh2(v[1][2], v[1][3]);
                    } else {
                        if (mode == 1) {
#pragma unroll
                            for (int n = 0; n < 2; ++n)
#pragma unroll
                                for (int e = 0; e < 4; ++e) v[n][e] = silu_f(v[n][e]);
                        }
                        w.x = pk2(v[0][0], v[0][1]); w.y = pk2(v[0][2], v[0][3]); w.z = pk2(v[1][0], v[1][1]); w.w = pk2(v[1][2], v[1][3]);
                    }
                    if (grp != 5 || colg + bj * 128 < 352) *(v4u*)(rowp + bj * 128) = w; } }
    }
};
template <bool RBF>
struct EpiRes {
    static constexpr bool PREP_EARLY = true;
    const void* resid; bf16_t* xn; float* ssp;
    __device__ __forceinline__ void prep(const Unit&, int) const {}
    __device__ __forceinline__ void operator()(const AccT& acc, const Unit& u, int par, int wr, int wc, int fr, int fq, int wid, int lane) const {
        const int col0 = u.pn * 256 + wc * 32 + 8 * fq;
        const size_t rowb = (size_t)(u.pm * 256 + wr * 64 + fr);
        constexpr int NB = RBF ? 8 : 4;
#pragma unroll
        for (int b0 = 0; b0 < 8; b0 += NB) {
            v4u rb[NB][2]; f32x4 rf[NB][2][2];
#pragma unroll
            for (int q = 0; q < NB; ++q) { const int g = b0 + q; const size_t off0 = (rowb + (g >> 2) * 128 + (g & 3) * 16) * D + col0;
#pragma unroll
                for (int bj = 0; bj < 2; ++bj) {
                    if constexpr (RBF) rb[q][bj] = *(const v4u*)((const bf16_t*)resid + off0 + bj * 128);
                    else { rf[q][bj][0] = *(const f32x4*)((const float*)resid + off0 + bj * 128); rf[q][bj][1] = *(const f32x4*)((const float*)resid + off0 + bj * 128 + 4); } } }
            asm volatile("" ::: "memory");
#pragma unroll
            for (int q = 0; q < NB; ++q) { const int g = b0 + q, ai = g >> 2, m = g & 3; const size_t row = rowb + ai * 128 + m * 16; float sq = 0.f;
#pragma unroll
                for (int bj = 0; bj < 2; ++bj) { const size_t off = row * D + col0 + bj * 128; f32x4 r0, r1;
                    if constexpr (RBF) { const v4u w_ = rb[q][bj]; r0 = (f32x4){pg8::bf_lo(w_.x), pg8::bf_hi(w_.x), pg8::bf_lo(w_.y), pg8::bf_hi(w_.y)}; r1 = (f32x4){pg8::bf_lo(w_.z), pg8::bf_hi(w_.z), pg8::bf_lo(w_.w), pg8::bf_hi(w_.w)}; }
                    else { r0 = rf[q][bj][0]; r1 = rf[q][bj][1]; }
                    const f32x4 o0 = r0 + acc[ai][bj][m][0], o1 = r1 + acc[ai][bj][m][1];
                    v4u w; w.x = pk2(o0[0], o0[1]); w.y = pk2(o0[2], o0[3]); w.z = pk2(o1[0], o1[1]); w.w = pk2(o1[2], o1[3]); *(v4u*)(xn + off) = w;
                    sq += (o0[0] * o0[0] + o0[1] * o0[1]) + (o0[2] * o0[2] + o0[3] * o0[3]) + (o1[0] * o1[0] + o1[1] * o1[1]) + (o1[2] * o1[2] + o1[3] * o1[3]); }
                sq += __shfl_xor(sq, 16); sq += __shfl_xor(sq, 32);
                if (fq == 0) ssp[row * 16 + u.pn * 4 + wc] = sq; }
        }
    }
};
struct EpiHeadNorm {
    static constexpr bool PREP_EARLY = false;
    const float* ssp; const float* gain; bf16_t* O; LAS float* RS; LAS float* XP; float gscale; int ldo; int nnorm; int pad_;
    __device__ __forceinline__ void prep(const Unit& u, int par) const { const int t = pg8::tid_opaque(); if (ssp && t < 256) RS[par * 256 + t] = rstd16(ssp + (size_t)(u.pm * 256 + t) * 16); }
    __device__ __forceinline__ void operator()(const AccT& acc, const Unit& u, int par, int wr, int wc, int fr, int fq, int wid, int lane) const {
        const bool norm = u.pn < nnorm; const int colh = wc * 32 + 8 * fq;
        if (norm) {
#pragma unroll
            for (int ai = 0; ai < 2; ++ai)
#pragma unroll
                for (int m = 0; m < 4; ++m) { float sq = 0.f;
#pragma unroll
                    for (int bj = 0; bj < 2; ++bj)
#pragma unroll
                        for (int n = 0; n < 2; ++n) { const f32x4 v = acc[ai][bj][m][n]; sq += (v[0] * v[0] + v[1] * v[1]) + (v[2] * v[2] + v[3] * v[3]); }
                    sq += __shfl_xor(sq, 16); sq += __shfl_xor(sq, 32);
                    if (fq == 0) XP[(ai * 128 + wr * 64 + m * 16 + fr) * 4 + wc] = sq; }
        }
        asm volatile("s_waitcnt lgkmcnt(0)" ::: "memory"); __builtin_amdgcn_s_barrier(); asm volatile("" ::: "memory");
        f32x4 g[2][2];
#pragma unroll
        for (int bj = 0; bj < 2; ++bj)
#pragma unroll
            for (int n = 0; n < 2; ++n) g[bj][n] = norm ? *(const f32x4*)(gain + colh + bj * 128 + 4 * n) * gscale : (f32x4){1.f, 1.f, 1.f, 1.f};
#pragma unroll
        for (int ai = 0; ai < 2; ++ai)
#pragma unroll
            for (int m = 0; m < 4; ++m) { const int rl = ai * 128 + wr * 64 + m * 16 + fr; const size_t row = (size_t)(u.pm * 256 + rl);
                float h = 1.0f;
                if (norm) { const f32x4 p = *(const LAS f32x4*)(XP + rl * 4); const float rs = ssp ? RS[par * 256 + rl] : 1.0f; const float s = ((p[0] + p[1]) + (p[2] + p[3])) * rs * rs; h = rs * rsq(s * (1.f / 256.f) + EPS); }
#pragma unroll
                for (int bj = 0; bj < 2; ++bj) { const f32x4 v0 = acc[ai][bj][m][0] * h * g[bj][0], v1 = acc[ai][bj][m][1] * h * g[bj][1];
                    v4u w; w.x = pk2(v0[0], v0[1]); w.y = pk2(v0[2], v0[3]); w.z = pk2(v1[0], v1[1]); w.w = pk2(v1[2], v1[3]);
                    *(v4u*)(O + row * ldo + u.pn * 256 + colh + bj * 128) = w; } }
        asm volatile("s_waitcnt lgkmcnt(0)" ::: "memory"); __builtin_amdgcn_s_barrier(); asm volatile("" ::: "memory");
    }
};
struct EpiRouter {
    static constexpr bool PREP_EARLY = false; static constexpr bool SKIP_BJ1 = true;
    const float* ssp; const float* bg; const float* be; float* LG; LAS float* RS; int pad_;
    __device__ __forceinline__ void prep(const Unit& u, int par) const { const int t = pg8::tid_opaque(); if (t < 256) RS[par * 256 + t] = rstd16(ssp + (size_t)(u.pm * 256 + t) * 16); }
    __device__ __forceinline__ void operator()(const AccT& acc, const Unit& u, int par, int wr, int wc, int fr, int fq, int wid, int lane) const {
        const int col0 = wc * 32 + 8 * fq;
        if (col0 < 72) {
            f32x4 b0, b1;
#pragma unroll
            for (int e = 0; e < 4; ++e) { const int c0 = col0 + e, c1 = col0 + 4 + e; b0[e] = c0 < 8 ? bg[c0] : be[c0 - 8]; b1[e] = c1 < 8 ? bg[c1] : be[c1 - 8]; }
#pragma unroll
            for (int ai = 0; ai < 2; ++ai)
#pragma unroll
                for (int m = 0; m < 4; ++m) { const int rl = ai * 128 + wr * 64 + m * 16 + fr; const float rs = RS[par * 256 + rl]; float* p = LG + (size_t)(u.pm * 256 + rl) * 72 + col0;
                    *(f32x4*)p = acc[ai][0][m][0] * rs + b0; *(f32x4*)(p + 4) = acc[ai][0][m][1] * rs + b1; }
        }
    }
};
struct SchedMoeA {
    const int* tilee; const int* rowe; const char* XN; const char* WGU; int ntile, G, c, pad_;
    __device__ __forceinline__ bool next(int i, Unit& u) const { const long L = (long)i * G + c; if (L >= (long)ntile * 2) return false; const int tl = (int)(L >> 1), pn = (int)(L & 1);
        const int e = __builtin_amdgcn_readfirstlane(tilee[tl]);
        u.pm = tl; u.pn = pn; u.a = XN; u.rows = rowe + tl * 256; u.map0 = nullptr; u.map1 = nullptr; u.b0 = u.b1 = WGU + (size_t)e * (512 * 1024 * 2) + (size_t)pn * (256 * 1024 * 2); return true; }
};
struct EpiMoeA {
    static constexpr bool PREP_EARLY = false;
    const float* ssp; const float* wslot; bf16_t* H; LAS float* RS; LAS float* WG;
    __device__ __forceinline__ void prep(const Unit& u, int par) const { const int t = pg8::tid_opaque(); if (t < 256) { const int tok = u.rows[t];
        RS[par * 256 + t] = tok < 0 ? 0.f : rstd16(ssp + (size_t)tok * 16); WG[par * 256 + t] = wslot[u.pm * 256 + t]; } }
    __device__ __forceinline__ void operator()(const AccT& acc, const Unit& u, int par, int wr, int wc, int fr, int fq, int wid, int lane) const {
#pragma unroll
        for (int ai = 0; ai < 2; ++ai)
#pragma unroll
            for (int m = 0; m < 4; ++m) { const int rl = ai * 128 + wr * 64 + m * 16 + fr; const float rs = RS[par * 256 + rl], wg = WG[par * 256 + rl]; float h[8];
#pragma unroll
                for (int n = 0; n < 2; ++n)
#pragma unroll
                    for (int e = 0; e < 4; ++e) h[n * 4 + e] = silu_f(acc[ai][0][m][n][e] * rs) * (acc[ai][1][m][n][e] * rs) * wg;
                v4u w; w.x = pk2(h[0], h[1]); w.y = pk2(h[2], h[3]); w.z = pk2(h[4], h[5]); w.w = pk2(h[6], h[7]);
                *(v4u*)(H + (size_t)(u.pm * 256 + rl) * 256 + u.pn * 128 + wc * 32 + 8 * fq) = w; }
    }
};
struct SchedMoeB {
    const int* tilep; const int* rowp; const int* slotA; const int* slotB; const char* Hb; const char* WD; int ntile, G, c, pad_;
    __device__ __forceinline__ bool next(int i, Unit& u) const { const long L = (long)i * G + c; if (L >= (long)ntile * 4) return false; const int tl = (int)(L >> 2), pn = (int)(L & 3);
        const int b = __builtin_amdgcn_readfirstlane(tilep[tl]), ea = (b >> 6) * 8 + ((b >> 3) & 7), eb = (b >> 6) * 8 + (b & 7);
        u.pm = tl; u.pn = pn; u.a = Hb; u.rows = slotA + tl * 256; u.map0 = rowp + tl * 256; u.map1 = slotB + tl * 256;
        u.hi = (__builtin_amdgcn_readfirstlane(rowp[tl * 256 + 128]) >= 0) ? 1 : 0;
        u.b0 = WD + (size_t)ea * (1024 * 256 * 2) + (size_t)pn * (256 * 256 * 2); u.b1 = WD + (size_t)eb * (1024 * 256 * 2) + (size_t)pn * (256 * 256 * 2); return true; }
};
struct EpiMoeB {
    static constexpr bool PREP_EARLY = true;
    const bf16_t* xres; float* out; LAS int* TOK; int pad_;
    __device__ __forceinline__ void prep(const Unit& u, int par) const { const int t = pg8::tid_opaque(); if (t < 256) TOK[par * 256 + t] = u.map0[t]; }
    __device__ __forceinline__ void operator()(const AccT& acc, const Unit& u, int par, int wr, int wc, int fr, int fq, int wid, int lane) const {
        const int col0 = u.pn * 256 + wc * 32 + 8 * fq;
        int tok[8]; v4u rb[8][2];
#pragma unroll
        for (int g = 0; g < 8; ++g) { tok[g] = TOK[par * 256 + (g >> 2) * 128 + wr * 64 + (g & 3) * 16 + fr]; const unsigned off = (unsigned)(tok[g] < 0 ? 0 : tok[g]) * (unsigned)D + (unsigned)col0;
            rb[g][0] = *(const v4u*)(xres + off); rb[g][1] = *(const v4u*)(xres + off + 128); }
        asm volatile("" ::: "memory");
#pragma unroll
        for (int g = 0; g < 8; ++g) { const int ai = g >> 2, m = g & 3; const unsigned off = (unsigned)(tok[g] < 0 ? 0 : tok[g]) * (unsigned)D + (unsigned)col0;
#pragma unroll
            for (int bj = 0; bj < 2; ++bj) { const v4u w_ = rb[g][bj];
                const f32x4 o0 = (f32x4){pg8::bf_lo(w_.x), pg8::bf_hi(w_.x), pg8::bf_lo(w_.y), pg8::bf_hi(w_.y)} + acc[ai][bj][m][0], o1 = (f32x4){pg8::bf_lo(w_.z), pg8::bf_hi(w_.z), pg8::bf_lo(w_.w), pg8::bf_hi(w_.w)} + acc[ai][bj][m][1];
                if (tok[g] >= 0) { *(f32x4*)(out + off + bj * 128) = o0; *(f32x4*)(out + off + bj * 128 + 4) = o1; } } }
    }
};
namespace att {
__device__ __forceinline__ int crow(int r, int hi) { return (r & 3) + 8 * (r >> 2) + 4 * hi; }
__device__ __forceinline__ void glds16(const void* gsrc, unsigned lds_dst) { unsigned keep;
    asm volatile("s_mov_b32 %0, m0\n\ts_mov_b32 m0, %2\n\ts_nop 0\n\tglobal_load_lds_dwordx4 %1, off\n\ts_mov_b32 m0, %0" : "=&s"(keep) : "v"(gsrc), "s"(lds_dst) : "memory"); }
typedef __attribute__((address_space(3))) const char* lds_cptr;
typedef short v4i16_t __attribute__((ext_vector_type(4)));
__device__ __forceinline__ s16x4 vtr(lds_cptr p) { return __builtin_bit_cast(s16x4, __builtin_amdgcn_ds_read_tr16_b64_v4i16((__attribute__((address_space(3))) v4i16_t*)p)); }

typedef float f32x2_t __attribute__((ext_vector_type(2))); typedef __bf16 bf16x2_t __attribute__((ext_vector_type(2)));
__device__ __forceinline__ unsigned cvtpk_s(float lo, float hi) { f32x2_t v = {lo, hi}; bf16x2_t b = __builtin_convertvector(v, bf16x2_t); return __builtin_bit_cast(unsigned, b); }
struct Tensors { const bf16* Q; const bf16* K; const bf16* V; bf16* O; int qp, kp, vp, op; };

template <int KS, int DVB, int NDV, int QW, bool QREG, bool NOSHIFT>
__device__ __forceinline__ void unit(const Tensors& Tn, const int q0, const int NT, const float cbound, char* shm, LAS float* wsf_all) {
    constexpr int KSLOT = 64 * KS * 32, VSLOT = 64 * DVB * 64, SLOT = KSLOT + VSLOT, NKP = KS * 2, NVP = DVB * 4;
    constexpr bool KLINE = (KS % 4 == 0);
    const int tid = pg8::tid_opaque(), lane = tid & 63, r32 = lane & 31, hi = lane >> 5; const int wid = __builtin_amdgcn_readfirstlane(tid >> 6);
    const int qb = wid % QW, dvb0 = (wid / QW) * NDV;
    const unsigned lds0 = (unsigned)(uintptr_t)shm;
    LAS float* wsf = wsf_all + wid * 64;
    const lds_cptr shm3 = (lds_cptr)shm;
    const bf16* ksrc = Tn.K + (size_t)lane * Tn.kp;
    const bf16* vsrc = Tn.V + (size_t)(lane >> 2) * Tn.vp + (lane & 3) * 8;
#define ATT_DMA(t, slot) do { \
        if constexpr (KLINE) {   \
            _Pragma("unroll") for (int p_ = 0; p_ < NKP / 8; ++p_) { const int c_ = wid + 8 * p_, cg_ = c_ >> 3, kg_ = c_ & 7; \
                glds16(Tn.K + ((size_t)(t) * 64 + 8 * kg_ + (lane & 7)) * Tn.kp + (8 * cg_ + ((lane >> 3) ^ (kg_ & 1))) * 8, (unsigned)__builtin_amdgcn_readfirstlane(lds0 + (slot) * SLOT + c_ * 1024)); } } \
        else { _Pragma("unroll") for (int p_ = 0; p_ < (NKP + 7) / 8; ++p_) { const int c_ = wid + 8 * p_; if (c_ < NKP) glds16(ksrc + (size_t)(t) * 64 * Tn.kp + c_ * 8, (unsigned)__builtin_amdgcn_readfirstlane(lds0 + (slot) * SLOT + c_ * 1024)); } } \
        _Pragma("unroll") for (int p_ = 0; p_ < (NVP + 7) / 8; ++p_) { const int c_ = wid + 8 * p_; if (c_ < NVP) { const int dg_ = c_ >> 2, kg_ = c_ & 3; \
            glds16(vsrc + ((size_t)(t) * 64 + 16 * kg_) * Tn.vp + dg_ * 32, (unsigned)__builtin_amdgcn_readfirstlane(lds0 + (slot) * SLOT + KSLOT + c_ * 1024)); } } } while (0)
    ATT_DMA(0, 0);
    const bf16* Qw = Tn.Q + (size_t)(q0 + qb * 32 + r32) * Tn.qp + hi * 8;
    bf16x8 qr[KS];
    if constexpr (QREG) {
#pragma unroll
      for (int d0 = 0; d0 < KS; ++d0) qr[d0] = *reinterpret_cast<const bf16x8*>(Qw + d0 * 16); }
    f32x16 o[NDV];
#pragma unroll
    for (int j = 0; j < NDV; ++j) o[j] = f32x16{};
    float l_reg = 0.f;
    f32x16 negc;
#pragma unroll
    for (int r = 0; r < 16; ++r) negc[r] = -cbound;
    asm volatile("s_waitcnt vmcnt(0)" ::: "memory"); __builtin_amdgcn_s_barrier(); asm volatile("" ::: "memory");
#ifdef ATT_PROBE_TILES
    for (int rep_ = 0; rep_ < 2; ++rep_) {
    if (rep_ == 1) { ATT_DMA(0, 0); l_reg = 0.f;
#pragma unroll
        for (int j = 0; j < NDV; ++j) o[j] = f32x16{};
        asm volatile("s_waitcnt vmcnt(0)" ::: "memory"); __builtin_amdgcn_s_barrier(); asm volatile("" ::: "memory"); }
#endif
#pragma nounroll
    for (int t = 0; t < NT; ++t) {
        const int sl = t & 1;
        if (t + 1 < NT) ATT_DMA(t + 1, sl ^ 1);
        const lds_cptr kb = KLINE ? shm3 + sl * SLOT + (r32 >> 3) * 1024 + (hi ^ ((r32 >> 3) & 1)) * 128 + (r32 & 7) * 16 : shm3 + sl * SLOT + hi * 1024 + r32 * 16;
        const lds_cptr vp_ = shm3 + sl * SLOT + KSLOT + ((lane >> 4) & 1) * 32 + (lane & 3) * 8 + (4 * hi + ((lane & 15) >> 2)) * 64;
#pragma nounroll
        for (int kh = 0; kh < 2; ++kh) {
            f32x16 p; if constexpr (NOSHIFT) p = f32x16{}; else p = negc;
#pragma unroll
            for (int d0 = 0; d0 < KS; ++d0) {
                if constexpr (!QREG) { if ((d0 & 3) == 0) { asm volatile("" ::: "memory");
#pragma unroll
                    for (int dd = 0; dd < 4; ++dd) qr[d0 + dd] = *reinterpret_cast<const bf16x8*>(Qw + (d0 + dd) * 16);
                    asm volatile("" ::: "memory"); } }
                const bf16x8 b0 = *(const __attribute__((address_space(3))) bf16x8*)(kb + (KLINE ? (d0 >> 2) * 8192 + (d0 & 3) * 256 + kh * 4096 : d0 * 2048 + kh * 512));
                p = __builtin_amdgcn_mfma_f32_32x32x16_bf16(b0, qr[d0], p, 0, 0, 0);
            }
            float sacc = 0.f;
#pragma unroll
            for (int r = 0; r < 16; ++r) { p[r] = fast_exp2(p[r]); sacc += p[r]; }
            l_reg += sacc;
            v4u pw[2];
            pw[0] = (v4u){pk2(p[0], p[1]), pk2(p[2], p[3]), pk2(p[4], p[5]), pk2(p[6], p[7])};
            pw[1] = (v4u){pk2(p[8], p[9]), pk2(p[10], p[11]), pk2(p[12], p[13]), pk2(p[14], p[15])};
            s16x4 vl[2][2], vh2[2][2];
#pragma unroll
            for (int ks = 0; ks < 2; ++ks) { vl[0][ks] = vtr(vp_ + (dvb0 + 0) * 4096 + (2 * kh + ks) * 1024); vh2[0][ks] = vtr(vp_ + (dvb0 + 0) * 4096 + (2 * kh + ks) * 1024 + 512); }
#pragma unroll
            for (int j = 0; j < NDV; ++j) {
                if (j + 1 < NDV) {
#pragma unroll
                    for (int ks = 0; ks < 2; ++ks) { vl[(j + 1) & 1][ks] = vtr(vp_ + (dvb0 + j + 1) * 4096 + (2 * kh + ks) * 1024); vh2[(j + 1) & 1][ks] = vtr(vp_ + (dvb0 + j + 1) * 4096 + (2 * kh + ks) * 1024 + 512); }
                }
#pragma unroll
                for (int ks = 0; ks < 2; ++ks) { const s16x4 lo = vl[j & 1][ks], hh = vh2[j & 1][ks];
                    o[j] = __builtin_amdgcn_mfma_f32_32x32x16_bf16(__builtin_bit_cast(bf16x8, pw[ks]), (bf16x8){lo[0], lo[1], lo[2], lo[3], hh[0], hh[1], hh[2], hh[3]}, o[j], 0, 0, 0); }
                if (NDV > 2) { __builtin_amdgcn_sched_group_barrier(0x100, 4, 0); __builtin_amdgcn_sched_group_barrier(0x8, 2, 0); }
            }
        }
        asm volatile("s_waitcnt vmcnt(0) lgkmcnt(0)" ::: "memory"); __builtin_amdgcn_s_barrier(); asm volatile("" ::: "memory");
    }
#ifdef ATT_PROBE_TILES
    }
#endif
#undef ATT_DMA
    l_reg += __shfl_xor(l_reg, 32);
    if (hi == 0) wsf[r32] = l_reg;
    asm volatile("s_waitcnt lgkmcnt(0)" ::: "memory");
    float rli[16];
#pragma unroll
    for (int r = 0; r < 16; ++r) rli[r] = fast_rcp(wsf[crow(r, hi)]);
    constexpr int SW = NDV * 32;
    LAS bf16* stg = (LAS bf16*)(shm3) + wid * (32 * SW);
#pragma unroll
    for (int r = 0; r < 16; ++r) { const int orow = crow(r, hi);
#pragma unroll
        for (int j = 0; j < NDV; j += 2) { const unsigned w_ = cvtpk_s(o[j][r] * rli[r], o[j + 1][r] * rli[r]); stg[orow * SW + j * 32 + r32] = (bf16)(w_ & 0xffffu); stg[orow * SW + (j + 1) * 32 + r32] = (bf16)(w_ >> 16); } }
    asm volatile("s_waitcnt lgkmcnt(0)" ::: "memory");
    bf16* Ow = Tn.O + (size_t)(q0 + qb * 32) * Tn.op + dvb0 * 32;
    constexpr int CPR = SW / 8;
#pragma unroll
    for (int i = 0; i < (32 * CPR) / 64; ++i) { const int idx = i * 64 + lane, row = idx / CPR, ch = idx % CPR;
        const v4u v = *(const LAS v4u*)(stg + row * SW + ch * 8); *(v4u*)(Ow + (size_t)row * Tn.op + ch * 8) = v; }
    asm volatile("s_waitcnt lgkmcnt(0)" ::: "memory");        __builtin_amdgcn_s_barrier(); asm volatile("" ::: "memory");
}

template <int KS, int DVB>
__device__ __forceinline__ void unit2(const Tensors& Tn, const int q0, const int NT, const float cbound, char* shm, LAS float* wsf_all) {
    constexpr int KSLOT = 64 * KS * 32, VSLOT = 64 * DVB * 64, SLOT = KSLOT + VSLOT, NKP = KS * 2, NVP = DVB * 4;
    const int tid = pg8::tid_opaque(), lane = tid & 63, r32 = lane & 31, hi = lane >> 5; const int wid = __builtin_amdgcn_readfirstlane(tid >> 6);
    const unsigned lds0 = (unsigned)(uintptr_t)shm;
    LAS float* wsf = wsf_all + wid * 64;
    const lds_cptr shm3 = (lds_cptr)shm;
    const bf16* ksrc = Tn.K + (size_t)lane * Tn.kp;
    const bf16* vsrc = Tn.V + (size_t)(lane >> 2) * Tn.vp + (lane & 3) * 8;
#define ATT_DMA(t, slot) do { \
        _Pragma("unroll") for (int p_ = 0; p_ < (NKP + 7) / 8; ++p_) { const int c_ = wid + 8 * p_; if (c_ < NKP) glds16(ksrc + (size_t)(t) * 64 * Tn.kp + c_ * 8, (unsigned)__builtin_amdgcn_readfirstlane(lds0 + (slot) * SLOT + c_ * 1024)); } \
        _Pragma("unroll") for (int p_ = 0; p_ < (NVP + 7) / 8; ++p_) { const int c_ = wid + 8 * p_; if (c_ < NVP) { const int dg_ = c_ >> 2, kg_ = c_ & 3; \
            glds16(vsrc + ((size_t)(t) * 64 + 16 * kg_) * Tn.vp + dg_ * 32, (unsigned)__builtin_amdgcn_readfirstlane(lds0 + (slot) * SLOT + KSLOT + c_ * 1024)); } } } while (0)
    ATT_DMA(0, 0);
    bf16x8 qa[KS], qb[KS];
    { const bf16* Qw = Tn.Q + (size_t)(q0 + wid * 64 + r32) * Tn.qp + hi * 8;
#pragma unroll
      for (int d0 = 0; d0 < KS; ++d0) { qa[d0] = *reinterpret_cast<const bf16x8*>(Qw + d0 * 16); qb[d0] = *reinterpret_cast<const bf16x8*>(Qw + (size_t)32 * Tn.qp + d0 * 16); } }
    f32x16 oa[DVB], ob[DVB];
#pragma unroll
    for (int j = 0; j < DVB; ++j) { oa[j] = f32x16{}; ob[j] = f32x16{}; }
    float la = 0.f, lb = 0.f;
    asm volatile("s_waitcnt vmcnt(0)" ::: "memory"); __builtin_amdgcn_s_barrier(); asm volatile("" ::: "memory");
#pragma nounroll
    for (int t = 0; t < NT; ++t) {
        const int sl = t & 1;
        if (t + 1 < NT) ATT_DMA(t + 1, sl ^ 1);
        const lds_cptr kb = shm3 + sl * SLOT + hi * 1024 + r32 * 16;
        const lds_cptr vp_ = shm3 + sl * SLOT + KSLOT + ((lane >> 4) & 1) * 32 + (lane & 3) * 8 + (4 * hi + ((lane & 15) >> 2)) * 64;
#pragma unroll
        for (int kh = 0; kh < 2; ++kh) {
            bf16x8 kf[KS];
#pragma unroll
            for (int d0 = 0; d0 < KS; ++d0) kf[d0] = *(const __attribute__((address_space(3))) bf16x8*)(kb + d0 * 2048 + kh * 512);
            f32x16 pa = f32x16{}, pb = f32x16{};
#pragma unroll
            for (int d0 = 0; d0 < KS; ++d0) pa = __builtin_amdgcn_mfma_f32_32x32x16_bf16(kf[d0], qa[d0], pa, 0, 0, 0);
#pragma unroll
            for (int d0 = 0; d0 < KS; ++d0) pb = __builtin_amdgcn_mfma_f32_32x32x16_bf16(kf[d0], qb[d0], pb, 0, 0, 0);
            __builtin_amdgcn_sched_barrier(0);
            bf16x8 vf[DVB][2];
#pragma unroll
            for (int j = 0; j < DVB; ++j)
#pragma unroll
                for (int ks = 0; ks < 2; ++ks) { const s16x4 lo = vtr(vp_ + j * 4096 + (2 * kh + ks) * 1024), hh = vtr(vp_ + j * 4096 + (2 * kh + ks) * 1024 + 512);
                    vf[j][ks] = (bf16x8){lo[0], lo[1], lo[2], lo[3], hh[0], hh[1], hh[2], hh[3]}; }
            float sa = 0.f, sb = 0.f;
#pragma unroll
            for (int r = 0; r < 16; ++r) { pa[r] = fast_exp2(pa[r]); sa += pa[r]; }
            v4u wa[2], wb[2];
            wa[0] = (v4u){pk2(pa[0], pa[1]), pk2(pa[2], pa[3]), pk2(pa[4], pa[5]), pk2(pa[6], pa[7])};
            wa[1] = (v4u){pk2(pa[8], pa[9]), pk2(pa[10], pa[11]), pk2(pa[12], pa[13]), pk2(pa[14], pa[15])};
            la += sa;
            __builtin_amdgcn_sched_barrier(0);
#pragma unroll
            for (int j = 0; j < DVB; ++j)
#pragma unroll
                for (int ks = 0; ks < 2; ++ks) oa[j] = __builtin_amdgcn_mfma_f32_32x32x16_bf16(__builtin_bit_cast(bf16x8, wa[ks]), vf[j][ks], oa[j], 0, 0, 0);
            __builtin_amdgcn_sched_barrier(0);
#pragma unroll
            for (int r = 0; r < 16; ++r) { pb[r] = fast_exp2(pb[r]); sb += pb[r]; }
            wb[0] = (v4u){pk2(pb[0], pb[1]), pk2(pb[2], pb[3]), pk2(pb[4], pb[5]), pk2(pb[6], pb[7])};
            wb[1] = (v4u){pk2(pb[8], pb[9]), pk2(pb[10], pb[11]), pk2(pb[12], pb[13]), pk2(pb[14], pb[15])};
            lb += sb;
            __builtin_amdgcn_sched_barrier(0);
#pragma unroll
            for (int j = 0; j < DVB; ++j)
#pragma unroll
                for (int ks = 0; ks < 2; ++ks) { const s16x4 lo = vtr(vp_ + j * 4096 + (2 * kh + ks) * 1024), hh = vtr(vp_ + j * 4096 + (2 * kh + ks) * 1024 + 512);
                    ob[j] = __builtin_amdgcn_mfma_f32_32x32x16_bf16(__builtin_bit_cast(bf16x8, wb[ks]), (bf16x8){lo[0], lo[1], lo[2], lo[3], hh[0], hh[1], hh[2], hh[3]}, ob[j], 0, 0, 0); }
        }
        asm volatile("s_waitcnt vmcnt(0) lgkmcnt(0)" ::: "memory"); __builtin_amdgcn_s_barrier(); asm volatile("" ::: "memory");
    }
#undef ATT_DMA
    la += __shfl_xor(la, 32); lb += __shfl_xor(lb, 32);
    if (hi == 0) { wsf[r32] = la; wsf[32 + r32] = lb; }
    asm volatile("s_waitcnt lgkmcnt(0)" ::: "memory");
    constexpr int SW = DVB * 32;
    LAS bf16* stg = (LAS bf16*)(shm3) + wid * (64 * SW);
#pragma unroll
    for (int r = 0; r < 16; ++r) { const int orow = crow(r, hi); const float ra = fast_rcp(wsf[orow]), rb = fast_rcp(wsf[32 + orow]);
#pragma unroll
        for (int j = 0; j < DVB; ++j) { const unsigned w_ = cvtpk_s(oa[j][r] * ra, ob[j][r] * rb); stg[orow * SW + j * 32 + r32] = (bf16)(w_ & 0xffffu); stg[(32 + orow) * SW + j * 32 + r32] = (bf16)(w_ >> 16); } }
    asm volatile("s_waitcnt lgkmcnt(0)" ::: "memory");
    bf16* Ow = Tn.O + (size_t)(q0 + wid * 64) * Tn.op;
    constexpr int CPR = SW / 8;
#pragma unroll
    for (int i = 0; i < (64 * CPR) / 64; ++i) { const int idx = i * 64 + lane, row = idx / CPR, ch = idx % CPR;
        const v4u v = *(const LAS v4u*)(stg + row * SW + ch * 8); *(v4u*)(Ow + (size_t)row * Tn.op + ch * 8) = v; }
    asm volatile("s_waitcnt vmcnt(0) lgkmcnt(0)" ::: "memory"); __builtin_amdgcn_s_barrier(); asm volatile("" ::: "memory");
}

template <int KS, int DVB>
__device__ __forceinline__ void unit3(const Tensors& Tn, const int q0, const int NT, char* shm, LAS float* wsf_all) {
    constexpr int KSLOT = 64 * KS * 32, VSLOT = 64 * DVB * 64, SLOT = KSLOT + VSLOT, NKP = KS * 2, NVP = DVB * 4;
    const int tid = pg8::tid_opaque(), lane = tid & 63, r32 = lane & 31, hi = lane >> 5; const int wid = __builtin_amdgcn_readfirstlane(tid >> 6);
    const unsigned lds0 = (unsigned)(uintptr_t)shm;
    LAS float* wsf = wsf_all + wid * 64;
    const lds_cptr shm3 = (lds_cptr)shm;
    const bf16* ksrc = Tn.K + (size_t)lane * Tn.kp;
    const bf16* vsrc = Tn.V + (size_t)(lane >> 2) * Tn.vp + (lane & 3) * 8;
#define ATT_DMA(t, slotb) do { \
        _Pragma("unroll") for (int p_ = 0; p_ < (NKP + 7) / 8; ++p_) { const int c_ = wid + 8 * p_; if (c_ < NKP) glds16(ksrc + (size_t)(t) * 64 * Tn.kp + c_ * 8, (unsigned)__builtin_amdgcn_readfirstlane(lds0 + (slotb) + c_ * 1024)); } \
        _Pragma("unroll") for (int p_ = 0; p_ < (NVP + 7) / 8; ++p_) { const int c_ = wid + 8 * p_; if (c_ < NVP) { const int dg_ = c_ >> 2, kg_ = c_ & 3; \
            glds16(vsrc + ((size_t)(t) * 64 + 16 * kg_) * Tn.vp + dg_ * 32, (unsigned)__builtin_amdgcn_readfirstlane(lds0 + (slotb) + KSLOT + c_ * 1024)); } } } while (0)
    ATT_DMA(0, 0); if (NT > 1) ATT_DMA(1, SLOT);
    bf16x8 qa[KS], qb[KS];
    { const bf16* Qw = Tn.Q + (size_t)(q0 + wid * 64 + r32) * Tn.qp + hi * 8;
#pragma unroll
      for (int d0 = 0; d0 < KS; ++d0) { qa[d0] = *reinterpret_cast<const bf16x8*>(Qw + d0 * 16); qb[d0] = *reinterpret_cast<const bf16x8*>(Qw + (size_t)32 * Tn.qp + d0 * 16); } }
    f32x16 oa[DVB], ob[DVB];
#pragma unroll
    for (int j = 0; j < DVB; ++j) { oa[j] = f32x16{}; ob[j] = f32x16{}; }
    float la0 = 0.f, la1 = 0.f, la2 = 0.f, la3 = 0.f, lb0 = 0.f, lb1 = 0.f, lb2 = 0.f, lb3 = 0.f;
    asm volatile("s_waitcnt vmcnt(0)" ::: "memory"); __builtin_amdgcn_s_barrier(); asm volatile("" ::: "memory");
    const int koff = hi * 1024 + r32 * 16, voff = KSLOT + ((lane >> 4) & 1) * 32 + (lane & 3) * 8 + (4 * hi + ((lane & 15) >> 2)) * 64;
    bf16x8 kf[KS];
    f32x16 pa = f32x16{}, pb;
#pragma unroll
    for (int d0 = 0; d0 < KS; ++d0) kf[d0] = *(const __attribute__((address_space(3))) bf16x8*)(shm3 + koff + d0 * 2048);
#pragma unroll
    for (int d0 = 0; d0 < KS; ++d0) pa = __builtin_amdgcn_mfma_f32_32x32x16_bf16(kf[d0], qa[d0], pa, 0, 0, 0);
    int sl = 0, sn = SLOT, snn = 2 * SLOT;
#define ATT_LDV(dst, slotb, kh) do { _Pragma("unroll") for (int j = 0; j < DVB; ++j) _Pragma("unroll") for (int ks = 0; ks < 2; ++ks) { \
        const s16x4 lo_ = vtr(shm3 + (slotb) + voff + j * 4096 + (2 * (kh) + ks) * 1024), hh_ = vtr(shm3 + (slotb) + voff + j * 4096 + (2 * (kh) + ks) * 1024 + 512); \
        dst[j][ks] = (bf16x8){lo_[0], lo_[1], lo_[2], lo_[3], hh_[0], hh_[1], hh_[2], hh_[3]}; } } while (0)
#define ATT_HALF(kh, NEXT, SLV) do { \
        bf16x8 vf[DVB][2]; ATT_LDV(vf, SLV, kh); \
        pb = f32x16{}; \
        _Pragma("unroll") for (int d0 = 0; d0 < KS; ++d0) pb = __builtin_amdgcn_mfma_f32_32x32x16_bf16(kf[d0], qb[d0], pb, 0, 0, 0); \
        _Pragma("unroll") for (int r = 0; r < 16; ++r) pa[r] = fast_exp2(pa[r]); \
        v4u wa[2], wb[2]; \
        wa[0] = (v4u){cvtpk_s(pa[0], pa[1]), cvtpk_s(pa[2], pa[3]), cvtpk_s(pa[4], pa[5]), cvtpk_s(pa[6], pa[7])}; \
        wa[1] = (v4u){cvtpk_s(pa[8], pa[9]), cvtpk_s(pa[10], pa[11]), cvtpk_s(pa[12], pa[13]), cvtpk_s(pa[14], pa[15])}; \
        _Pragma("unroll") for (int g_ = 0; g_ < 5; ++g_) { __builtin_amdgcn_sched_group_barrier(0x8, 1, 0); __builtin_amdgcn_sched_group_barrier(0x400, 3, 0); } \
        __builtin_amdgcn_sched_group_barrier(0x8, 1, 0); __builtin_amdgcn_sched_group_barrier(0x400, 1, 0); __builtin_amdgcn_sched_group_barrier(0x2, 8, 0); \
          \
        _Pragma("unroll") for (int j = 0; j < DVB; ++j) _Pragma("unroll") for (int ks = 0; ks < 2; ++ks) oa[j] = __builtin_amdgcn_mfma_f32_32x32x16_bf16(__builtin_bit_cast(bf16x8, wa[ks]), vf[j][ks], oa[j], 0, 0, 0); \
        _Pragma("unroll") for (int r = 0; r < 16; ++r) pb[r] = fast_exp2(pb[r]); \
        _Pragma("unroll") for (int g_ = 0; g_ < 4; ++g_) { __builtin_amdgcn_sched_group_barrier(0x8, 1, 0); __builtin_amdgcn_sched_group_barrier(0x400, 4, 0); } \
        if ((NEXT) == 2) { asm volatile("s_waitcnt vmcnt(0) lgkmcnt(0)" ::: "memory"); __builtin_amdgcn_s_barrier(); asm volatile("" ::: "memory"); if (t + 2 < NT) ATT_DMA(t + 2, snn); } \
          \
        f32x16 pn = f32x16{}; \
        if ((NEXT) != 0) { \
            _Pragma("unroll") for (int d0 = 0; d0 < KS; ++d0) kf[d0] = *(const __attribute__((address_space(3))) bf16x8*)(shm3 + ((NEXT) == 2 ? sn : sl) + koff + d0 * 2048 + ((NEXT) == 2 ? 0 : 512)); \
            _Pragma("unroll") for (int d0 = 0; d0 < KS; ++d0) pn = __builtin_amdgcn_mfma_f32_32x32x16_bf16(kf[d0], qa[d0], pn, 0, 0, 0); } \
        wb[0] = (v4u){cvtpk_s(pb[0], pb[1]), cvtpk_s(pb[2], pb[3]), cvtpk_s(pb[4], pb[5]), cvtpk_s(pb[6], pb[7])}; \
        wb[1] = (v4u){cvtpk_s(pb[8], pb[9]), cvtpk_s(pb[10], pb[11]), cvtpk_s(pb[12], pb[13]), cvtpk_s(pb[14], pb[15])}; \
        la0 += (pa[0] + pa[1]) + (pa[2] + pa[3]); la1 += (pa[4] + pa[5]) + (pa[6] + pa[7]); la2 += (pa[8] + pa[9]) + (pa[10] + pa[11]); la3 += (pa[12] + pa[13]) + (pa[14] + pa[15]); \
        if ((NEXT) != 0) { _Pragma("unroll") for (int g_ = 0; g_ < 6; ++g_) { __builtin_amdgcn_sched_group_barrier(0x8, 1, 0); __builtin_amdgcn_sched_group_barrier(0x2, 4, 0); } } \
          \
        _Pragma("unroll") for (int j = 0; j < DVB; ++j) _Pragma("unroll") for (int ks = 0; ks < 2; ++ks) ob[j] = __builtin_amdgcn_mfma_f32_32x32x16_bf16(__builtin_bit_cast(bf16x8, wb[ks]), vf[j][ks], ob[j], 0, 0, 0); \
        lb0 += (pb[0] + pb[1]) + (pb[2] + pb[3]); lb1 += (pb[4] + pb[5]) + (pb[6] + pb[7]); lb2 += (pb[8] + pb[9]) + (pb[10] + pb[11]); lb3 += (pb[12] + pb[13]) + (pb[14] + pb[15]); \
        _Pragma("unroll") for (int g_ = 0; g_ < 4; ++g_) { __builtin_amdgcn_sched_group_barrier(0x8, 1, 0); __builtin_amdgcn_sched_group_barrier(0x2, 4, 0); } \
        pa = pn; } while (0)
    int t = 0;
#pragma nounroll
    for (; t + 1 < NT; ++t) {
        ATT_HALF(0, 1, sl);
        ATT_HALF(1, 2, sl);
        { const int tmp_ = sl; sl = sn; sn = snn; snn = tmp_; }
    }
    ATT_HALF(0, 1, sl);
    ATT_HALF(1, 0, sl);
#undef ATT_HALF
#undef ATT_LDV
#undef ATT_DMA
    float la = (la0 + la1) + (la2 + la3), lb = (lb0 + lb1) + (lb2 + lb3);
    la += __shfl_xor(la, 32); lb += __shfl_xor(lb, 32);
    asm volatile("s_waitcnt vmcnt(0) lgkmcnt(0)" ::: "memory"); __builtin_amdgcn_s_barrier(); asm volatile("" ::: "memory");
    if (hi == 0) { wsf[r32] = la; wsf[32 + r32] = lb; }
    asm volatile("s_waitcnt lgkmcnt(0)" ::: "memory");
    constexpr int SW = DVB * 32;
    LAS bf16* stg = (LAS bf16*)(shm3) + wid * (64 * SW);
#pragma unroll
    for (int r = 0; r < 16; ++r) { const int orow = crow(r, hi); const float ra = fast_rcp(wsf[orow]), rb = fast_rcp(wsf[32 + orow]);
#pragma unroll
        for (int j = 0; j < DVB; ++j) { const unsigned w_ = cvtpk_s(oa[j][r] * ra, ob[j][r] * rb); stg[orow * SW + j * 32 + r32] = (bf16)(w_ & 0xffffu); stg[(32 + orow) * SW + j * 32 + r32] = (bf16)(w_ >> 16); } }
    asm volatile("s_waitcnt lgkmcnt(0)" ::: "memory");
    bf16* Ow = Tn.O + (size_t)(q0 + wid * 64) * Tn.op;
    constexpr int CPR = SW / 8;
#pragma unroll
    for (int i = 0; i < (64 * CPR) / 64; ++i) { const int idx = i * 64 + lane, row = idx / CPR, ch = idx % CPR;
        const v4u v = *(const LAS v4u*)(stg + row * SW + ch * 8); *(v4u*)(Ow + (size_t)row * Tn.op + ch * 8) = v; }
    asm volatile("s_waitcnt lgkmcnt(0)" ::: "memory");        __builtin_amdgcn_s_barrier(); asm volatile("" ::: "memory");
}
}
constexpr float QSCALE_MLA = 0.10206207261596575f * LOG2E;
__device__ __forceinline__ void mla_proj(Frame& F, const Inputs& in) {
    const int lane = F.lane(), w = F.wave, tk = lane & 15, g = lane >> 4;
    const bf16* LAT = (const bf16*)(F.ws + WS_LAT); const float* COS = (const float*)(F.ws + WS_COS); const float* SIN = (const float*)(F.ws + WS_SIN);
    bf16* Qo = (bf16*)(F.ws + WS_Q); bf16* Ko = (bf16*)(F.ws + WS_K); bf16* Vo = (bf16*)(F.ws + WS_V);
    const int ngrp = T / 16;
    int g0_, g1_;
    if (F.G == 256) { const int c_ = (int)blockIdx.x;
        if (c_ < 128) { g0_ = c_ * 14; g1_ = g0_ + 14; } else { g0_ = 128 * 14 + (c_ - 128) * 18; g1_ = g0_ + 18; } }
    else { const int per_ = (ngrp + F.G - 1) / F.G; g0_ = F.vcu * per_; g1_ = g0_ + per_ < ngrp ? g0_ + per_ : ngrp; if (g0_ > ngrp) g0_ = ngrp; }
    LAS float* gn_s = (LAS float*)(F.lds + AUX_XP);
    if (F.tid() < 96) { gn_s[F.tid()] = in.q_norm[F.tid()]; gn_s[96 + F.tid()] = in.k_norm[F.tid()]; }
    __syncthreads();
    {
        bf16x8 wq[6][6];
        const bf16* W = (const bf16*)(F.ws + W_Q) + (size_t)(96 * w + tk) * 192 + 8 * g;
#pragma unroll
        for (int nt = 0; nt < 6; ++nt)
#pragma unroll
            for (int ks = 0; ks < 6; ++ks) wq[nt][ks] = *(const bf16x8*)(W + (size_t)nt * 16 * 192 + ks * 32);
        LAS unsigned char* stg = F.lds + RING_OFF; int sb = 0;
        bf16x8 xn[6]; f32x4 cn = {0.f, 0.f, 0.f, 0.f}, sn = {0.f, 0.f, 0.f, 0.f};
        if (g0_ < g1_) {
#pragma unroll
            for (int ks = 0; ks < 6; ++ks) xn[ks] = *(const bf16x8*)(LAT + (size_t)(g0_ * 16 + tk) * 512 + ks * 32 + 8 * g);
            cn = *(const f32x4*)(COS + (size_t)(g0_ * 16 + tk) * 16 + 4 * g); sn = *(const f32x4*)(SIN + (size_t)(g0_ * 16 + tk) * 16 + 4 * g); }
        for (int grp = g0_; grp < g1_; ++grp) {
            unsigned long long tq0_ = 0, tq1_ = 0, tq2_ = 0; (void)tq0_; (void)tq1_; (void)tq2_; TP_NOW(tq0_);
            const int tok = grp * 16 + tk;
            const f32x4 c = cn, s = sn;
            float ss = 0.f;
#pragma unroll
            for (int ks = 0; ks < 6; ++ks) {
#pragma unroll
                for (int j = 0; j < 8; ++j) { const float v = bf2f((bf16)xn[ks][j]); ss += v * v; } }
            f32x4 acc[6];
#pragma unroll
            for (int nt = 0; nt < 6; ++nt) { acc[nt] = (f32x4){0.f, 0.f, 0.f, 0.f};
#pragma unroll
                for (int ks = 0; ks < 6; ++ks) acc[nt] = __builtin_amdgcn_mfma_f32_16x16x32_bf16(wq[nt][ks], xn[ks], acc[nt], 0, 0, 0); }
            __builtin_amdgcn_sched_barrier(0);
            if (grp + 1 < g1_) {
#pragma unroll
                for (int ks = 0; ks < 6; ++ks) xn[ks] = *(const bf16x8*)(LAT + (size_t)((grp + 1) * 16 + tk) * 512 + ks * 32 + 8 * g);
                cn = *(const f32x4*)(COS + (size_t)((grp + 1) * 16 + tk) * 16 + 4 * g); sn = *(const f32x4*)(SIN + (size_t)((grp + 1) * 16 + tk) * 16 + 4 * g); }
            __builtin_amdgcn_sched_barrier(0);
            TP_NOW(tq1_);
            ss += __shfl_xor(ss, 16); ss += __shfl_xor(ss, 32);
            const float rc = rsq(ss * (1.f / 192.f) + EPS);
            float hs = 0.f;
#pragma unroll
            for (int nt = 0; nt < 6; ++nt) { acc[nt] = acc[nt] * rc; hs += (acc[nt][0] * acc[nt][0] + acc[nt][1] * acc[nt][1]) + (acc[nt][2] * acc[nt][2] + acc[nt][3] * acc[nt][3]); }
            hs += __shfl_xor(hs, 16); hs += __shfl_xor(hs, 32);
            const float rq = QSCALE_MLA * rsq(hs * (1.f / 96.f) + EPS);
#pragma unroll
            for (int nt = 0; nt < 6; ++nt) { const f32x4 qg = *(const LAS f32x4*)(gn_s + 16 * nt + 4 * g); acc[nt] = acc[nt] * rq * qg; }
            const f32x4 x1 = acc[4], x2 = acc[5]; acc[4] = x1 * c - x2 * s; acc[5] = x2 * c + x1 * s;
#pragma unroll
            for (int nt = 0; nt < 6; ++nt) { v2u o; o.x = pk2(acc[nt][0], acc[nt][1]); o.y = pk2(acc[nt][2], acc[nt][3]); *(LAS v2u*)(stg + sb * (16 * 1552) + tk * 1552 + (96 * w + 16 * nt + 4 * g) * 2) = o; }
            asm volatile("s_waitcnt lgkmcnt(0)" ::: "memory"); __builtin_amdgcn_s_barrier(); asm volatile("" ::: "memory");
#pragma unroll
            for (int i = 0; i < 3; ++i) { const int c = F.tid() + 512 * i, row = c / 96, ch = c % 96;
                *(v4u*)(Qo + (size_t)(grp * 16 + row) * 768 + ch * 8) = *(const LAS v4u*)(stg + sb * (16 * 1552) + row * 1552 + ch * 16); }
            sb ^= 1;
            TP_NOW(tq2_); TP_ADD(F.lds, w, 0, tq0_, tq1_); TP_ADD(F.lds, w, 1, tq0_, tq2_);
        }
        __syncthreads();
    }
    {
        bf16x8 wk[8][4];
        const bf16* W = (const bf16*)(F.ws + W_KV) + (size_t)(128 * w + tk) * 128 + 8 * g;
#pragma unroll
        for (int nt = 0; nt < 8; ++nt)
#pragma unroll
            for (int ks = 0; ks < 4; ++ks) wk[nt][ks] = *(const bf16x8*)(W + (size_t)nt * 16 * 128 + ks * 32);
        LAS unsigned char* stg = F.lds + RING_OFF; int sb = 0; constexpr int KVB = 16 * (1552 + 1040);
        bf16x8 xn[5]; f32x4 cn0 = {0.f, 0.f, 0.f, 0.f}, cn1 = cn0, sn0 = cn0, sn1 = cn0;
        if (g0_ < g1_) {
#pragma unroll
            for (int ks = 0; ks < 4; ++ks) xn[ks] = *(const bf16x8*)(LAT + (size_t)(g0_ * 16 + tk) * 512 + 192 + ks * 32 + 8 * g);
            xn[4] = *(const bf16x8*)(LAT + (size_t)(g0_ * 16 + tk) * 512 + 320 + 8 * g);
            const size_t tb_ = (size_t)(g0_ * 16 + tk) * 16 + 8 * (g & 1); cn0 = *(const f32x4*)(COS + tb_); cn1 = *(const f32x4*)(COS + tb_ + 4); sn0 = *(const f32x4*)(SIN + tb_); sn1 = *(const f32x4*)(SIN + tb_ + 4); }
        for (int grp = g0_; grp < g1_; ++grp) {
            const int tok = grp * 16 + tk;
            const f32x4 c0 = cn0, c1 = cn1, s0 = sn0, s1 = sn1;
            float ss = 0.f;
#pragma unroll
            for (int ks = 0; ks < 4; ++ks) {
#pragma unroll
                for (int j = 0; j < 8; ++j) { const float v = bf2f((bf16)xn[ks][j]); ss += v * v; } }
            float kr[8], sr = 0.f;
#pragma unroll
            for (int e = 0; e < 8; ++e) { kr[e] = bf2f((bf16)xn[4][e]); sr += kr[e] * kr[e]; }
            f32x4 acc[8];
#pragma unroll
            for (int nt = 0; nt < 8; ++nt) { acc[nt] = (f32x4){0.f, 0.f, 0.f, 0.f};
#pragma unroll
                for (int ks = 0; ks < 4; ++ks) acc[nt] = __builtin_amdgcn_mfma_f32_16x16x32_bf16(wk[nt][ks], xn[ks], acc[nt], 0, 0, 0); }
            __builtin_amdgcn_sched_barrier(0);
            if (grp + 1 < g1_) {
#pragma unroll
                for (int ks = 0; ks < 4; ++ks) xn[ks] = *(const bf16x8*)(LAT + (size_t)((grp + 1) * 16 + tk) * 512 + 192 + ks * 32 + 8 * g);
                xn[4] = *(const bf16x8*)(LAT + (size_t)((grp + 1) * 16 + tk) * 512 + 320 + 8 * g);
                const size_t tb_ = (size_t)((grp + 1) * 16 + tk) * 16 + 8 * (g & 1); cn0 = *(const f32x4*)(COS + tb_); cn1 = *(const f32x4*)(COS + tb_ + 4); sn0 = *(const f32x4*)(SIN + tb_); sn1 = *(const f32x4*)(SIN + tb_ + 4); }
            __builtin_amdgcn_sched_barrier(0);
            ss += __shfl_xor(ss, 16); ss += __shfl_xor(ss, 32); sr += __shfl_xor(sr, 16); sr += __shfl_xor(sr, 32);
            const float rc = rsq(ss * (1.f / 128.f) + EPS);
            float hs = 0.f;
#pragma unroll
            for (int nt = 0; nt < 8; ++nt) { acc[nt] = acc[nt] * rc;
                if (nt < 4) hs += (acc[nt][0] * acc[nt][0] + acc[nt][1] * acc[nt][1]) + (acc[nt][2] * acc[nt][2] + acc[nt][3] * acc[nt][3]); }
            hs += __shfl_xor(hs, 16); hs += __shfl_xor(hs, 32);
            const float rk = rsq((hs + sr) * (1.f / 96.f) + EPS);
#pragma unroll
            for (int nt = 0; nt < 4; ++nt) { const f32x4 kg = *(const LAS f32x4*)(gn_s + 96 + 16 * nt + 4 * g) * rk; v2u o; o.x = pk2(acc[nt][0] * kg[0], acc[nt][1] * kg[1]); o.y = pk2(acc[nt][2] * kg[2], acc[nt][3] * kg[3]);
                *(LAS v2u*)(stg + sb * KVB + tk * 1552 + (96 * w + 16 * nt + 4 * g) * 2) = o; }
#pragma unroll
            for (int nt = 4; nt < 8; ++nt) { v2u o; o.x = pk2(acc[nt][0], acc[nt][1]); o.y = pk2(acc[nt][2], acc[nt][3]); *(LAS v2u*)(stg + sb * KVB + 16 * 1552 + tk * 1040 + (64 * w + 16 * (nt - 4) + 4 * g) * 2) = o; }
            const f32x4 kg0 = *(const LAS f32x4*)(gn_s + 96 + 64 + 8 * g), kg1 = *(const LAS f32x4*)(gn_s + 96 + 64 + 8 * g + 4);
            float ro[8];
#pragma unroll
            for (int e = 0; e < 8; ++e) { const float own = kr[e] * rk * (e < 4 ? kg0[e] : kg1[e - 4]); const float oth = __shfl_xor(own, 32); const float cc = e < 4 ? c0[e] : c1[e - 4], sn = e < 4 ? s0[e] : s1[e - 4];
                ro[e] = (g < 2) ? own * cc - oth * sn : own * cc + oth * sn; }
            v4u o; o.x = pk2(ro[0], ro[1]); o.y = pk2(ro[2], ro[3]); o.z = pk2(ro[4], ro[5]); o.w = pk2(ro[6], ro[7]);
            *(LAS v4u*)(stg + sb * KVB + tk * 1552 + (96 * w + 64 + 8 * g) * 2) = o;
            asm volatile("s_waitcnt lgkmcnt(0)" ::: "memory"); __builtin_amdgcn_s_barrier(); asm volatile("" ::: "memory");
#pragma unroll
            for (int i = 0; i < 3; ++i) { const int c = F.tid() + 512 * i, row = c / 96, ch = c % 96;
                *(v4u*)(Ko + (size_t)(grp * 16 + row) * 768 + ch * 8) = *(const LAS v4u*)(stg + sb * KVB + row * 1552 + ch * 16); }
#pragma unroll
            for (int i = 0; i < 2; ++i) { const int c = F.tid() + 512 * i, row = c >> 6, ch = c & 63;
                *(v4u*)(Vo + (size_t)(grp * 16 + row) * 512 + ch * 8) = *(const LAS v4u*)(stg + sb * KVB + 16 * 1552 + row * 1040 + ch * 16); }
            sb ^= 1;
        }
        __syncthreads();
    }
}

__device__ __forceinline__ float dpp_scan(float v) {
#define HG_DPP(ctrl, rm) v += __builtin_bit_cast(float, __builtin_amdgcn_update_dpp(0, __builtin_bit_cast(int, v), ctrl, rm, 0xf, false))
    HG_DPP(0x111, 0xf); HG_DPP(0x112, 0xf); HG_DPP(0x114, 0xf); HG_DPP(0x118, 0xf); HG_DPP(0x142, 0xa); HG_DPP(0x143, 0xc);
#undef HG_DPP
    return v;
}
typedef _Float16 f16x8 __attribute__((ext_vector_type(8)));
constexpr int HGL_QT = 0, HGL_KC = 32768, HGL_VP = 65536, HGL_SP = 81920, HGL_DEC = 114688, HGL_DUMP = 116736, HGL_GT = 117760;
__device__ __forceinline__ void hgrn2_scan(Frame& F, char* shm) {
    using att::lds_cptr; using att::vtr; using att::crow;
    const int lane = F.lane(), w = F.wave, r32 = lane & 31, hi = lane >> 5;
    const unsigned lds0 = (unsigned)(uintptr_t)shm; const lds_cptr shm3 = (lds_cptr)shm;
    const int laneoff = ((lane >> 4) & 1) * 32 + (lane & 3) * 8 + (4 * hi + ((lane & 15) >> 2)) * 64;
    const int laneoffS = ((lane >> 4) & 1) * 32 + (lane & 3) * 8 + (8 * hi + ((lane & 15) >> 2)) * 64;
    const int koff = (2 * ((lane >> 4) & 1) + ((lane & 3) >> 1)) * 1024 + (4 * hi + ((lane & 15) >> 2)) * 16 + 8 * (lane & 1);
    const int n16 = lane & 15, q4 = lane >> 4;
    const int goff = ((lane & 3) >> 1) * 1024 + (8 * q4 + ((lane >> 2) & 3)) * 16 + (lane & 1) * 8;
    const int groff = (q4 >> 1) * 1024 + n16 * 16 + (q4 & 1) * 8;
    v4u tri0, tri1; const v4u fones = {0x3C003C00u, 0x3C003C00u, 0x3C003C00u, 0x3C003C00u};
    { const int thr0 = n16 - 8 * q4, thr1 = (q4 < 2) ? 64 : n16 - 8 * (q4 - 2);
#pragma unroll
      for (int p_ = 0; p_ < 4; ++p_) { tri0[p_] = (thr0 >= 2 * p_ + 1) ? 0x3C003C00u : (thr0 == 2 * p_ ? 0x00003C00u : 0u); tri1[p_] = (thr1 >= 2 * p_ + 1) ? 0x3C003C00u : (thr1 == 2 * p_ ? 0x00003C00u : 0u); } }
    for (int item = F.vcu; item < 256; item += F.G) {
        const int vh = item & 1, dir = (item >> 1) & 1, h = (item >> 2) & 3, b = item >> 4;
        const bf16* HQ = (const bf16*)(F.ws + WS_HQ) + h * 128 + 16 * w;
        const unsigned short* GG = (const unsigned short*)(F.ws + (dir ? WS_GB : WS_GF)) + h * 128 + 16 * w;
        const bf16* HI = (const bf16*)(F.ws + WS_HI) + h * 128 + vh * 64;
        bf16* OUT = (bf16*)(F.ws + (dir ? WS_OB : WS_OF)) + h * 128 + vh * 64;
        const int tfirst = b * SEQ + (dir ? SEQ - 1 : 0), tstep = dir ? -1 : 1;
        f32x16 S0 = f32x16{}, S1 = f32x16{};
        v2u hq_n[4], hq_[4], gr_[4]; v4u g_n[2]; f32x4 c_[4]; const unsigned gtw = lds0 + HGL_GT + w * 2048 + lane * 16;
#define HG_VDMA(nn) do { const int vg_ = w >> 2, ig_ = w & 3; const int trow_ = tfirst + tstep * (64 * (nn) + 16 * ig_ + (lane >> 2)); \
            att::glds16(HI + (size_t)trow_ * 512 + vg_ * 32 + (lane & 3) * 8, (unsigned)__builtin_amdgcn_readfirstlane(lds0 + HGL_VP + ((nn) & 1) * 8192 + w * 1024)); } while (0)
#define HG_LOAD(nn) do { const int nl_ = (nn) < SEQ / 64 ? (nn) : SEQ / 64 - 1; const int tb_ = tfirst + tstep * (64 * nl_);        \
            _Pragma("unroll") for (int tj = 0; tj < 4; ++tj) { const bf16* p_ = HQ + (size_t)(tb_ + tstep * (16 * tj + n16)) * 512 + 4 * q4; asm volatile("global_load_dwordx2 %0, %1, off" : "=&v"(hq_n[tj]) : "v"(p_)); } \
            const unsigned short* pg_ = GG + (size_t)(tb_ + tstep * lane) * 512; \
            asm volatile("global_load_dwordx4 %0, %1, off" : "=&v"(g_n[0]) : "v"(pg_)); asm volatile("global_load_dwordx4 %0, %1, off offset:16" : "=&v"(g_n[1]) : "v"(pg_)); } while (0)
#define HG_ROWS_LANDED(cnt) asm volatile("s_waitcnt vmcnt(" #cnt ") lgkmcnt(0)\n\tv_mov_b64 %0, %4\n\tv_mov_b64 %1, %5\n\tv_mov_b64 %2, %6\n\tv_mov_b64 %3, %7\n\tds_write_b128 %8, %9\n\tds_write_b128 %8, %10 offset:1024" \
            : "=&v"(hq_[0]), "=&v"(hq_[1]), "=&v"(hq_[2]), "=&v"(hq_[3]) : "v"(hq_n[0]), "v"(hq_n[1]), "v"(hq_n[2]), "v"(hq_n[3]), "v"(gtw), "v"(g_n[0]), "v"(g_n[1]) : "memory")
#define HG_CUM(nn) do { \
            HG_LOAD((nn) + 1); \
            const lds_cptr gt_ = shm3 + HGL_GT + w * 2048; \
            const s16x4 a0l_ = vtr(gt_ + goff), a0h_ = vtr(gt_ + goff + 64), a1l_ = vtr(gt_ + goff + 512), a1h_ = vtr(gt_ + goff + 576); \
            _Pragma("unroll") for (int tj = 0; tj < 4; ++tj) gr_[tj] = *(const LAS v2u*)(gt_ + groff + tj * 256); \
            const f16x8 A0_ = __builtin_bit_cast(f16x8, (bf16x8){a0l_[0], a0l_[1], a0l_[2], a0l_[3], a0h_[0], a0h_[1], a0h_[2], a0h_[3]}), A1_ = __builtin_bit_cast(f16x8, (bf16x8){a1l_[0], a1l_[1], a1l_[2], a1l_[3], a1h_[0], a1h_[1], a1h_[2], a1h_[3]}); \
            const f32x4 z_ = {0.f, 0.f, 0.f, 0.f}; \
            c_[0] = __builtin_amdgcn_mfma_f32_16x16x32_f16(A0_, __builtin_bit_cast(f16x8, tri0), z_, 0, 0, 0); c_[1] = __builtin_amdgcn_mfma_f32_16x16x32_f16(A0_, __builtin_bit_cast(f16x8, tri1), z_, 0, 0, 0); \
            { const f32x4 cf_ = __builtin_amdgcn_mfma_f32_16x16x32_f16(A0_, __builtin_bit_cast(f16x8, fones), z_, 0, 0, 0); \
              c_[2] = __builtin_amdgcn_mfma_f32_16x16x32_f16(A1_, __builtin_bit_cast(f16x8, tri0), cf_, 0, 0, 0); c_[3] = __builtin_amdgcn_mfma_f32_16x16x32_f16(A1_, __builtin_bit_cast(f16x8, tri1), cf_, 0, 0, 0); } } while (0)
#define HG_FIN(nn) do { const int pp_ = (nn) & 1; \
            _Pragma("unroll") for (int tj = 0; tj < 4; ++tj) { \
                const float q_[4] = {pg8::bf_lo(hq_[tj].x), pg8::bf_hi(hq_[tj].x), pg8::bf_lo(hq_[tj].y), pg8::bf_hi(hq_[tj].y)}; \
                const float gg_[4] = {h2f((unsigned short)(gr_[tj].x & 0xffffu)), h2f((unsigned short)(gr_[tj].x >> 16)), h2f((unsigned short)(gr_[tj].y & 0xffffu)), h2f((unsigned short)(gr_[tj].y >> 16))}; \
                float bq_[4], kk_[4], E_[4]; \
                _Pragma("unroll") for (int i = 0; i < 4; ++i) { const float bsum = c_[tj][i]; E_[i] = fast_exp2(bsum); const float Ei = fast_exp2(-bsum), kx = 1.0f - fast_exp2(gg_[i]); bq_[i] = q_[i] * E_[i]; kk_[i] = kx * Ei; } \
                *(LAS v2u*)(shm3 + HGL_QT + pp_ * 16384 + (2 * w) * 1024 + groff + tj * 256) = (v2u){pk2(bq_[0], bq_[1]), pk2(bq_[2], bq_[3])}; \
                *(LAS v2u*)(shm3 + HGL_KC + pp_ * 16384 + (2 * w) * 1024 + groff + tj * 256) = (v2u){pk2(kk_[0], kk_[1]), pk2(kk_[2], kk_[3])}; \
                if (tj == 3) { if (n16 == 15) *(LAS f32x4*)(shm3 + HGL_DEC + pp_ * 512 + 64 * w + 16 * q4) = (f32x4){E_[0], E_[1], E_[2], E_[3]}; } } } while (0)
        HG_LOAD(0); HG_ROWS_LANDED(0);
        HG_CUM(0); HG_VDMA(0); HG_FIN(0);
        HG_ROWS_LANDED(0); __builtin_amdgcn_s_barrier(); asm volatile("" ::: "memory");
        for (int n = 0; n < SEQ / 64; ++n) {
            unsigned long long th0_ = 0, th1_ = 0, th2_ = 0, th3_ = 0; (void)th0_; (void)th1_; (void)th2_; (void)th3_; TP_NOW(th0_);
            const int par = n & 1;
            const int qtc = HGL_QT + par * 16384, kcc = HGL_KC + par * 16384, vpc = HGL_VP + par * 8192, spc = HGL_SP + par * 16384, spn = HGL_SP + (par ^ 1) * 16384, decc = HGL_DEC + par * 512;
            HG_CUM(n + 1);
            if (n + 1 < SEQ / 64) HG_VDMA(n + 1);
            if (w < 4) {
                const int tb = w >> 1, vb = w & 1;
                S0 = f32x16{};
                bf16x8 qf[8];
#pragma unroll
                for (int kd = 0; kd < 8; ++kd) qf[kd] = *(const LAS bf16x8*)(shm3 + qtc + (2 * kd + hi) * 1024 + (32 * tb + r32) * 16);
                {
                    bf16x8 kf[8], kg[8]; s16x4 vl[2], vh_[2], ul[2], uh_[2];
#pragma unroll
                    for (int kd = 0; kd < 8; ++kd) kf[kd] = *(const LAS bf16x8*)(shm3 + kcc + (2 * kd + hi) * 1024 + (32 * tb + r32) * 16);
#pragma unroll
                    for (int ks = 0; ks < 2; ++ks) { vl[ks] = vtr(shm3 + vpc + (vb * 4 + 2 * tb + ks) * 1024 + laneoff); vh_[ks] = vtr(shm3 + vpc + (vb * 4 + 2 * tb + ks) * 1024 + laneoff + 512); }
                    S1 = f32x16{};
#pragma unroll
                    for (int kd = 0; kd < 8; ++kd) S1 = __builtin_amdgcn_mfma_f32_32x32x16_bf16(kf[kd], qf[kd], S1, 0, 0, 0);
                    if (tb == 1) {
#pragma unroll
                        for (int kd = 0; kd < 8; ++kd) kg[kd] = *(const LAS bf16x8*)(shm3 + kcc + (2 * kd + hi) * 1024 + r32 * 16);
#pragma unroll
                        for (int ks = 0; ks < 2; ++ks) { ul[ks] = vtr(shm3 + vpc + (vb * 4 + ks) * 1024 + laneoff); uh_[ks] = vtr(shm3 + vpc + (vb * 4 + ks) * 1024 + laneoff + 512); }
                    }
#pragma unroll
                    for (int r = 0; r < 16; ++r) if (crow(r, hi) > r32) S1[r] = 0.f;
                    { const v4u pw0 = (v4u){pk2(S1[0], S1[1]), pk2(S1[2], S1[3]), pk2(S1[4], S1[5]), pk2(S1[6], S1[7])}, pw1 = (v4u){pk2(S1[8], S1[9]), pk2(S1[10], S1[11]), pk2(S1[12], S1[13]), pk2(S1[14], S1[15])};
#pragma unroll
                      for (int ks = 0; ks < 2; ++ks)
                        S0 = __builtin_amdgcn_mfma_f32_32x32x16_bf16(__builtin_bit_cast(bf16x8, ks ? pw1 : pw0), (bf16x8){vl[ks][0], vl[ks][1], vl[ks][2], vl[ks][3], vh_[ks][0], vh_[ks][1], vh_[ks][2], vh_[ks][3]}, S0, 0, 0, 0); }
                    if (tb == 1) {
                        S1 = f32x16{};
#pragma unroll
                        for (int kd = 0; kd < 8; ++kd) S1 = __builtin_amdgcn_mfma_f32_32x32x16_bf16(kg[kd], qf[kd], S1, 0, 0, 0);
                        const v4u pw0 = (v4u){pk2(S1[0], S1[1]), pk2(S1[2], S1[3]), pk2(S1[4], S1[5]), pk2(S1[6], S1[7])}, pw1 = (v4u){pk2(S1[8], S1[9]), pk2(S1[10], S1[11]), pk2(S1[12], S1[13]), pk2(S1[14], S1[15])};
#pragma unroll
                        for (int ks = 0; ks < 2; ++ks)
                            S0 = __builtin_amdgcn_mfma_f32_32x32x16_bf16(__builtin_bit_cast(bf16x8, ks ? pw1 : pw0), (bf16x8){ul[ks][0], ul[ks][1], ul[ks][2], ul[ks][3], uh_[ks][0], uh_[ks][1], uh_[ks][2], uh_[ks][3]}, S0, 0, 0, 0);
                    }
                }
                if (n > 0) {
                    s16x4 sl[8], sh[8];
#pragma unroll
                    for (int kd = 0; kd < 8; ++kd) { sl[kd] = vtr(shm3 + spc + (vb * 8 + kd) * 1024 + laneoffS); sh[kd] = vtr(shm3 + spc + (vb * 8 + kd) * 1024 + laneoffS + 256); }
#pragma unroll
                    for (int kd = 0; kd < 8; ++kd)
                        S0 = __builtin_amdgcn_mfma_f32_32x32x16_bf16(qf[kd], (bf16x8){sl[kd][0], sl[kd][1], sl[kd][2], sl[kd][3], sh[kd][0], sh[kd][1], sh[kd][2], sh[kd][3]}, S0, 0, 0, 0);
                }
                TP_NOW(th1_);
                if (n + 1 < SEQ / 64) HG_FIN(n + 1);
                TP_NOW(th2_);
#pragma unroll
                for (int r = 0; r < 16; r += 2) { const unsigned w_ = att::cvtpk_s(S0[r], S0[r + 1]);
                    const int i0 = 32 * tb + crow(r, hi), i1 = 32 * tb + crow(r + 1, hi);
                    OUT[(size_t)(tfirst + tstep * (64 * n + i0)) * 512 + vb * 32 + r32] = (bf16)(w_ & 0xffffu); OUT[(size_t)(tfirst + tstep * (64 * n + i1)) * 512 + vb * 32 + r32] = (bf16)(w_ >> 16); }
            } else {
                const int db = w - 4;
                if (n + 1 < SEQ / 64) HG_FIN(n + 1);
                s16x4 kl[4], kh_[4], v0l[4], v0h[4], v1l[4], v1h[4];
#pragma unroll
                for (int ig = 0; ig < 4; ++ig) {
                    kl[ig] = vtr(shm3 + kcc + (4 * db) * 1024 + ig * 256 + koff); kh_[ig] = vtr(shm3 + kcc + (4 * db) * 1024 + ig * 256 + koff + 128);
                    v0l[ig] = vtr(shm3 + vpc + (0 * 4 + ig) * 1024 + laneoff); v0h[ig] = vtr(shm3 + vpc + (0 * 4 + ig) * 1024 + laneoff + 512);
                    v1l[ig] = vtr(shm3 + vpc + (1 * 4 + ig) * 1024 + laneoff); v1h[ig] = vtr(shm3 + vpc + (1 * 4 + ig) * 1024 + laneoff + 512); }
#pragma unroll
                for (int ig = 0; ig < 4; ++ig) {
                    const bf16x8 ka = (bf16x8){kl[ig][0], kl[ig][1], kl[ig][2], kl[ig][3], kh_[ig][0], kh_[ig][1], kh_[ig][2], kh_[ig][3]};
                    S0 = __builtin_amdgcn_mfma_f32_32x32x16_bf16(ka, (bf16x8){v0l[ig][0], v0l[ig][1], v0l[ig][2], v0l[ig][3], v0h[ig][0], v0h[ig][1], v0h[ig][2], v0h[ig][3]}, S0, 0, 0, 0);
                    S1 = __builtin_amdgcn_mfma_f32_32x32x16_bf16(ka, (bf16x8){v1l[ig][0], v1l[ig][1], v1l[ig][2], v1l[ig][3], v1h[ig][0], v1h[ig][1], v1h[ig][2], v1h[ig][3]}, S1, 0, 0, 0);
                }
                TP_NOW(th1_);
                TP_NOW(th2_);
#pragma unroll
                for (int r = 0; r < 16; ++r) { const int d = 32 * db + crow(r, hi); const float dc = ((const LAS float*)(shm3 + decc))[d]; S0[r] *= dc; S1[r] *= dc;
                    const unsigned w_ = att::cvtpk_s(S0[r], S1[r]);
                    *(LAS bf16*)(shm3 + spn + (0 * 8 + (d >> 4)) * 1024 + (d & 15) * 64 + r32 * 2) = (bf16)(w_ & 0xffffu);
                    *(LAS bf16*)(shm3 + spn + (1 * 8 + (d >> 4)) * 1024 + (d & 15) * 64 + r32 * 2) = (bf16)(w_ >> 16); }
            }
            if (n + 2 < SEQ / 64) { if (w < 4) HG_ROWS_LANDED(16); else HG_ROWS_LANDED(0); }
            else HG_ROWS_LANDED(0);
            __builtin_amdgcn_s_barrier(); asm volatile("" ::: "memory");
            TP_NOW(th3_);
#if MK_TPROBE
            TP_ADD((LAS unsigned char*)shm3, w, 1, th0_, th3_);
            if (MK_TPHG == 0) TP_ADD((LAS unsigned char*)shm3, w, 0, th0_, th1_); else if (MK_TPHG == 1) TP_ADD((LAS unsigned char*)shm3, w, 0, th1_, th2_); else TP_ADD((LAS unsigned char*)shm3, w, 0, th2_, th3_);
#endif
        }
#undef HG_VDMA
#undef HG_LOAD
#undef HG_ROWS_LANDED
#undef HG_CUM
#undef HG_FIN
    }
}
__device__ __forceinline__ void hg_combine(Frame& F, const Inputs& in) {
    const int gw = F.vcu * NWAVES + F.wave, NGW = F.G * NWAVES, lane = F.lane();
    const bf16* OFp = (const bf16*)(F.ws + WS_OF); const bf16* OBp = (const bf16*)(F.ws + WS_OB); const bf16* HG = (const bf16*)(F.ws + WS_HG); bf16* CAT = (bf16*)(F.ws + WS_CAT);
    float on[8];
#pragma unroll
    for (int e = 0; e < 8; ++e) on[e] = in.o_norm[(lane & 15) * 8 + e];
    for (int t = gw; t < T; t += NGW) {
        const v4u a = *(const v4u*)(OFp + (size_t)t * 512 + lane * 8), bq = *(const v4u*)(OBp + (size_t)t * 512 + lane * 8), gq = *(const v4u*)(HG + (size_t)t * 512 + lane * 8);
        float x[8], ss = 0.f;
#pragma unroll
        for (int e = 0; e < 4; ++e) { x[2 * e] = pg8::bf_lo(a[e]) + pg8::bf_lo(bq[e]); x[2 * e + 1] = pg8::bf_hi(a[e]) + pg8::bf_hi(bq[e]); ss += x[2 * e] * x[2 * e] + x[2 * e + 1] * x[2 * e + 1]; }
        ss += __shfl_xor(ss, 1); ss += __shfl_xor(ss, 2); ss += __shfl_xor(ss, 4); ss += __shfl_xor(ss, 8);
        const float r = rsq(ss * (1.f / 128.f) + EPS);
        v4u o;
#pragma unroll
        for (int e = 0; e < 4; ++e) o[e] = pk2(x[2 * e] * r * on[2 * e] * pg8::bf_lo(gq[e]), x[2 * e + 1] * r * on[2 * e + 1] * pg8::bf_hi(gq[e]));
        *(v4u*)(CAT + (size_t)t * 1024 + 512 + lane * 8) = o;
    }
}
__device__ __forceinline__ void moe_route(Frame& F, const int tok0, const int ntok) {
    const int gt = tok0 + F.tid(), NGT = NWAVES * 64;
    const float* LG = (const float*)(F.ws + WS_LG); int* rec = (int*)(F.ws + WS_REC);
    int* bk = rec; int* ps = rec + T; float* wA = (float*)(rec + 2 * T); float* wB = (float*)(rec + 3 * T);
    LAS unsigned* lcnt = (LAS unsigned*)(F.lds + RING_OFF); LAS unsigned* lbase = lcnt + 512;
    for (int tokc = tok0; tokc < tok0 + ntok; tokc += NGT) {
    __syncthreads();
    lcnt[F.tid()] = 0u;
    __syncthreads();
    const int tok = tokc + F.tid(); const bool live = tok < tok0 + ntok;
    int bucket = 0; unsigned lrank = 0u; float wAv = 0.f, wBv = 0.f;
    if (live) {
        const float* l = LG + (size_t)tok * 72;
        float gl[8]; { const f32x4 a = *(const f32x4*)l, b = *(const f32x4*)(l + 4); gl[0] = a[0]; gl[1] = a[1]; gl[2] = a[2]; gl[3] = a[3]; gl[4] = b[0]; gl[5] = b[1]; gl[6] = b[2]; gl[7] = b[3]; }
        float mx = gl[0]; int gs = 0;
#pragma unroll
        for (int g = 1; g < 8; ++g) if (gl[g] > mx) { mx = gl[g]; gs = g; }
        float den = 0.f;
#pragma unroll
        for (int g = 0; g < 8; ++g) den += expf(gl[g] - mx);
        const float gwt = 1.0f / den;
        float el[8]; { const f32x4 a = *(const f32x4*)(l + 8 + gs * 8), b = *(const f32x4*)(l + 12 + gs * 8); el[0] = a[0]; el[1] = a[1]; el[2] = a[2]; el[3] = a[3]; el[4] = b[0]; el[5] = b[1]; el[6] = b[2]; el[7] = b[3]; }
        int i0 = 0; float m0 = el[0];
#pragma unroll
        for (int e = 1; e < 8; ++e) if (el[e] > m0) { m0 = el[e]; i0 = e; }
        int i1 = -1; float m1 = -INFINITY;
#pragma unroll
        for (int e = 0; e < 8; ++e) if (e != i0 && el[e] > m1) { m1 = el[e]; i1 = e; }
        if (i1 < 0) i1 = (i0 == 0) ? 1 : 0;
        const float e1 = expf(m1 - m0); const float wa = gwt / (1.0f + e1), wb = gwt * e1 / (1.0f + e1);
        const int ea = i0 < i1 ? i0 : i1, eb = i0 < i1 ? i1 : i0;
        bucket = gs * 64 + ea * 8 + eb;
        lrank = __hip_atomic_fetch_add((unsigned*)(lcnt + bucket), 1u, __ATOMIC_RELAXED, __HIP_MEMORY_SCOPE_WORKGROUP);
        wAv = i0 < i1 ? wa : wb; wBv = i0 < i1 ? wb : wa;
    }
    __syncthreads();
    { const unsigned c_ = lcnt[F.tid()]; if (c_ != 0u) lbase[F.tid()] = __hip_atomic_fetch_add((unsigned*)(F.ctl + CW_CNTP) + F.tid() * 32, c_, RLX_AGENT); }
    __syncthreads();
    if (live) { bk[tok] = bucket; ps[tok] = (int)(lbase[bucket] + lrank); wA[tok] = wAv; wB[tok] = wBv; }
    }
    __syncthreads();
}
__device__ __forceinline__ void moe_place(Frame& F) {
    LAS int* cn_s = (LAS int*)(F.lds + RING_OFF); LAS int* ts_s = cn_s + 512; LAS int* ba_s = cn_s + 1024; LAS int* bb_s = cn_s + 1536; LAS int* ne_s = cn_s + 2048; LAS int* te_s = cn_s + 2112;
    const int t = F.tid();
    const int cnt = (int)__hip_atomic_load((unsigned*)(F.ctl + CW_CNTP) + t * 32, RLX_AGENT);
    cn_s[t] = cnt;
    __syncthreads();
    const int g = t >> 6, ea = (t >> 3) & 7, eb = t & 7;
    int st = 0;
    for (int j = 0; j < t; ++j) st += (cn_s[j] + 255) >> 8;
    ts_s[t] = st;
    int ba = 0, bb = 0;
    for (int j = g * 64; j < t; ++j) { const int ja = (j >> 3) & 7, jb = j & 7; const int c = cn_s[j]; if (ja == ea || jb == ea) ba += c; if (ja == eb || jb == eb) bb += c; }
    ba_s[t] = ba; bb_s[t] = bb;
    int cntE = 0;
    if (t < 64) { const int x = t & 7; for (int j = (t >> 3) * 64; j < (t >> 3) * 64 + 64; ++j) { const int ja = (j >> 3) & 7, jb = j & 7; if (ja < jb && (ja == x || jb == x)) cntE += cn_s[j]; } ne_s[t] = (cntE + 255) >> 8; }
    __syncthreads();
    int ste = 0;
    if (t < 64) { for (int j = 0; j < t; ++j) ste += ne_s[j]; te_s[t] = ste; }
    __syncthreads();
    unsigned char* rec = F.ws + WS_REC;
    int* rowpa = (int*)(rec + REC_ROWPA); int* rowpb = (int*)(rec + REC_ROWPB); int* rowp = (int*)(rec + REC_ROWP); int* tilep = (int*)(rec + REC_TILEP); int* rowe = (int*)(rec + REC_ROWE); float* wslot = (float*)(rec + REC_WSLOT); int* tilee = (int*)(rec + REC_TILEE);
    if (blockIdx.x == 0) {
        const int ntb = (cnt + 255) >> 8;
        for (int k = 0; k < ntb; ++k) tilep[st + k] = t;
        for (int r = cnt; r < ntb * 256; ++r) { rowp[st * 256 + r] = -1; rowpa[st * 256 + r] = 0; rowpb[st * 256 + r] = 0; }
        if (t == 511) __hip_atomic_store((unsigned*)(F.ctl + CW_NT), (unsigned)(st + ntb), RLX_AGENT);
        if (t < 64) { const int nte = (cntE + 255) >> 8;
            for (int k = 0; k < nte; ++k) tilee[ste + k] = t;
            for (int r = cntE; r < nte * 256; ++r) { rowe[ste * 256 + r] = -1; wslot[ste * 256 + r] = 0.f; }
            if (t == 63) __hip_atomic_store((unsigned*)(F.ctl + CW_NTE), (unsigned)(ste + nte), RLX_AGENT); }
    }
    const int gt = (F.vcu * NWAVES + F.wave) * 64 + F.lane(), NGT = F.G * NWAVES * 64;
    const int* ri = (const int*)rec; int* wi = (int*)rec;
    for (int tok = gt; tok < T; tok += NGT) {
        const int bkt = ri[tok], pos = ri[T + tok];
        rowp[ts_s[bkt] * 256 + pos] = tok;
        const int eag = (bkt >> 6) * 8 + ((bkt >> 3) & 7), ebg = (bkt >> 6) * 8 + (bkt & 7);
        const int sa = te_s[eag] * 256 + ba_s[bkt] + pos, sb = te_s[ebg] * 256 + bb_s[bkt] + pos;
        rowe[sa] = tok; rowe[sb] = tok; wslot[sa] = __int_as_float(ri[2 * T + tok]); wslot[sb] = __int_as_float(ri[3 * T + tok]);
        rowpa[ts_s[bkt] * 256 + pos] = sa; rowpb[ts_s[bkt] * 256 + pos] = sb;
    }
    __syncthreads();
}
#ifndef MK_WGM1
#define MK_WGM1 8
#endif
__device__ __forceinline__ void phase_0(Frame& F, const Inputs& in, float* d_out_, unsigned char* ws, unsigned char* lds) {
    LAS float* RS = (LAS float*)(F.lds + AUX_RS); LAS float* WG = (LAS float*)(F.lds + AUX_WG); LAS int* TOK = (LAS int*)(F.lds + AUX_TOK); LAS float* XP = (LAS float*)(F.lds + AUX_XP);
    const float* misc = (const float*)(ws + WS_MISC); (void)RS; (void)WG; (void)TOK; (void)XP; (void)misc;
 p0_prologue(F, in);
}
__device__ __forceinline__ void phase_1(Frame& F, const Inputs& in, float* d_out_, unsigned char* ws, unsigned char* lds) {
    LAS float* RS = (LAS float*)(F.lds + AUX_RS); LAS float* WG = (LAS float*)(F.lds + AUX_WG); LAS int* TOK = (LAS int*)(F.lds + AUX_TOK); LAS float* XP = (LAS float*)(F.lds + AUX_XP);
    const float* misc = (const float*)(ws + WS_MISC); (void)RS; (void)WG; (void)TOK; (void)XP; (void)misc;
        SchedGrid S; S.pad_ = 11  ; S.o.init(T / 256, 12, F.G, (int)blockIdx.x, MK_WGM1); S.A = (const char*)(ws + WS_XN); S.B = (const char*)(ws + W_IN); S.astep = (size_t)256 * 1024 * 2; S.bstep = (size_t)256 * 1024 * 2;
        EpiIn E{(bf16_t*)(ws + WS_HQ), (const float*)(ws + WS_SS0), misc, RS, 0};
        pg8::gemm_phase<EpiIn, SchedGrid, true, 0, 1024, 1024, 1024, 16>(F.lds + RING_OFF, S, E);
#ifdef MK_PROBE_P1CHEAP
        { __syncthreads(); EpiIn E2{(bf16_t*)(ws + WS_Q), (const float*)(ws + WS_SS0), misc, RS, MK_PROBE_P1CHEAP}; pg8::gemm_phase<EpiIn, SchedGrid, true, 0, 1024, 1024, 1024, 16>(F.lds + RING_OFF, S, E2); }
#endif

}
__device__ __forceinline__ void phase_2(Frame& F, const Inputs& in, float* d_out_, unsigned char* ws, unsigned char* lds) {
    LAS float* RS = (LAS float*)(F.lds + AUX_RS); LAS float* WG = (LAS float*)(F.lds + AUX_WG); LAS int* TOK = (LAS int*)(F.lds + AUX_TOK); LAS float* XP = (LAS float*)(F.lds + AUX_XP);
    const float* misc = (const float*)(ws + WS_MISC); (void)RS; (void)WG; (void)TOK; (void)XP; (void)misc;
#ifdef MK_TPROBE_MLA
        TP_SET(F.lds, 1u);
#endif
#ifdef MK_TPS_MLA
        { TPS_BEGIN(); mla_proj(F, in); TPS_END(F); }
#else
        mla_proj(F, in);
#endif
#ifdef MK_TPROBE_MLA
        TP_SET(F.lds, 0u);
#endif
#ifdef MK_REP_MLA
        mla_proj(F, in);
#endif
        { SchedGrid S; S.pad_ = 0; S.o.init(16, 8, F.G, (int)blockIdx.x); S.A = (const char*)(ws + WS_MN); S.B = (const char*)(ws + W_XKV); S.astep = (size_t)256 * 1024 * 2; S.bstep = (size_t)256 * 1024 * 2;
          EpiHeadNorm E{nullptr, in.x_k_norm, (bf16_t*)(ws + WS_KVX), RS, XP, 1.0f, 2048, 4, 0};
          pg8::gemm_phase<EpiHeadNorm, SchedGrid, true, 0, 1024, 1024, 1024, 16>(F.lds + RING_OFF, S, E); }
        __syncthreads();
#if defined(MK_TPHG)
        TP_SET(F.lds, 1u); hgrn2_scan(F, (char*)lds + RING_OFF); TP_SET(F.lds, 0u);
#elif defined(MK_TPS_HG)
        { TPS_BEGIN(); hgrn2_scan(F, (char*)lds + RING_OFF); TPS_END(F); }
#else
        hgrn2_scan(F, (char*)lds + RING_OFF);
#endif
#ifdef MK_REP_HG
        __syncthreads(); hgrn2_scan(F, (char*)lds + RING_OFF);
#endif

}
__device__ __forceinline__ void phase_3(Frame& F, const Inputs& in, float* d_out_, unsigned char* ws, unsigned char* lds) {
    LAS float* RS = (LAS float*)(F.lds + AUX_RS); LAS float* WG = (LAS float*)(F.lds + AUX_WG); LAS int* TOK = (LAS int*)(F.lds + AUX_TOK); LAS float* XP = (LAS float*)(F.lds + AUX_XP);
    const float* misc = (const float*)(ws + WS_MISC); (void)RS; (void)WG; (void)TOK; (void)XP; (void)misc;
        hg_combine(F, in);
        const float cb = misc[1024];
        if (cb < 64.f) {
        for (int un = F.vcu; un < BATCH * 8 * 8; un += F.G) {
            const int qb = un & 7, bh = un >> 3, b = bh >> 3, h = bh & 7;
            att::Tensors Tn; Tn.Q = (const bf16*)(ws + WS_Q) + (size_t)b * SEQ * 768 + h * 96; Tn.K = (const bf16*)(ws + WS_K) + (size_t)b * SEQ * 768 + h * 96;
            Tn.V = (const bf16*)(ws + WS_V) + (size_t)b * SEQ * 512 + h * 64; Tn.O = (bf16*)(ws + WS_CAT) + (size_t)b * SEQ * 1024 + h * 64; Tn.qp = 768; Tn.kp = 768; Tn.vp = 512; Tn.op = 1024;
            att::unit3<6, 2>(Tn, qb * 512, SEQ / 64, (char*)lds + RING_OFF, (LAS float*)(F.lds + AUX_WSF));
        }
        } else {
        for (int un = F.vcu; un < BATCH * 8 * 16; un += F.G) {
            const int qb = un & 15, bh = un >> 4, b = bh >> 3, h = bh & 7;
            att::Tensors Tn; Tn.Q = (const bf16*)(ws + WS_Q) + (size_t)b * SEQ * 768 + h * 96; Tn.K = (const bf16*)(ws + WS_K) + (size_t)b * SEQ * 768 + h * 96;
            Tn.V = (const bf16*)(ws + WS_V) + (size_t)b * SEQ * 512 + h * 64; Tn.O = (bf16*)(ws + WS_CAT) + (size_t)b * SEQ * 1024 + h * 64; Tn.qp = 768; Tn.kp = 768; Tn.vp = 512; Tn.op = 1024;
            att::unit<6, 2, 2, 8, true, false>(Tn, qb * 256, SEQ / 64, cb, (char*)lds + RING_OFF, (LAS float*)(F.lds + AUX_WSF));
        }
        }

}
__device__ __forceinline__ void phase_4(Frame& F, const Inputs& in, float* d_out_, unsigned char* ws, unsigned char* lds) {
    LAS float* RS = (LAS float*)(F.lds + AUX_RS); LAS float* WG = (LAS float*)(F.lds + AUX_WG); LAS int* TOK = (LAS int*)(F.lds + AUX_TOK); LAS float* XP = (LAS float*)(F.lds + AUX_XP);
    const float* misc = (const float*)(ws + WS_MISC); (void)RS; (void)WG; (void)TOK; (void)XP; (void)misc;
    SchedGrid S; S.pad_ = 0; S.o.init(T / 256, 4, F.G, (int)blockIdx.x); S.A = (const char*)(ws + WS_CAT); S.B = (const char*)(ws + W_OUT); S.astep = (size_t)256 * 1024 * 2; S.bstep = (size_t)256 * 1024 * 2;
    EpiRes<XN0_KEPT> E{XN0_KEPT ? (const void*)(ws + WS_XN) : (const void*)in.x, (bf16_t*)(ws + WS_XN), (float*)(ws + WS_SSP1)};
    pg8::gemm_phase<EpiRes<XN0_KEPT>, SchedGrid, true, 0, 1024, 1024, 1024, 16>(F.lds + RING_OFF, S, E);
}
__device__ __forceinline__ void phase_5(Frame& F, const Inputs& in, float* d_out_, unsigned char* ws, unsigned char* lds) {
    LAS float* RS = (LAS float*)(F.lds + AUX_RS); LAS float* WG = (LAS float*)(F.lds + AUX_WG); LAS int* TOK = (LAS int*)(F.lds + AUX_TOK); LAS float* XP = (LAS float*)(F.lds + AUX_XP);
    const float* misc = (const float*)(ws + WS_MISC); (void)RS; (void)WG; (void)TOK; (void)XP; (void)misc;
    SchedGrid S; S.pad_ = 0; S.o.init(T / 256, 4, F.G, (int)blockIdx.x); S.A = (const char*)(ws + WS_XN); S.B = (const char*)(ws + W_XQ); S.astep = (size_t)256 * 1024 * 2; S.bstep = (size_t)256 * 1024 * 2;
    { EpiHeadNorm E{(const float*)(ws + WS_SSP1), in.x_q_norm, (bf16_t*)(ws + WS_QX), RS, XP, 0.0625f * LOG2E, 1024, 4, 0};
      pg8::gemm_phase<EpiHeadNorm, SchedGrid, true, 0, 1024, 1024, 1024, 16>(F.lds + RING_OFF, S, E); }
    asm volatile("s_waitcnt vmcnt(0) lgkmcnt(0)" ::: "memory"); __syncthreads(); __builtin_amdgcn_fence(__ATOMIC_ACQUIRE, "agent"); asm volatile("s_waitcnt vmcnt(0)" ::: "memory"); __syncthreads();
    const float cb = misc[1025];
    for (int i = 0;; ++i) { int pm, h; if (!S.o.tile(i, pm, h)) break;
        const int b = pm >> 4, q0 = (pm & 15) * 256;
        att::Tensors Tn; Tn.Q = (const bf16*)(ws + WS_QX) + (size_t)b * SEQ * 1024 + h * 256; Tn.K = (const bf16*)(ws + WS_KVX) + (size_t)b * MEML * 2048 + h * 256;
        Tn.V = (const bf16*)(ws + WS_KVX) + (size_t)b * MEML * 2048 + 1024 + h * 256; Tn.O = (bf16*)(ws + WS_QX) + (size_t)b * SEQ * 1024 + h * 256; Tn.qp = 1024; Tn.kp = 2048; Tn.vp = 2048; Tn.op = 1024;
        att::unit<16, 8, 8, 8, true, true>(Tn, q0, MEML / 64, cb, (char*)lds + RING_OFF, (LAS float*)(F.lds + AUX_WSF)); }
}
__device__ __forceinline__ void phase_6(Frame& F, const Inputs& in, float* d_out_, unsigned char* ws, unsigned char* lds) {
    LAS float* RS = (LAS float*)(F.lds + AUX_RS); LAS float* WG = (LAS float*)(F.lds + AUX_WG); LAS int* TOK = (LAS int*)(F.lds + AUX_TOK); LAS float* XP = (LAS float*)(F.lds + AUX_XP);
    const float* misc = (const float*)(ws + WS_MISC); (void)RS; (void)WG; (void)TOK; (void)XP; (void)misc;
}
__device__ __forceinline__ void phase_7(Frame& F, const Inputs& in, float* d_out_, unsigned char* ws, unsigned char* lds) {
    LAS float* RS = (LAS float*)(F.lds + AUX_RS); LAS float* WG = (LAS float*)(F.lds + AUX_WG); LAS int* TOK = (LAS int*)(F.lds + AUX_TOK); LAS float* XP = (LAS float*)(F.lds + AUX_XP);
    const float* misc = (const float*)(ws + WS_MISC); (void)RS; (void)WG; (void)TOK; (void)XP; (void)misc;
    SchedGrid S; S.pad_ = 0; S.o.init(T / 256, 4, F.G, (int)blockIdx.x); S.A = (const char*)(ws + WS_QX); S.B = (const char*)(ws + W_XO); S.astep = (size_t)256 * 1024 * 2; S.bstep = (size_t)256 * 1024 * 2;
    EpiRes<true> E{(const void*)(ws + WS_XN), (bf16_t*)(ws + WS_XN), (float*)(ws + WS_SSP2)};
    pg8::gemm_phase<EpiRes<true>, SchedGrid, true, 0, 1024, 1024, 1024, 16>(F.lds + RING_OFF, S, E);
}
__device__ __forceinline__ void phase_8(Frame& F, const Inputs& in, float* d_out_, unsigned char* ws, unsigned char* lds) {
    LAS float* RS = (LAS float*)(F.lds + AUX_RS); LAS float* WG = (LAS float*)(F.lds + AUX_WG); LAS int* TOK = (LAS int*)(F.lds + AUX_TOK); LAS float* XP = (LAS float*)(F.lds + AUX_XP);
    const float* misc = (const float*)(ws + WS_MISC); (void)RS; (void)WG; (void)TOK; (void)XP; (void)misc;
    { SchedGrid S; S.pad_ = 0; S.o.init(T / 256, 1, F.G, (int)blockIdx.x); S.A = (const char*)(ws + WS_XN); S.B = (const char*)(ws + W_R); S.astep = (size_t)256 * 1024 * 2; S.bstep = 0;
      EpiRouter E{(const float*)(ws + WS_SSP2), in.b_group, in.b_expert, (float*)(ws + WS_LG), RS, 0};
      pg8::gemm_phase<EpiRouter, SchedGrid, true, 0, 1024, 1024, 1024, 16>(F.lds + RING_OFF, S, E);
      __syncthreads(); __builtin_amdgcn_fence(__ATOMIC_ACQUIRE, "agent"); asm volatile("s_waitcnt vmcnt(0)" ::: "memory"); __syncthreads();
      for (int i = 0;; ++i) { int pm, pn; if (!S.o.tile(i, pm, pn)) break; moe_route(F, pm * 256, 256); } }
}
__device__ __forceinline__ void phase_9(Frame& F, const Inputs& in, float* d_out_, unsigned char* ws, unsigned char* lds) {
    LAS float* RS = (LAS float*)(F.lds + AUX_RS); LAS float* WG = (LAS float*)(F.lds + AUX_WG); LAS int* TOK = (LAS int*)(F.lds + AUX_TOK); LAS float* XP = (LAS float*)(F.lds + AUX_XP);
    const float* misc = (const float*)(ws + WS_MISC); (void)RS; (void)WG; (void)TOK; (void)XP; (void)misc;
}
__device__ __forceinline__ void phase_10(Frame& F, const Inputs& in, float* d_out_, unsigned char* ws, unsigned char* lds) {
    LAS float* RS = (LAS float*)(F.lds + AUX_RS); LAS float* WG = (LAS float*)(F.lds + AUX_WG); LAS int* TOK = (LAS int*)(F.lds + AUX_TOK); LAS float* XP = (LAS float*)(F.lds + AUX_XP);
    const float* misc = (const float*)(ws + WS_MISC); (void)RS; (void)WG; (void)TOK; (void)XP; (void)misc;
 moe_place(F);
}
__device__ __forceinline__ void phase_11(Frame& F, const Inputs& in, float* d_out_, unsigned char* ws, unsigned char* lds) {
    LAS float* RS = (LAS float*)(F.lds + AUX_RS); LAS float* WG = (LAS float*)(F.lds + AUX_WG); LAS int* TOK = (LAS int*)(F.lds + AUX_TOK); LAS float* XP = (LAS float*)(F.lds + AUX_XP);
    const float* misc = (const float*)(ws + WS_MISC); (void)RS; (void)WG; (void)TOK; (void)XP; (void)misc;
        SchedMoeA S; S.pad_ = 0; S.ntile = __builtin_amdgcn_readfirstlane((int)__hip_atomic_load((unsigned*)(F.ctl + CW_NTE), RLX_AGENT)); S.G = F.G; S.c = F.vcu;
        S.tilee = (const int*)(ws + WS_REC + REC_TILEE); S.rowe = (const int*)(ws + WS_REC + REC_ROWE); S.XN = (const char*)(ws + WS_XN); S.WGU = (const char*)(ws + WS_WGU);
        EpiMoeA E{(const float*)(ws + WS_SSP2), (const float*)(ws + WS_REC + REC_WSLOT), (bf16_t*)(ws + WS_H), RS, WG};
        pg8::gemm_phase<EpiMoeA, SchedMoeA, true, 1, 1024, 1024, 1024, 16>(F.lds + RING_OFF, S, E);
}
__device__ __forceinline__ void phase_12(Frame& F, const Inputs& in, float* d_out_, unsigned char* ws, unsigned char* lds) {
    LAS float* RS = (LAS float*)(F.lds + AUX_RS); LAS float* WG = (LAS float*)(F.lds + AUX_WG); LAS int* TOK = (LAS int*)(F.lds + AUX_TOK); LAS float* XP = (LAS float*)(F.lds + AUX_XP);
    const float* misc = (const float*)(ws + WS_MISC); (void)RS; (void)WG; (void)TOK; (void)XP; (void)misc;
        SchedMoeB S; S.pad_ = 0; S.ntile = __builtin_amdgcn_readfirstlane((int)__hip_atomic_load((unsigned*)(F.ctl + CW_NT), RLX_AGENT)); S.G = F.G; S.c = F.vcu;
        S.tilep = (const int*)(ws + WS_REC + REC_TILEP); S.rowp = (const int*)(ws + WS_REC + REC_ROWP); S.slotA = (const int*)(ws + WS_REC + REC_ROWPA); S.slotB = (const int*)(ws + WS_REC + REC_ROWPB);
        S.Hb = (const char*)(ws + WS_H); S.WD = (const char*)(ws + WS_WD);
        EpiMoeB E{(const bf16_t*)(ws + WS_XN), d_out_, TOK, 0};
        pg8::gemm_phase<EpiMoeB, SchedMoeB, true, 2, 512, 256, 256, 4>(F.lds + RING_OFF, S, E);
}

constexpr int N_PHASES = 13;
struct Args { Inputs in; float* out; unsigned char* ws; int ph_lo, ph_hi; };
__global__ void __launch_bounds__(NWAVES * 64, 2) mega_fwd(Args args) {
    extern __shared__ __attribute__((aligned(16))) unsigned char lds[];
    Frame F;
    F.lds = (LAS unsigned char*)lds;
    F.MISC = (volatile LAS unsigned*)(F.lds + MISC_OFF);
    F.wave = __builtin_amdgcn_readfirstlane((int)threadIdx.x >> 6);
    F.G = gridDim.x; { const int bx = blockIdx.x; F.vcu = (F.G % 8 == 0) ? (bx % 8) * (F.G / 8) + bx / 8 : bx; }
    F.ws = args.ws; F.ctl = (gu32*)(args.ws + WS_CTL);
    const Inputs& in = args.in;
    unsigned char* ws = args.ws;
    for (int u = F.tid(); u < 32; u += NWAVES * 64) ((LAS unsigned*)(F.lds + MISC_OFF))[u] = 0u;
    __syncthreads();
#if MK_TPROBE
    for (int u = F.tid(); u < 128; u += NWAVES * 64) ((LAS unsigned*)(F.lds + TP_LDS_OFF))[u] = 0u;
    __syncthreads();
#endif
    unsigned long long tk0_ = 0, tk1_ = 0; (void)tk0_; (void)tk1_; TP_NOW(tk0_);
    const int lo = args.ph_lo, hi = args.ph_hi;
    const bool multi = (hi - lo) > 1;
    XcdBarrier bar; bar.bar = (unsigned*)(F.ctl + CW_BAR); bar.x = 0; bar.st = nullptr;
    if (multi) bar = xcd_barrier_post((unsigned*)(F.ctl + CW_BAR), F.MISC + 8);
#ifndef MK_PHASE_MASK
#define MK_PHASE_MASK 0xffff
#endif
#define IN(k) ((((MK_PHASE_MASK) >> (k)) & 1) && lo <= (k) && (k) < hi)
#ifndef MK_REP_MASK
#define MK_REP_MASK 0
#endif
#define REPS(k) ((((MK_REP_MASK) >> (k)) & 1) ? 2 : 1)
#ifndef MK_TPROBE_PHASE
#define MK_TPROBE_PHASE -1
#endif
#ifndef MK_TPROBE_PHT
#define MK_TPROBE_PHT -1
#endif
#ifndef MK_TPROBE_Q
#define MK_TPROBE_Q 10
#endif
#ifndef MK_TPROBE_OFS
#define MK_TPROBE_OFS 0.5
#endif
#ifdef MK_TPS_BAR
#ifndef MK_TPS_BAR_MASK
#define MK_TPS_BAR_MASK 0xffff
#endif
#define SEAM(k) do { if (IN(k) && IN((k) + 1)) { if ((MK_TPS_BAR_MASK >> (k)) & 1) { TPS_BEGIN(); xcd_barrier(bar); TPS_END(F); } else xcd_barrier(bar); } } while (0)
#else
#define SEAM(k) do { if (MK_TPROBE && (k) == MK_TPROBE_PHASE) TP_SET(F.lds, 0u); if (IN(k) && IN((k) + 1)) xcd_barrier(bar); } while (0)
#endif
#if MK_DEBUG
#define MW_R0 0, 16384, 0, 0
#define MW_R1 0, 16384, 0, 0
#define MW_R2 0, 16384, 0, 0
#define MW_R3 0, 16384, 0, 0
#define MW_R4 0, 24576, 0, (1 << 20)
#define MW_R6 0, 16384, 0, 0
#define MW_R7 0, 16384, 0, 0
#define MW_R9 0, 16384, 0, 0
#else
#define MW_R0 0, 16384, 0, 2
#define MW_R1 0, 16384, 2, 4
#define MW_R2 0, 16384, 4, 6
#define MW_R3 0, 16384, 6, (1 << 20)
#define MW_R4 16384, 8192, 0, 1
#define MW_R6 16384, 8192, 1, 2
#define MW_R7 16384, 8192, 2, 3
#define MW_R9 16384, 8192, 3, (1 << 20)
#endif
#define SEAMW(k, ...) SEAMW_(k, __VA_ARGS__)
#define SEAMW_(k, ib, ic, r0, r1) do { if (MK_TPROBE && (k) == MK_TPROBE_PHASE) TP_SET(F.lds, 0u); \
        if (IN(k) && IN((k) + 1)) { xcd_barrier_arrive(bar); moe_weights(F, in, ib, ic, r0, r1); xcd_barrier_wait(bar); } else if (IN(k)) { __syncthreads(); moe_weights(F, in, ib, ic, r0, r1); } } while (0)
    LAS float* RS = (LAS float*)(F.lds + AUX_RS); LAS float* WG = (LAS float*)(F.lds + AUX_WG); LAS int* TOK = (LAS int*)(F.lds + AUX_TOK); LAS float* XP = (LAS float*)(F.lds + AUX_XP);
    const float* misc = (const float*)(ws + WS_MISC);

    if (IN(0)) { unsigned long long pt0_ = 0, pt1_ = 0; (void)pt0_; (void)pt1_; if (MK_TPROBE && 0 == MK_TPROBE_PHT) TP_NOW(pt0_); if (MK_TPROBE && 0 == MK_TPROBE_PHASE) TP_SET(F.lds, 1u); phase_0(F, in, args.out, ws, lds); if (REPS(0) > 1) { __syncthreads(); phase_0(F, in, args.out, ws, lds); }  if (MK_TPROBE && 0 == MK_TPROBE_PHT) { TP_NOW(pt1_); if (F.lane() == 0) { volatile LAS unsigned long long* q_ = (volatile LAS unsigned long long*)(F.lds + TP_LDS_OFF + 256) + F.wave * 4 + 2; *q_ = *q_ + (pt1_ - pt0_); } } }
    SEAMW(0, MW_R0);
    if (IN(1)) { unsigned long long pt0_ = 0, pt1_ = 0; (void)pt0_; (void)pt1_; if (MK_TPROBE && 1 == MK_TPROBE_PHT) TP_NOW(pt0_); if (MK_TPROBE && 1 == MK_TPROBE_PHASE) TP_SET(F.lds, 1u); phase_1(F, in, args.out, ws, lds); if (REPS(1) > 1) { __syncthreads(); phase_1(F, in, args.out, ws, lds); }  if (MK_TPROBE && 1 == MK_TPROBE_PHT) { TP_NOW(pt1_); if (F.lane() == 0) { volatile LAS unsigned long long* q_ = (volatile LAS unsigned long long*)(F.lds + TP_LDS_OFF + 256) + F.wave * 4 + 2; *q_ = *q_ + (pt1_ - pt0_); } } }
    SEAMW(1, MW_R1);
    if (IN(2)) { unsigned long long pt0_ = 0, pt1_ = 0; (void)pt0_; (void)pt1_; if (MK_TPROBE && 2 == MK_TPROBE_PHT) TP_NOW(pt0_); if (MK_TPROBE && 2 == MK_TPROBE_PHASE) TP_SET(F.lds, 1u); phase_2(F, in, args.out, ws, lds); if (REPS(2) > 1) { __syncthreads(); phase_2(F, in, args.out, ws, lds); }  if (MK_TPROBE && 2 == MK_TPROBE_PHT) { TP_NOW(pt1_); if (F.lane() == 0) { volatile LAS unsigned long long* q_ = (volatile LAS unsigned long long*)(F.lds + TP_LDS_OFF + 256) + F.wave * 4 + 2; *q_ = *q_ + (pt1_ - pt0_); } } }
    SEAMW(2, MW_R2);
    if (IN(3)) { unsigned long long pt0_ = 0, pt1_ = 0; (void)pt0_; (void)pt1_; if (MK_TPROBE && 3 == MK_TPROBE_PHT) TP_NOW(pt0_); if (MK_TPROBE && 3 == MK_TPROBE_PHASE) TP_SET(F.lds, 1u); phase_3(F, in, args.out, ws, lds); if (REPS(3) > 1) { __syncthreads(); phase_3(F, in, args.out, ws, lds); }  if (MK_TPROBE && 3 == MK_TPROBE_PHT) { TP_NOW(pt1_); if (F.lane() == 0) { volatile LAS unsigned long long* q_ = (volatile LAS unsigned long long*)(F.lds + TP_LDS_OFF + 256) + F.wave * 4 + 2; *q_ = *q_ + (pt1_ - pt0_); } } }
    SEAMW(3, MW_R3);
    if (IN(4)) { unsigned long long pt0_ = 0, pt1_ = 0; (void)pt0_; (void)pt1_; if (MK_TPROBE && 4 == MK_TPROBE_PHT) TP_NOW(pt0_); if (MK_TPROBE && 4 == MK_TPROBE_PHASE) TP_SET(F.lds, 1u); phase_4(F, in, args.out, ws, lds); if (REPS(4) > 1) { __syncthreads(); phase_4(F, in, args.out, ws, lds); }  if (MK_TPROBE && 4 == MK_TPROBE_PHT) { TP_NOW(pt1_); if (F.lane() == 0) { volatile LAS unsigned long long* q_ = (volatile LAS unsigned long long*)(F.lds + TP_LDS_OFF + 256) + F.wave * 4 + 2; *q_ = *q_ + (pt1_ - pt0_); } } }
    SEAMW(4, MW_R4);
    if (IN(5)) { unsigned long long pt0_ = 0, pt1_ = 0; (void)pt0_; (void)pt1_; if (MK_TPROBE && 5 == MK_TPROBE_PHT) TP_NOW(pt0_); if (MK_TPROBE && 5 == MK_TPROBE_PHASE) TP_SET(F.lds, 1u); phase_5(F, in, args.out, ws, lds); if (REPS(5) > 1) { __syncthreads(); phase_5(F, in, args.out, ws, lds); }  if (MK_TPROBE && 5 == MK_TPROBE_PHT) { TP_NOW(pt1_); if (F.lane() == 0) { volatile LAS unsigned long long* q_ = (volatile LAS unsigned long long*)(F.lds + TP_LDS_OFF + 256) + F.wave * 4 + 2; *q_ = *q_ + (pt1_ - pt0_); } } }
    if (IN(6)) { unsigned long long pt0_ = 0, pt1_ = 0; (void)pt0_; (void)pt1_; if (MK_TPROBE && 6 == MK_TPROBE_PHT) TP_NOW(pt0_); if (MK_TPROBE && 6 == MK_TPROBE_PHASE) TP_SET(F.lds, 1u); phase_6(F, in, args.out, ws, lds); if (REPS(6) > 1) { __syncthreads(); phase_6(F, in, args.out, ws, lds); }  if (MK_TPROBE && 6 == MK_TPROBE_PHT) { TP_NOW(pt1_); if (F.lane() == 0) { volatile LAS unsigned long long* q_ = (volatile LAS unsigned long long*)(F.lds + TP_LDS_OFF + 256) + F.wave * 4 + 2; *q_ = *q_ + (pt1_ - pt0_); } } }
    SEAMW(6, MW_R6);
    if (IN(7)) { unsigned long long pt0_ = 0, pt1_ = 0; (void)pt0_; (void)pt1_; if (MK_TPROBE && 7 == MK_TPROBE_PHT) TP_NOW(pt0_); if (MK_TPROBE && 7 == MK_TPROBE_PHASE) TP_SET(F.lds, 1u); phase_7(F, in, args.out, ws, lds); if (REPS(7) > 1) { __syncthreads(); phase_7(F, in, args.out, ws, lds); }  if (MK_TPROBE && 7 == MK_TPROBE_PHT) { TP_NOW(pt1_); if (F.lane() == 0) { volatile LAS unsigned long long* q_ = (volatile LAS unsigned long long*)(F.lds + TP_LDS_OFF + 256) + F.wave * 4 + 2; *q_ = *q_ + (pt1_ - pt0_); } } }
    SEAMW(7, MW_R7);
    if (IN(8)) { unsigned long long pt0_ = 0, pt1_ = 0; (void)pt0_; (void)pt1_; if (MK_TPROBE && 8 == MK_TPROBE_PHT) TP_NOW(pt0_); if (MK_TPROBE && 8 == MK_TPROBE_PHASE) TP_SET(F.lds, 1u); phase_8(F, in, args.out, ws, lds); if (REPS(8) > 1) { __syncthreads(); phase_8(F, in, args.out, ws, lds); }  if (MK_TPROBE && 8 == MK_TPROBE_PHT) { TP_NOW(pt1_); if (F.lane() == 0) { volatile LAS unsigned long long* q_ = (volatile LAS unsigned long long*)(F.lds + TP_LDS_OFF + 256) + F.wave * 4 + 2; *q_ = *q_ + (pt1_ - pt0_); } } }
    if (IN(9)) { unsigned long long pt0_ = 0, pt1_ = 0; (void)pt0_; (void)pt1_; if (MK_TPROBE && 9 == MK_TPROBE_PHT) TP_NOW(pt0_); if (MK_TPROBE && 9 == MK_TPROBE_PHASE) TP_SET(F.lds, 1u); phase_9(F, in, args.out, ws, lds); if (REPS(9) > 1) { __syncthreads(); phase_9(F, in, args.out, ws, lds); }  if (MK_TPROBE && 9 == MK_TPROBE_PHT) { TP_NOW(pt1_); if (F.lane() == 0) { volatile LAS unsigned long long* q_ = (volatile LAS unsigned long long*)(F.lds + TP_LDS_OFF + 256) + F.wave * 4 + 2; *q_ = *q_ + (pt1_ - pt0_); } } }
    SEAMW(9, MW_R9);
    if (IN(10)) { unsigned long long pt0_ = 0, pt1_ = 0; (void)pt0_; (void)pt1_; if (MK_TPROBE && 10 == MK_TPROBE_PHT) TP_NOW(pt0_); if (MK_TPROBE && 10 == MK_TPROBE_PHASE) TP_SET(F.lds, 1u); phase_10(F, in, args.out, ws, lds); if (REPS(10) > 1) { __syncthreads(); phase_10(F, in, args.out, ws, lds); }  if (MK_TPROBE && 10 == MK_TPROBE_PHT) { TP_NOW(pt1_); if (F.lane() == 0) { volatile LAS unsigned long long* q_ = (volatile LAS unsigned long long*)(F.lds + TP_LDS_OFF + 256) + F.wave * 4 + 2; *q_ = *q_ + (pt1_ - pt0_); } } }
    SEAM(10);
    if (IN(11)) { unsigned long long pt0_ = 0, pt1_ = 0; (void)pt0_; (void)pt1_; if (MK_TPROBE && 11 == MK_TPROBE_PHT) TP_NOW(pt0_); if (MK_TPROBE && 11 == MK_TPROBE_PHASE) TP_SET(F.lds, 1u); phase_11(F, in, args.out, ws, lds); if (REPS(11) > 1) { __syncthreads(); phase_11(F, in, args.out, ws, lds); }  if (MK_TPROBE && 11 == MK_TPROBE_PHT) { TP_NOW(pt1_); if (F.lane() == 0) { volatile LAS unsigned long long* q_ = (volatile LAS unsigned long long*)(F.lds + TP_LDS_OFF + 256) + F.wave * 4 + 2; *q_ = *q_ + (pt1_ - pt0_); } } }
    SEAM(11);
    if (IN(12)) { unsigned long long pt0_ = 0, pt1_ = 0; (void)pt0_; (void)pt1_; if (MK_TPROBE && 12 == MK_TPROBE_PHT) TP_NOW(pt0_); if (MK_TPROBE && 12 == MK_TPROBE_PHASE) TP_SET(F.lds, 1u); phase_12(F, in, args.out, ws, lds); if (REPS(12) > 1) { __syncthreads(); phase_12(F, in, args.out, ws, lds); }  if (MK_TPROBE && 12 == MK_TPROBE_PHT) { TP_NOW(pt1_); if (F.lane() == 0) { volatile LAS unsigned long long* q_ = (volatile LAS unsigned long long*)(F.lds + TP_LDS_OFF + 256) + F.wave * 4 + 2; *q_ = *q_ + (pt1_ - pt0_); } } }
#if MK_TPROBE
    {
        TP_NOW(tk1_);
        TP_SET(F.lds, 0u);
        if (F.lane() == 0) { volatile LAS unsigned long long* p_ = (volatile LAS unsigned long long*)(F.lds + TP_LDS_OFF + 256) + F.wave * 4;
            atomicAdd((unsigned long long*)(F.ctl + 30000), p_[0]); atomicAdd((unsigned long long*)(F.ctl + 30002), p_[1] + p_[2]); atomicAdd((unsigned long long*)(F.ctl + 30004), (unsigned long long)(tk1_ - tk0_)); }
        xcd_barrier(bar);
        const double a_ = (double)__hip_atomic_load((unsigned long long*)(F.ctl + 30000), RLX_AGENT), b_ = (double)__hip_atomic_load((unsigned long long*)(F.ctl + 30002), RLX_AGENT);
#ifdef MK_TPROBE_REL
        const float rat_ = (float)(b_ / (double)__hip_atomic_load((unsigned long long*)(F.ctl + 30004), RLX_AGENT));
#elif defined(MK_TPROBE_ABS)
        const float rat_ = (float)(b_ / (double)(MK_TPROBE_ABS));
#else
        const float rat_ = (float)(a_ / (b_ > 0.0 ? b_ : 1.0));
#endif
        const float sc_ = 1.0f + floorf(rat_ * (float)MK_TPROBE_Q + (float)MK_TPROBE_OFS) / (float)MK_TPROBE_Q;
        const size_t gt_ = ((size_t)F.vcu * NWAVES + F.wave) * 64 + F.lane(), ng_ = (size_t)F.G * NWAVES * 64;
        for (size_t i = gt_; i < (size_t)T * D / 4; i += ng_) { f32x4 v = ((f32x4*)args.out)[i]; ((f32x4*)args.out)[i] = v * sc_; }
    }
#endif
#undef IN
#undef SEAM
}
#ifndef MK_DEBUG
#define MK_DEBUG 0
#endif
#ifndef MK_PER_PHASE
#define MK_PER_PHASE MK_DEBUG
#endif
#if MK_DEBUG
struct CmpDesc { const void* test; const float* ref; size_t rhs; int ttype, tld, rld, cw, rows, cols, tfm, slot; float rscale; int pad; };
__global__ void __launch_bounds__(256) cmp_k(CmpDesc d, double* sums) {
    __shared__ double red[2][4];
    double sd = 0.0, sr = 0.0;
    const size_t n = (size_t)d.rows * d.cols;
    for (size_t idx = (size_t)blockIdx.x * 256 + threadIdx.x; idx < n; idx += (size_t)gridDim.x * 256) {
        const int r = (int)(idx / d.cols), c = (int)(idx % d.cols);
        float tv;
        if (d.ttype == 0) tv = bf2f(((const bf16*)d.test)[(size_t)r * d.tld + c]);
        else if (d.ttype == 1) tv = h2f(((const unsigned short*)d.test)[(size_t)r * d.tld + c]);
        else tv = ((const float*)d.test)[(size_t)r * d.tld + c];
        float rv = d.ref[(size_t)(c / d.cw) * d.rhs + (size_t)r * d.rld + (c % d.cw)] * d.rscale;
        if (d.tfm == 1) rv = rv / (1.0f + expf(-rv));
        if (d.tfm == 2) tv = exp2f(tv);
        const double df = (double)tv - (double)rv; sd += df * df; sr += (double)rv * (double)rv;
    }
    for (int o = 32; o; o >>= 1) { sd += __shfl_xor(sd, o); sr += __shfl_xor(sr, o); }
    if ((threadIdx.x & 63) == 0) { red[0][threadIdx.x >> 6] = sd; red[1][threadIdx.x >> 6] = sr; }
    __syncthreads();
    if (threadIdx.x == 0) { atomicAdd(&sums[2 * d.slot], red[0][0] + red[0][1] + red[0][2] + red[0][3]); atomicAdd(&sums[2 * d.slot + 1], red[1][0] + red[1][1] + red[1][2] + red[1][3]); }
}
__global__ void verdict_k(const double* sums, const float* tols, int nslot, unsigned* code) {
    if (threadIdx.x == 0 && blockIdx.x == 0) { unsigned c = 0;
        for (int k = 0; k < nslot; ++k) { const double rvr = sums[2 * k] / sums[2 * k + 1]; if (!(rvr <= (double)tols[k])) { c = (unsigned)(k + 1); break; } }
        *code = c; }
}
__global__ void poison_k(const unsigned* code, const float* x, float* out, size_t n) {
    const unsigned c = *code; if (c == 0) return;
    const float f = 1.0f + exp2f((float)c);
    for (size_t i = (size_t)blockIdx.x * blockDim.x + threadIdx.x; i < n; i += (size_t)gridDim.x * blockDim.x) out[i] = x[i] * f;
}
__global__ void settol_k(float* tols) { const float t[16] = MK_TOLS; if (threadIdx.x < 16) tols[threadIdx.x] = t[threadIdx.x]; }
#endif

extern "C" void kernel_launch(void* const* d_in, const int* in_sizes, int n_in, void* d_out, int out_size, void* d_ws, size_t ws_size, hipStream_t stream) {
    static int grid = 0;
    if (grid == 0) {
        if (n_in != 29 || out_size != T * D || ws_size < (MK_DEBUG ? WS_END + 192 * MiB : WS_END_REL)) { fprintf(stderr, "kernel_launch: unexpected shapes (n_in %d, out %d, ws %zu)\n", n_in, out_size, ws_size); grid = -1; return; }
        int dev = 0, cus = 0;
        if (hipGetDevice(&dev) != hipSuccess || hipDeviceGetAttribute(&cus, hipDeviceAttributeMultiprocessorCount, dev) != hipSuccess) { grid = -1; return; }
        if (hipFuncSetAttribute((const void*)mega_fwd, hipFuncAttributeMaxDynamicSharedMemorySize, LDS_BYTES) != hipSuccess) { fprintf(stderr, "kernel_launch: hipFuncSetAttribute failed\n"); grid = -1; return; }
        int per_cu = 0;
        if (hipOccupancyMaxActiveBlocksPerMultiprocessor(&per_cu, (const void*)mega_fwd, NWAVES * 64, LDS_BYTES) != hipSuccess || per_cu < 1) { fprintf(stderr, "kernel_launch: occupancy query says %d\n", per_cu); }
        (void)hipGetLastError();
        grid = cus;
    }
    if (grid < 0) return;
    (void)hipMemsetAsync((char*)d_ws + WS_CTL, 0, CTL_ZERO_BYTES, stream);
    Args a{};
    Inputs& w = a.in;
    w.x = (const float*)d_in[0]; w.mem = (const float*)d_in[1]; w.pos = (const int*)d_in[2]; w.norm_mix = (const float*)d_in[3]; w.w_in = (const float*)d_in[4];
    w.q_a_norm = (const float*)d_in[5]; w.w_q_up = (const float*)d_in[6]; w.kv_a_norm = (const float*)d_in[7]; w.w_kv_up = (const float*)d_in[8];
    w.q_norm = (const float*)d_in[9]; w.k_norm = (const float*)d_in[10]; w.lb_logits = (const float*)d_in[11]; w.o_norm = (const float*)d_in[12]; w.w_out = (const float*)d_in[13];
    w.norm_cross = (const float*)d_in[14]; w.norm_mem = (const float*)d_in[15]; w.x_w_q = (const float*)d_in[16]; w.x_w_kv = (const float*)d_in[17];
    w.x_q_norm = (const float*)d_in[18]; w.x_k_norm = (const float*)d_in[19]; w.x_w_o = (const float*)d_in[20]; w.norm_ffn = (const float*)d_in[21];
    w.w_group = (const float*)d_in[22]; w.b_group = (const float*)d_in[23]; w.w_expert = (const float*)d_in[24]; w.b_expert = (const float*)d_in[25];
    w.w_gate = (const float*)d_in[26]; w.w_up = (const float*)d_in[27]; w.w_down = (const float*)d_in[28];
    a.out = (float*)d_out; a.ws = (unsigned char*)d_ws;
    unsigned char* ws = (unsigned char*)d_ws;
#if MK_DEBUG
    constexpr int BC = MK_DEBUG_BATCH;
    orc::W ow; static_assert(sizeof(orc::W) == sizeof(Inputs), "same field list"); memcpy(&ow, &w, sizeof(ow));
    orc::Bufs B; B.carve2((float*)d_out, (float*)(ws + WS_END));
    double* sums = (double*)(ws + WS_CTL + CW_CHK * 4); float* tols = (float*)(sums + 64); unsigned* code = (unsigned*)(tols + 32);
    settol_k<<<1, 64, 0, stream>>>(tols);
    orc::pack_router<<<(1024 * 72 + 255) / 256, 256, 0, stream>>>(ow.w_group, ow.w_expert, B.wr);
    orc::run_batch(ow, B, BC, B.outb, stream);
    auto CMP = [&](int slot, const void* test, int ttype, int tld, const float* ref, int rld, int cw, size_t rhs, int rows, int cols, float rscale, int tfm) {
        CmpDesc d{}; d.test = test; d.ref = ref; d.rhs = rhs; d.ttype = ttype; d.tld = tld; d.rld = rld; d.cw = cw; d.rows = rows; d.cols = cols; d.tfm = tfm; d.slot = slot; d.rscale = rscale;
        cmp_k<<<512, 256, 0, stream>>>(d, sums); };
    const size_t r0 = (size_t)BC * SEQ;
#endif
    auto PH = [&](int lo, int hi) { a.ph_lo = lo; a.ph_hi = hi; hipLaunchKernelGGL(mega_fwd, dim3(grid), dim3(NWAVES * 64), LDS_BYTES, stream, a); };
#if MK_PER_PHASE
    for (int p = 0; p < N_PHASES; ++p) {
        PH(p, p + 1);
#if MK_DEBUG
        if (p == 1) {
            CMP(0, (bf16*)(ws + WS_HQ) + r0 * 512, 0, 512, B.qs, 512, 512, 0, SEQ, 512, 1.f, 0);
            CMP(1, (bf16*)(ws + WS_GF) + r0 * 512, 1, 512, B.f, 512, 512, 0, SEQ, 512, 1.f, 2);
            CMP(1, (bf16*)(ws + WS_GB) + r0 * 512, 1, 512, B.f + (size_t)SEQ * 512, 512, 512, 0, SEQ, 512, 1.f, 2);
            CMP(2, (bf16*)(ws + WS_HI) + r0 * 512, 0, 512, B.p + 1888, 2912, 512, 0, SEQ, 512, 1.f, 0);
            CMP(2, (bf16*)(ws + WS_HG) + r0 * 512, 0, 512, B.p + 2400, 2912, 512, 0, SEQ, 512, 1.f, 1);
            CMP(3, (bf16*)(ws + WS_LAT) + r0 * 512, 0, 512, B.p, 2912, 352, 0, SEQ, 352, 1.f, 0);
        }
        if (p == 2) {
            CMP(4, (bf16*)(ws + WS_Q) + r0 * 768, 0, 768, B.Qn, 96, 96, (size_t)SEQ * 96, SEQ, 768, QSCALE_MLA, 0);
            CMP(5, (bf16*)(ws + WS_K) + r0 * 768, 0, 768, B.Kn, 96, 96, (size_t)SEQ * 96, SEQ, 768, 1.f, 0);
            CMP(6, (bf16*)(ws + WS_V) + r0 * 512, 0, 512, B.V, 64, 64, (size_t)SEQ * 64, SEQ, 512, 1.f, 0);
            CMP(7, (bf16*)(ws + WS_KVX) + (size_t)BC * MEML * 2048, 0, 2048, B.kvx, 2048, 2048, 0, MEML, 2048, 1.f, 0);
            CMP(8, (bf16*)(ws + WS_OF) + r0 * 512, 0, 512, B.o, 512, 512, 0, SEQ, 512, 1.f, 0);
            CMP(8, (bf16*)(ws + WS_OB) + r0 * 512, 0, 512, B.o + (size_t)SEQ * 512, 512, 512, 0, SEQ, 512, 1.f, 0);
        }
        if (p == 3) {
            CMP(9, (bf16*)(ws + WS_CAT) + r0 * 1024 + 512, 0, 1024, B.cat + 512, 1024, 512, 0, SEQ, 512, 1.f, 0);
            CMP(10, (bf16*)(ws + WS_CAT) + r0 * 1024, 0, 1024, B.cat, 1024, 512, 0, SEQ, 512, 1.f, 0);
        }
        if (p == 4) CMP(11, (bf16*)(ws + WS_XN) + r0 * 1024, 0, 1024, B.x1, 1024, 1024, 0, SEQ, 1024, 1.f, 0);
        if (0) CMP(12, (bf16*)(ws + WS_QX) + r0 * 1024, 0, 1024, B.qx, 1024, 1024, 0, SEQ, 1024, 0.0625f * LOG2E, 0);
        if (p == 5) CMP(13, (bf16*)(ws + WS_QX) + r0 * 1024, 0, 1024, B.ox, 1024, 1024, 0, SEQ, 1024, 1.f, 0);
        if (p == 7) CMP(14, (bf16*)(ws + WS_XN) + r0 * 1024, 0, 1024, B.x2, 1024, 1024, 0, SEQ, 1024, 1.f, 0);
        if (p == 12) CMP(15, (float*)d_out + r0 * 1024, 2, 1024, B.outb, 1024, 1024, 0, SEQ, 1024, 1.f, 0);
#endif
    }
#if MK_DEBUG
    verdict_k<<<1, 64, 0, stream>>>(sums, tols, 16, code);
    poison_k<<<1024, 256, 0, stream>>>(code, w.x, (float*)d_out, (size_t)T * D);
#endif
#else
    PH(0, N_PHASES);
#endif
}
```
